# Optimizing an MI355X kernel written in HIP

```python
import math
import jax, jax.numpy as jnp
from jax import lax
import numpy as np


D_MODEL = 1024
BATCH = 8
SEQ = 4096
DEPTH = 1
DEC_BATCH = 2
DEC_SEQ = 8192
PAST_LEN = 128

HEAD_DIM = 64
N_ATTN_HEADS = 8
ATTN_WIDTH = N_ATTN_HEADS * HEAD_DIM
ROT_DIM = HEAD_DIM // 4
ROPE_THETA = 500000.0
DILATED_PATTERNS = ((128, 1), (512, 4), (2048, 16))
N_SSM_HEADS = 8
SSM_HEAD_DIM = 64
SSM_WIDTH = N_SSM_HEADS * SSM_HEAD_DIM
SSM_GROUPS = 2
D_STATE = 128
CONV_K = 5
CHUNK = 128
CONV_CH = SSM_WIDTH + 2 * SSM_GROUPS * D_STATE
MIX_WIDTH = ATTN_WIDTH + SSM_WIDTH
IN_SIZES = (ATTN_WIDTH, ATTN_WIDTH, ATTN_WIDTH, SSM_WIDTH, SSM_WIDTH,
            SSM_GROUPS * D_STATE, SSM_GROUPS * D_STATE, N_SSM_HEADS, N_SSM_HEADS)
IN_WIDTH = 3 * ATTN_WIDTH + 2 * SSM_WIDTH + 2 * SSM_GROUPS * D_STATE + 2 * N_SSM_HEADS
N_EXPERTS = 16
CAPACITY_FACTOR = 2
D_FF_EXPERT = 2816
ALPHA = (2.0 * DEPTH) ** 0.25
BETA = (8.0 * DEPTH) ** -0.25
LN_EPS = 1e-5
RMS_EPS = 1e-5

kernel_name = 'hybrid_dilated_attn_ssd_ec_moe_encoder'


def layer_norm(x, g, b):
    xf = x.astype(jnp.float32)
    mu = jnp.mean(xf, axis=-1, keepdims=True)
    var = jnp.mean(jnp.square(xf - mu), axis=-1, keepdims=True)
    return ((xf - mu) * lax.rsqrt(var + LN_EPS) * g.astype(jnp.float32) + b.astype(jnp.float32)).astype(x.dtype)


def partial_rotary(t, pos):
    half = ROT_DIM // 2
    inv = ROPE_THETA ** (-jnp.arange(half, dtype=jnp.float32) * 2.0 / ROT_DIM)
    ang = pos.astype(jnp.float32)[:, None] * inv[None, :]
    cos = jnp.cos(ang)[None, :, None, :].astype(t.dtype)
    sin = jnp.sin(ang)[None, :, None, :].astype(t.dtype)
    t1 = t[..., :half]
    t2 = t[..., half:ROT_DIM]
    return jnp.concatenate([t1 * cos - t2 * sin, t2 * cos + t1 * sin, t[..., ROT_DIM:]], axis=-1)


def dilated_window_attention(q, k, v, window, dil):
    b, s, h, e = q.shape
    half = window // (2 * dil)
    L = s // dil
    nb = -(-L // half)
    Lp = nb * half

    def to_sub(t):
        t = t.reshape(b, L, dil, h, e).transpose(0, 2, 1, 3, 4)
        t = jnp.pad(t, ((0, 0), (0, 0), (0, Lp - L), (0, 0), (0, 0)))
        return t.reshape(b, dil, nb, half, h, e)

    def band(t):
        tp = jnp.pad(t, ((0, 0), (0, 0), (1, 1), (0, 0), (0, 0), (0, 0)))
        return jnp.concatenate([tp[:, :, :-2], tp[:, :, 1:-1], tp[:, :, 2:]], axis=3)

    qs = to_sub(q)
    kb = band(to_sub(k))
    vb = band(to_sub(v))
    qpos = jnp.arange(nb)[:, None] * half + jnp.arange(half)[None, :]
    kpos = (jnp.arange(nb)[:, None] - 1) * half + jnp.arange(3 * half)[None, :]
    mask = ((jnp.abs(qpos[:, :, None] - kpos[:, None, :]) <= half)
            & (kpos[:, None, :] >= 0) & (kpos[:, None, :] < L))
    scores = jnp.einsum('bdnqhe,bdnkhe->bdnhqk', qs, kb,
                        preferred_element_type=jnp.float32) * (e ** -0.5)
    scores = jnp.where(mask[None, None, :, None], scores, -jnp.inf)
    lse = jax.nn.logsumexp(scores, axis=-1)
    p = jnp.exp(scores - lse[..., None])
    o = jnp.einsum('bdnhqk,bdnkhe->bdnqhe', p, vb.astype(jnp.float32))
    o = o.reshape(b, dil, Lp, h, e)[:, :, :L].transpose(0, 2, 1, 3, 4).reshape(b, s, h, e)
    lse = lse.transpose(0, 1, 2, 4, 3).reshape(b, dil, Lp, h)[:, :, :L]
    lse = lse.transpose(0, 2, 1, 3).reshape(b, s, h)
    return o, lse


def centred_dwconv(u, w, bias):
    out = lax.conv_general_dilated(u, w[:, None, :].astype(u.dtype), window_strides=(1,),
                                   padding=[(CONV_K // 2, CONV_K // 2)],
                                   dimension_numbers=('NWC', 'WIO', 'NWC'),
                                   feature_group_count=u.shape[-1])
    return out + bias.astype(u.dtype)


def ssd_scan(x, dt, A, Bm, Cm):
    b, s, h, p = x.shape
    g = Bm.shape[2]
    r = h // g
    n = Bm.shape[3]
    nc = s // CHUNK
    xc = x.astype(jnp.float32).reshape(b, nc, CHUNK, g, r, p)
    dtc = dt.reshape(b, nc, CHUNK, g, r)
    Bc = Bm.astype(jnp.float32).reshape(b, nc, CHUNK, g, n)
    Cc = Cm.astype(jnp.float32).reshape(b, nc, CHUNK, g, n)
    a_cs = jnp.cumsum(dtc * A.reshape(g, r), axis=2)
    xdt = xc * dtc[..., None]
    diff = a_cs[:, :, :, None] - a_cs[:, :, None, :]
    tri = jnp.tril(jnp.ones((CHUNK, CHUNK), dtype=bool))[:, :, None, None]
    Lm = jnp.exp(jnp.where(tri, diff, -jnp.inf))
    cb = jnp.einsum('bclgn,bcsgn->bclsg', Cc, Bc)
    y_diag = jnp.einsum('bclsgr,bcsgrp->bclgrp', cb[..., None] * Lm, xdt)
    decay_to_end = jnp.exp(a_cs[:, :, -1:] - a_cs)
    states = jnp.einsum('bclgn,bclgr,bclgrp->bcgrpn', Bc, decay_to_end, xdt)
    chunk_decay = jnp.exp(a_cs[:, :, -1])

    def step(prev, inp):
        st, dec = inp
        return prev * dec[..., None, None] + st, prev

    init = jnp.zeros((b, g, r, p, n), jnp.float32)
    _, prev_states = lax.scan(step, init, (states.swapaxes(0, 1), chunk_decay.swapaxes(0, 1)))
    prev_states = prev_states.swapaxes(0, 1)
    y_off = jnp.einsum('bclgn,bcgrpn,bclgr->bclgrp', Cc, prev_states, jnp.exp(a_cs))
    return (y_diag + y_off).reshape(b, s, h, p)


def hybrid_mixer(x, w_in, conv_w, conv_b, dt_bias, a_log, d_skip, ssm_norm_w, w_out):
    b, s, _ = x.shape
    proj = x @ w_in
    cuts = []
    acc = 0
    for sz in IN_SIZES[:-1]:
        acc += sz
        cuts.append(acc)
    q, k, v, z, xs, Bs, Cs, dtf, dtb = jnp.split(proj, cuts, axis=-1)

    pos = jnp.arange(s)
    q = partial_rotary(q.reshape(b, s, N_ATTN_HEADS, HEAD_DIM), pos)
    k = partial_rotary(k.reshape(b, s, N_ATTN_HEADS, HEAD_DIM), pos)
    v = v.reshape(b, s, N_ATTN_HEADS, HEAD_DIM)
    outs = []
    lses = []
    for window, dil in DILATED_PATTERNS:
        o_i, l_i = dilated_window_attention(q, k, v, window, dil)
        outs.append(o_i)
        lses.append(l_i)
    wts = jax.nn.softmax(jnp.stack(lses, axis=0), axis=0)
    attn = jnp.sum(wts[..., None] * jnp.stack(outs, axis=0), axis=0)
    attn = attn.reshape(b, s, ATTN_WIDTH).astype(x.dtype)

    xBC = jax.nn.silu(centred_dwconv(jnp.concatenate([xs, Bs, Cs], axis=-1), conv_w, conv_b))
    xs, Bs, Cs = jnp.split(xBC, [SSM_WIDTH, SSM_WIDTH + SSM_GROUPS * D_STATE], axis=-1)
    xh = xs.reshape(b, s, N_SSM_HEADS, SSM_HEAD_DIM)
    Bg = Bs.reshape(b, s, SSM_GROUPS, D_STATE)
    Cg = Cs.reshape(b, s, SSM_GROUPS, D_STATE)
    dtb32 = dt_bias.astype(jnp.float32)
    dt_f = jax.nn.softplus(dtf.astype(jnp.float32) + dtb32[0])
    dt_b = jax.nn.softplus(dtb.astype(jnp.float32) + dtb32[1])
    A = -jnp.exp(a_log.astype(jnp.float32))
    rev = lambda t: jnp.flip(t, axis=1)
    y_f = ssd_scan(xh, dt_f, A[0], Bg, Cg)
    y_b = rev(ssd_scan(rev(xh), rev(dt_b), A[1], rev(Bg), rev(Cg)))
    y = y_f + y_b + d_skip.astype(jnp.float32)[:, None] * xh.astype(jnp.float32)
    y = y.reshape(b, s, SSM_WIDTH) * jax.nn.silu(z.astype(jnp.float32))
    y = y * lax.rsqrt(jnp.mean(jnp.square(y), axis=-1, keepdims=True) + RMS_EPS) * ssm_norm_w.astype(jnp.float32)

    return jnp.concatenate([attn, y.astype(x.dtype)], axis=-1) @ w_out


def expert_choice_ffn(x, w_router, w_gate, w_up, w_down):
    b, s, d = x.shape
    T = b * s
    cap = CAPACITY_FACTOR * T // N_EXPERTS
    h = x.reshape(T, d)
    aff = jax.nn.softmax((h @ w_router).astype(jnp.float32), axis=-1)
    gate_vals, tok_idx = lax.top_k(aff.T, cap)
    xg = h[tok_idx]
    hid = jax.nn.silu(jnp.einsum('ecd,edf->ecf', xg, w_gate)) * jnp.einsum('ecd,edf->ecf', xg, w_up)
    out = jnp.einsum('ecf,efd->ecd', hid, w_down) * gate_vals[..., None].astype(x.dtype)
    y = jnp.zeros_like(h).at[tok_idx.reshape(-1)].add(out.reshape(-1, d))
    return y.reshape(b, s, d)


def setup_inputs(seed: int = 0) -> dict:
    key = jax.random.key(seed)
    ks = jax.random.split(key, 20)
    f32 = jnp.float32
    x_prompt = jax.random.normal(ks[0], (BATCH, SEQ, D_MODEL), f32)
    x_sample = jax.random.normal(ks[1], (DEC_BATCH, DEC_SEQ, D_MODEL), f32)
    w_in = jax.random.normal(ks[2], (DEPTH, D_MODEL, IN_WIDTH), f32) * D_MODEL ** -0.5
    conv_w = jax.random.normal(ks[3], (DEPTH, CONV_K, CONV_CH), f32) * CONV_K ** -0.5
    conv_b = 0.02 * jax.random.normal(ks[4], (DEPTH, CONV_CH), f32)
    u = jax.random.uniform(ks[5], (DEPTH, 2, N_SSM_HEADS), f32)
    dt0 = jnp.exp(u * (math.log(0.1) - math.log(1e-3)) + math.log(1e-3))
    dt_bias = dt0 + jnp.log(-jnp.expm1(-dt0))
    a_log = jnp.log(jax.random.uniform(ks[6], (DEPTH, 2, N_SSM_HEADS), f32, minval=1.0, maxval=16.0))
    d_skip = 1.0 + 0.1 * jax.random.normal(ks[7], (DEPTH, N_SSM_HEADS), f32)
    ssm_norm_w = 1.0 + 0.1 * jax.random.normal(ks[8], (DEPTH, SSM_WIDTH), f32)
    w_out = jax.random.normal(ks[9], (DEPTH, MIX_WIDTH, D_MODEL), f32) * (MIX_WIDTH ** -0.5) * BETA
    ln1_g = 1.0 + 0.1 * jax.random.normal(ks[10], (DEPTH, D_MODEL), f32)
    ln1_b = 0.02 * jax.random.normal(ks[11], (DEPTH, D_MODEL), f32)
    w_router = jax.random.normal(ks[12], (DEPTH, D_MODEL, N_EXPERTS), f32) * D_MODEL ** -0.5
    w_gate = jax.random.normal(ks[13], (DEPTH, N_EXPERTS, D_MODEL, D_FF_EXPERT), f32) * D_MODEL ** -0.5
    w_up = jax.random.normal(ks[14], (DEPTH, N_EXPERTS, D_MODEL, D_FF_EXPERT), f32) * D_MODEL ** -0.5
    w_down = jax.random.normal(ks[15], (DEPTH, N_EXPERTS, D_FF_EXPERT, D_MODEL), f32) * (D_FF_EXPERT ** -0.5) * BETA
    ln2_g = 1.0 + 0.1 * jax.random.normal(ks[16], (DEPTH, D_MODEL), f32)
    ln2_b = 0.02 * jax.random.normal(ks[17], (DEPTH, D_MODEL), f32)
    return {'x_prompt': x_prompt, 'x_sample': x_sample, 'w_in': w_in, 'conv_w': conv_w,
            'conv_b': conv_b, 'dt_bias': dt_bias, 'a_log': a_log, 'd_skip': d_skip,
            'ssm_norm_w': ssm_norm_w, 'w_out': w_out, 'ln1_g': ln1_g, 'ln1_b': ln1_b,
            'w_router': w_router, 'w_gate': w_gate, 'w_up': w_up, 'w_down': w_down,
            'ln2_g': ln2_g, 'ln2_b': ln2_b}


def reference(x_prompt, x_sample, w_in, conv_w, conv_b, dt_bias, a_log, d_skip, ssm_norm_w,
              w_out, ln1_g, ln1_b, w_router, w_gate, w_up, w_down, ln2_g, ln2_b):
    def trunk(x):
        for l in range(DEPTH):
            mix = hybrid_mixer(x, w_in[l], conv_w[l], conv_b[l], dt_bias[l], a_log[l],
                               d_skip[l], ssm_norm_w[l], w_out[l])
            x = layer_norm(ALPHA * x + mix, ln1_g[l], ln1_b[l])
            ffn = expert_choice_ffn(x, w_router[l], w_gate[l], w_up[l], w_down[l])
            x = layer_norm(ALPHA * x + ffn, ln2_g[l], ln2_b[l])
        return x

    y_prompt = trunk(x_prompt)
    y_sample = trunk(x_sample)
    return (y_prompt, y_sample)
```

```cpp
#include <hip/hip_runtime.h>
#include <hip/hip_cooperative_groups.h>
#include <cstdio>
#include <cstdint>
namespace cg = cooperative_groups;

#define DI __device__ __forceinline__
#define LAS __attribute__((address_space(3)))
typedef unsigned short bf16_t;
typedef short bf16x8 __attribute__((ext_vector_type(8)));
typedef short s16x4 __attribute__((ext_vector_type(4)));
typedef float f32x4 __attribute__((ext_vector_type(4)));
typedef unsigned u32x4 __attribute__((ext_vector_type(4)));
typedef unsigned u32x2 __attribute__((ext_vector_type(2)));

constexpr int TT = 49152;
constexpr int TP = 32768;
constexpr int DM = 1024;
constexpr int INW = 3088;
constexpr int FF = 2816;
constexpr int NE = 16;
constexpr int SLOTS_E = 6144;
constexpr float ALPHA = 1.189207115002721f;
constexpr float LN_EPS = 1e-5f, RMS_EPS = 1e-5f;

constexpr size_t MiB = 1u << 20;
constexpr size_t TILE_ELEMS = (size_t)TT * 256;
constexpr size_t TILE_BYTES = TILE_ELEMS * 2;
constexpr size_t WS_WI = 0;
constexpr size_t WS_WO = 6 * MiB;
constexpr size_t WS_DT = 8 * MiB;
constexpr size_t WS_ROPE = 11 * MiB;
constexpr size_t WS_AFF = 12 * MiB;
constexpr size_t WS_IDX = 15 * MiB;
constexpr size_t WS_GATE = 15 * MiB + 512 * 1024;
constexpr size_t WS_P = 20 * MiB;
constexpr size_t WS_XC = 308 * MiB;
constexpr size_t WS_XB = 404 * MiB;
constexpr size_t WS_MIX = WS_XB;
constexpr size_t WS_YF = WS_P + 8 * TILE_BYTES;
constexpr size_t WS_YB = WS_P + 10 * TILE_BYTES;
constexpr size_t WS_WGU = 20 * MiB;
constexpr size_t WS_WD = 196 * MiB;
constexpr size_t WS_X1B = 308 * MiB;
constexpr size_t WS_HID = 404 * MiB;
constexpr size_t WS_END = 668 * MiB;

constexpr int LDS_BYTES = 147456;
constexpr int NTHR = 512;

DI unsigned f2bf(float f) { unsigned u = __float_as_uint(f); return (u + 0x7fffu + ((u >> 16) & 1u)) >> 16; }
DI unsigned pk2(float lo, float hi) { return f2bf(lo) | (f2bf(hi) << 16); }
DI float bflo(unsigned u) { return __uint_as_float(u << 16); }
DI float bfhi(unsigned u) { return __uint_as_float(u & 0xffff0000u); }
DI float wave_sum(float v) {
#pragma unroll
    for (int o = 1; o < 64; o <<= 1) v += __shfl_xor(v, o);
    return v;
}
DI float silu_f(float x) { return x / (1.0f + __expf(-x)); }
#define LDS_WAIT() asm volatile("s_waitcnt lgkmcnt(0)" ::: "memory")

struct Params { const float* in[18]; float* out; unsigned char* ws; };

DI const float* xrow_ptr(const Params& p, int t) { return t < TP ? p.in[0] + (size_t)t * DM : p.in[1] + (size_t)(t - TP) * DM; }

namespace pg8 {
constexpr int BM = 256, BK = 64, HALF = 128, HTB = HALF * BK * 2, NXCD = 8, WGM = 8;
DI int lds_byte(int r, int c) { const int st = (r >> 4) * 2 + (c >> 5), rr = r & 15, cc = c & 31, ob = rr * 64 + cc * 2; return st * 1024 + (ob ^ (((ob >> 9) & 1) << 5)); }
DI void stage_rc(int b, int& R, int& C) { const int st = b / 1024, sb = b % 1024, swz = sb ^ (((sb >> 9) & 1) << 5); R = (st >> 1) * 16 + swz / 64; C = (st & 1) * 32 + (swz % 64) / 2; }
DI int perm32(int rho) { const int n = rho >> 4, i = rho & 15; return 8 * (i >> 2) + 4 * n + (i & 3); }

struct Unit { int pm, pn, bt; };

DI int xcd_remap(int L, int nwg) { const int q = nwg / NXCD, r = nwg % NXCD, xcd = L % NXCD, off = L / NXCD; return (xcd < r ? xcd * (q + 1) : r * (q + 1) + (xcd - r) * q) + off; }

struct SchedPlain {
    int nM, nN, nwg, G, c;
    DI void init(int M, int N, int G_, int c_) { nM = M / BM; nN = N / BM; nwg = nM * nN; G = G_; c = c_; }
    DI bool next(int i, Unit& u) const {
        const int L = i * G + c; if (L >= nwg) return false;
        const int wgid = xcd_remap(L, nwg);
        const int nig = WGM * nN, gid = wgid / nig, fm = gid * WGM, gsz = (nM - fm) < WGM ? (nM - fm) : WGM;
        u.pm = fm + ((wgid % nig) % gsz); u.pn = (wgid % nig) / gsz; u.bt = u.pn; return true;
    }
    DI int arow(const Unit& u, int r) const { return u.pm * BM + r; }
};
template <int NPN, bool GATHER> struct SchedGrouped {
    int G, c; const int* idx;
    DI bool next(int i, Unit& u) const {
        constexpr int PER_E = 24 * NPN, NWG = 8 * PER_E;
        const int L = i * G + c; if (L >= NWG) return false;
        const int wgid = xcd_remap(L, NWG);
        const int e = wgid / PER_E, rem = wgid % PER_E;
        const int gid = rem / (8 * NPN), w2 = rem % (8 * NPN);
        u.pm = e * 24 + gid * 8 + (w2 % 8); u.pn = w2 / 8; u.bt = e * NPN + u.pn; return true;
    }
    DI int arow(const Unit& u, int r) const { if (GATHER) return idx[u.pm * BM + r]; else return u.pm * BM + r; }
};

template <class Epi, class Sched>
DI void gemm_phase(LAS unsigned char* lds, const bf16_t* Ag, const bf16_t* Btg, const int K, const Sched& S, const Epi& E) {
    int tid_ = threadIdx.x; asm volatile("" : "+v"(tid_));
    const int tid = tid_, wid = __builtin_amdgcn_readfirstlane(tid >> 6), lane = tid & 63, wr = wid >> 2, wc = wid & 3, fr = lane & 15, fq = lane >> 4;
    const int nt = K / BK;
    int Rr[2], Cc[2]; unsigned voffB[2];
#pragma unroll
    for (int i = 0; i < 2; ++i) { int R, C; stage_rc(tid * 16 + i * 8192, R, C); const int Rb = Epi::PERM ? ((R & ~31) + perm32(R & 31)) : R;
        Rr[i] = R; Cc[i] = C; voffB[i] = (unsigned)(Rb * K + C) * 2u; }
    const unsigned rowbytes = (unsigned)K * 2u;
    const size_t kstep = (size_t)(BK * 2);
    const size_t hstep = (size_t)HALF * K * 2;
    const size_t tstep = 2 * hstep;
    const unsigned ldsw = (unsigned)wid * 1024u;
    const int aoff = lds_byte(wr * 64 + fr, fq * 8), boff = lds_byte(wc * 32 + fr, fq * 8);
#define PG8_SA(b, h) (((b) * 2 + (h)) * HTB)
#define PG8_SB(b, h) ((4 + (b) * 2 + (h)) * HTB)
#define PG8_STAGE(bufoff, gbase, voff) do { _Pragma("unroll") for (int _i = 0; _i < 2; ++_i) \
        __builtin_amdgcn_global_load_lds((const unsigned*)((const char*)(gbase) + (voff)[_i]), (LAS unsigned*)(lds + (bufoff) + ldsw + _i * 8192), 16, 0, 0); } while (0)
#define PG8_STAGEA(bufoff, o0, o1, kb) do { \
        __builtin_amdgcn_global_load_lds((const unsigned*)((const char*)Ag + (size_t)(o0) + (size_t)(kb)), (LAS unsigned*)(lds + (bufoff) + ldsw), 16, 0, 0); \
        __builtin_amdgcn_global_load_lds((const unsigned*)((const char*)Ag + (size_t)(o1) + (size_t)(kb)), (LAS unsigned*)(lds + (bufoff) + ldsw + 8192), 16, 0, 0); } while (0)
#define PG8_LDA(dst, b, h) do { _Pragma("unroll") for (int m = 0; m < 4; ++m) _Pragma("unroll") for (int k = 0; k < 2; ++k) dst[m][k] = *(const LAS bf16x8*)(lds + PG8_SA(b, h) + aoff + m * 2048 + k * 1024); } while (0)
#define PG8_LDB(dst, b, h) do { _Pragma("unroll") for (int n = 0; n < 2; ++n) _Pragma("unroll") for (int k = 0; k < 2; ++k) dst[n][k] = *(const LAS bf16x8*)(lds + PG8_SB(b, h) + boff + n * 2048 + k * 1024); } while (0)
#define PG8_MMA(ai, bj, At, Bt) do { __builtin_amdgcn_s_setprio(1); _Pragma("unroll") for (int m = 0; m < 4; ++m) _Pragma("unroll") for (int n = 0; n < 2; ++n) _Pragma("unroll") for (int k = 0; k < 2; ++k) \
        acc[ai][bj][m][n] = __builtin_amdgcn_mfma_f32_16x16x32_bf16(Bt[n][k], At[m][k], acc[ai][bj][m][n], 0, 0, 0); __builtin_amdgcn_s_setprio(0); } while (0)
#define PG8_WAIT_V(n) asm volatile("s_waitcnt vmcnt(" #n ")" ::: "memory")
#define PG8_WAIT_L(n) asm volatile("s_waitcnt lgkmcnt(" #n ")" ::: "memory")
#define PG8_BAR __builtin_amdgcn_s_barrier()
#define PG8_SCHED __builtin_amdgcn_sched_barrier(0)
#define PG8_OFFS(u, o00, o01, o10, o11) do { \
        o00 = (unsigned)S.arow(u, Rr[0]) * rowbytes + (unsigned)Cc[0] * 2u; o01 = (unsigned)S.arow(u, Rr[1]) * rowbytes + (unsigned)Cc[1] * 2u; \
        o10 = (unsigned)S.arow(u, HALF + Rr[0]) * rowbytes + (unsigned)Cc[0] * 2u; o11 = (unsigned)S.arow(u, HALF + Rr[1]) * rowbytes + (unsigned)Cc[1] * 2u; } while (0)
    Unit cur, nxt; int ui = 0;
    if (!S.next(0, cur)) return;
    f32x4 acc[2][2][4][2];
#pragma unroll
    for (int a = 0; a < 2; ++a)
#pragma unroll
        for (int b = 0; b < 2; ++b)
#pragma unroll
            for (int m = 0; m < 4; ++m)
#pragma unroll
                for (int n = 0; n < 2; ++n) acc[a][b][m][n] = (f32x4){0.f, 0.f, 0.f, 0.f};
    bf16x8 At[4][2], B0[2][2], B1[2][2];
    unsigned c00, c01, c10, c11;
    PG8_OFFS(cur, c00, c01, c10, c11);
    const char* cB = (const char*)Btg + (size_t)cur.bt * tstep;
    PG8_STAGE(PG8_SB(0, 0), cB, voffB); PG8_STAGE(PG8_SB(0, 1), cB + hstep, voffB); PG8_STAGEA(PG8_SA(0, 0), c00, c01, 0); PG8_STAGEA(PG8_SA(0, 1), c10, c11, 0);
    if (wr == 1) PG8_BAR;
    PG8_WAIT_V(2); PG8_BAR;
    PG8_STAGE(PG8_SB(1, 0), cB + kstep, voffB); PG8_STAGEA(PG8_SA(1, 0), c00, c01, kstep); PG8_STAGE(PG8_SB(1, 1), cB + hstep + kstep, voffB);
    PG8_WAIT_V(6); PG8_BAR;
    for (;;) {
        const bool has_next = S.next(ui + 1, nxt);
        const char* nB = has_next ? (const char*)Btg + (size_t)nxt.bt * tstep : cB;
        for (int t = 0; t < nt; t += 2) {
            const bool last = (t == nt - 2);
            const size_t kb1 = (size_t)(t + 1) * kstep;
            const size_t kb2 = last ? 0 : (size_t)(t + 2) * kstep, kb3 = kb2 + kstep;
            const char* b2 = last ? nB : cB + (size_t)(t + 2) * kstep; const char* b3 = b2 + kstep;
            PG8_LDB(B0, 0, 0); PG8_LDB(B1, 0, 1); PG8_SCHED; PG8_LDA(At, 0, 0); PG8_STAGEA(PG8_SA(1, 1), c10, c11, kb1);
            PG8_WAIT_V(8); PG8_WAIT_L(0); PG8_BAR; PG8_MMA(0, 0, At, B0); PG8_MMA(0, 1, At, B1); PG8_BAR; PG8_SCHED;
            if (last && has_next) { PG8_OFFS(nxt, c00, c01, c10, c11); }
            PG8_LDA(At, 0, 1); PG8_STAGE(PG8_SB(0, 0), b2, voffB); PG8_STAGE(PG8_SB(0, 1), b2 + hstep, voffB); PG8_STAGEA(PG8_SA(0, 0), c00, c01, kb2);
            PG8_WAIT_V(8); PG8_WAIT_L(0); PG8_BAR; PG8_MMA(1, 0, At, B0); PG8_MMA(1, 1, At, B1); PG8_BAR; PG8_SCHED;
            PG8_LDB(B0, 1, 0); PG8_LDB(B1, 1, 1); PG8_SCHED; PG8_LDA(At, 1, 0); PG8_STAGEA(PG8_SA(0, 1), c10, c11, kb2);
            PG8_WAIT_V(8); PG8_WAIT_L(0); PG8_BAR; PG8_MMA(0, 0, At, B0); PG8_MMA(0, 1, At, B1); PG8_BAR; PG8_SCHED;
            PG8_LDA(At, 1, 1); PG8_STAGE(PG8_SB(1, 0), b3, voffB); PG8_STAGE(PG8_SB(1, 1), b3 + hstep, voffB); PG8_STAGEA(PG8_SA(1, 0), c00, c01, kb3);
            PG8_WAIT_V(8); PG8_WAIT_L(0); PG8_BAR; PG8_MMA(1, 0, At, B0); PG8_MMA(1, 1, At, B1); PG8_BAR; PG8_SCHED;
        }
        if (wr == 0) PG8_BAR;
        E(acc, cur, wr, wc, fr, fq);
        if (!has_next) break;
#pragma unroll
        for (int a = 0; a < 2; ++a)
#pragma unroll
            for (int b = 0; b < 2; ++b)
#pragma unroll
                for (int m = 0; m < 4; ++m)
#pragma unroll
                    for (int n = 0; n < 2; ++n) acc[a][b][m][n] = (f32x4){0.f, 0.f, 0.f, 0.f};
        cur = nxt; cB = nB; ++ui;
        if (wr == 1) PG8_BAR;
    }
    PG8_WAIT_V(0);
    PG8_BAR;
#undef PG8_SA
#undef PG8_SB
#undef PG8_STAGE
#undef PG8_STAGEA
#undef PG8_LDA
#undef PG8_LDB
#undef PG8_MMA
#undef PG8_WAIT_V
#undef PG8_WAIT_L
#undef PG8_BAR
#undef PG8_SCHED
#undef PG8_OFFS
}

struct EpiProj {
    static constexpr bool PERM = true;
    bf16_t* P; const float* rope;
    DI void operator()(const f32x4 (&acc)[2][2][4][2], const Unit& u, int wr, int wc, int fr, int fq) const {
        bf16_t* base = P + (size_t)u.pn * TILE_ELEMS;
        const bool rot = (u.pn < 4) && ((wc & 1) == 0);
#pragma unroll
        for (int ai = 0; ai < 2; ++ai)
#pragma unroll
            for (int m = 0; m < 4; ++m) {
                const int row = u.pm * BM + ai * HALF + wr * 64 + m * 16 + fr;
                asm volatile("" ::: "memory");
                f32x4 cs0 = {1.f, 1.f, 1.f, 1.f}, cs1 = cs0, sn0 = {0.f, 0.f, 0.f, 0.f}, sn1 = sn0;
                if (rot && fq < 2) {
                    const int s = row < TP ? (row & 4095) : (row & 8191);
                    const f32x4* rp = (const f32x4*)(rope + (size_t)s * 16);
                    cs0 = rp[0]; cs1 = rp[1]; sn0 = rp[2]; sn1 = rp[3];
                    if (fq == 0) { sn0 = -sn0; sn1 = -sn1; }
                }
#pragma unroll
                for (int bj = 0; bj < 2; ++bj) {
                    f32x4 v0 = acc[ai][bj][m][0], v1 = acc[ai][bj][m][1];
                    if (rot) {
                        f32x4 o0, o1;
#pragma unroll
                        for (int j = 0; j < 4; ++j) { o0[j] = __shfl_xor(v0[j], 16); o1[j] = __shfl_xor(v1[j], 16); }
                        if (fq < 2) { v0 = v0 * cs0 + o0 * sn0; v1 = v1 * cs1 + o1 * sn1; }
                    }
                    u32x4 w; w.x = pk2(v0[0], v0[1]); w.y = pk2(v0[2], v0[3]); w.z = pk2(v1[0], v1[1]); w.w = pk2(v1[2], v1[3]);
                    *(u32x4*)(base + (size_t)row * 256 + bj * HALF + wc * 32 + 8 * fq) = w;
                }
            }
    }
};
struct EpiOut {
    static constexpr bool PERM = false;
    Params p;
    DI void operator()(const f32x4 (&acc)[2][2][4][2], const Unit& u, int wr, int wc, int fr, int fq) const {
#pragma unroll
        for (int ai = 0; ai < 2; ++ai)
#pragma unroll
            for (int m = 0; m < 4; ++m) {
                const int row = u.pm * BM + ai * HALF + wr * 64 + m * 16 + fr;
                const float* xr = xrow_ptr(p, row); float* orow = p.out + (size_t)row * DM;
#pragma unroll
                for (int bj = 0; bj < 2; ++bj)
#pragma unroll
                    for (int n = 0; n < 2; ++n) {
                        const int col = u.pn * BM + bj * HALF + wc * 32 + 16 * n + 4 * fq;
                        const f32x4 xv = *(const f32x4*)(xr + col);
                        *(f32x4*)(orow + col) = xv * ALPHA + acc[ai][bj][m][n];
                    }
            }
    }
};
struct EpiGU {
    static constexpr bool PERM = true;
    bf16_t* H;
    DI void operator()(const f32x4 (&acc)[2][2][4][2], const Unit& u, int wr, int wc, int fr, int fq) const {
#pragma unroll
        for (int ai = 0; ai < 2; ++ai)
#pragma unroll
            for (int m = 0; m < 4; ++m) {
                const int row = u.pm * BM + ai * HALF + wr * 64 + m * 16 + fr;
                const f32x4 g0 = acc[ai][0][m][0], g1 = acc[ai][0][m][1], u0 = acc[ai][1][m][0], u1 = acc[ai][1][m][1];
                f32x4 h0, h1;
#pragma unroll
                for (int j = 0; j < 4; ++j) { h0[j] = silu_f(g0[j]) * u0[j]; h1[j] = silu_f(g1[j]) * u1[j]; }
                u32x4 w; w.x = pk2(h0[0], h0[1]); w.y = pk2(h0[2], h0[3]); w.z = pk2(h1[0], h1[1]); w.w = pk2(h1[2], h1[3]);
                *(u32x4*)(H + (size_t)row * FF + u.pn * 128 + wc * 32 + 8 * fq) = w;
            }
    }
};
struct EpiDown {
    static constexpr bool PERM = false;
    float* out; const int* idx; const float* gate;
    DI void operator()(const f32x4 (&acc)[2][2][4][2], const Unit& u, int wr, int wc, int fr, int fq) const {
#pragma unroll
        for (int ai = 0; ai < 2; ++ai)
#pragma unroll
            for (int m = 0; m < 4; ++m) {
                const int slot = u.pm * BM + ai * HALF + wr * 64 + m * 16 + fr;
                const int tok = idx[slot]; const float gv = gate[slot];
                float* orow = out + (size_t)tok * DM;
#pragma unroll
                for (int bj = 0; bj < 2; ++bj)
#pragma unroll
                    for (int n = 0; n < 2; ++n) {
                        const int col = u.pn * BM + bj * HALF + wc * 32 + 16 * n + 4 * fq;
#pragma unroll
                        for (int j = 0; j < 4; ++j) atomicAdd(orow + col + j, gv * acc[ai][bj][m][n][j]);
                    }
            }
    }
};
}

DI void transpose_item(const float* W, int ldw, int k0, int n0, bf16_t* WT, int ldt, int drow0, LAS float* scr, int lane) {
#pragma unroll 8
    for (int i = 0; i < 32; ++i) { const int kk = 2 * i + (lane >> 5); scr[kk * 33 + (lane & 31)] = W[(size_t)(k0 + kk) * ldw + n0 + (lane & 31)]; }
    LDS_WAIT();
    const int c = lane & 7;
#pragma unroll
    for (int j = 0; j < 4; ++j) { const int n = (lane >> 3) + 8 * j; const LAS float* s = scr + (8 * c) * 33 + n;
        u32x4 o; o.x = pk2(s[0 * 33], s[1 * 33]); o.y = pk2(s[2 * 33], s[3 * 33]); o.z = pk2(s[4 * 33], s[5 * 33]); o.w = pk2(s[6 * 33], s[7 * 33]);
        *(u32x4*)(WT + (size_t)(drow0 + n) * ldt + k0 + 8 * c) = o; }
    LDS_WAIT();
}

DI void sincos_small(double r, double& s, double& c) {
    const double r2 = r * r; double ss = 1.0, cc = 1.0;
#pragma unroll
    for (int n = 12; n >= 1; --n) { ss = 1.0 - ss * r2 * (1.0 / (double)((2 * n) * (2 * n + 1))); cc = 1.0 - cc * r2 * (1.0 / (double)((2 * n - 1) * (2 * n))); }
    s = r * ss; c = cc;
}

DI void dot16(const f32x4 (&v)[4], const LAS float* wT, int lane, float (&r)[16]) {
#pragma unroll
    for (int e = 0; e < 16; ++e) {
        float a = 0.f;
        if ((e & 1) == 0) asm volatile("" ::: "memory");
#pragma unroll
        for (int j = 0; j < 4; ++j) { const f32x4 w = *(const LAS f32x4*)(wT + e * 1024 + 256 * j + 4 * lane); a += v[j][0] * w[0] + v[j][1] * w[1] + v[j][2] * w[2] + v[j][3] * w[3]; }
        r[e] = wave_sum(a);
    }
}

DI void phase0(const Params& p, LAS unsigned char* lds, int gw, int NGW, int wave, int lane) {
    const int tid = threadIdx.x;
    {
        LAS float* scr = (LAS float*)(lds + wave * 16384);
        for (int it = gw; it < 2048; it += NGW) {
            if (it < 1536) { const int kb = it / 96, nb = it % 96; transpose_item(p.in[2], INW, 64 * kb, 32 * nb, (bf16_t*)(p.ws + WS_WI), DM, 32 * nb, scr, lane); }
            else { const int r = it - 1536, kb = r / 32, nb = r % 32; transpose_item(p.in[9], DM, 64 * kb, 32 * nb, (bf16_t*)(p.ws + WS_WO), DM, 32 * nb, scr, lane); }
        }
    }
    {
        float* rope = (float*)(p.ws + WS_ROPE);
        const float invf[8] = {1.0f, 0.1939227432012558f, 0.03760603070259094f, 0.007292664609849453f, 0.0014142135623842478f, 0.00027424818836152554f, 5.318296098266728e-05f, 1.0313386155758053e-05f};
        for (int id = blockIdx.x * NTHR + tid; id < 8192 * 8; id += gridDim.x * NTHR) {
            const int pos = id >> 3, i = id & 7;
            float inv = invf[0];
#pragma unroll
            for (int k = 1; k < 8; ++k) inv = (i == k) ? invf[k] : inv;
            const float ang = (float)pos * inv;
            const double x = (double)ang; const double kq = rint(x * 0.15915494309189535); const double r = x - kq * 6.283185307179586476925;
            double s, c; sincos_small(r, s, c);
            rope[pos * 16 + i] = (float)c; rope[pos * 16 + 8 + i] = (float)s;
        }
    }
    __syncthreads();
    LAS float* wT = (LAS float*)lds;
    for (int id = tid; id < 16384; id += NTHR) { const int k = id >> 4, e = id & 15; wT[e * 1024 + k] = p.in[2][(size_t)k * INW + 3072 + e]; }
    __syncthreads();
    const float* dtb = p.in[5];
    float bias = 0.f;
    if (lane < 16) bias = dtb[lane];
    bf16_t* xb = (bf16_t*)(p.ws + WS_XB); float* dtout = (float*)(p.ws + WS_DT);
    for (int t = gw; t < TT; t += NGW) {
        const f32x4* xr = (const f32x4*)xrow_ptr(p, t) + lane;
        f32x4 v[4];
#pragma unroll
        for (int j = 0; j < 4; ++j) v[j] = xr[64 * j];
        u32x2* o8 = (u32x2*)(xb + (size_t)t * DM) + lane;
#pragma unroll
        for (int j = 0; j < 4; ++j) { u32x2 w; w.x = pk2(v[j][0], v[j][1]); w.y = pk2(v[j][2], v[j][3]); o8[64 * j] = w; }
        float r[16]; dot16(v, wT, lane, r);
        float mine = 0.f;
#pragma unroll
        for (int e = 0; e < 16; ++e) mine = (lane == e) ? r[e] : mine;
        if (lane < 16) { const float z = mine + bias; dtout[(size_t)t * 16 + lane] = fmaxf(z, 0.f) + log1pf(__expf(-fabsf(z))); }
    }
}

DI void conv_phase(const Params& p) {
    const int tid = blockIdx.x * NTHR + threadIdx.x, nthr = gridDim.x * NTHR;
    const int c = tid & 127, ch = 8 * c, tile = ch >> 8, cit = ch & 255;
    const float* cw = p.in[3]; const float* cb = p.in[4];
    float w[5][8], b[8];
#pragma unroll
    for (int j = 0; j < 5; ++j)
#pragma unroll
        for (int e = 0; e < 8; ++e) w[j][e] = cw[j * 1024 + ch + e];
#pragma unroll
    for (int e = 0; e < 8; ++e) b[e] = cb[ch + e];
    const bf16_t* src = (const bf16_t*)(p.ws + WS_P) + (size_t)(8 + tile) * TILE_ELEMS + cit;
    bf16_t* dst = (bf16_t*)(p.ws + WS_XC) + (size_t)tile * TILE_ELEMS + cit;
    for (int it = tid; it < TT * 128; it += nthr) {
        const int t = it >> 7;
        const int S = t < TP ? 4096 : 8192, s = t & (S - 1);
        float a[8];
#pragma unroll
        for (int e = 0; e < 8; ++e) a[e] = b[e];
#pragma unroll
        for (int j = 0; j < 5; ++j) {
            const int sj = s + j - 2;
            if (sj >= 0 && sj < S) {
                const u32x4 v = *(const u32x4*)(src + (size_t)(t + j - 2) * 256);
                a[0] += bflo(v.x) * w[j][0]; a[1] += bfhi(v.x) * w[j][1]; a[2] += bflo(v.y) * w[j][2]; a[3] += bfhi(v.y) * w[j][3];
                a[4] += bflo(v.z) * w[j][4]; a[5] += bfhi(v.z) * w[j][5]; a[6] += bflo(v.w) * w[j][6]; a[7] += bfhi(v.w) * w[j][7];
            }
        }
        u32x4 o; o.x = pk2(silu_f(a[0]), silu_f(a[1])); o.y = pk2(silu_f(a[2]), silu_f(a[3])); o.z = pk2(silu_f(a[4]), silu_f(a[5])); o.w = pk2(silu_f(a[6]), silu_f(a[7]));
        *(u32x4*)(dst + (size_t)t * 256) = o;
    }
}

DI void attn_phase(const Params& p, LAS unsigned char* lds, int gw, int NGW, int wave, int lane) {
    LAS bf16_t* Vt = (LAS bf16_t*)(lds + wave * 4608);
    const bf16_t* Pb = (const bf16_t*)(p.ws + WS_P);
    bf16_t* mix = (bf16_t*)(p.ws + WS_MIX);
    const int c = lane & 15, q = lane >> 4;
    for (int wi = gw; wi < 24576; wi += NGW) {
        const int head = wi & 7, qg = wi >> 3;
        const int t0 = (qg >> 4) * 256 + (qg & 15);
        const int S = t0 < TP ? 4096 : 8192, sbase = t0 & ~(S - 1), p0 = t0 - sbase;
        const int hoff = (head & 3) * 64;
        const bf16_t* Qt = Pb + (size_t)(0 + (head >> 2)) * TILE_ELEMS + hoff;
        const bf16_t* Kt = Pb + (size_t)(2 + (head >> 2)) * TILE_ELEMS + hoff;
        const bf16_t* Vg = Pb + (size_t)(4 + (head >> 2)) * TILE_ELEMS + hoff;
        bf16x8 qf[2];
        { const bf16_t* qrow = Qt + (size_t)(t0 + 16 * c) * 256; qf[0] = *(const bf16x8*)(qrow + 8 * q); qf[1] = *(const bf16x8*)(qrow + 32 + 8 * q); }
        f32x4 O[4];
#pragma unroll
        for (int d4 = 0; d4 < 4; ++d4) O[d4] = (f32x4){0.f, 0.f, 0.f, 0.f};
        float mrun = -1e30f, lsum = 0.f;
        const int pq = p0 + 16 * c;
        for (int pi = 0; pi < 3; ++pi) {
            const int d = 1 << (2 * pi);
            const int base = p0 - 64 * d, nk = 240 / d + 129, nst = (nk + 31) >> 5, win = 64 * d;
            for (int st = 0; st < nst; ++st) {
                const int kbase = 32 * st;
#pragma unroll
                for (int i = 0; i < 4; ++i) {
                    const int id = lane + 64 * i, key = id >> 3, dc = id & 7;
                    int pos = base + d * (kbase + key); pos = pos < 0 ? 0 : (pos > S - 1 ? S - 1 : pos);
                    const u32x4 v = *(const u32x4*)(Vg + (size_t)(sbase + pos) * 256 + 8 * dc);
                    LAS bf16_t* w = Vt + (8 * dc) * 36 + key;
                    w[0 * 36] = (bf16_t)(v.x & 0xffffu); w[1 * 36] = (bf16_t)(v.x >> 16); w[2 * 36] = (bf16_t)(v.y & 0xffffu); w[3 * 36] = (bf16_t)(v.y >> 16);
                    w[4 * 36] = (bf16_t)(v.z & 0xffffu); w[5 * 36] = (bf16_t)(v.z >> 16); w[6 * 36] = (bf16_t)(v.w & 0xffffu); w[7 * 36] = (bf16_t)(v.w >> 16);
                }
                f32x4 sc[2];
#pragma unroll
                for (int kt = 0; kt < 2; ++kt) {
                    int pos = base + d * (kbase + 16 * kt + c); pos = pos < 0 ? 0 : (pos > S - 1 ? S - 1 : pos);
                    const bf16_t* krow = Kt + (size_t)(sbase + pos) * 256;
                    const bf16x8 k0 = *(const bf16x8*)(krow + 8 * q), k1 = *(const bf16x8*)(krow + 32 + 8 * q);
                    f32x4 a = {0.f, 0.f, 0.f, 0.f};
                    a = __builtin_amdgcn_mfma_f32_16x16x32_bf16(k0, qf[0], a, 0, 0, 0);
                    a = __builtin_amdgcn_mfma_f32_16x16x32_bf16(k1, qf[1], a, 0, 0, 0);
                    sc[kt] = a;
                }
                bool valid[2][4]; float mloc = -1e30f;
#pragma unroll
                for (int kt = 0; kt < 2; ++kt)
#pragma unroll
                    for (int j = 0; j < 4; ++j) {
                        const int kk = kbase + 16 * kt + 4 * q + j, pk = base + d * kk;
                        int df = pk - pq; df = df < 0 ? -df : df;
                        valid[kt][j] = (kk < nk) && (pk >= 0) && (pk < S) && (df <= win);
                        const float sv = valid[kt][j] ? sc[kt][j] * 0.125f : -1e30f;
                        sc[kt][j] = sv; mloc = fmaxf(mloc, sv);
                    }
                mloc = fmaxf(mloc, __shfl_xor(mloc, 16)); mloc = fmaxf(mloc, __shfl_xor(mloc, 32));
                const float mnew = fmaxf(mrun, mloc), alpha = __expf(mrun - mnew);
                mrun = mnew;
                float ps = 0.f; float pv[2][4];
#pragma unroll
                for (int kt = 0; kt < 2; ++kt)
#pragma unroll
                    for (int j = 0; j < 4; ++j) { pv[kt][j] = valid[kt][j] ? __expf(sc[kt][j] - mnew) : 0.f; ps += pv[kt][j]; }
                lsum = lsum * alpha + ps;
#pragma unroll
                for (int d4 = 0; d4 < 4; ++d4) O[d4] = O[d4] * alpha;
                u32x4 pw; pw.x = pk2(pv[0][0], pv[0][1]); pw.y = pk2(pv[0][2], pv[0][3]); pw.z = pk2(pv[1][0], pv[1][1]); pw.w = pk2(pv[1][2], pv[1][3]);
                const bf16x8 pf = __builtin_bit_cast(bf16x8, pw);
#pragma unroll
                for (int d4 = 0; d4 < 4; ++d4) {
                    const LAS bf16_t* vr = Vt + (16 * d4 + c) * 36 + 4 * q;
                    const s16x4 lo = *(const LAS s16x4*)vr, hi = *(const LAS s16x4*)(vr + 16);
                    const bf16x8 vf = __builtin_shufflevector(lo, hi, 0, 1, 2, 3, 4, 5, 6, 7);
                    O[d4] = __builtin_amdgcn_mfma_f32_16x16x32_bf16(vf, pf, O[d4], 0, 0, 0);
                }
            }
        }
        lsum += __shfl_xor(lsum, 16); lsum += __shfl_xor(lsum, 32);
        const float inv = 1.0f / lsum;
        bf16_t* orow = mix + (size_t)(t0 + 16 * c) * DM + head * 64 + 4 * q;
#pragma unroll
        for (int d4 = 0; d4 < 4; ++d4) { u32x2 w; w.x = pk2(O[d4][0] * inv, O[d4][1] * inv); w.y = pk2(O[d4][2] * inv, O[d4][3] * inv); *(u32x2*)(orow + 16 * d4) = w; }
    }
}

constexpr int SSD_ACS = 0, SSD_DTS = 512, SSD_XT1 = 1024, SSD_XT2 = SSD_XT1 + 64 * 272, SSD_BT = SSD_XT2 + 64 * 272, SSD_SBF = SSD_BT + 128 * 272, SSD_END = SSD_SBF + 64 * 272;
static_assert(SSD_END <= 131072, "ssd lds");
DI void ssd_phase(const Params& p, LAS unsigned char* lds, int wave, int lane) {
    const int wk = blockIdx.x;
    if (wk >= 160) return;
    const int tid = threadIdx.x;
    const int seq = wk / 16, h = (wk >> 1) & 7, dir = wk & 1, g = h >> 2;
    const int S = seq < 8 ? 4096 : 8192, sbase = seq < 8 ? seq * 4096 : TP + (seq - 8) * 8192, nc = S / 128;
    const float A = -__expf(p.in[6][dir * 8 + h]);
    const float* dtg = (const float*)(p.ws + WS_DT) + dir * 8 + h;
    const bf16_t* XCb = (const bf16_t*)(p.ws + WS_XC);
    const bf16_t* Xg = XCb + (size_t)(h >> 2) * TILE_ELEMS + (h & 3) * 64;
    const bf16_t* Bg = XCb + 2 * TILE_ELEMS + g * 128;
    const bf16_t* Cg = XCb + 3 * TILE_ELEMS + g * 128;
    bf16_t* Y = (bf16_t*)(p.ws + (dir ? WS_YB : WS_YF)) + h * 64;
    LAS float* acs = (LAS float*)(lds + SSD_ACS); LAS float* dts = (LAS float*)(lds + SSD_DTS);
    LAS bf16_t* Xt1 = (LAS bf16_t*)(lds + SSD_XT1); LAS bf16_t* Xt2 = (LAS bf16_t*)(lds + SSD_XT2);
    LAS bf16_t* Bt = (LAS bf16_t*)(lds + SSD_BT); LAS bf16_t* Sbf = (LAS bf16_t*)(lds + SSD_SBF);
    for (int i = tid; i < 64 * 136 / 2; i += NTHR) ((LAS unsigned*)Sbf)[i] = 0u;
    const int c = lane & 15, q = lane >> 4, w = wave;
    f32x4 St[4];
#pragma unroll
    for (int pt = 0; pt < 4; ++pt) St[pt] = (f32x4){0.f, 0.f, 0.f, 0.f};
    for (int ci = 0; ci < nc; ++ci) {
        const int tb = dir ? sbase + S - 1 - 128 * ci : sbase + 128 * ci, ts = dir ? -1 : 1;
#define TOK(l) (tb + ts * (l))
        if (w == 0) {
            const float d0 = dtg[(size_t)TOK(2 * lane) * 16], d1 = dtg[(size_t)TOK(2 * lane + 1) * 16];
            const float v0 = d0 * A, v1 = d1 * A; float ps = v0 + v1;
#pragma unroll
            for (int o = 1; o < 64; o <<= 1) { const float t = __shfl_up(ps, o); if (lane >= o) ps += t; }
            acs[2 * lane] = ps - v1; acs[2 * lane + 1] = ps; dts[2 * lane] = d0; dts[2 * lane + 1] = d1;
        }
        __syncthreads();
        const float aend = acs[127];
#pragma unroll
        for (int i = 0; i < 2; ++i) {
            const int id = tid + NTHR * i, l = id >> 3, pc = id & 7;
            const u32x4 v = *(const u32x4*)(Xg + (size_t)TOK(l) * 256 + 8 * pc);
            const float s1 = dts[l], s2 = s1 * __expf(aend - acs[l]);
            float x[8] = {bflo(v.x), bfhi(v.x), bflo(v.y), bfhi(v.y), bflo(v.z), bfhi(v.z), bflo(v.w), bfhi(v.w)};
#pragma unroll
            for (int e = 0; e < 8; ++e) { Xt1[(8 * pc + e) * 136 + l] = (bf16_t)f2bf(x[e] * s1); Xt2[(8 * pc + e) * 136 + l] = (bf16_t)f2bf(x[e] * s2); }
        }
#pragma unroll
        for (int i = 0; i < 4; ++i) {
            const int id = tid + NTHR * i, l = id >> 4, ncn = id & 15;
            const u32x4 v = *(const u32x4*)(Bg + (size_t)TOK(l) * 256 + 8 * ncn);
            LAS bf16_t* wp = Bt + (8 * ncn) * 136 + l;
            wp[0 * 136] = (bf16_t)(v.x & 0xffffu); wp[1 * 136] = (bf16_t)(v.x >> 16); wp[2 * 136] = (bf16_t)(v.y & 0xffffu); wp[3 * 136] = (bf16_t)(v.y >> 16);
            wp[4 * 136] = (bf16_t)(v.z & 0xffffu); wp[5 * 136] = (bf16_t)(v.z >> 16); wp[6 * 136] = (bf16_t)(v.w & 0xffffu); wp[7 * 136] = (bf16_t)(v.w >> 16);
        }
        __syncthreads();
        {
            const int l = 16 * w + c;
            const float al = acs[l];
            bf16x8 Cf[4];
            { const bf16_t* cr = Cg + (size_t)TOK(l) * 256 + 8 * q;
#pragma unroll
              for (int ks = 0; ks < 4; ++ks) Cf[ks] = *(const bf16x8*)(cr + 32 * ks); }
            f32x4 acc[4];
#pragma unroll
            for (int pt = 0; pt < 4; ++pt) {
                f32x4 a = {0.f, 0.f, 0.f, 0.f};
#pragma unroll
                for (int ks = 0; ks < 4; ++ks) { const bf16x8 sf = *(const LAS bf16x8*)(Sbf + (16 * pt + c) * 136 + 32 * ks + 8 * q); a = __builtin_amdgcn_mfma_f32_16x16x32_bf16(sf, Cf[ks], a, 0, 0, 0); }
                acc[pt] = a * __expf(al);
            }
            const int nsp = (w >> 1) + 1;
            for (int sp = 0; sp < nsp; ++sp) {
                f32x4 M[2];
#pragma unroll
                for (int hh = 0; hh < 2; ++hh) {
                    const int st = 2 * sp + hh;
                    f32x4 G = {0.f, 0.f, 0.f, 0.f};
                    if (st <= w) {
                        const bf16_t* br = Bg + (size_t)TOK(16 * st + c) * 256 + 8 * q;
#pragma unroll
                        for (int ks = 0; ks < 4; ++ks) { const bf16x8 bfr = *(const bf16x8*)(br + 32 * ks); G = __builtin_amdgcn_mfma_f32_16x16x32_bf16(bfr, Cf[ks], G, 0, 0, 0); }
#pragma unroll
                        for (int j = 0; j < 4; ++j) { const int s = 16 * st + 4 * q + j; const float e = __expf(al - acs[s]); G[j] = (s <= l) ? G[j] * e : 0.f; }
                    }
                    M[hh] = G;
                }
                u32x4 pw; pw.x = pk2(M[0][0], M[0][1]); pw.y = pk2(M[0][2], M[0][3]); pw.z = pk2(M[1][0], M[1][1]); pw.w = pk2(M[1][2], M[1][3]);
                const bf16x8 pf = __builtin_bit_cast(bf16x8, pw);
#pragma unroll
                for (int pt = 0; pt < 4; ++pt) {
                    const LAS bf16_t* xr = Xt1 + (16 * pt + c) * 136 + 32 * sp + 4 * q;
                    const s16x4 lo = *(const LAS s16x4*)xr, hi = *(const LAS s16x4*)(xr + 16);
                    const bf16x8 xf = __builtin_shufflevector(lo, hi, 0, 1, 2, 3, 4, 5, 6, 7);
                    acc[pt] = __builtin_amdgcn_mfma_f32_16x16x32_bf16(xf, pf, acc[pt], 0, 0, 0);
                }
            }
            bf16_t* yr = Y + (size_t)TOK(l) * 512 + 4 * q;
#pragma unroll
            for (int pt = 0; pt < 4; ++pt) { u32x2 o; o.x = pk2(acc[pt][0], acc[pt][1]); o.y = pk2(acc[pt][2], acc[pt][3]); *(u32x2*)(yr + 16 * pt) = o; }
        }
        {
            const float dec = __expf(aend);
#pragma unroll
            for (int pt = 0; pt < 4; ++pt) {
                f32x4 a = St[pt] * dec;
#pragma unroll
                for (int ks = 0; ks < 4; ++ks) {
                    const bf16x8 xf = *(const LAS bf16x8*)(Xt2 + (16 * pt + c) * 136 + 32 * ks + 8 * q);
                    const bf16x8 bfr = *(const LAS bf16x8*)(Bt + (16 * w + c) * 136 + 32 * ks + 8 * q);
                    a = __builtin_amdgcn_mfma_f32_16x16x32_bf16(xf, bfr, a, 0, 0, 0);
                }
                St[pt] = a;
            }
        }
        __syncthreads();
#pragma unroll
        for (int pt = 0; pt < 4; ++pt)
#pragma unroll
            for (int j = 0; j < 4; ++j) Sbf[(16 * pt + 4 * q + j) * 136 + 16 * w + c] = (bf16_t)f2bf(St[pt][j]);
#undef TOK
    }
}

DI void gate_phase(const Params& p, int gw, int NGW, int lane) {
    const bf16_t* yf = (const bf16_t*)(p.ws + WS_YF); const bf16_t* yb = (const bf16_t*)(p.ws + WS_YB);
    const bf16_t* xh = (const bf16_t*)(p.ws + WS_XC) + (size_t)(lane >> 5) * TILE_ELEMS + (8 * lane & 255);
    const bf16_t* zt = (const bf16_t*)(p.ws + WS_P) + (size_t)(6 + (lane >> 5)) * TILE_ELEMS + (8 * lane & 255);
    bf16_t* mix = (bf16_t*)(p.ws + WS_MIX) + 512 + 8 * lane;
    const float D = p.in[7][lane >> 3];
    float nw[8];
#pragma unroll
    for (int e = 0; e < 8; ++e) nw[e] = p.in[8][8 * lane + e];
    for (int t = gw; t < TT; t += NGW) {
        const u32x4 a = *(const u32x4*)(yf + (size_t)t * 512 + 8 * lane), b = *(const u32x4*)(yb + (size_t)t * 512 + 8 * lane);
        const u32x4 x = *(const u32x4*)(xh + (size_t)t * 256), z = *(const u32x4*)(zt + (size_t)t * 256);
        float y[8];
        y[0] = (bflo(a.x) + bflo(b.x) + D * bflo(x.x)) * silu_f(bflo(z.x)); y[1] = (bfhi(a.x) + bfhi(b.x) + D * bfhi(x.x)) * silu_f(bfhi(z.x));
        y[2] = (bflo(a.y) + bflo(b.y) + D * bflo(x.y)) * silu_f(bflo(z.y)); y[3] = (bfhi(a.y) + bfhi(b.y) + D * bfhi(x.y)) * silu_f(bfhi(z.y));
        y[4] = (bflo(a.z) + bflo(b.z) + D * bflo(x.z)) * silu_f(bflo(z.z)); y[5] = (bfhi(a.z) + bfhi(b.z) + D * bfhi(x.z)) * silu_f(bfhi(z.z));
        y[6] = (bflo(a.w) + bflo(b.w) + D * bflo(x.w)) * silu_f(bflo(z.w)); y[7] = (bfhi(a.w) + bfhi(b.w) + D * bfhi(x.w)) * silu_f(bfhi(z.w));
        float ss = 0.f;
#pragma unroll
        for (int e = 0; e < 8; ++e) ss += y[e] * y[e];
        ss = wave_sum(ss);
        const float r = 1.0f / sqrtf(ss * (1.0f / 512.0f) + RMS_EPS);
        u32x4 o; o.x = pk2(y[0] * r * nw[0], y[1] * r * nw[1]); o.y = pk2(y[2] * r * nw[2], y[3] * r * nw[3]); o.z = pk2(y[4] * r * nw[4], y[5] * r * nw[5]); o.w = pk2(y[6] * r * nw[6], y[7] * r * nw[7]);
        *(u32x4*)(mix + (size_t)t * DM) = o;
    }
}

DI void expert_weights_phase(const Params& p, LAS unsigned char* lds, int gw, int NGW, int wave, int lane) {
    LAS float* scr = (LAS float*)(lds + wave * 16384);
    bf16_t* Wgu = (bf16_t*)(p.ws + WS_WGU); bf16_t* Wd = (bf16_t*)(p.ws + WS_WD);
    for (int it = gw; it < 16 * 4224; it += NGW) {
        const int e = it / 4224, r = it % 4224;
        if (r < 2816) {
            const int isup = r >= 1408, rr = isup ? r - 1408 : r, kb = rr / 88, nb = rr % 88, n0 = 32 * nb;
            const float* W = (isup ? p.in[14] : p.in[13]) + (size_t)e * DM * FF;
            transpose_item(W, FF, 64 * kb, n0, Wgu, DM, e * 5632 + 256 * (n0 >> 7) + (n0 & 127) + (isup ? 128 : 0), scr, lane);
        } else {
            const int rr = r - 2816, kb = rr / 32, nb = rr % 32;
            transpose_item(p.in[15] + (size_t)e * FF * DM, DM, 64 * kb, 32 * nb, Wd, FF, e * 1024 + 32 * nb, scr, lane);
        }
    }
}

DI void ln1_router_phase(const Params& p, LAS unsigned char* lds, int gw, int NGW, int lane) {
    const int tid = threadIdx.x;
    LAS float* wT = (LAS float*)lds;
    for (int id = tid; id < 16384; id += NTHR) { const int k = id >> 4, e = id & 15; wT[e * 1024 + k] = p.in[12][id]; }
    __syncthreads();
    f32x4 gg[4], bb[4];
#pragma unroll
    for (int j = 0; j < 4; ++j) { gg[j] = ((const f32x4*)p.in[10])[64 * j + lane]; bb[j] = ((const f32x4*)p.in[11])[64 * j + lane]; }
    bf16_t* x1b = (bf16_t*)(p.ws + WS_X1B); float* aff = (float*)(p.ws + WS_AFF);
    for (int t = gw; t < TT; t += NGW) {
        f32x4* orow = (f32x4*)(p.out + (size_t)t * DM) + lane;
        f32x4 v[4]; float s = 0.f;
#pragma unroll
        for (int j = 0; j < 4; ++j) { v[j] = orow[64 * j]; s += (v[j][0] + v[j][1]) + (v[j][2] + v[j][3]); }
        const float mean = wave_sum(s) * (1.0f / DM); float s2 = 0.f;
#pragma unroll
        for (int j = 0; j < 4; ++j) { v[j] = v[j] - mean; s2 += (v[j][0] * v[j][0] + v[j][1] * v[j][1]) + (v[j][2] * v[j][2] + v[j][3] * v[j][3]); }
        const float rstd = 1.0f / sqrtf(wave_sum(s2) * (1.0f / DM) + LN_EPS);
        u32x2* o8 = (u32x2*)(x1b + (size_t)t * DM) + lane;
#pragma unroll
        for (int j = 0; j < 4; ++j) {
            v[j] = v[j] * rstd * gg[j] + bb[j];
            orow[64 * j] = v[j] * ALPHA;
            u32x2 w; w.x = pk2(v[j][0], v[j][1]); w.y = pk2(v[j][2], v[j][3]); o8[64 * j] = w;
        }
        float r[16]; dot16(v, wT, lane, r);
        float mx = r[0];
#pragma unroll
        for (int e = 1; e < 16; ++e) mx = fmaxf(mx, r[e]);
        float den = 0.f, mine = 0.f;
#pragma unroll
        for (int e = 0; e < 16; ++e) { const float ex = __expf(r[e] - mx); den += ex; mine = (lane == e) ? ex : mine; }
        if (lane < 16) aff[(size_t)lane * TT + t] = mine / den;
    }
}

DI void select_phase(const Params& p, LAS unsigned char* lds, int wave, int lane) {
    const int wk = blockIdx.x;
    if (wk >= 32) return;
    const int tid = threadIdx.x;
    const int trunk = wk >> 4, e = wk & 15;
    const int Tn = trunk ? 16384 : 32768, tbase = trunk ? TP : 0, cap = Tn / 8;
    const unsigned* col = (const unsigned*)(p.ws + WS_AFF) + (size_t)e * TT + tbase;
    LAS unsigned* hist = (LAS unsigned*)lds;
    LAS unsigned* ctl = (LAS unsigned*)(lds + 1024);
    LAS unsigned* wcnt = (LAS unsigned*)(lds + 2048);
    unsigned prefix = 0, remaining = (unsigned)cap;
    for (int pass = 0; pass < 4; ++pass) {
        const int shift = 24 - 8 * pass;
        for (int i = tid; i < 256; i += NTHR) hist[i] = 0u;
        __syncthreads();
        for (int i = tid; i < Tn; i += NTHR) {
            const unsigned bits = col[i];
            if (pass == 0 || (bits >> (shift + 8)) == prefix) atomicAdd((unsigned*)(hist + ((bits >> shift) & 255u)), 1u);
        }
        __syncthreads();
        if (tid == 0) {
            unsigned cum = 0; int b = 255;
            for (; b > 0; --b) { const unsigned hcnt = hist[b]; if (cum + hcnt >= remaining) break; cum += hcnt; }
            ctl[0] = (prefix << 8) | (unsigned)b; ctl[1] = remaining - cum;
        }
        __syncthreads();
        prefix = ctl[0]; remaining = ctl[1];
        __syncthreads();
    }
    const unsigned thr = prefix, need_eq = remaining;
    int* idx = (int*)(p.ws + WS_IDX) + e * SLOTS_E + (trunk ? 4096 : 0);
    float* gate = (float*)(p.ws + WS_GATE) + e * SLOTS_E + (trunk ? 4096 : 0);
    unsigned sel_base = 0, eq_base = 0;
    for (int b0 = 0; b0 < Tn; b0 += NTHR) {
        const unsigned bits = col[b0 + tid];
        const bool gt = bits > thr, eq = bits == thr;
        const unsigned long long meq = __ballot(eq);
        const unsigned eq_before_w = (unsigned)__popcll(meq & ((1ull << lane) - 1ull));
        if (lane == 0) wcnt[wave] = (unsigned)__popcll(meq);
        __syncthreads();
        unsigned eq_off = 0, eq_tot = 0;
#pragma unroll
        for (int w2 = 0; w2 < 8; ++w2) { const unsigned cnt = wcnt[w2]; eq_off += (w2 < wave) ? cnt : 0u; eq_tot += cnt; }
        const bool sel = gt || (eq && (eq_base + eq_off + eq_before_w) < need_eq);
        const unsigned long long msel = __ballot(sel);
        const unsigned sel_before_w = (unsigned)__popcll(msel & ((1ull << lane) - 1ull));
        if (lane == 0) wcnt[8 + wave] = (unsigned)__popcll(msel);
        __syncthreads();
        unsigned sel_off = 0, sel_tot = 0;
#pragma unroll
        for (int w2 = 0; w2 < 8; ++w2) { const unsigned cnt = wcnt[8 + w2]; sel_off += (w2 < wave) ? cnt : 0u; sel_tot += cnt; }
        if (sel) { const unsigned pos = sel_base + sel_off + sel_before_w; if (pos < (unsigned)cap) { idx[pos] = tbase + b0 + tid; gate[pos] = __uint_as_float(bits); } }
        sel_base += sel_tot; eq_base += eq_tot;
        __syncthreads();
    }
}

DI void ln2_phase(const Params& p, int gw, int NGW, int lane) {
    f32x4 gg[4], bb[4];
#pragma unroll
    for (int j = 0; j < 4; ++j) { gg[j] = ((const f32x4*)p.in[16])[64 * j + lane]; bb[j] = ((const f32x4*)p.in[17])[64 * j + lane]; }
    for (int t = gw; t < TT; t += NGW) {
        f32x4* orow = (f32x4*)(p.out + (size_t)t * DM) + lane;
        f32x4 v[4]; float s = 0.f;
#pragma unroll
        for (int j = 0; j < 4; ++j) { v[j] = orow[64 * j]; s += (v[j][0] + v[j][1]) + (v[j][2] + v[j][3]); }
        const float mean = wave_sum(s) * (1.0f / DM); float s2 = 0.f;
#pragma unroll
        for (int j = 0; j < 4; ++j) { v[j] = v[j] - mean; s2 += (v[j][0] * v[j][0] + v[j][1] * v[j][1]) + (v[j][2] * v[j][2] + v[j][3] * v[j][3]); }
        const float rstd = 1.0f / sqrtf(wave_sum(s2) * (1.0f / DM) + LN_EPS);
#pragma unroll
        for (int j = 0; j < 4; ++j) orow[64 * j] = v[j] * rstd * gg[j] + bb[j];
    }
}

__global__ void __launch_bounds__(NTHR, 2) fwd_megakernel(Params p) {
    extern __shared__ __attribute__((aligned(16))) unsigned char lds_raw[];
    LAS unsigned char* lds = (LAS unsigned char*)lds_raw;
    cg::grid_group grid = cg::this_grid();
#define IDS() int tid_ = threadIdx.x; asm volatile("" : "+v"(tid_)); const int lane = tid_ & 63, wave = __builtin_amdgcn_readfirstlane(tid_ >> 6); \
    const int G = gridDim.x, gw = blockIdx.x * 8 + wave, NGW = G * 8; (void)lane; (void)gw; (void)NGW; (void)G;
    { IDS(); phase0(p, lds, gw, NGW, wave, lane); }
    grid.sync();
    {
        IDS();
        pg8::SchedPlain S; S.init(TT, 3072, G, (int)blockIdx.x);
        pg8::EpiProj E{(bf16_t*)(p.ws + WS_P), (const float*)(p.ws + WS_ROPE)};
        pg8::gemm_phase<pg8::EpiProj, pg8::SchedPlain>(lds, (const bf16_t*)(p.ws + WS_XB), (const bf16_t*)(p.ws + WS_WI), DM, S, E);
    }
    grid.sync();
    conv_phase(p);
    { IDS(); attn_phase(p, lds, gw, NGW, wave, lane); }
    grid.sync();
    { IDS(); ssd_phase(p, lds, wave, lane); }
    grid.sync();
    { IDS(); gate_phase(p, gw, NGW, lane); }
    grid.sync();
    { IDS(); expert_weights_phase(p, lds, gw, NGW, wave, lane); }
    __syncthreads();
    {
        IDS();
        pg8::SchedPlain S; S.init(TT, DM, G, (int)blockIdx.x);
        pg8::EpiOut E{p};
        pg8::gemm_phase<pg8::EpiOut, pg8::SchedPlain>(lds, (const bf16_t*)(p.ws + WS_MIX), (const bf16_t*)(p.ws + WS_WO), DM, S, E);
    }
    grid.sync();
    { IDS(); ln1_router_phase(p, lds, gw, NGW, lane); }
    grid.sync();
    { IDS(); select_phase(p, lds, wave, lane); }
    grid.sync();
#pragma unroll 1
    for (int rnd = 0; rnd < 2; ++rnd) {
        {
            IDS();
            const int* idx = (const int*)(p.ws + WS_IDX) + rnd * 8 * SLOTS_E;
            pg8::SchedGrouped<22, true> S{G, (int)blockIdx.x, idx};
            pg8::EpiGU E{(bf16_t*)(p.ws + WS_HID)};
            pg8::gemm_phase<pg8::EpiGU, pg8::SchedGrouped<22, true>>(lds, (const bf16_t*)(p.ws + WS_X1B), (const bf16_t*)(p.ws + WS_WGU) + (size_t)rnd * 8 * 5632 * DM, DM, S, E);
        }
        grid.sync();
        {
            IDS();
            const int* idx = (const int*)(p.ws + WS_IDX) + rnd * 8 * SLOTS_E;
            const float* gate = (const float*)(p.ws + WS_GATE) + rnd * 8 * SLOTS_E;
            pg8::SchedGrouped<4, false> S{G, (int)blockIdx.x, idx};
            pg8::EpiDown E{p.out, idx, gate};
            pg8::gemm_phase<pg8::EpiDown, pg8::SchedGrouped<4, false>>(lds, (const bf16_t*)(p.ws + WS_HID), (const bf16_t*)(p.ws + WS_WD) + (size_t)rnd * 8 * 1024 * FF, FF, S, E);
        }
        grid.sync();
    }
    { IDS(); ln2_phase(p, gw, NGW, lane); }
#undef IDS
}

extern "C" void kernel_launch(void* const* d_in, const int* in_sizes, int n_in, void* d_out, int out_size, void* d_ws, size_t ws_size, hipStream_t stream) {
    static int grid_blocks = 0;
    if (grid_blocks == 0) {
        if (n_in != 18 || ws_size < WS_END || out_size != TT * DM) { fprintf(stderr, "kernel_launch: unexpected shapes (n_in %d out %d ws %zu)\n", n_in, out_size, ws_size); grid_blocks = -1; return; }
        int dev = 0, cus = 0, per_cu = 0;
        hipGetDevice(&dev);
        hipDeviceGetAttribute(&cus, hipDeviceAttributeMultiprocessorCount, dev);
        if (hipFuncSetAttribute((const void*)fwd_megakernel, hipFuncAttributeMaxDynamicSharedMemorySize, LDS_BYTES) != hipSuccess) { fprintf(stderr, "kernel_launch: hipFuncSetAttribute failed\n"); }
        hipOccupancyMaxActiveBlocksPerMultiprocessor(&per_cu, (const void*)fwd_megakernel, NTHR, LDS_BYTES);
        if (per_cu < 1) per_cu = 1;
        (void)hipGetLastError();
        grid_blocks = cus * per_cu;
    }
    if (grid_blocks < 0) return;
    Params p{};
    for (int i = 0; i < 18; ++i) p.in[i] = (const float*)d_in[i];
    p.out = (float*)d_out; p.ws = (unsigned char*)d_ws;
    void* args[] = {&p};
    hipError_t e = hipLaunchCooperativeKernel((void*)fwd_megakernel, dim3(grid_blocks), dim3(NTHR), args, LDS_BYTES, stream);
    if (e != hipSuccess) fprintf(stderr, "cooperative launch failed: %s (grid %d)\n", hipGetErrorString(e), grid_blocks);
}
```

```cpp
#include <hip/hip_runtime.h>
#include <hip/hip_cooperative_groups.h>
#include <cstdio>
#include <cstdint>
namespace cg = cooperative_groups;

#define DI __device__ __forceinline__
#define LAS __attribute__((address_space(3)))
typedef unsigned short bf16_t;
typedef short bf16x8 __attribute__((ext_vector_type(8)));
typedef short s16x4 __attribute__((ext_vector_type(4)));
typedef float f32x4 __attribute__((ext_vector_type(4)));
typedef unsigned u32x4 __attribute__((ext_vector_type(4)));
typedef unsigned u32x2 __attribute__((ext_vector_type(2)));

constexpr int TT = 49152;
constexpr int TP = 32768;
constexpr int DM = 1024;
constexpr int INW = 3088;
constexpr int FF = 2816;
constexpr int NE = 16;
constexpr int SLOTS_E = 6144;
constexpr float ALPHA = 1.189207115002721f;
constexpr float LN_EPS = 1e-5f, RMS_EPS = 1e-5f;

constexpr size_t MiB = 1u << 20;
constexpr size_t TILE_ELEMS = (size_t)TT * 256;
constexpr size_t TILE_BYTES = TILE_ELEMS * 2;
constexpr size_t WS_WI = 0;
constexpr size_t WS_WO = 6 * MiB;
constexpr size_t WS_DT = 8 * MiB;
constexpr size_t WS_ROPE = 11 * MiB;
constexpr size_t WS_AFF = 12 * MiB;
constexpr size_t WS_IDX = 15 * MiB;
constexpr size_t WS_GATE = 15 * MiB + 512 * 1024;
constexpr size_t WS_P = 20 * MiB;
constexpr size_t WS_XC = 308 * MiB;
constexpr size_t WS_XB = 404 * MiB;
constexpr size_t WS_MIX = WS_XB;
constexpr size_t WS_YF = WS_P + 8 * TILE_BYTES;
constexpr size_t WS_YB = WS_P + 10 * TILE_BYTES;
constexpr size_t WS_INV = 16 * MiB;
constexpr size_t WS_WD = 20 * MiB;
constexpr size_t WS_WGU1 = 108 * MiB;
constexpr size_t WS_WGU0 = 196 * MiB;
constexpr size_t WS_EO = 212 * MiB;
constexpr size_t WS_X1B = 308 * MiB;
constexpr size_t WS_HID = 404 * MiB;
constexpr size_t WS_END = 668 * MiB;

constexpr int LDS_BYTES = 147456;
constexpr int NTHR = 512;

DI unsigned f2bf(float f) { unsigned u = __float_as_uint(f); return (u + 0x7fffu + ((u >> 16) & 1u)) >> 16; }
DI unsigned pk2(float lo, float hi) { return f2bf(lo) | (f2bf(hi) << 16); }
DI float bflo(unsigned u) { return __uint_as_float(u << 16); }
DI float bfhi(unsigned u) { return __uint_as_float(u & 0xffff0000u); }
DI float wave_sum(float v) {
#pragma unroll
    for (int o = 1; o < 64; o <<= 1) v += __shfl_xor(v, o);
    return v;
}
DI float silu_f(float x) { return x / (1.0f + __expf(-x)); }
#define LDS_WAIT() asm volatile("s_waitcnt lgkmcnt(0)" ::: "memory")

struct Params { const float* in[18]; float* out; unsigned char* ws; };

DI const float* xrow_ptr(const Params& p, int t) { return t < TP ? p.in[0] + (size_t)t * DM : p.in[1] + (size_t)(t - TP) * DM; }

namespace pg8 {
constexpr int BM = 256, BK = 64, HALF = 128, HTB = HALF * BK * 2, NXCD = 8, WGM = 8;
DI int lds_byte(int r, int c) { const int st = (r >> 4) * 2 + (c >> 5), rr = r & 15, cc = c & 31, ob = rr * 64 + cc * 2; return st * 1024 + (ob ^ (((ob >> 9) & 1) << 5)); }
DI void stage_rc(int b, int& R, int& C) { const int st = b / 1024, sb = b % 1024, swz = sb ^ (((sb >> 9) & 1) << 5); R = (st >> 1) * 16 + swz / 64; C = (st & 1) * 32 + (swz % 64) / 2; }
DI int perm32(int rho) { const int n = rho >> 4, i = rho & 15; return 8 * (i >> 2) + 4 * n + (i & 3); }

struct Unit { int pm, pn, bt; };

DI int xcd_remap(int L, int nwg) { const int q = nwg / NXCD, r = nwg % NXCD, xcd = L % NXCD, off = L / NXCD; return (xcd < r ? xcd * (q + 1) : r * (q + 1) + (xcd - r) * q) + off; }

struct SchedPlain {
    int nM, nN, nwg, G, c;
    DI void init(int M, int N, int G_, int c_) { nM = M / BM; nN = N / BM; nwg = nM * nN; G = G_; c = c_; }
    DI bool next(int i, Unit& u) const {
        const int L = i * G + c; if (L >= nwg) return false;
        const int wgid = xcd_remap(L, nwg);
        const int nig = WGM * nN, gid = wgid / nig, fm = gid * WGM, gsz = (nM - fm) < WGM ? (nM - fm) : WGM;
        u.pm = fm + ((wgid % nig) % gsz); u.pn = (wgid % nig) / gsz; u.bt = u.pn; return true;
    }
    DI int arow(const Unit& u, int r) const { return u.pm * BM + r; }
};
template <int NPN, bool GATHER> struct SchedGrouped {
    int G, c; const int* idx;
    DI bool next(int i, Unit& u) const {
        constexpr int PER_E = 24 * NPN, NWG = 8 * PER_E;
        const int L = i * G + c; if (L >= NWG) return false;
        const int wgid = xcd_remap(L, NWG);
        const int e = wgid / PER_E, rem = wgid % PER_E;
        const int gid = rem / (8 * NPN), w2 = rem % (8 * NPN);
        u.pm = e * 24 + gid * 8 + (w2 % 8); u.pn = w2 / 8; u.bt = e * NPN + u.pn; return true;
    }
    DI int arow(const Unit& u, int r) const { if (GATHER) return idx[u.pm * BM + r]; else return u.pm * BM + r; }
};

template <class Epi, class Sched>
DI void gemm_phase(LAS unsigned char* lds, const bf16_t* Ag, const bf16_t* Btg, const int K, const Sched& S, const Epi& E) {
    int tid_ = threadIdx.x; asm volatile("" : "+v"(tid_));
    const int tid = tid_, wid = __builtin_amdgcn_readfirstlane(tid >> 6), lane = tid & 63, wr = wid >> 2, wc = wid & 3, fr = lane & 15, fq = lane >> 4;
    const int nt = K / BK;
    int Rr[2], Cc[2]; unsigned voffB[2];
#pragma unroll
    for (int i = 0; i < 2; ++i) { int R, C; stage_rc(tid * 16 + i * 8192, R, C); const int Rb = Epi::PERM ? ((R & ~31) + perm32(R & 31)) : R;
        Rr[i] = R; Cc[i] = C; voffB[i] = (unsigned)(Rb * K + C) * 2u; }
    const unsigned rowbytes = (unsigned)K * 2u;
    const size_t kstep = (size_t)(BK * 2);
    const size_t hstep = (size_t)HALF * K * 2;
    const size_t tstep = 2 * hstep;
    const unsigned ldsw = (unsigned)wid * 1024u;
    const int aoff = lds_byte(wr * 64 + fr, fq * 8), boff = lds_byte(wc * 32 + fr, fq * 8);
#define PG8_SA(b, h) (((b) * 2 + (h)) * HTB)
#define PG8_SB(b, h) ((4 + (b) * 2 + (h)) * HTB)
#define PG8_STAGE(bufoff, gbase, voff) do { _Pragma("unroll") for (int _i = 0; _i < 2; ++_i) \
        __builtin_amdgcn_global_load_lds((const unsigned*)((const char*)(gbase) + (voff)[_i]), (LAS unsigned*)(lds + (bufoff) + ldsw + _i * 8192), 16, 0, 0); } while (0)
#define PG8_STAGEA(bufoff, o0, o1, kb) do { \
        __builtin_amdgcn_global_load_lds((const unsigned*)((const char*)Ag + (size_t)(o0) + (size_t)(kb)), (LAS unsigned*)(lds + (bufoff) + ldsw), 16, 0, 0); \
        __builtin_amdgcn_global_load_lds((const unsigned*)((const char*)Ag + (size_t)(o1) + (size_t)(kb)), (LAS unsigned*)(lds + (bufoff) + ldsw + 8192), 16, 0, 0); } while (0)
#define PG8_LDA(dst, b, h) do { _Pragma("unroll") for (int m = 0; m < 4; ++m) _Pragma("unroll") for (int k = 0; k < 2; ++k) dst[m][k] = *(const LAS bf16x8*)(lds + PG8_SA(b, h) + aoff + m * 2048 + k * 1024); } while (0)
#define PG8_LDB(dst, b, h) do { _Pragma("unroll") for (int n = 0; n < 2; ++n) _Pragma("unroll") for (int k = 0; k < 2; ++k) dst[n][k] = *(const LAS bf16x8*)(lds + PG8_SB(b, h) + boff + n * 2048 + k * 1024); } while (0)
#define PG8_MMA(ai, bj, At, Bt) do { __builtin_amdgcn_s_setprio(1); _Pragma("unroll") for (int m = 0; m < 4; ++m) _Pragma("unroll") for (int n = 0; n < 2; ++n) _Pragma("unroll") for (int k = 0; k < 2; ++k) \
        acc[ai][bj][m][n] = __builtin_amdgcn_mfma_f32_16x16x32_bf16(Bt[n][k], At[m][k], acc[ai][bj][m][n], 0, 0, 0); __builtin_amdgcn_s_setprio(0); } while (0)
#define PG8_WAIT_V(n) asm volatile("s_waitcnt vmcnt(" #n ")" ::: "memory")
#define PG8_WAIT_L(n) asm volatile("s_waitcnt lgkmcnt(" #n ")" ::: "memory")
#define PG8_BAR __builtin_amdgcn_s_barrier()
#define PG8_SCHED __builtin_amdgcn_sched_barrier(0)
#define PG8_OFFS(u, o00, o01, o10, o11) do { \
        o00 = (unsigned)S.arow(u, Rr[0]) * rowbytes + (unsigned)Cc[0] * 2u; o01 = (unsigned)S.arow(u, Rr[1]) * rowbytes + (unsigned)Cc[1] * 2u; \
        o10 = (unsigned)S.arow(u, HALF + Rr[0]) * rowbytes + (unsigned)Cc[0] * 2u; o11 = (unsigned)S.arow(u, HALF + Rr[1]) * rowbytes + (unsigned)Cc[1] * 2u; } while (0)
    Unit cur, nxt; int ui = 0;
    if (!S.next(0, cur)) return;
    f32x4 acc[2][2][4][2];
#pragma unroll
    for (int a = 0; a < 2; ++a)
#pragma unroll
        for (int b = 0; b < 2; ++b)
#pragma unroll
            for (int m = 0; m < 4; ++m)
#pragma unroll
                for (int n = 0; n < 2; ++n) acc[a][b][m][n] = (f32x4){0.f, 0.f, 0.f, 0.f};
    bf16x8 At[4][2], B0[2][2], B1[2][2];
    unsigned c00, c01, c10, c11;
    PG8_OFFS(cur, c00, c01, c10, c11);
    const char* cB = (const char*)Btg + (size_t)cur.bt * tstep;
    PG8_STAGE(PG8_SB(0, 0), cB, voffB); PG8_STAGE(PG8_SB(0, 1), cB + hstep, voffB); PG8_STAGEA(PG8_SA(0, 0), c00, c01, 0); PG8_STAGEA(PG8_SA(0, 1), c10, c11, 0);
    if (wr == 1) PG8_BAR;
    PG8_WAIT_V(2); PG8_BAR;
    PG8_STAGE(PG8_SB(1, 0), cB + kstep, voffB); PG8_STAGEA(PG8_SA(1, 0), c00, c01, kstep); PG8_STAGE(PG8_SB(1, 1), cB + hstep + kstep, voffB);
    PG8_WAIT_V(6); PG8_BAR;
    for (;;) {
        const bool has_next = S.next(ui + 1, nxt);
        const char* nB = has_next ? (const char*)Btg + (size_t)nxt.bt * tstep : cB;
        for (int t = 0; t < nt; t += 2) {
            const bool last = (t == nt - 2);
            const size_t kb1 = (size_t)(t + 1) * kstep;
            const size_t kb2 = last ? 0 : (size_t)(t + 2) * kstep, kb3 = kb2 + kstep;
            const char* b2 = last ? nB : cB + (size_t)(t + 2) * kstep; const char* b3 = b2 + kstep;
            PG8_LDB(B0, 0, 0); PG8_LDB(B1, 0, 1); PG8_SCHED; PG8_LDA(At, 0, 0); PG8_STAGEA(PG8_SA(1, 1), c10, c11, kb1);
            PG8_WAIT_V(8); PG8_WAIT_L(0); PG8_BAR; PG8_MMA(0, 0, At, B0); PG8_MMA(0, 1, At, B1); PG8_BAR; PG8_SCHED;
            if (last && has_next) { PG8_OFFS(nxt, c00, c01, c10, c11); }
            PG8_LDA(At, 0, 1); PG8_STAGE(PG8_SB(0, 0), b2, voffB); PG8_STAGE(PG8_SB(0, 1), b2 + hstep, voffB); PG8_STAGEA(PG8_SA(0, 0), c00, c01, kb2);
            PG8_WAIT_V(8); PG8_WAIT_L(0); PG8_BAR; PG8_MMA(1, 0, At, B0); PG8_MMA(1, 1, At, B1); PG8_BAR; PG8_SCHED;
            PG8_LDB(B0, 1, 0); PG8_LDB(B1, 1, 1); PG8_SCHED; PG8_LDA(At, 1, 0); PG8_STAGEA(PG8_SA(0, 1), c10, c11, kb2);
            PG8_WAIT_V(8); PG8_WAIT_L(0); PG8_BAR; PG8_MMA(0, 0, At, B0); PG8_MMA(0, 1, At, B1); PG8_BAR; PG8_SCHED;
            PG8_LDA(At, 1, 1); PG8_STAGE(PG8_SB(1, 0), b3, voffB); PG8_STAGE(PG8_SB(1, 1), b3 + hstep, voffB); PG8_STAGEA(PG8_SA(1, 0), c00, c01, kb3);
            PG8_WAIT_V(8); PG8_WAIT_L(0); PG8_BAR; PG8_MMA(1, 0, At, B0); PG8_MMA(1, 1, At, B1); PG8_BAR; PG8_SCHED;
        }
        if (wr == 0) PG8_BAR;
        E(acc, cur, wr, wc, fr, fq);
        if (!has_next) break;
#pragma unroll
        for (int a = 0; a < 2; ++a)
#pragma unroll
            for (int b = 0; b < 2; ++b)
#pragma unroll
                for (int m = 0; m < 4; ++m)
#pragma unroll
                    for (int n = 0; n < 2; ++n) acc[a][b][m][n] = (f32x4){0.f, 0.f, 0.f, 0.f};
        cur = nxt; cB = nB; ++ui;
        if (wr == 1) PG8_BAR;
    }
    PG8_WAIT_V(0);
    PG8_BAR;
#undef PG8_SA
#undef PG8_SB
#undef PG8_STAGE
#undef PG8_STAGEA
#undef PG8_LDA
#undef PG8_LDB
#undef PG8_MMA
#undef PG8_WAIT_V
#undef PG8_WAIT_L
#undef PG8_BAR
#undef PG8_SCHED
#undef PG8_OFFS
}

struct EpiProj {
    static constexpr bool PERM = true;
    bf16_t* P; const float* rope;
    DI void operator()(const f32x4 (&acc)[2][2][4][2], const Unit& u, int wr, int wc, int fr, int fq) const {
        bf16_t* base = P + (size_t)u.pn * TILE_ELEMS;
        const bool rot = (u.pn < 4) && ((wc & 1) == 0);
#pragma unroll
        for (int ai = 0; ai < 2; ++ai)
#pragma unroll
            for (int m = 0; m < 4; ++m) {
                const int row = u.pm * BM + ai * HALF + wr * 64 + m * 16 + fr;
                asm volatile("" ::: "memory");
                f32x4 cs0 = {1.f, 1.f, 1.f, 1.f}, cs1 = cs0, sn0 = {0.f, 0.f, 0.f, 0.f}, sn1 = sn0;
                if (rot && fq < 2) {
                    const int s = row < TP ? (row & 4095) : (row & 8191);
                    const f32x4* rp = (const f32x4*)(rope + (size_t)s * 16);
                    cs0 = rp[0]; cs1 = rp[1]; sn0 = rp[2]; sn1 = rp[3];
                    if (fq == 0) { sn0 = -sn0; sn1 = -sn1; }
                }
#pragma unroll
                for (int bj = 0; bj < 2; ++bj) {
                    f32x4 v0 = acc[ai][bj][m][0], v1 = acc[ai][bj][m][1];
                    if (rot) {
                        f32x4 o0, o1;
#pragma unroll
                        for (int j = 0; j < 4; ++j) { o0[j] = __shfl_xor(v0[j], 16); o1[j] = __shfl_xor(v1[j], 16); }
                        if (fq < 2) { v0 = v0 * cs0 + o0 * sn0; v1 = v1 * cs1 + o1 * sn1; }
                    }
                    u32x4 w; w.x = pk2(v0[0], v0[1]); w.y = pk2(v0[2], v0[3]); w.z = pk2(v1[0], v1[1]); w.w = pk2(v1[2], v1[3]);
                    *(u32x4*)(base + (size_t)row * 256 + bj * HALF + wc * 32 + 8 * fq) = w;
                }
            }
    }
};
struct EpiOut {
    static constexpr bool PERM = false;
    Params p;
    DI void operator()(const f32x4 (&acc)[2][2][4][2], const Unit& u, int wr, int wc, int fr, int fq) const {
#pragma unroll
        for (int ai = 0; ai < 2; ++ai)
#pragma unroll
            for (int m = 0; m < 4; ++m) {
                const int row = u.pm * BM + ai * HALF + wr * 64 + m * 16 + fr;
                const float* xr = xrow_ptr(p, row); float* orow = p.out + (size_t)row * DM;
#pragma unroll
                for (int bj = 0; bj < 2; ++bj)
#pragma unroll
                    for (int n = 0; n < 2; ++n) {
                        const int col = u.pn * BM + bj * HALF + wc * 32 + 16 * n + 4 * fq;
                        const f32x4 xv = *(const f32x4*)(xr + col);
                        *(f32x4*)(orow + col) = xv * ALPHA + acc[ai][bj][m][n];
                    }
            }
    }
};
struct EpiGU {
    static constexpr bool PERM = true;
    bf16_t* H;
    DI void operator()(const f32x4 (&acc)[2][2][4][2], const Unit& u, int wr, int wc, int fr, int fq) const {
#pragma unroll
        for (int ai = 0; ai < 2; ++ai)
#pragma unroll
            for (int m = 0; m < 4; ++m) {
                const int row = u.pm * BM + ai * HALF + wr * 64 + m * 16 + fr;
                const f32x4 g0 = acc[ai][0][m][0], g1 = acc[ai][0][m][1], u0 = acc[ai][1][m][0], u1 = acc[ai][1][m][1];
                f32x4 h0, h1;
#pragma unroll
                for (int j = 0; j < 4; ++j) { h0[j] = silu_f(g0[j]) * u0[j]; h1[j] = silu_f(g1[j]) * u1[j]; }
                u32x4 w; w.x = pk2(h0[0], h0[1]); w.y = pk2(h0[2], h0[3]); w.z = pk2(h1[0], h1[1]); w.w = pk2(h1[2], h1[3]);
                *(u32x4*)(H + (size_t)row * FF + u.pn * 128 + wc * 32 + 8 * fq) = w;
            }
    }
};
struct EpiDown {
    static constexpr bool PERM = true;
    bf16_t* eo; const float* gate;
    DI void operator()(const f32x4 (&acc)[2][2][4][2], const Unit& u, int wr, int wc, int fr, int fq) const {
#pragma unroll
        for (int ai = 0; ai < 2; ++ai)
#pragma unroll
            for (int m = 0; m < 4; ++m) {
                const int slot = u.pm * BM + ai * HALF + wr * 64 + m * 16 + fr;
                const float gv = gate[slot];
                bf16_t* orow = eo + (size_t)slot * DM + u.pn * BM + wc * 32 + 8 * fq;
#pragma unroll
                for (int bj = 0; bj < 2; ++bj) {
                    const f32x4 v0 = acc[ai][bj][m][0] * gv, v1 = acc[ai][bj][m][1] * gv;
                    u32x4 w; w.x = pk2(v0[0], v0[1]); w.y = pk2(v0[2], v0[3]); w.z = pk2(v1[0], v1[1]); w.w = pk2(v1[2], v1[3]);
                    *(u32x4*)(orow + bj * HALF) = w;
                }
            }
    }
};
}

DI void transpose_item(const float* W, int ldw, int k0, int n0, bf16_t* WT, int ldt, int drow0, LAS float* scr, int lane) {
#pragma unroll 8
    for (int i = 0; i < 32; ++i) { const int kk = 2 * i + (lane >> 5); scr[kk * 33 + (lane & 31)] = W[(size_t)(k0 + kk) * ldw + n0 + (lane & 31)]; }
    LDS_WAIT();
    const int c = lane & 7;
#pragma unroll
    for (int j = 0; j < 4; ++j) { const int n = (lane >> 3) + 8 * j; const LAS float* s = scr + (8 * c) * 33 + n;
        u32x4 o; o.x = pk2(s[0 * 33], s[1 * 33]); o.y = pk2(s[2 * 33], s[3 * 33]); o.z = pk2(s[4 * 33], s[5 * 33]); o.w = pk2(s[6 * 33], s[7 * 33]);
        *(u32x4*)(WT + (size_t)(drow0 + n) * ldt + k0 + 8 * c) = o; }
    LDS_WAIT();
}

DI void sincos_small(double r, double& s, double& c) {
    const double r2 = r * r; double ss = 1.0, cc = 1.0;
#pragma unroll
    for (int n = 12; n >= 1; --n) { ss = 1.0 - ss * r2 * (1.0 / (double)((2 * n) * (2 * n + 1))); cc = 1.0 - cc * r2 * (1.0 / (double)((2 * n - 1) * (2 * n))); }
    s = r * ss; c = cc;
}

DI void dot16(const f32x4 (&v)[4], const LAS float* wT, int lane, float (&r)[16]) {
#pragma unroll
    for (int e = 0; e < 16; ++e) {
        float a = 0.f;
        if ((e & 1) == 0) asm volatile("" ::: "memory");
#pragma unroll
        for (int j = 0; j < 4; ++j) { const f32x4 w = *(const LAS f32x4*)(wT + e * 1024 + 256 * j + 4 * lane); a += v[j][0] * w[0] + v[j][1] * w[1] + v[j][2] * w[2] + v[j][3] * w[3]; }
        r[e] = wave_sum(a);
    }
}

DI void phase0(const Params& p, LAS unsigned char* lds, int gw, int NGW, int wave, int lane) {
    const int tid = threadIdx.x;
    {
        LAS float* scr = (LAS float*)(lds + wave * 16384);
        for (int it = gw; it < 2048; it += NGW) {
            if (it < 1536) { const int kb = it / 96, nb = it % 96; transpose_item(p.in[2], INW, 64 * kb, 32 * nb, (bf16_t*)(p.ws + WS_WI), DM, 32 * nb, scr, lane); }
            else { const int r = it - 1536, kb = r / 32, nb = r % 32; transpose_item(p.in[9], DM, 64 * kb, 32 * nb, (bf16_t*)(p.ws + WS_WO), DM, 32 * nb, scr, lane); }
        }
    }
    {
        float* rope = (float*)(p.ws + WS_ROPE);
        const float invf[8] = {1.0f, 0.1939227432012558f, 0.03760603070259094f, 0.007292664609849453f, 0.0014142135623842478f, 0.00027424818836152554f, 5.318296098266728e-05f, 1.0313386155758053e-05f};
        for (int id = blockIdx.x * NTHR + tid; id < 8192 * 8; id += gridDim.x * NTHR) {
            const int pos = id >> 3, i = id & 7;
            float inv = invf[0];
#pragma unroll
            for (int k = 1; k < 8; ++k) inv = (i == k) ? invf[k] : inv;
            const float ang = (float)pos * inv;
            const double x = (double)ang; const double kq = rint(x * 0.15915494309189535); const double r = x - kq * 6.283185307179586476925;
            double s, c; sincos_small(r, s, c);
            rope[pos * 16 + i] = (float)c; rope[pos * 16 + 8 + i] = (float)s;
        }
    }
    __syncthreads();
    LAS float* wT = (LAS float*)lds;
    for (int id = tid; id < 16384; id += NTHR) { const int k = id >> 4, e = id & 15; wT[e * 1024 + k] = p.in[2][(size_t)k * INW + 3072 + e]; }
    __syncthreads();
    const float* dtb = p.in[5];
    float bias = 0.f;
    if (lane < 16) bias = dtb[lane];
    bf16_t* xb = (bf16_t*)(p.ws + WS_XB); float* dtout = (float*)(p.ws + WS_DT);
    for (int t = gw; t < TT; t += NGW) {
        const f32x4* xr = (const f32x4*)xrow_ptr(p, t) + lane;
        f32x4 v[4];
#pragma unroll
        for (int j = 0; j < 4; ++j) v[j] = xr[64 * j];
        u32x2* o8 = (u32x2*)(xb + (size_t)t * DM) + lane;
#pragma unroll
        for (int j = 0; j < 4; ++j) { u32x2 w; w.x = pk2(v[j][0], v[j][1]); w.y = pk2(v[j][2], v[j][3]); o8[64 * j] = w; }
        float r[16]; dot16(v, wT, lane, r);
        float mine = 0.f;
#pragma unroll
        for (int e = 0; e < 16; ++e) mine = (lane == e) ? r[e] : mine;
        if (lane < 16) { const float z = mine + bias; dtout[(size_t)t * 16 + lane] = fmaxf(z, 0.f) + log1pf(__expf(-fabsf(z))); }
    }
}

DI void conv_phase(const Params& p) {
    const int tid = blockIdx.x * NTHR + threadIdx.x, nthr = gridDim.x * NTHR;
    const int c = tid & 127, ch = 8 * c, tile = ch >> 8, cit = ch & 255;
    const float* cw = p.in[3]; const float* cb = p.in[4];
    float w[5][8], b[8];
#pragma unroll
    for (int j = 0; j < 5; ++j)
#pragma unroll
        for (int e = 0; e < 8; ++e) w[j][e] = cw[j * 1024 + ch + e];
#pragma unroll
    for (int e = 0; e < 8; ++e) b[e] = cb[ch + e];
    const bf16_t* src = (const bf16_t*)(p.ws + WS_P) + (size_t)(8 + tile) * TILE_ELEMS + cit;
    bf16_t* dst = (bf16_t*)(p.ws + WS_XC) + (size_t)tile * TILE_ELEMS + cit;
    for (int it = tid; it < TT * 128; it += nthr) {
        const int t = it >> 7;
        const int S = t < TP ? 4096 : 8192, s = t & (S - 1);
        float a[8];
#pragma unroll
        for (int e = 0; e < 8; ++e) a[e] = b[e];
#pragma unroll
        for (int j = 0; j < 5; ++j) {
            const int sj = s + j - 2;
            if (sj >= 0 && sj < S) {
                const u32x4 v = *(const u32x4*)(src + (size_t)(t + j - 2) * 256);
                a[0] += bflo(v.x) * w[j][0]; a[1] += bfhi(v.x) * w[j][1]; a[2] += bflo(v.y) * w[j][2]; a[3] += bfhi(v.y) * w[j][3];
                a[4] += bflo(v.z) * w[j][4]; a[5] += bfhi(v.z) * w[j][5]; a[6] += bflo(v.w) * w[j][6]; a[7] += bfhi(v.w) * w[j][7];
            }
        }
        u32x4 o; o.x = pk2(silu_f(a[0]), silu_f(a[1])); o.y = pk2(silu_f(a[2]), silu_f(a[3])); o.z = pk2(silu_f(a[4]), silu_f(a[5])); o.w = pk2(silu_f(a[6]), silu_f(a[7]));
        *(u32x4*)(dst + (size_t)t * 256) = o;
    }
}

DI void attn_phase(const Params& p, LAS unsigned char* lds, int gw, int NGW, int wave, int lane) {
    LAS bf16_t* Vt = (LAS bf16_t*)(lds + wave * 4608);
    const bf16_t* Pb = (const bf16_t*)(p.ws + WS_P);
    bf16_t* mix = (bf16_t*)(p.ws + WS_MIX);
    const int c = lane & 15, q = lane >> 4;
    for (int wi = gw; wi < 24576; wi += NGW) {
        const int head = wi & 7, qg = wi >> 3;
        const int t0 = (qg >> 4) * 256 + (qg & 15);
        const int S = t0 < TP ? 4096 : 8192, sbase = t0 & ~(S - 1), p0 = t0 - sbase;
        const int hoff = (head & 3) * 64;
        const bf16_t* Qt = Pb + (size_t)(0 + (head >> 2)) * TILE_ELEMS + hoff;
        const bf16_t* Kt = Pb + (size_t)(2 + (head >> 2)) * TILE_ELEMS + hoff;
        const bf16_t* Vg = Pb + (size_t)(4 + (head >> 2)) * TILE_ELEMS + hoff;
        bf16x8 qf[2];
        { const bf16_t* qrow = Qt + (size_t)(t0 + 16 * c) * 256; qf[0] = *(const bf16x8*)(qrow + 8 * q); qf[1] = *(const bf16x8*)(qrow + 32 + 8 * q); }
        f32x4 O[4];
#pragma unroll
        for (int d4 = 0; d4 < 4; ++d4) O[d4] = (f32x4){0.f, 0.f, 0.f, 0.f};
        float mrun = -1e30f, lsum = 0.f;
        const int pq = p0 + 16 * c;
        for (int pi = 0; pi < 3; ++pi) {
            const int d = 1 << (2 * pi);
            const int base = p0 - 64 * d, nk = 240 / d + 129, nst = (nk + 31) >> 5, win = 64 * d;
            for (int st = 0; st < nst; ++st) {
                const int kbase = 32 * st;
#pragma unroll
                for (int i = 0; i < 4; ++i) {
                    const int id = lane + 64 * i, key = id >> 3, dc = id & 7;
                    int pos = base + d * (kbase + key); pos = pos < 0 ? 0 : (pos > S - 1 ? S - 1 : pos);
                    const u32x4 v = *(const u32x4*)(Vg + (size_t)(sbase + pos) * 256 + 8 * dc);
                    LAS bf16_t* w = Vt + (8 * dc) * 36 + key;
                    w[0 * 36] = (bf16_t)(v.x & 0xffffu); w[1 * 36] = (bf16_t)(v.x >> 16); w[2 * 36] = (bf16_t)(v.y & 0xffffu); w[3 * 36] = (bf16_t)(v.y >> 16);
                    w[4 * 36] = (bf16_t)(v.z & 0xffffu); w[5 * 36] = (bf16_t)(v.z >> 16); w[6 * 36] = (bf16_t)(v.w & 0xffffu); w[7 * 36] = (bf16_t)(v.w >> 16);
                }
                f32x4 sc[2];
#pragma unroll
                for (int kt = 0; kt < 2; ++kt) {
                    int pos = base + d * (kbase + 16 * kt + c); pos = pos < 0 ? 0 : (pos > S - 1 ? S - 1 : pos);
                    const bf16_t* krow = Kt + (size_t)(sbase + pos) * 256;
                    const bf16x8 k0 = *(const bf16x8*)(krow + 8 * q), k1 = *(const bf16x8*)(krow + 32 + 8 * q);
                    f32x4 a = {0.f, 0.f, 0.f, 0.f};
                    a = __builtin_amdgcn_mfma_f32_16x16x32_bf16(k0, qf[0], a, 0, 0, 0);
                    a = __builtin_amdgcn_mfma_f32_16x16x32_bf16(k1, qf[1], a, 0, 0, 0);
                    sc[kt] = a;
                }
                bool valid[2][4]; float mloc = -1e30f;
#pragma unroll
                for (int kt = 0; kt < 2; ++kt)
#pragma unroll
                    for (int j = 0; j < 4; ++j) {
                        const int kk = kbase + 16 * kt + 4 * q + j, pk = base + d * kk;
                        int df = pk - pq; df = df < 0 ? -df : df;
                        valid[kt][j] = (kk < nk) && (pk >= 0) && (pk < S) && (df <= win);
                        const float sv = valid[kt][j] ? sc[kt][j] * 0.125f : -1e30f;
                        sc[kt][j] = sv; mloc = fmaxf(mloc, sv);
                    }
                mloc = fmaxf(mloc, __shfl_xor(mloc, 16)); mloc = fmaxf(mloc, __shfl_xor(mloc, 32));
                const float mnew = fmaxf(mrun, mloc), alpha = __expf(mrun - mnew);
                mrun = mnew;
                float ps = 0.f; float pv[2][4];
#pragma unroll
                for (int kt = 0; kt < 2; ++kt)
#pragma unroll
                    for (int j = 0; j < 4; ++j) { pv[kt][j] = valid[kt][j] ? __expf(sc[kt][j] - mnew) : 0.f; ps += pv[kt][j]; }
                lsum = lsum * alpha + ps;
#pragma unroll
                for (int d4 = 0; d4 < 4; ++d4) O[d4] = O[d4] * alpha;
                u32x4 pw; pw.x = pk2(pv[0][0], pv[0][1]); pw.y = pk2(pv[0][2], pv[0][3]); pw.z = pk2(pv[1][0], pv[1][1]); pw.w = pk2(pv[1][2], pv[1][3]);
                const bf16x8 pf = __builtin_bit_cast(bf16x8, pw);
#pragma unroll
                for (int d4 = 0; d4 < 4; ++d4) {
                    const LAS bf16_t* vr = Vt + (16 * d4 + c) * 36 + 4 * q;
                    const s16x4 lo = *(const LAS s16x4*)vr, hi = *(const LAS s16x4*)(vr + 16);
                    const bf16x8 vf = __builtin_shufflevector(lo, hi, 0, 1, 2, 3, 4, 5, 6, 7);
                    O[d4] = __builtin_amdgcn_mfma_f32_16x16x32_bf16(vf, pf, O[d4], 0, 0, 0);
                }
            }
        }
        lsum += __shfl_xor(lsum, 16); lsum += __shfl_xor(lsum, 32);
        const float inv = 1.0f / lsum;
        bf16_t* orow = mix + (size_t)(t0 + 16 * c) * DM + head * 64 + 4 * q;
#pragma unroll
        for (int d4 = 0; d4 < 4; ++d4) { u32x2 w; w.x = pk2(O[d4][0] * inv, O[d4][1] * inv); w.y = pk2(O[d4][2] * inv, O[d4][3] * inv); *(u32x2*)(orow + 16 * d4) = w; }
    }
}

constexpr int SSD_ACS = 0, SSD_DTS = 512, SSD_XT1 = 1024, SSD_XT2 = SSD_XT1 + 64 * 272, SSD_BT = SSD_XT2 + 64 * 272, SSD_SBF = SSD_BT + 128 * 272, SSD_END = SSD_SBF + 64 * 272;
static_assert(SSD_END <= 131072, "ssd lds");
DI void ssd_phase(const Params& p, LAS unsigned char* lds, int wave, int lane) {
    const int wk = blockIdx.x;
    if (wk >= 160) return;
    const int tid = threadIdx.x;
    const int seq = wk / 16, h = (wk >> 1) & 7, dir = wk & 1, g = h >> 2;
    const int S = seq < 8 ? 4096 : 8192, sbase = seq < 8 ? seq * 4096 : TP + (seq - 8) * 8192, nc = S / 128;
    const float A = -__expf(p.in[6][dir * 8 + h]);
    const float* dtg = (const float*)(p.ws + WS_DT) + dir * 8 + h;
    const bf16_t* XCb = (const bf16_t*)(p.ws + WS_XC);
    const bf16_t* Xg = XCb + (size_t)(h >> 2) * TILE_ELEMS + (h & 3) * 64;
    const bf16_t* Bg = XCb + 2 * TILE_ELEMS + g * 128;
    const bf16_t* Cg = XCb + 3 * TILE_ELEMS + g * 128;
    bf16_t* Y = (bf16_t*)(p.ws + (dir ? WS_YB : WS_YF)) + h * 64;
    LAS float* acs = (LAS float*)(lds + SSD_ACS); LAS float* dts = (LAS float*)(lds + SSD_DTS);
    LAS bf16_t* Xt1 = (LAS bf16_t*)(lds + SSD_XT1); LAS bf16_t* Xt2 = (LAS bf16_t*)(lds + SSD_XT2);
    LAS bf16_t* Bt = (LAS bf16_t*)(lds + SSD_BT); LAS bf16_t* Sbf = (LAS bf16_t*)(lds + SSD_SBF);
    for (int i = tid; i < 64 * 136 / 2; i += NTHR) ((LAS unsigned*)Sbf)[i] = 0u;
    const int c = lane & 15, q = lane >> 4, w = wave;
    f32x4 St[4];
#pragma unroll
    for (int pt = 0; pt < 4; ++pt) St[pt] = (f32x4){0.f, 0.f, 0.f, 0.f};
    for (int ci = 0; ci < nc; ++ci) {
        const int tb = dir ? sbase + S - 1 - 128 * ci : sbase + 128 * ci, ts = dir ? -1 : 1;
#define TOK(l) (tb + ts * (l))
        if (w == 0) {
            const float d0 = dtg[(size_t)TOK(2 * lane) * 16], d1 = dtg[(size_t)TOK(2 * lane + 1) * 16];
            const float v0 = d0 * A, v1 = d1 * A; float ps = v0 + v1;
#pragma unroll
            for (int o = 1; o < 64; o <<= 1) { const float t = __shfl_up(ps, o); if (lane >= o) ps += t; }
            acs[2 * lane] = ps - v1; acs[2 * lane + 1] = ps; dts[2 * lane] = d0; dts[2 * lane + 1] = d1;
        }
        __syncthreads();
        const float aend = acs[127];
#pragma unroll
        for (int i = 0; i < 2; ++i) {
            const int id = tid + NTHR * i, l = id >> 3, pc = id & 7;
            const u32x4 v = *(const u32x4*)(Xg + (size_t)TOK(l) * 256 + 8 * pc);
            const float s1 = dts[l], s2 = s1 * __expf(aend - acs[l]);
            float x[8] = {bflo(v.x), bfhi(v.x), bflo(v.y), bfhi(v.y), bflo(v.z), bfhi(v.z), bflo(v.w), bfhi(v.w)};
#pragma unroll
            for (int e = 0; e < 8; ++e) { Xt1[(8 * pc + e) * 136 + l] = (bf16_t)f2bf(x[e] * s1); Xt2[(8 * pc + e) * 136 + l] = (bf16_t)f2bf(x[e] * s2); }
        }
#pragma unroll
        for (int i = 0; i < 4; ++i) {
            const int id = tid + NTHR * i, l = id >> 4, ncn = id & 15;
            const u32x4 v = *(const u32x4*)(Bg + (size_t)TOK(l) * 256 + 8 * ncn);
            LAS bf16_t* wp = Bt + (8 * ncn) * 136 + l;
            wp[0 * 136] = (bf16_t)(v.x & 0xffffu); wp[1 * 136] = (bf16_t)(v.x >> 16); wp[2 * 136] = (bf16_t)(v.y & 0xffffu); wp[3 * 136] = (bf16_t)(v.y >> 16);
            wp[4 * 136] = (bf16_t)(v.z & 0xffffu); wp[5 * 136] = (bf16_t)(v.z >> 16); wp[6 * 136] = (bf16_t)(v.w & 0xffffu); wp[7 * 136] = (bf16_t)(v.w >> 16);
        }
        __syncthreads();
        {
            const int l = 16 * w + c;
            const float al = acs[l];
            bf16x8 Cf[4];
            { const bf16_t* cr = Cg + (size_t)TOK(l) * 256 + 8 * q;
#pragma unroll
              for (int ks = 0; ks < 4; ++ks) Cf[ks] = *(const bf16x8*)(cr + 32 * ks); }
            f32x4 acc[4];
#pragma unroll
            for (int pt = 0; pt < 4; ++pt) {
                f32x4 a = {0.f, 0.f, 0.f, 0.f};
#pragma unroll
                for (int ks = 0; ks < 4; ++ks) { const bf16x8 sf = *(const LAS bf16x8*)(Sbf + (16 * pt + c) * 136 + 32 * ks + 8 * q); a = __builtin_amdgcn_mfma_f32_16x16x32_bf16(sf, Cf[ks], a, 0, 0, 0); }
                acc[pt] = a * __expf(al);
            }
            const int nsp = (w >> 1) + 1;
            for (int sp = 0; sp < nsp; ++sp) {
                f32x4 M[2];
#pragma unroll
                for (int hh = 0; hh < 2; ++hh) {
                    const int st = 2 * sp + hh;
                    f32x4 G = {0.f, 0.f, 0.f, 0.f};
                    if (st <= w) {
                        const bf16_t* br = Bg + (size_t)TOK(16 * st + c) * 256 + 8 * q;
#pragma unroll
                        for (int ks = 0; ks < 4; ++ks) { const bf16x8 bfr = *(const bf16x8*)(br + 32 * ks); G = __builtin_amdgcn_mfma_f32_16x16x32_bf16(bfr, Cf[ks], G, 0, 0, 0); }
#pragma unroll
                        for (int j = 0; j < 4; ++j) { const int s = 16 * st + 4 * q + j; const float e = __expf(al - acs[s]); G[j] = (s <= l) ? G[j] * e : 0.f; }
                    }
                    M[hh] = G;
                }
                u32x4 pw; pw.x = pk2(M[0][0], M[0][1]); pw.y = pk2(M[0][2], M[0][3]); pw.z = pk2(M[1][0], M[1][1]); pw.w = pk2(M[1][2], M[1][3]);
                const bf16x8 pf = __builtin_bit_cast(bf16x8, pw);
#pragma unroll
                for (int pt = 0; pt < 4; ++pt) {
                    const LAS bf16_t* xr = Xt1 + (16 * pt + c) * 136 + 32 * sp + 4 * q;
                    const s16x4 lo = *(const LAS s16x4*)xr, hi = *(const LAS s16x4*)(xr + 16);
                    const bf16x8 xf = __builtin_shufflevector(lo, hi, 0, 1, 2, 3, 4, 5, 6, 7);
                    acc[pt] = __builtin_amdgcn_mfma_f32_16x16x32_bf16(xf, pf, acc[pt], 0, 0, 0);
                }
            }
            bf16_t* yr = Y + (size_t)TOK(l) * 512 + 4 * q;
#pragma unroll
            for (int pt = 0; pt < 4; ++pt) { u32x2 o; o.x = pk2(acc[pt][0], acc[pt][1]); o.y = pk2(acc[pt][2], acc[pt][3]); *(u32x2*)(yr + 16 * pt) = o; }
        }
        {
            const float dec = __expf(aend);
#pragma unroll
            for (int pt = 0; pt < 4; ++pt) {
                f32x4 a = St[pt] * dec;
#pragma unroll
                for (int ks = 0; ks < 4; ++ks) {
                    const bf16x8 xf = *(const LAS bf16x8*)(Xt2 + (16 * pt + c) * 136 + 32 * ks + 8 * q);
                    const bf16x8 bfr = *(const LAS bf16x8*)(Bt + (16 * w + c) * 136 + 32 * ks + 8 * q);
                    a = __builtin_amdgcn_mfma_f32_16x16x32_bf16(xf, bfr, a, 0, 0, 0);
                }
                St[pt] = a;
            }
        }
        __syncthreads();
#pragma unroll
        for (int pt = 0; pt < 4; ++pt)
#pragma unroll
            for (int j = 0; j < 4; ++j) Sbf[(16 * pt + 4 * q + j) * 136 + 16 * w + c] = (bf16_t)f2bf(St[pt][j]);
#undef TOK
    }
}

DI void gate_phase(const Params& p, int gw, int NGW, int lane) {
    const bf16_t* yf = (const bf16_t*)(p.ws + WS_YF); const bf16_t* yb = (const bf16_t*)(p.ws + WS_YB);
    const bf16_t* xh = (const bf16_t*)(p.ws + WS_XC) + (size_t)(lane >> 5) * TILE_ELEMS + (8 * lane & 255);
    const bf16_t* zt = (const bf16_t*)(p.ws + WS_P) + (size_t)(6 + (lane >> 5)) * TILE_ELEMS + (8 * lane & 255);
    bf16_t* mix = (bf16_t*)(p.ws + WS_MIX) + 512 + 8 * lane;
    const float D = p.in[7][lane >> 3];
    float nw[8];
#pragma unroll
    for (int e = 0; e < 8; ++e) nw[e] = p.in[8][8 * lane + e];
    for (int t = gw; t < TT; t += NGW) {
        const u32x4 a = *(const u32x4*)(yf + (size_t)t * 512 + 8 * lane), b = *(const u32x4*)(yb + (size_t)t * 512 + 8 * lane);
        const u32x4 x = *(const u32x4*)(xh + (size_t)t * 256), z = *(const u32x4*)(zt + (size_t)t * 256);
        float y[8];
        y[0] = (bflo(a.x) + bflo(b.x) + D * bflo(x.x)) * silu_f(bflo(z.x)); y[1] = (bfhi(a.x) + bfhi(b.x) + D * bfhi(x.x)) * silu_f(bfhi(z.x));
        y[2] = (bflo(a.y) + bflo(b.y) + D * bflo(x.y)) * silu_f(bflo(z.y)); y[3] = (bfhi(a.y) + bfhi(b.y) + D * bfhi(x.y)) * silu_f(bfhi(z.y));
        y[4] = (bflo(a.z) + bflo(b.z) + D * bflo(x.z)) * silu_f(bflo(z.z)); y[5] = (bfhi(a.z) + bfhi(b.z) + D * bfhi(x.z)) * silu_f(bfhi(z.z));
        y[6] = (bflo(a.w) + bflo(b.w) + D * bflo(x.w)) * silu_f(bflo(z.w)); y[7] = (bfhi(a.w) + bfhi(b.w) + D * bfhi(x.w)) * silu_f(bfhi(z.w));
        float ss = 0.f;
#pragma unroll
        for (int e = 0; e < 8; ++e) ss += y[e] * y[e];
        ss = wave_sum(ss);
        const float r = 1.0f / sqrtf(ss * (1.0f / 512.0f) + RMS_EPS);
        u32x4 o; o.x = pk2(y[0] * r * nw[0], y[1] * r * nw[1]); o.y = pk2(y[2] * r * nw[2], y[3] * r * nw[3]); o.z = pk2(y[4] * r * nw[4], y[5] * r * nw[5]); o.w = pk2(y[6] * r * nw[6], y[7] * r * nw[7]);
        *(u32x4*)(mix + (size_t)t * DM) = o;
    }
}

DI void expert_weights_phase(const Params& p, LAS unsigned char* lds, int gw, int NGW, int wave, int lane) {
    LAS float* scr = (LAS float*)(lds + wave * 16384);
    bf16_t* Wd = (bf16_t*)(p.ws + WS_WD);
    for (int it = gw; it < 16 * 4224; it += NGW) {
        const int e = it / 4224, r = it % 4224;
        if (r < 2816) {
            const int isup = r >= 1408, rr = isup ? r - 1408 : r, kb = rr / 88, nb = rr % 88, n0 = 32 * nb;
            const float* W = (isup ? p.in[14] : p.in[13]) + (size_t)e * DM * FF;
            bf16_t* Wgu = (bf16_t*)(p.ws + (e < 8 ? WS_WGU0 : WS_WGU1));
            transpose_item(W, FF, 64 * kb, n0, Wgu, DM, (e & 7) * 5632 + 256 * (n0 >> 7) + (n0 & 127) + (isup ? 128 : 0), scr, lane);
        } else {
            const int rr = r - 2816, kb = rr / 32, nb = rr % 32;
            transpose_item(p.in[15] + (size_t)e * FF * DM, DM, 64 * kb, 32 * nb, Wd, FF, e * 1024 + 32 * nb, scr, lane);
        }
    }
}

DI void ln1_router_phase(const Params& p, LAS unsigned char* lds, int gw, int NGW, int lane) {
    const int tid = threadIdx.x;
    LAS float* wT = (LAS float*)lds;
    for (int id = tid; id < 16384; id += NTHR) { const int k = id >> 4, e = id & 15; wT[e * 1024 + k] = p.in[12][id]; }
    __syncthreads();
    f32x4 gg[4], bb[4];
#pragma unroll
    for (int j = 0; j < 4; ++j) { gg[j] = ((const f32x4*)p.in[10])[64 * j + lane]; bb[j] = ((const f32x4*)p.in[11])[64 * j + lane]; }
    bf16_t* x1b = (bf16_t*)(p.ws + WS_X1B); float* aff = (float*)(p.ws + WS_AFF);
    for (int t = gw; t < TT; t += NGW) {
        f32x4* orow = (f32x4*)(p.out + (size_t)t * DM) + lane;
        f32x4 v[4]; float s = 0.f;
#pragma unroll
        for (int j = 0; j < 4; ++j) { v[j] = orow[64 * j]; s += (v[j][0] + v[j][1]) + (v[j][2] + v[j][3]); }
        const float mean = wave_sum(s) * (1.0f / DM); float s2 = 0.f;
#pragma unroll
        for (int j = 0; j < 4; ++j) { v[j] = v[j] - mean; s2 += (v[j][0] * v[j][0] + v[j][1] * v[j][1]) + (v[j][2] * v[j][2] + v[j][3] * v[j][3]); }
        const float rstd = 1.0f / sqrtf(wave_sum(s2) * (1.0f / DM) + LN_EPS);
        u32x2* o8 = (u32x2*)(x1b + (size_t)t * DM) + lane;
#pragma unroll
        for (int j = 0; j < 4; ++j) {
            v[j] = v[j] * rstd * gg[j] + bb[j];
            orow[64 * j] = v[j] * ALPHA;
            u32x2 w; w.x = pk2(v[j][0], v[j][1]); w.y = pk2(v[j][2], v[j][3]); o8[64 * j] = w;
        }
        float r[16]; dot16(v, wT, lane, r);
        float mx = r[0];
#pragma unroll
        for (int e = 1; e < 16; ++e) mx = fmaxf(mx, r[e]);
        float den = 0.f, mine = 0.f;
#pragma unroll
        for (int e = 0; e < 16; ++e) { const float ex = __expf(r[e] - mx); den += ex; mine = (lane == e) ? ex : mine; }
        if (lane < 16) aff[(size_t)lane * TT + t] = mine / den;
    }
}

DI void select_phase(const Params& p, LAS unsigned char* lds, int wave, int lane) {
    const int wk = blockIdx.x;
    if (wk >= 32) return;
    const int tid = threadIdx.x;
    const int trunk = wk >> 4, e = wk & 15;
    const int Tn = trunk ? 16384 : 32768, tbase = trunk ? TP : 0, cap = Tn / 8;
    const unsigned* col = (const unsigned*)(p.ws + WS_AFF) + (size_t)e * TT + tbase;
    LAS unsigned* hist = (LAS unsigned*)lds;
    LAS unsigned* ctl = (LAS unsigned*)(lds + 1024);
    LAS unsigned* wcnt = (LAS unsigned*)(lds + 2048);
    unsigned prefix = 0, remaining = (unsigned)cap;
    for (int pass = 0; pass < 4; ++pass) {
        const int shift = 24 - 8 * pass;
        for (int i = tid; i < 256; i += NTHR) hist[i] = 0u;
        __syncthreads();
        for (int i = tid; i < Tn; i += NTHR) {
            const unsigned bits = col[i];
            if (pass == 0 || (bits >> (shift + 8)) == prefix) atomicAdd((unsigned*)(hist + ((bits >> shift) & 255u)), 1u);
        }
        __syncthreads();
        if (tid == 0) {
            unsigned cum = 0; int b = 255;
            for (; b > 0; --b) { const unsigned hcnt = hist[b]; if (cum + hcnt >= remaining) break; cum += hcnt; }
            ctl[0] = (prefix << 8) | (unsigned)b; ctl[1] = remaining - cum;
        }
        __syncthreads();
        prefix = ctl[0]; remaining = ctl[1];
        __syncthreads();
    }
    const unsigned thr = prefix, need_eq = remaining;
    int* idx = (int*)(p.ws + WS_IDX) + e * SLOTS_E + (trunk ? 4096 : 0);
    int* inv = (int*)(p.ws + WS_INV) + (size_t)e * TT + tbase;
    const int slot0 = e * SLOTS_E + (trunk ? 4096 : 0);
    float* gate = (float*)(p.ws + WS_GATE) + e * SLOTS_E + (trunk ? 4096 : 0);
    unsigned sel_base = 0, eq_base = 0;
    for (int b0 = 0; b0 < Tn; b0 += NTHR) {
        const unsigned bits = col[b0 + tid];
        const bool gt = bits > thr, eq = bits == thr;
        const unsigned long long meq = __ballot(eq);
        const unsigned eq_before_w = (unsigned)__popcll(meq & ((1ull << lane) - 1ull));
        if (lane == 0) wcnt[wave] = (unsigned)__popcll(meq);
        __syncthreads();
        unsigned eq_off = 0, eq_tot = 0;
#pragma unroll
        for (int w2 = 0; w2 < 8; ++w2) { const unsigned cnt = wcnt[w2]; eq_off += (w2 < wave) ? cnt : 0u; eq_tot += cnt; }
        const bool sel = gt || (eq && (eq_base + eq_off + eq_before_w) < need_eq);
        const unsigned long long msel = __ballot(sel);
        const unsigned sel_before_w = (unsigned)__popcll(msel & ((1ull << lane) - 1ull));
        if (lane == 0) wcnt[8 + wave] = (unsigned)__popcll(msel);
        __syncthreads();
        unsigned sel_off = 0, sel_tot = 0;
#pragma unroll
        for (int w2 = 0; w2 < 8; ++w2) { const unsigned cnt = wcnt[8 + w2]; sel_off += (w2 < wave) ? cnt : 0u; sel_tot += cnt; }
        { const unsigned pos = sel_base + sel_off + sel_before_w; const bool ok = sel && pos < (unsigned)cap;
          if (ok) { idx[pos] = tbase + b0 + tid; gate[pos] = __uint_as_float(bits); }
          inv[b0 + tid] = ok ? slot0 + (int)pos : -1; }
        sel_base += sel_tot; eq_base += eq_tot;
        __syncthreads();
    }
}

DI void ln2_phase(const Params& p, int gw, int NGW, int lane) {
    f32x4 gg[4], bb[4];
#pragma unroll
    for (int j = 0; j < 4; ++j) { gg[j] = ((const f32x4*)p.in[16])[64 * j + lane]; bb[j] = ((const f32x4*)p.in[17])[64 * j + lane]; }
    const int* inv = (const int*)(p.ws + WS_INV); const bf16_t* eo = (const bf16_t*)(p.ws + WS_EO);
    for (int t = gw; t < TT; t += NGW) {
        f32x4* orow = (f32x4*)(p.out + (size_t)t * DM) + lane;
        f32x4 v[4]; float s = 0.f;
#pragma unroll
        for (int j = 0; j < 4; ++j) v[j] = orow[64 * j];
        const int myslot = lane < 16 ? inv[(size_t)lane * TT + t] : -1;
        for (int e = 0; e < 16; ++e) {
            const int sl = __shfl(myslot, e);
            if (sl >= 0) {
                const u32x2* er = (const u32x2*)(eo + (size_t)sl * DM) + lane;
#pragma unroll
                for (int j = 0; j < 4; ++j) { const u32x2 w = er[64 * j]; v[j][0] += bflo(w.x); v[j][1] += bfhi(w.x); v[j][2] += bflo(w.y); v[j][3] += bfhi(w.y); }
            }
        }
#pragma unroll
        for (int j = 0; j < 4; ++j) s += (v[j][0] + v[j][1]) + (v[j][2] + v[j][3]);
        const float mean = wave_sum(s) * (1.0f / DM); float s2 = 0.f;
#pragma unroll
        for (int j = 0; j < 4; ++j) { v[j] = v[j] - mean; s2 += (v[j][0] * v[j][0] + v[j][1] * v[j][1]) + (v[j][2] * v[j][2] + v[j][3] * v[j][3]); }
        const float rstd = 1.0f / sqrtf(wave_sum(s2) * (1.0f / DM) + LN_EPS);
#pragma unroll
        for (int j = 0; j < 4; ++j) orow[64 * j] = v[j] * rstd * gg[j] + bb[j];
    }
}

__global__ void __launch_bounds__(NTHR, 2) fwd_megakernel(Params p) {
    extern __shared__ __attribute__((aligned(16))) unsigned char lds_raw[];
    LAS unsigned char* lds = (LAS unsigned char*)lds_raw;
    cg::grid_group grid = cg::this_grid();
#define IDS() int tid_ = threadIdx.x; asm volatile("" : "+v"(tid_)); const int lane = tid_ & 63, wave = __builtin_amdgcn_readfirstlane(tid_ >> 6); \
    const int G = gridDim.x, gw = blockIdx.x * 8 + wave, NGW = G * 8; (void)lane; (void)gw; (void)NGW; (void)G;
    { IDS(); phase0(p, lds, gw, NGW, wave, lane); }
    grid.sync();
    {
        IDS();
        pg8::SchedPlain S; S.init(TT, 3072, G, (int)blockIdx.x);
        pg8::EpiProj E{(bf16_t*)(p.ws + WS_P), (const float*)(p.ws + WS_ROPE)};
        pg8::gemm_phase<pg8::EpiProj, pg8::SchedPlain>(lds, (const bf16_t*)(p.ws + WS_XB), (const bf16_t*)(p.ws + WS_WI), DM, S, E);
    }
    grid.sync();
    conv_phase(p);
    { IDS(); attn_phase(p, lds, gw, NGW, wave, lane); }
    grid.sync();
    { IDS(); ssd_phase(p, lds, wave, lane); }
    grid.sync();
    { IDS(); gate_phase(p, gw, NGW, lane); }
    grid.sync();
    { IDS(); expert_weights_phase(p, lds, gw, NGW, wave, lane); }
    __syncthreads();
    {
        IDS();
        pg8::SchedPlain S; S.init(TT, DM, G, (int)blockIdx.x);
        pg8::EpiOut E{p};
        pg8::gemm_phase<pg8::EpiOut, pg8::SchedPlain>(lds, (const bf16_t*)(p.ws + WS_MIX), (const bf16_t*)(p.ws + WS_WO), DM, S, E);
    }
    grid.sync();
    { IDS(); ln1_router_phase(p, lds, gw, NGW, lane); }
    grid.sync();
    { IDS(); select_phase(p, lds, wave, lane); }
    grid.sync();
#pragma unroll 1
    for (int rnd = 0; rnd < 2; ++rnd) {
        {
            IDS();
            const int* idx = (const int*)(p.ws + WS_IDX) + rnd * 8 * SLOTS_E;
            pg8::SchedGrouped<22, true> S{G, (int)blockIdx.x, idx};
            pg8::EpiGU E{(bf16_t*)(p.ws + WS_HID)};
            pg8::gemm_phase<pg8::EpiGU, pg8::SchedGrouped<22, true>>(lds, (const bf16_t*)(p.ws + WS_X1B), (const bf16_t*)(p.ws + (rnd ? WS_WGU1 : WS_WGU0)), DM, S, E);
        }
        grid.sync();
        {
            IDS();
            const int* idx = (const int*)(p.ws + WS_IDX) + rnd * 8 * SLOTS_E;
            const float* gate = (const float*)(p.ws + WS_GATE) + rnd * 8 * SLOTS_E;
            pg8::SchedGrouped<4, false> S{G, (int)blockIdx.x, idx};
            pg8::EpiDown E{(bf16_t*)(p.ws + WS_EO) + (size_t)rnd * 8 * SLOTS_E * DM, gate};
            pg8::gemm_phase<pg8::EpiDown, pg8::SchedGrouped<4, false>>(lds, (const bf16_t*)(p.ws + WS_HID), (const bf16_t*)(p.ws + WS_WD) + (size_t)rnd * 8 * 1024 * FF, FF, S, E);
        }
        grid.sync();
    }
    { IDS(); ln2_phase(p, gw, NGW, lane); }
#undef IDS
}

extern "C" void kernel_launch(void* const* d_in, const int* in_sizes, int n_in, void* d_out, int out_size, void* d_ws, size_t ws_size, hipStream_t stream) {
    static int grid_blocks = 0;
    if (grid_blocks == 0) {
        if (n_in != 18 || ws_size < WS_END || out_size != TT * DM) { fprintf(stderr, "kernel_launch: unexpected shapes (n_in %d out %d ws %zu)\n", n_in, out_size, ws_size); grid_blocks = -1; return; }
        int dev = 0, cus = 0, per_cu = 0;
        hipGetDevice(&dev);
        hipDeviceGetAttribute(&cus, hipDeviceAttributeMultiprocessorCount, dev);
        if (hipFuncSetAttribute((const void*)fwd_megakernel, hipFuncAttributeMaxDynamicSharedMemorySize, LDS_BYTES) != hipSuccess) { fprintf(stderr, "kernel_launch: hipFuncSetAttribute failed\n"); }
        hipOccupancyMaxActiveBlocksPerMultiprocessor(&per_cu, (const void*)fwd_megakernel, NTHR, LDS_BYTES);
        if (per_cu < 1) per_cu = 1;
        (void)hipGetLastError();
        grid_blocks = cus * per_cu;
    }
    if (grid_blocks < 0) return;
    Params p{};
    for (int i = 0; i < 18; ++i) p.in[i] = (const float*)d_in[i];
    p.out = (float*)d_out; p.ws = (unsigned char*)d_ws;
    void* args[] = {&p};
    hipError_t e = hipLaunchCooperativeKernel((void*)fwd_megakernel, dim3(grid_blocks), dim3(NTHR), args, LDS_BYTES, stream);
    if (e != hipSuccess) fprintf(stderr, "cooperative launch failed: %s (grid %d)\n", hipGetErrorString(e), grid_blocks);
}
```

```cpp
#include <hip/hip_runtime.h>
#include <hip/hip_cooperative_groups.h>
#include <cstdio>
#include <cstdint>
namespace cg = cooperative_groups;

#define DI __device__ __forceinline__
#define LAS __attribute__((address_space(3)))
typedef unsigned short bf16_t;
typedef short bf16x8 __attribute__((ext_vector_type(8)));
typedef short s16x4 __attribute__((ext_vector_type(4)));
typedef float f32x4 __attribute__((ext_vector_type(4)));
typedef unsigned u32x4 __attribute__((ext_vector_type(4)));
typedef unsigned u32x2 __attribute__((ext_vector_type(2)));

constexpr int TT = 49152;
constexpr int TP = 32768;
constexpr int DM = 1024;
constexpr int INW = 3088;
constexpr int FF = 2816;
constexpr int NE = 16;
constexpr int SLOTS_E = 6144;
constexpr float ALPHA = 1.189207115002721f;
constexpr float LN_EPS = 1e-5f, RMS_EPS = 1e-5f;

constexpr size_t MiB = 1u << 20;
constexpr size_t TILE_ELEMS = (size_t)TT * 256;
constexpr size_t TILE_BYTES = TILE_ELEMS * 2;
constexpr size_t WS_WI = 0;
constexpr size_t WS_WO = 6 * MiB;
constexpr size_t WS_DT = 8 * MiB;
constexpr size_t WS_ROPE = 11 * MiB;
constexpr size_t WS_AFF = 12 * MiB;
constexpr size_t WS_IDX = 15 * MiB;
constexpr size_t WS_GATE = 15 * MiB + 512 * 1024;
constexpr size_t WS_P = 20 * MiB;
constexpr size_t WS_XC = 308 * MiB;
constexpr size_t WS_XB = 404 * MiB;
constexpr size_t WS_MIX = WS_XB;
constexpr size_t WS_YF = WS_P + 8 * TILE_BYTES;
constexpr size_t WS_YB = WS_P + 10 * TILE_BYTES;
constexpr size_t WS_INV = 16 * MiB;
constexpr size_t WS_WD = 20 * MiB;
constexpr size_t WS_WGU1 = 108 * MiB;
constexpr size_t WS_WGU0 = 196 * MiB;
constexpr size_t WS_EO = 212 * MiB;
constexpr size_t WS_X1B = 308 * MiB;
constexpr size_t WS_HID = 404 * MiB;
constexpr size_t WS_END = 668 * MiB;

constexpr int LDS_BYTES = 147456;
constexpr int NTHR = 512;

DI unsigned f2bf(float f) { unsigned u = __float_as_uint(f); return (u + 0x7fffu + ((u >> 16) & 1u)) >> 16; }
DI unsigned pk2(float lo, float hi) { return f2bf(lo) | (f2bf(hi) << 16); }
DI float bflo(unsigned u) { return __uint_as_float(u << 16); }
DI float bfhi(unsigned u) { return __uint_as_float(u & 0xffff0000u); }
DI float wave_sum(float v) {
#pragma unroll
    for (int o = 1; o < 64; o <<= 1) v += __shfl_xor(v, o);
    return v;
}
DI void st_tr8_pair(LAS bf16_t* base, int stride, int colpair, int lane, const u32x4 v) {
    const unsigned px = __shfl_xor(v.x, 1), py = __shfl_xor(v.y, 1), pz = __shfl_xor(v.z, 1), pw = __shfl_xor(v.w, 1);
    const bool odd = (lane & 1) != 0;
    const unsigned d0 = odd ? ((px >> 16) | (v.x & 0xffff0000u)) : ((v.x & 0xffffu) | (px << 16));
    const unsigned d1 = odd ? ((py >> 16) | (v.y & 0xffff0000u)) : ((v.y & 0xffffu) | (py << 16));
    const unsigned d2 = odd ? ((pz >> 16) | (v.z & 0xffff0000u)) : ((v.z & 0xffffu) | (pz << 16));
    const unsigned d3 = odd ? ((pw >> 16) | (v.w & 0xffff0000u)) : ((v.w & 0xffffu) | (pw << 16));
    LAS unsigned* wp = (LAS unsigned*)(base + (odd ? stride : 0)) + colpair;
    wp[0] = d0; wp[stride] = d1; wp[2 * stride] = d2; wp[3 * stride] = d3;
}
DI float silu_f(float x) { return x / (1.0f + __expf(-x)); }
#define LDS_WAIT() asm volatile("s_waitcnt lgkmcnt(0)" ::: "memory")

struct Params { const float* in[18]; float* out; unsigned char* ws; };

DI const float* xrow_ptr(const Params& p, int t) { return t < TP ? p.in[0] + (size_t)t * DM : p.in[1] + (size_t)(t - TP) * DM; }

namespace pg8 {
constexpr int BM = 256, BK = 64, HALF = 128, HTB = HALF * BK * 2, NXCD = 8, WGM = 8;
DI int lds_byte(int r, int c) { const int st = (r >> 4) * 2 + (c >> 5), rr = r & 15, cc = c & 31, ob = rr * 64 + cc * 2; return st * 1024 + (ob ^ (((ob >> 9) & 1) << 5)); }
DI void stage_rc(int b, int& R, int& C) { const int st = b / 1024, sb = b % 1024, swz = sb ^ (((sb >> 9) & 1) << 5); R = (st >> 1) * 16 + swz / 64; C = (st & 1) * 32 + (swz % 64) / 2; }
DI int perm32(int rho) { const int n = rho >> 4, i = rho & 15; return 8 * (i >> 2) + 4 * n + (i & 3); }

struct Unit { int pm, pn, bt; };

DI int xcd_remap(int L, int nwg) { const int q = nwg / NXCD, r = nwg % NXCD, xcd = L % NXCD, off = L / NXCD; return (xcd < r ? xcd * (q + 1) : r * (q + 1) + (xcd - r) * q) + off; }

struct SchedPlain {
    int nM, nN, nwg, G, c;
    DI void init(int M, int N, int G_, int c_) { nM = M / BM; nN = N / BM; nwg = nM * nN; G = G_; c = c_; }
    DI bool next(int i, Unit& u) const {
        const int L = i * G + c; if (L >= nwg) return false;
        const int wgid = xcd_remap(L, nwg);
        const int nig = WGM * nN, gid = wgid / nig, fm = gid * WGM, gsz = (nM - fm) < WGM ? (nM - fm) : WGM;
        u.pm = fm + ((wgid % nig) % gsz); u.pn = (wgid % nig) / gsz; u.bt = u.pn; return true;
    }
    DI int arow(const Unit& u, int r) const { return u.pm * BM + r; }
};
template <int NPN, bool GATHER> struct SchedGrouped {
    int G, c; const int* idx;
    DI bool next(int i, Unit& u) const {
        constexpr int PER_E = 24 * NPN, NWG = 8 * PER_E;
        const int L = i * G + c; if (L >= NWG) return false;
        const int wgid = xcd_remap(L, NWG);
        const int e = wgid / PER_E, rem = wgid % PER_E;
        const int gid = rem / (8 * NPN), w2 = rem % (8 * NPN);
        u.pm = e * 24 + gid * 8 + (w2 % 8); u.pn = w2 / 8; u.bt = e * NPN + u.pn; return true;
    }
    DI int arow(const Unit& u, int r) const { if (GATHER) return idx[u.pm * BM + r]; else return u.pm * BM + r; }
};

template <class Epi, class Sched>
DI void gemm_phase(LAS unsigned char* lds, const bf16_t* Ag, const bf16_t* Btg, const int K, const Sched& S, const Epi& E) {
    int tid_ = threadIdx.x; asm volatile("" : "+v"(tid_));
    const int tid = tid_, wid = __builtin_amdgcn_readfirstlane(tid >> 6), lane = tid & 63, wr = wid >> 2, wc = wid & 3, fr = lane & 15, fq = lane >> 4;
    const int nt = K / BK;
    int Rr[2], Cc[2]; unsigned voffB[2];
#pragma unroll
    for (int i = 0; i < 2; ++i) { int R, C; stage_rc(tid * 16 + i * 8192, R, C); const int Rb = Epi::PERM ? ((R & ~31) + perm32(R & 31)) : R;
        Rr[i] = R; Cc[i] = C; voffB[i] = (unsigned)(Rb * K + C) * 2u; }
    const unsigned rowbytes = (unsigned)K * 2u;
    const size_t kstep = (size_t)(BK * 2);
    const size_t hstep = (size_t)HALF * K * 2;
    const size_t tstep = 2 * hstep;
    const unsigned ldsw = (unsigned)wid * 1024u;
    const int aoff = lds_byte(wr * 64 + fr, fq * 8), boff = lds_byte(wc * 32 + fr, fq * 8);
#define PG8_SA(b, h) (((b) * 2 + (h)) * HTB)
#define PG8_SB(b, h) ((4 + (b) * 2 + (h)) * HTB)
#define PG8_STAGE(bufoff, gbase, voff) do { _Pragma("unroll") for (int _i = 0; _i < 2; ++_i) \
        __builtin_amdgcn_global_load_lds((const unsigned*)((const char*)(gbase) + (voff)[_i]), (LAS unsigned*)(lds + (bufoff) + ldsw + _i * 8192), 16, 0, 0); } while (0)
#define PG8_STAGEA(bufoff, o0, o1, kb) do { \
        __builtin_amdgcn_global_load_lds((const unsigned*)((const char*)Ag + (size_t)(o0) + (size_t)(kb)), (LAS unsigned*)(lds + (bufoff) + ldsw), 16, 0, 0); \
        __builtin_amdgcn_global_load_lds((const unsigned*)((const char*)Ag + (size_t)(o1) + (size_t)(kb)), (LAS unsigned*)(lds + (bufoff) + ldsw + 8192), 16, 0, 0); } while (0)
#define PG8_LDA(dst, b, h) do { _Pragma("unroll") for (int m = 0; m < 4; ++m) _Pragma("unroll") for (int k = 0; k < 2; ++k) dst[m][k] = *(const LAS bf16x8*)(lds + PG8_SA(b, h) + aoff + m * 2048 + k * 1024); } while (0)
#define PG8_LDB(dst, b, h) do { _Pragma("unroll") for (int n = 0; n < 2; ++n) _Pragma("unroll") for (int k = 0; k < 2; ++k) dst[n][k] = *(const LAS bf16x8*)(lds + PG8_SB(b, h) + boff + n * 2048 + k * 1024); } while (0)
#define PG8_MMA(ai, bj, At, Bt) do { __builtin_amdgcn_s_setprio(1); _Pragma("unroll") for (int m = 0; m < 4; ++m) _Pragma("unroll") for (int n = 0; n < 2; ++n) _Pragma("unroll") for (int k = 0; k < 2; ++k) \
        acc[ai][bj][m][n] = __builtin_amdgcn_mfma_f32_16x16x32_bf16(Bt[n][k], At[m][k], acc[ai][bj][m][n], 0, 0, 0); __builtin_amdgcn_s_setprio(0); } while (0)
#define PG8_WAIT_V(n) asm volatile("s_waitcnt vmcnt(" #n ")" ::: "memory")
#define PG8_WAIT_L(n) asm volatile("s_waitcnt lgkmcnt(" #n ")" ::: "memory")
#define PG8_BAR __builtin_amdgcn_s_barrier()
#define PG8_SCHED __builtin_amdgcn_sched_barrier(0)
#define PG8_OFFS(u, o00, o01, o10, o11) do { \
        o00 = (unsigned)S.arow(u, Rr[0]) * rowbytes + (unsigned)Cc[0] * 2u; o01 = (unsigned)S.arow(u, Rr[1]) * rowbytes + (unsigned)Cc[1] * 2u; \
        o10 = (unsigned)S.arow(u, HALF + Rr[0]) * rowbytes + (unsigned)Cc[0] * 2u; o11 = (unsigned)S.arow(u, HALF + Rr[1]) * rowbytes + (unsigned)Cc[1] * 2u; } while (0)
    Unit cur, nxt; int ui = 0;
    if (!S.next(0, cur)) return;
    f32x4 acc[2][2][4][2];
#pragma unroll
    for (int a = 0; a < 2; ++a)
#pragma unroll
        for (int b = 0; b < 2; ++b)
#pragma unroll
            for (int m = 0; m < 4; ++m)
#pragma unroll
                for (int n = 0; n < 2; ++n) acc[a][b][m][n] = (f32x4){0.f, 0.f, 0.f, 0.f};
    bf16x8 At[4][2], B0[2][2], B1[2][2];
    unsigned c00, c01, c10, c11;
    PG8_OFFS(cur, c00, c01, c10, c11);
    const char* cB = (const char*)Btg + (size_t)cur.bt * tstep;
    PG8_STAGE(PG8_SB(0, 0), cB, voffB); PG8_STAGE(PG8_SB(0, 1), cB + hstep, voffB); PG8_STAGEA(PG8_SA(0, 0), c00, c01, 0); PG8_STAGEA(PG8_SA(0, 1), c10, c11, 0);
    if (wr == 1) PG8_BAR;
    PG8_WAIT_V(2); PG8_BAR;
    PG8_STAGE(PG8_SB(1, 0), cB + kstep, voffB); PG8_STAGEA(PG8_SA(1, 0), c00, c01, kstep); PG8_STAGE(PG8_SB(1, 1), cB + hstep + kstep, voffB);
    PG8_WAIT_V(6); PG8_BAR;
    for (;;) {
        const bool has_next = S.next(ui + 1, nxt);
        const char* nB = has_next ? (const char*)Btg + (size_t)nxt.bt * tstep : cB;
        for (int t = 0; t < nt; t += 2) {
            const bool last = (t == nt - 2);
            const size_t kb1 = (size_t)(t + 1) * kstep;
            const size_t kb2 = last ? 0 : (size_t)(t + 2) * kstep, kb3 = kb2 + kstep;
            const char* b2 = last ? nB : cB + (size_t)(t + 2) * kstep; const char* b3 = b2 + kstep;
            PG8_LDB(B0, 0, 0); PG8_LDB(B1, 0, 1); PG8_SCHED; PG8_LDA(At, 0, 0); PG8_STAGEA(PG8_SA(1, 1), c10, c11, kb1);
            PG8_WAIT_V(8); PG8_WAIT_L(0); PG8_BAR; PG8_MMA(0, 0, At, B0); PG8_MMA(0, 1, At, B1); PG8_BAR; PG8_SCHED;
            if (last && has_next) { PG8_OFFS(nxt, c00, c01, c10, c11); }
            PG8_LDA(At, 0, 1); PG8_STAGE(PG8_SB(0, 0), b2, voffB); PG8_STAGE(PG8_SB(0, 1), b2 + hstep, voffB); PG8_STAGEA(PG8_SA(0, 0), c00, c01, kb2);
            PG8_WAIT_V(8); PG8_WAIT_L(0); PG8_BAR; PG8_MMA(1, 0, At, B0); PG8_MMA(1, 1, At, B1); PG8_BAR; PG8_SCHED;
            PG8_LDB(B0, 1, 0); PG8_LDB(B1, 1, 1); PG8_SCHED; PG8_LDA(At, 1, 0); PG8_STAGEA(PG8_SA(0, 1), c10, c11, kb2);
            PG8_WAIT_V(8); PG8_WAIT_L(0); PG8_BAR; PG8_MMA(0, 0, At, B0); PG8_MMA(0, 1, At, B1); PG8_BAR; PG8_SCHED;
            PG8_LDA(At, 1, 1); PG8_STAGE(PG8_SB(1, 0), b3, voffB); PG8_STAGE(PG8_SB(1, 1), b3 + hstep, voffB); PG8_STAGEA(PG8_SA(1, 0), c00, c01, kb3);
            PG8_WAIT_V(8); PG8_WAIT_L(0); PG8_BAR; PG8_MMA(1, 0, At, B0); PG8_MMA(1, 1, At, B1); PG8_BAR; PG8_SCHED;
        }
        if (wr == 0) PG8_BAR;
        E(acc, cur, wr, wc, fr, fq);
        if (!has_next) break;
#pragma unroll
        for (int a = 0; a < 2; ++a)
#pragma unroll
            for (int b = 0; b < 2; ++b)
#pragma unroll
                for (int m = 0; m < 4; ++m)
#pragma unroll
                    for (int n = 0; n < 2; ++n) acc[a][b][m][n] = (f32x4){0.f, 0.f, 0.f, 0.f};
        cur = nxt; cB = nB; ++ui;
        if (wr == 1) PG8_BAR;
    }
    PG8_WAIT_V(0);
    PG8_BAR;
#undef PG8_SA
#undef PG8_SB
#undef PG8_STAGE
#undef PG8_STAGEA
#undef PG8_LDA
#undef PG8_LDB
#undef PG8_MMA
#undef PG8_WAIT_V
#undef PG8_WAIT_L
#undef PG8_BAR
#undef PG8_SCHED
#undef PG8_OFFS
}

struct EpiProj {
    static constexpr bool PERM = true;
    bf16_t* P; const float* rope;
    DI void operator()(const f32x4 (&acc)[2][2][4][2], const Unit& u, int wr, int wc, int fr, int fq) const {
        bf16_t* base = P + (size_t)u.pn * TILE_ELEMS;
        const bool rot = (u.pn < 4) && ((wc & 1) == 0);
#pragma unroll
        for (int ai = 0; ai < 2; ++ai)
#pragma unroll
            for (int m = 0; m < 4; ++m) {
                const int row = u.pm * BM + ai * HALF + wr * 64 + m * 16 + fr;
                asm volatile("" ::: "memory");
                f32x4 cs0 = {1.f, 1.f, 1.f, 1.f}, cs1 = cs0, sn0 = {0.f, 0.f, 0.f, 0.f}, sn1 = sn0;
                if (rot && fq < 2) {
                    const int s = row < TP ? (row & 4095) : (row & 8191);
                    const f32x4* rp = (const f32x4*)(rope + (size_t)s * 16);
                    cs0 = rp[0]; cs1 = rp[1]; sn0 = rp[2]; sn1 = rp[3];
                    if (fq == 0) { sn0 = -sn0; sn1 = -sn1; }
                }
#pragma unroll
                for (int bj = 0; bj < 2; ++bj) {
                    f32x4 v0 = acc[ai][bj][m][0], v1 = acc[ai][bj][m][1];
                    if (rot) {
                        f32x4 o0, o1;
#pragma unroll
                        for (int j = 0; j < 4; ++j) { o0[j] = __shfl_xor(v0[j], 16); o1[j] = __shfl_xor(v1[j], 16); }
                        if (fq < 2) { v0 = v0 * cs0 + o0 * sn0; v1 = v1 * cs1 + o1 * sn1; }
                    }
                    u32x4 w; w.x = pk2(v0[0], v0[1]); w.y = pk2(v0[2], v0[3]); w.z = pk2(v1[0], v1[1]); w.w = pk2(v1[2], v1[3]);
                    *(u32x4*)(base + (size_t)row * 256 + bj * HALF + wc * 32 + 8 * fq) = w;
                }
            }
    }
};
struct EpiOut {
    static constexpr bool PERM = false;
    Params p;
    DI void operator()(const f32x4 (&acc)[2][2][4][2], const Unit& u, int wr, int wc, int fr, int fq) const {
#pragma unroll
        for (int ai = 0; ai < 2; ++ai)
#pragma unroll
            for (int m = 0; m < 4; ++m) {
                const int row = u.pm * BM + ai * HALF + wr * 64 + m * 16 + fr;
                const float* xr = xrow_ptr(p, row); float* orow = p.out + (size_t)row * DM;
#pragma unroll
                for (int bj = 0; bj < 2; ++bj)
#pragma unroll
                    for (int n = 0; n < 2; ++n) {
                        const int col = u.pn * BM + bj * HALF + wc * 32 + 16 * n + 4 * fq;
                        const f32x4 xv = *(const f32x4*)(xr + col);
                        *(f32x4*)(orow + col) = xv * ALPHA + acc[ai][bj][m][n];
                    }
            }
    }
};
struct EpiGU {
    static constexpr bool PERM = true;
    bf16_t* H;
    DI void operator()(const f32x4 (&acc)[2][2][4][2], const Unit& u, int wr, int wc, int fr, int fq) const {
#pragma unroll
        for (int ai = 0; ai < 2; ++ai)
#pragma unroll
            for (int m = 0; m < 4; ++m) {
                const int row = u.pm * BM + ai * HALF + wr * 64 + m * 16 + fr;
                const f32x4 g0 = acc[ai][0][m][0], g1 = acc[ai][0][m][1], u0 = acc[ai][1][m][0], u1 = acc[ai][1][m][1];
                f32x4 h0, h1;
#pragma unroll
                for (int j = 0; j < 4; ++j) { h0[j] = silu_f(g0[j]) * u0[j]; h1[j] = silu_f(g1[j]) * u1[j]; }
                u32x4 w; w.x = pk2(h0[0], h0[1]); w.y = pk2(h0[2], h0[3]); w.z = pk2(h1[0], h1[1]); w.w = pk2(h1[2], h1[3]);
                *(u32x4*)(H + (size_t)row * FF + u.pn * 128 + wc * 32 + 8 * fq) = w;
            }
    }
};
struct EpiDown {
    static constexpr bool PERM = true;
    bf16_t* eo; const float* gate;
    DI void operator()(const f32x4 (&acc)[2][2][4][2], const Unit& u, int wr, int wc, int fr, int fq) const {
#pragma unroll
        for (int ai = 0; ai < 2; ++ai)
#pragma unroll
            for (int m = 0; m < 4; ++m) {
                const int slot = u.pm * BM + ai * HALF + wr * 64 + m * 16 + fr;
                const float gv = gate[slot];
                bf16_t* orow = eo + (size_t)slot * DM + u.pn * BM + wc * 32 + 8 * fq;
#pragma unroll
                for (int bj = 0; bj < 2; ++bj) {
                    const f32x4 v0 = acc[ai][bj][m][0] * gv, v1 = acc[ai][bj][m][1] * gv;
                    u32x4 w; w.x = pk2(v0[0], v0[1]); w.y = pk2(v0[2], v0[3]); w.z = pk2(v1[0], v1[1]); w.w = pk2(v1[2], v1[3]);
                    *(u32x4*)(orow + bj * HALF) = w;
                }
            }
    }
};
}

DI void transpose_item(const float* W, int ldw, int k0, int n0, bf16_t* WT, int ldt, int drow0, LAS float* scr, int lane) {
#pragma unroll 8
    for (int i = 0; i < 32; ++i) { const int kk = 2 * i + (lane >> 5); scr[kk * 33 + (lane & 31)] = W[(size_t)(k0 + kk) * ldw + n0 + (lane & 31)]; }
    LDS_WAIT();
    const int c = lane & 7;
#pragma unroll
    for (int j = 0; j < 4; ++j) { const int n = (lane >> 3) + 8 * j; const LAS float* s = scr + (8 * c) * 33 + n;
        u32x4 o; o.x = pk2(s[0 * 33], s[1 * 33]); o.y = pk2(s[2 * 33], s[3 * 33]); o.z = pk2(s[4 * 33], s[5 * 33]); o.w = pk2(s[6 * 33], s[7 * 33]);
        *(u32x4*)(WT + (size_t)(drow0 + n) * ldt + k0 + 8 * c) = o; }
    LDS_WAIT();
}

DI void sincos_small(double r, double& s, double& c) {
    const double r2 = r * r; double ss = 1.0, cc = 1.0;
#pragma unroll
    for (int n = 12; n >= 1; --n) { ss = 1.0 - ss * r2 * (1.0 / (double)((2 * n) * (2 * n + 1))); cc = 1.0 - cc * r2 * (1.0 / (double)((2 * n - 1) * (2 * n))); }
    s = r * ss; c = cc;
}

DI void dot16(const f32x4 (&v)[4], const LAS float* wT, int lane, float (&r)[16]) {
#pragma unroll
    for (int e = 0; e < 16; ++e) {
        float a = 0.f;
        if ((e & 1) == 0) asm volatile("" ::: "memory");
#pragma unroll
        for (int j = 0; j < 4; ++j) { const f32x4 w = *(const LAS f32x4*)(wT + e * 1024 + 256 * j + 4 * lane); a += v[j][0] * w[0] + v[j][1] * w[1] + v[j][2] * w[2] + v[j][3] * w[3]; }
        r[e] = wave_sum(a);
    }
}

DI void phase0(const Params& p, LAS unsigned char* lds, int gw, int NGW, int wave, int lane) {
    const int tid = threadIdx.x;
    {
        LAS float* scr = (LAS float*)(lds + wave * 16384);
        for (int it = gw; it < 2048; it += NGW) {
            if (it < 1536) { const int kb = it / 96, nb = it % 96; transpose_item(p.in[2], INW, 64 * kb, 32 * nb, (bf16_t*)(p.ws + WS_WI), DM, 32 * nb, scr, lane); }
            else { const int r = it - 1536, kb = r / 32, nb = r % 32; transpose_item(p.in[9], DM, 64 * kb, 32 * nb, (bf16_t*)(p.ws + WS_WO), DM, 32 * nb, scr, lane); }
        }
    }
    {
        float* rope = (float*)(p.ws + WS_ROPE);
        const float invf[8] = {1.0f, 0.1939227432012558f, 0.03760603070259094f, 0.007292664609849453f, 0.0014142135623842478f, 0.00027424818836152554f, 5.318296098266728e-05f, 1.0313386155758053e-05f};
        for (int id = blockIdx.x * NTHR + tid; id < 8192 * 8; id += gridDim.x * NTHR) {
            const int pos = id >> 3, i = id & 7;
            float inv = invf[0];
#pragma unroll
            for (int k = 1; k < 8; ++k) inv = (i == k) ? invf[k] : inv;
            const float ang = (float)pos * inv;
            const double x = (double)ang; const double kq = rint(x * 0.15915494309189535); const double r = x - kq * 6.283185307179586476925;
            double s, c; sincos_small(r, s, c);
            rope[pos * 16 + i] = (float)c; rope[pos * 16 + 8 + i] = (float)s;
        }
    }
    __syncthreads();
    LAS float* wT = (LAS float*)lds;
    for (int id = tid; id < 16384; id += NTHR) { const int k = id >> 4, e = id & 15; wT[e * 1024 + k] = p.in[2][(size_t)k * INW + 3072 + e]; }
    __syncthreads();
    const float* dtb = p.in[5];
    float bias = 0.f;
    if (lane < 16) bias = dtb[lane];
    bf16_t* xb = (bf16_t*)(p.ws + WS_XB); float* dtout = (float*)(p.ws + WS_DT);
    for (int t = gw; t < TT; t += NGW) {
        const f32x4* xr = (const f32x4*)xrow_ptr(p, t) + lane;
        f32x4 v[4];
#pragma unroll
        for (int j = 0; j < 4; ++j) v[j] = xr[64 * j];
        u32x2* o8 = (u32x2*)(xb + (size_t)t * DM) + lane;
#pragma unroll
        for (int j = 0; j < 4; ++j) { u32x2 w; w.x = pk2(v[j][0], v[j][1]); w.y = pk2(v[j][2], v[j][3]); o8[64 * j] = w; }
        float r[16]; dot16(v, wT, lane, r);
        float mine = 0.f;
#pragma unroll
        for (int e = 0; e < 16; ++e) mine = (lane == e) ? r[e] : mine;
        if (lane < 16) { const float z = mine + bias; dtout[(size_t)t * 16 + lane] = fmaxf(z, 0.f) + log1pf(__expf(-fabsf(z))); }
    }
}

DI void conv_phase(const Params& p) {
    const int tid = blockIdx.x * NTHR + threadIdx.x, nthr = gridDim.x * NTHR;
    const int c = tid & 127, ch = 8 * c, tile = ch >> 8, cit = ch & 255;
    const float* cw = p.in[3]; const float* cb = p.in[4];
    float w[5][8], b[8];
#pragma unroll
    for (int j = 0; j < 5; ++j)
#pragma unroll
        for (int e = 0; e < 8; ++e) w[j][e] = cw[j * 1024 + ch + e];
#pragma unroll
    for (int e = 0; e < 8; ++e) b[e] = cb[ch + e];
    const bf16_t* src = (const bf16_t*)(p.ws + WS_P) + (size_t)(8 + tile) * TILE_ELEMS + cit;
    bf16_t* dst = (bf16_t*)(p.ws + WS_XC) + (size_t)tile * TILE_ELEMS + cit;
    for (int it = tid; it < TT * 128; it += nthr) {
        const int t = it >> 7;
        const int S = t < TP ? 4096 : 8192, s = t & (S - 1);
        float a[8];
#pragma unroll
        for (int e = 0; e < 8; ++e) a[e] = b[e];
#pragma unroll
        for (int j = 0; j < 5; ++j) {
            const int sj = s + j - 2;
            if (sj >= 0 && sj < S) {
                const u32x4 v = *(const u32x4*)(src + (size_t)(t + j - 2) * 256);
                a[0] += bflo(v.x) * w[j][0]; a[1] += bfhi(v.x) * w[j][1]; a[2] += bflo(v.y) * w[j][2]; a[3] += bfhi(v.y) * w[j][3];
                a[4] += bflo(v.z) * w[j][4]; a[5] += bfhi(v.z) * w[j][5]; a[6] += bflo(v.w) * w[j][6]; a[7] += bfhi(v.w) * w[j][7];
            }
        }
        u32x4 o; o.x = pk2(silu_f(a[0]), silu_f(a[1])); o.y = pk2(silu_f(a[2]), silu_f(a[3])); o.z = pk2(silu_f(a[4]), silu_f(a[5])); o.w = pk2(silu_f(a[6]), silu_f(a[7]));
        *(u32x4*)(dst + (size_t)t * 256) = o;
    }
}

DI void attn_phase(const Params& p, LAS unsigned char* lds, int gw, int NGW, int wave, int lane) {
    LAS bf16_t* Vt = (LAS bf16_t*)(lds + wave * 4608);
    const bf16_t* Pb = (const bf16_t*)(p.ws + WS_P);
    bf16_t* mix = (bf16_t*)(p.ws + WS_MIX);
    const int c = lane & 15, q = lane >> 4;
    for (int wi = gw; wi < 24576; wi += NGW) {
        const int head = wi & 7, qg = wi >> 3;
        const int t0 = (qg >> 4) * 256 + (qg & 15);
        const int S = t0 < TP ? 4096 : 8192, sbase = t0 & ~(S - 1), p0 = t0 - sbase;
        const int hoff = (head & 3) * 64;
        const bf16_t* Qt = Pb + (size_t)(0 + (head >> 2)) * TILE_ELEMS + hoff;
        const bf16_t* Kt = Pb + (size_t)(2 + (head >> 2)) * TILE_ELEMS + hoff;
        const bf16_t* Vg = Pb + (size_t)(4 + (head >> 2)) * TILE_ELEMS + hoff;
        bf16x8 qf[2];
        { const bf16_t* qrow = Qt + (size_t)(t0 + 16 * c) * 256; qf[0] = *(const bf16x8*)(qrow + 8 * q); qf[1] = *(const bf16x8*)(qrow + 32 + 8 * q); }
        f32x4 O[4];
#pragma unroll
        for (int d4 = 0; d4 < 4; ++d4) O[d4] = (f32x4){0.f, 0.f, 0.f, 0.f};
        float mrun = -1e30f, lsum = 0.f;
        const int pq = p0 + 16 * c;
        for (int pi = 0; pi < 3; ++pi) {
            const int d = 1 << (2 * pi);
            const int base = p0 - 64 * d, nk = 240 / d + 129, nst = (nk + 31) >> 5, win = 64 * d;
            for (int st = 0; st < nst; ++st) {
                const int kbase = 32 * st;
#pragma unroll
                for (int i = 0; i < 4; ++i) {
                    const int key = lane & 31, dc = (lane >> 5) + 2 * i;
                    int pos = base + d * (kbase + key); pos = pos < 0 ? 0 : (pos > S - 1 ? S - 1 : pos);
                    const u32x4 v = *(const u32x4*)(Vg + (size_t)(sbase + pos) * 256 + 8 * dc);
                    st_tr8_pair(Vt + (8 * dc) * 36, 36, key >> 1, lane, v);
                }
                f32x4 sc[2];
#pragma unroll
                for (int kt = 0; kt < 2; ++kt) {
                    int pos = base + d * (kbase + 16 * kt + c); pos = pos < 0 ? 0 : (pos > S - 1 ? S - 1 : pos);
                    const bf16_t* krow = Kt + (size_t)(sbase + pos) * 256;
                    const bf16x8 k0 = *(const bf16x8*)(krow + 8 * q), k1 = *(const bf16x8*)(krow + 32 + 8 * q);
                    f32x4 a = {0.f, 0.f, 0.f, 0.f};
                    a = __builtin_amdgcn_mfma_f32_16x16x32_bf16(k0, qf[0], a, 0, 0, 0);
                    a = __builtin_amdgcn_mfma_f32_16x16x32_bf16(k1, qf[1], a, 0, 0, 0);
                    sc[kt] = a;
                }
                bool valid[2][4]; float mloc = -1e30f;
#pragma unroll
                for (int kt = 0; kt < 2; ++kt)
#pragma unroll
                    for (int j = 0; j < 4; ++j) {
                        const int kk = kbase + 16 * kt + 4 * q + j, pk = base + d * kk;
                        int df = pk - pq; df = df < 0 ? -df : df;
                        valid[kt][j] = (kk < nk) && (pk >= 0) && (pk < S) && (df <= win);
                        const float sv = valid[kt][j] ? sc[kt][j] * 0.125f : -1e30f;
                        sc[kt][j] = sv; mloc = fmaxf(mloc, sv);
                    }
                mloc = fmaxf(mloc, __shfl_xor(mloc, 16)); mloc = fmaxf(mloc, __shfl_xor(mloc, 32));
                const float mnew = fmaxf(mrun, mloc), alpha = __expf(mrun - mnew);
                mrun = mnew;
                float ps = 0.f; float pv[2][4];
#pragma unroll
                for (int kt = 0; kt < 2; ++kt)
#pragma unroll
                    for (int j = 0; j < 4; ++j) { pv[kt][j] = valid[kt][j] ? __expf(sc[kt][j] - mnew) : 0.f; ps += pv[kt][j]; }
                lsum = lsum * alpha + ps;
#pragma unroll
                for (int d4 = 0; d4 < 4; ++d4) O[d4] = O[d4] * alpha;
                u32x4 pw; pw.x = pk2(pv[0][0], pv[0][1]); pw.y = pk2(pv[0][2], pv[0][3]); pw.z = pk2(pv[1][0], pv[1][1]); pw.w = pk2(pv[1][2], pv[1][3]);
                const bf16x8 pf = __builtin_bit_cast(bf16x8, pw);
#pragma unroll
                for (int d4 = 0; d4 < 4; ++d4) {
                    const LAS bf16_t* vr = Vt + (16 * d4 + c) * 36 + 4 * q;
                    const s16x4 lo = *(const LAS s16x4*)vr, hi = *(const LAS s16x4*)(vr + 16);
                    const bf16x8 vf = __builtin_shufflevector(lo, hi, 0, 1, 2, 3, 4, 5, 6, 7);
                    O[d4] = __builtin_amdgcn_mfma_f32_16x16x32_bf16(vf, pf, O[d4], 0, 0, 0);
                }
            }
        }
        lsum += __shfl_xor(lsum, 16); lsum += __shfl_xor(lsum, 32);
        const float inv = 1.0f / lsum;
        bf16_t* orow = mix + (size_t)(t0 + 16 * c) * DM + head * 64 + 4 * q;
#pragma unroll
        for (int d4 = 0; d4 < 4; ++d4) { u32x2 w; w.x = pk2(O[d4][0] * inv, O[d4][1] * inv); w.y = pk2(O[d4][2] * inv, O[d4][3] * inv); *(u32x2*)(orow + 16 * d4) = w; }
    }
}

constexpr size_t WS_SLOC = WS_P;
constexpr size_t WS_DEC = WS_P + 96 * MiB;
constexpr int N_SSD_ITEMS = 6144;
struct SsdItem { int h, dir, g, tb, ts; float A; };
DI SsdItem ssd_decode(const Params& p, int it) {
    int w, ci; if (it < 4096) { w = it >> 5; ci = it & 31; } else { w = 128 + ((it - 4096) >> 6); ci = (it - 4096) & 63; }
    SsdItem I; const int seq = w >> 4; I.h = (w >> 1) & 7; I.dir = w & 1; I.g = I.h >> 2;
    const int S = seq < 8 ? 4096 : 8192, sbase = seq < 8 ? seq * 4096 : TP + (seq - 8) * 8192;
    I.tb = I.dir ? sbase + S - 1 - 128 * ci : sbase + 128 * ci; I.ts = I.dir ? -1 : 1;
    I.A = -__expf(p.in[6][I.dir * 8 + I.h]);
    return I;
}
#define SSD_TOK(I, l) ((I).tb + (I).ts * (l))
DI void ssd_scan_chunk(float d0, float d1, float A, LAS float* acs, LAS float* dts, int lane) {
    const float v0 = d0 * A, v1 = d1 * A; float ps = v0 + v1;
#pragma unroll
    for (int o = 1; o < 64; o <<= 1) { const float t = __shfl_up(ps, o); if (lane >= o) ps += t; }
    acs[2 * lane] = ps - v1; acs[2 * lane + 1] = ps; dts[2 * lane] = d0; dts[2 * lane + 1] = d1;
}
DI void st_tr8(LAS bf16_t* wp, int stride, const u32x4 v) {
    wp[0 * stride] = (bf16_t)(v.x & 0xffffu); wp[1 * stride] = (bf16_t)(v.x >> 16); wp[2 * stride] = (bf16_t)(v.y & 0xffffu); wp[3 * stride] = (bf16_t)(v.y >> 16);
    wp[4 * stride] = (bf16_t)(v.z & 0xffffu); wp[5 * stride] = (bf16_t)(v.z >> 16); wp[6 * stride] = (bf16_t)(v.w & 0xffffu); wp[7 * stride] = (bf16_t)(v.w >> 16);
}
DI void ssd_state_phase(const Params& p, LAS unsigned char* lds, int wave, int lane) {
    const int tid = threadIdx.x, c = lane & 15, q = lane >> 4, w = wave;
    LAS float* acs = (LAS float*)(lds + 0); LAS float* dts = (LAS float*)(lds + 512);
    LAS bf16_t* Xt2 = (LAS bf16_t*)(lds + 1024); LAS bf16_t* Bt = (LAS bf16_t*)(lds + 1024 + 64 * 272);
    const float* dtb = (const float*)(p.ws + WS_DT);
    const bf16_t* XCb = (const bf16_t*)(p.ws + WS_XC);
    bf16_t* Sl = (bf16_t*)(p.ws + WS_SLOC); float* decv = (float*)(p.ws + WS_DEC);
    int it = blockIdx.x;
    if (it >= N_SSD_ITEMS) return;
    SsdItem I = ssd_decode(p, it);
    float pd0 = 0.f, pd1 = 0.f; u32x4 xv[2], bv[4];
#define SSD_LOADS_A(I) do { \
        if (w == 0) { pd0 = dtb[(size_t)SSD_TOK(I, 2 * lane) * 16 + (I).dir * 8 + (I).h]; pd1 = dtb[(size_t)SSD_TOK(I, 2 * lane + 1) * 16 + (I).dir * 8 + (I).h]; } \
        _Pragma("unroll") for (int i = 0; i < 2; ++i) { const int pc = (w >> 1) + 4 * i; \
            xv[i] = *(const u32x4*)(XCb + (size_t)((I).h >> 2) * TILE_ELEMS + (size_t)SSD_TOK(I, lrow) * 256 + ((I).h & 3) * 64 + 8 * pc); } \
        _Pragma("unroll") for (int i = 0; i < 4; ++i) { const int ncn = (w >> 1) + 4 * i; \
            bv[i] = *(const u32x4*)(XCb + 2 * TILE_ELEMS + (size_t)SSD_TOK(I, lrow) * 256 + (I).g * 128 + 8 * ncn); } } while (0)
    const int lrow = (w & 1) * 64 + lane;
    SSD_LOADS_A(I);
    for (; it < N_SSD_ITEMS; it += gridDim.x) {
        if (w == 0) ssd_scan_chunk(pd0, pd1, I.A, acs, dts, lane);
        __syncthreads();
        const float aend = acs[127];
#pragma unroll
        for (int i = 0; i < 2; ++i) {
            const int pc = (w >> 1) + 4 * i;
            const float s2 = dts[lrow] * __expf(aend - acs[lrow]);
            const u32x4 v = xv[i];
            u32x4 o; o.x = pk2(bflo(v.x) * s2, bfhi(v.x) * s2); o.y = pk2(bflo(v.y) * s2, bfhi(v.y) * s2); o.z = pk2(bflo(v.z) * s2, bfhi(v.z) * s2); o.w = pk2(bflo(v.w) * s2, bfhi(v.w) * s2);
            st_tr8_pair(Xt2 + (8 * pc) * 136, 136, lrow >> 1, lane, o);
        }
#pragma unroll
        for (int i = 0; i < 4; ++i) { const int ncn = (w >> 1) + 4 * i; st_tr8_pair(Bt + (8 * ncn) * 136, 136, lrow >> 1, lane, bv[i]); }
        const int itn = it + gridDim.x;
        if (itn < N_SSD_ITEMS) { I = ssd_decode(p, itn); SSD_LOADS_A(I); }
        __syncthreads();
        bf16_t* so = Sl + (size_t)it * 8192 + 16 * w + 4 * q;
#pragma unroll
        for (int pt = 0; pt < 4; ++pt) {
            f32x4 a = {0.f, 0.f, 0.f, 0.f};
#pragma unroll
            for (int ks = 0; ks < 4; ++ks) {
                const bf16x8 bfr = *(const LAS bf16x8*)(Bt + (16 * w + c) * 136 + 32 * ks + 8 * q);
                const bf16x8 xf = *(const LAS bf16x8*)(Xt2 + (16 * pt + c) * 136 + 32 * ks + 8 * q);
                a = __builtin_amdgcn_mfma_f32_16x16x32_bf16(bfr, xf, a, 0, 0, 0);
            }
            u32x2 o; o.x = pk2(a[0], a[1]); o.y = pk2(a[2], a[3]);
            *(u32x2*)(so + (16 * pt + c) * 128) = o;
        }
        if (tid == 0) decv[it] = __expf(aend);
    }
#undef SSD_LOADS_A
}
DI void ssd_scan_phase(const Params& p) {
    unsigned* Sl = (unsigned*)(p.ws + WS_SLOC); const float* decv = (const float*)(p.ws + WS_DEC);
    for (int chain = blockIdx.x * NTHR + threadIdx.x; chain < 160 * 4096; chain += gridDim.x * NTHR) {
        const int w = chain >> 12, j = chain & 4095;
        const int nc = w < 128 ? 32 : 64, cb = w < 128 ? 32 * w : 4096 + 64 * (w - 128);
        unsigned* ptr = Sl + (size_t)cb * 4096 + j; const float* dp = decv + cb;
        float s0 = 0.f, s1 = 0.f;
        for (int c0 = 0; c0 < nc; c0 += 8) {
            unsigned v[8]; float d[8];
#pragma unroll
            for (int k = 0; k < 8; ++k) { v[k] = ptr[(size_t)(c0 + k) * 4096]; d[k] = dp[c0 + k]; }
#pragma unroll
            for (int k = 0; k < 8; ++k) { ptr[(size_t)(c0 + k) * 4096] = pk2(s0, s1); s0 = s0 * d[k] + bflo(v[k]); s1 = s1 * d[k] + bfhi(v[k]); }
        }
    }
}
constexpr int SSDC_ACS = 0  , SSDC_XT1 = 2048, SSDC_BN = SSDC_XT1 + 64 * 272, SSDC_SBF = SSDC_BN + 128 * 272, SSDC_END = SSDC_SBF + 64 * 272;
static_assert(SSDC_END <= 131072, "ssd lds");
DI void ssd_out_phase(const Params& p, LAS unsigned char* lds, int wave, int lane) {
    const int tid = threadIdx.x, c = lane & 15, q = lane >> 4, w = wave;
    LAS bf16_t* Xt1 = (LAS bf16_t*)(lds + SSDC_XT1); LAS bf16_t* Bn = (LAS bf16_t*)(lds + SSDC_BN); LAS bf16_t* Sbf = (LAS bf16_t*)(lds + SSDC_SBF);
    const float* dtb = (const float*)(p.ws + WS_DT);
    const bf16_t* XCb = (const bf16_t*)(p.ws + WS_XC);
    const bf16_t* Sl = (const bf16_t*)(p.ws + WS_SLOC);
    int it = blockIdx.x;
    if (it >= N_SSD_ITEMS) return;
    SsdItem I = ssd_decode(p, it);
    float pd0 = 0.f, pd1 = 0.f; u32x4 xv[2], bv[4], sv[2]; bf16x8 Cn[4];
#define SSD_LOADS_C(I, itx) do { \
        if (w == 0) { pd0 = dtb[(size_t)SSD_TOK(I, 2 * lane) * 16 + (I).dir * 8 + (I).h]; pd1 = dtb[(size_t)SSD_TOK(I, 2 * lane + 1) * 16 + (I).dir * 8 + (I).h]; } \
        _Pragma("unroll") for (int i = 0; i < 2; ++i) { const int id = tid + NTHR * i, pc = (w >> 1) + 4 * i; \
            xv[i] = *(const u32x4*)(XCb + (size_t)((I).h >> 2) * TILE_ELEMS + (size_t)SSD_TOK(I, lrow) * 256 + ((I).h & 3) * 64 + 8 * pc); \
            sv[i] = *(const u32x4*)(Sl + (size_t)(itx) * 8192 + (size_t)id * 8); } \
        _Pragma("unroll") for (int i = 0; i < 4; ++i) { const int ncn = (w >> 1) + 4 * i; \
            bv[i] = *(const u32x4*)(XCb + 2 * TILE_ELEMS + (size_t)SSD_TOK(I, lrow) * 256 + (I).g * 128 + 8 * ncn); } \
        { const bf16_t* cr = XCb + 3 * TILE_ELEMS + (size_t)SSD_TOK(I, 16 * w + c) * 256 + (I).g * 128 + 8 * q; \
          _Pragma("unroll") for (int ks = 0; ks < 4; ++ks) Cn[ks] = *(const bf16x8*)(cr + 32 * ks); } } while (0)
    const int lrow = (w & 1) * 64 + lane;
    SSD_LOADS_C(I, it);
    int par = 0;
    for (; it < N_SSD_ITEMS; it += gridDim.x, par ^= 1) {
        LAS float* acs = (LAS float*)(lds + SSDC_ACS + par * 1024); LAS float* dts = acs + 128;
        if (w == 0) ssd_scan_chunk(pd0, pd1, I.A, acs, dts, lane);
        __syncthreads();
#pragma unroll
        for (int i = 0; i < 2; ++i) {
            const int id = tid + NTHR * i, pc = (w >> 1) + 4 * i;
            const float s1 = dts[lrow];
            const u32x4 v = xv[i];
            u32x4 o; o.x = pk2(bflo(v.x) * s1, bfhi(v.x) * s1); o.y = pk2(bflo(v.y) * s1, bfhi(v.y) * s1); o.z = pk2(bflo(v.z) * s1, bfhi(v.z) * s1); o.w = pk2(bflo(v.w) * s1, bfhi(v.w) * s1);
            st_tr8_pair(Xt1 + (8 * pc) * 136, 136, lrow >> 1, lane, o);
            *(LAS u32x4*)(Sbf + (id >> 4) * 136 + 8 * (id & 15)) = sv[i];
        }
#pragma unroll
        for (int i = 0; i < 4; ++i) { const int ncn = (w >> 1) + 4 * i; *(LAS u32x4*)(Bn + lrow * 136 + 8 * ncn) = bv[i]; }
        bf16x8 Cf[4];
#pragma unroll
        for (int ks = 0; ks < 4; ++ks) Cf[ks] = Cn[ks];
        const SsdItem Ic = I;
        const int itn = it + gridDim.x;
        if (itn < N_SSD_ITEMS) { I = ssd_decode(p, itn); SSD_LOADS_C(I, itn); }
        __syncthreads();
        {
            const int l = 16 * w + c;
            const float al = acs[l];
            f32x4 acc[4];
#pragma unroll
            for (int pt = 0; pt < 4; ++pt) {
                f32x4 a = {0.f, 0.f, 0.f, 0.f};
#pragma unroll
                for (int ks = 0; ks < 4; ++ks) { const bf16x8 sf = *(const LAS bf16x8*)(Sbf + (16 * pt + c) * 136 + 32 * ks + 8 * q); a = __builtin_amdgcn_mfma_f32_16x16x32_bf16(sf, Cf[ks], a, 0, 0, 0); }
                acc[pt] = a * __expf(al);
            }
            const int nsp = (w >> 1) + 1;
            for (int sp = 0; sp < nsp; ++sp) {
                f32x4 M[2];
#pragma unroll
                for (int hh = 0; hh < 2; ++hh) {
                    const int st = 2 * sp + hh;
                    f32x4 G = {0.f, 0.f, 0.f, 0.f};
                    if (st <= w) {
#pragma unroll
                        for (int ks = 0; ks < 4; ++ks) { const bf16x8 bfr = *(const LAS bf16x8*)(Bn + (16 * st + c) * 136 + 32 * ks + 8 * q); G = __builtin_amdgcn_mfma_f32_16x16x32_bf16(bfr, Cf[ks], G, 0, 0, 0); }
#pragma unroll
                        for (int j = 0; j < 4; ++j) { const int s = 16 * st + 4 * q + j; const float e = __expf(al - acs[s]); G[j] = (s <= l) ? G[j] * e : 0.f; }
                    }
                    M[hh] = G;
                }
                u32x4 pw; pw.x = pk2(M[0][0], M[0][1]); pw.y = pk2(M[0][2], M[0][3]); pw.z = pk2(M[1][0], M[1][1]); pw.w = pk2(M[1][2], M[1][3]);
                const bf16x8 pf = __builtin_bit_cast(bf16x8, pw);
#pragma unroll
                for (int pt = 0; pt < 4; ++pt) {
                    const LAS bf16_t* xr = Xt1 + (16 * pt + c) * 136 + 32 * sp + 4 * q;
                    const s16x4 lo = *(const LAS s16x4*)xr, hi = *(const LAS s16x4*)(xr + 16);
                    const bf16x8 xf = __builtin_shufflevector(lo, hi, 0, 1, 2, 3, 4, 5, 6, 7);
                    acc[pt] = __builtin_amdgcn_mfma_f32_16x16x32_bf16(xf, pf, acc[pt], 0, 0, 0);
                }
            }
            bf16_t* yr = (bf16_t*)(p.ws + (Ic.dir ? WS_YB : WS_YF)) + Ic.h * 64 + (size_t)SSD_TOK(Ic, l) * 512 + 4 * q;
#pragma unroll
            for (int pt = 0; pt < 4; ++pt) { u32x2 o; o.x = pk2(acc[pt][0], acc[pt][1]); o.y = pk2(acc[pt][2], acc[pt][3]); *(u32x2*)(yr + 16 * pt) = o; }
        }
    }
#undef SSD_LOADS_C
}

DI void gate_phase(const Params& p, int gw, int NGW, int lane) {
    const bf16_t* yf = (const bf16_t*)(p.ws + WS_YF); const bf16_t* yb = (const bf16_t*)(p.ws + WS_YB);
    const bf16_t* xh = (const bf16_t*)(p.ws + WS_XC) + (size_t)(lane >> 5) * TILE_ELEMS + (8 * lane & 255);
    const bf16_t* zt = (const bf16_t*)(p.ws + WS_P) + (size_t)(6 + (lane >> 5)) * TILE_ELEMS + (8 * lane & 255);
    bf16_t* mix = (bf16_t*)(p.ws + WS_MIX) + 512 + 8 * lane;
    const float D = p.in[7][lane >> 3];
    float nw[8];
#pragma unroll
    for (int e = 0; e < 8; ++e) nw[e] = p.in[8][8 * lane + e];
    for (int t = gw; t < TT; t += NGW) {
        const u32x4 a = *(const u32x4*)(yf + (size_t)t * 512 + 8 * lane), b = *(const u32x4*)(yb + (size_t)t * 512 + 8 * lane);
        const u32x4 x = *(const u32x4*)(xh + (size_t)t * 256), z = *(const u32x4*)(zt + (size_t)t * 256);
        float y[8];
        y[0] = (bflo(a.x) + bflo(b.x) + D * bflo(x.x)) * silu_f(bflo(z.x)); y[1] = (bfhi(a.x) + bfhi(b.x) + D * bfhi(x.x)) * silu_f(bfhi(z.x));
        y[2] = (bflo(a.y) + bflo(b.y) + D * bflo(x.y)) * silu_f(bflo(z.y)); y[3] = (bfhi(a.y) + bfhi(b.y) + D * bfhi(x.y)) * silu_f(bfhi(z.y));
        y[4] = (bflo(a.z) + bflo(b.z) + D * bflo(x.z)) * silu_f(bflo(z.z)); y[5] = (bfhi(a.z) + bfhi(b.z) + D * bfhi(x.z)) * silu_f(bfhi(z.z));
        y[6] = (bflo(a.w) + bflo(b.w) + D * bflo(x.w)) * silu_f(bflo(z.w)); y[7] = (bfhi(a.w) + bfhi(b.w) + D * bfhi(x.w)) * silu_f(bfhi(z.w));
        float ss = 0.f;
#pragma unroll
        for (int e = 0; e < 8; ++e) ss += y[e] * y[e];
        ss = wave_sum(ss);
        const float r = 1.0f / sqrtf(ss * (1.0f / 512.0f) + RMS_EPS);
        u32x4 o; o.x = pk2(y[0] * r * nw[0], y[1] * r * nw[1]); o.y = pk2(y[2] * r * nw[2], y[3] * r * nw[3]); o.z = pk2(y[4] * r * nw[4], y[5] * r * nw[5]); o.w = pk2(y[6] * r * nw[6], y[7] * r * nw[7]);
        *(u32x4*)(mix + (size_t)t * DM) = o;
    }
}

DI void expert_weights_phase(const Params& p, LAS unsigned char* lds, int gw, int NGW, int wave, int lane) {
    LAS float* scr = (LAS float*)(lds + wave * 16384);
    bf16_t* Wd = (bf16_t*)(p.ws + WS_WD);
    for (int it = gw; it < 16 * 4224; it += NGW) {
        const int e = it / 4224, r = it % 4224;
        if (r < 2816) {
            const int isup = r >= 1408, rr = isup ? r - 1408 : r, kb = rr / 88, nb = rr % 88, n0 = 32 * nb;
            const float* W = (isup ? p.in[14] : p.in[13]) + (size_t)e * DM * FF;
            bf16_t* Wgu = (bf16_t*)(p.ws + (e < 8 ? WS_WGU0 : WS_WGU1));
            transpose_item(W, FF, 64 * kb, n0, Wgu, DM, (e & 7) * 5632 + 256 * (n0 >> 7) + (n0 & 127) + (isup ? 128 : 0), scr, lane);
        } else {
            const int rr = r - 2816, kb = rr / 32, nb = rr % 32;
            transpose_item(p.in[15] + (size_t)e * FF * DM, DM, 64 * kb, 32 * nb, Wd, FF, e * 1024 + 32 * nb, scr, lane);
        }
    }
}

DI void ln1_router_phase(const Params& p, LAS unsigned char* lds, int gw, int NGW, int lane) {
    const int tid = threadIdx.x;
    LAS float* wT = (LAS float*)lds;
    for (int id = tid; id < 16384; id += NTHR) { const int k = id >> 4, e = id & 15; wT[e * 1024 + k] = p.in[12][id]; }
    __syncthreads();
    f32x4 gg[4], bb[4];
#pragma unroll
    for (int j = 0; j < 4; ++j) { gg[j] = ((const f32x4*)p.in[10])[64 * j + lane]; bb[j] = ((const f32x4*)p.in[11])[64 * j + lane]; }
    bf16_t* x1b = (bf16_t*)(p.ws + WS_X1B); float* aff = (float*)(p.ws + WS_AFF);
    for (int t = gw; t < TT; t += NGW) {
        f32x4* orow = (f32x4*)(p.out + (size_t)t * DM) + lane;
        f32x4 v[4]; float s = 0.f;
#pragma unroll
        for (int j = 0; j < 4; ++j) { v[j] = orow[64 * j]; s += (v[j][0] + v[j][1]) + (v[j][2] + v[j][3]); }
        const float mean = wave_sum(s) * (1.0f / DM); float s2 = 0.f;
#pragma unroll
        for (int j = 0; j < 4; ++j) { v[j] = v[j] - mean; s2 += (v[j][0] * v[j][0] + v[j][1] * v[j][1]) + (v[j][2] * v[j][2] + v[j][3] * v[j][3]); }
        const float rstd = 1.0f / sqrtf(wave_sum(s2) * (1.0f / DM) + LN_EPS);
        u32x2* o8 = (u32x2*)(x1b + (size_t)t * DM) + lane;
#pragma unroll
        for (int j = 0; j < 4; ++j) {
            v[j] = v[j] * rstd * gg[j] + bb[j];
            orow[64 * j] = v[j] * ALPHA;
            u32x2 w; w.x = pk2(v[j][0], v[j][1]); w.y = pk2(v[j][2], v[j][3]); o8[64 * j] = w;
        }
        float r[16]; dot16(v, wT, lane, r);
        float mx = r[0];
#pragma unroll
        for (int e = 1; e < 16; ++e) mx = fmaxf(mx, r[e]);
        float den = 0.f, mine = 0.f;
#pragma unroll
        for (int e = 0; e < 16; ++e) { const float ex = __expf(r[e] - mx); den += ex; mine = (lane == e) ? ex : mine; }
        if (lane < 16) aff[(size_t)lane * TT + t] = mine / den;
    }
}

DI void select_phase(const Params& p, LAS unsigned char* lds, int wave, int lane) {
    const int wk = blockIdx.x;
    if (wk >= 32) return;
    const int tid = threadIdx.x;
    const int trunk = wk >> 4, e = wk & 15;
    const int Tn = trunk ? 16384 : 32768, tbase = trunk ? TP : 0, cap = Tn / 8;
    const unsigned* col = (const unsigned*)(p.ws + WS_AFF) + (size_t)e * TT + tbase;
    LAS unsigned* hist = (LAS unsigned*)lds;
    LAS unsigned* ctl = (LAS unsigned*)(lds + 1024);
    LAS unsigned* wcnt = (LAS unsigned*)(lds + 2048);
    unsigned prefix = 0, remaining = (unsigned)cap;
    for (int pass = 0; pass < 4; ++pass) {
        const int shift = 24 - 8 * pass;
        for (int i = tid; i < 256; i += NTHR) hist[i] = 0u;
        __syncthreads();
        for (int i = tid; i < Tn; i += NTHR) {
            const unsigned bits = col[i];
            if (pass == 0 || (bits >> (shift + 8)) == prefix) atomicAdd((unsigned*)(hist + ((bits >> shift) & 255u)), 1u);
        }
        __syncthreads();
        if (tid == 0) {
            unsigned cum = 0; int b = 255;
            for (; b > 0; --b) { const unsigned hcnt = hist[b]; if (cum + hcnt >= remaining) break; cum += hcnt; }
            ctl[0] = (prefix << 8) | (unsigned)b; ctl[1] = remaining - cum;
        }
        __syncthreads();
        prefix = ctl[0]; remaining = ctl[1];
        __syncthreads();
    }
    const unsigned thr = prefix, need_eq = remaining;
    int* idx = (int*)(p.ws + WS_IDX) + e * SLOTS_E + (trunk ? 4096 : 0);
    int* inv = (int*)(p.ws + WS_INV) + (size_t)e * TT + tbase;
    const int slot0 = e * SLOTS_E + (trunk ? 4096 : 0);
    float* gate = (float*)(p.ws + WS_GATE) + e * SLOTS_E + (trunk ? 4096 : 0);
    unsigned sel_base = 0, eq_base = 0;
    for (int b0 = 0; b0 < Tn; b0 += NTHR) {
        const unsigned bits = col[b0 + tid];
        const bool gt = bits > thr, eq = bits == thr;
        const unsigned long long meq = __ballot(eq);
        const unsigned eq_before_w = (unsigned)__popcll(meq & ((1ull << lane) - 1ull));
        if (lane == 0) wcnt[wave] = (unsigned)__popcll(meq);
        __syncthreads();
        unsigned eq_off = 0, eq_tot = 0;
#pragma unroll
        for (int w2 = 0; w2 < 8; ++w2) { const unsigned cnt = wcnt[w2]; eq_off += (w2 < wave) ? cnt : 0u; eq_tot += cnt; }
        const bool sel = gt || (eq && (eq_base + eq_off + eq_before_w) < need_eq);
        const unsigned long long msel = __ballot(sel);
        const unsigned sel_before_w = (unsigned)__popcll(msel & ((1ull << lane) - 1ull));
        if (lane == 0) wcnt[8 + wave] = (unsigned)__popcll(msel);
        __syncthreads();
        unsigned sel_off = 0, sel_tot = 0;
#pragma unroll
        for (int w2 = 0; w2 < 8; ++w2) { const unsigned cnt = wcnt[8 + w2]; sel_off += (w2 < wave) ? cnt : 0u; sel_tot += cnt; }
        { const unsigned pos = sel_base + sel_off + sel_before_w; const bool ok = sel && pos < (unsigned)cap;
          if (ok) { idx[pos] = tbase + b0 + tid; gate[pos] = __uint_as_float(bits); }
          inv[b0 + tid] = ok ? slot0 + (int)pos : -1; }
        sel_base += sel_tot; eq_base += eq_tot;
        __syncthreads();
    }
}

DI void ln2_phase(const Params& p, int gw, int NGW, int lane) {
    f32x4 gg[4], bb[4];
#pragma unroll
    for (int j = 0; j < 4; ++j) { gg[j] = ((const f32x4*)p.in[16])[64 * j + lane]; bb[j] = ((const f32x4*)p.in[17])[64 * j + lane]; }
    const int* inv = (const int*)(p.ws + WS_INV); const bf16_t* eo = (const bf16_t*)(p.ws + WS_EO);
    for (int t = gw; t < TT; t += NGW) {
        f32x4* orow = (f32x4*)(p.out + (size_t)t * DM) + lane;
        f32x4 v[4]; float s = 0.f;
#pragma unroll
        for (int j = 0; j < 4; ++j) v[j] = orow[64 * j];
        const int myslot = lane < 16 ? inv[(size_t)lane * TT + t] : -1;
        for (int e = 0; e < 16; ++e) {
            const int sl = __shfl(myslot, e);
            if (sl >= 0) {
                const u32x2* er = (const u32x2*)(eo + (size_t)sl * DM) + lane;
#pragma unroll
                for (int j = 0; j < 4; ++j) { const u32x2 w = er[64 * j]; v[j][0] += bflo(w.x); v[j][1] += bfhi(w.x); v[j][2] += bflo(w.y); v[j][3] += bfhi(w.y); }
            }
        }
#pragma unroll
        for (int j = 0; j < 4; ++j) s += (v[j][0] + v[j][1]) + (v[j][2] + v[j][3]);
        const float mean = wave_sum(s) * (1.0f / DM); float s2 = 0.f;
#pragma unroll
        for (int j = 0; j < 4; ++j) { v[j] = v[j] - mean; s2 += (v[j][0] * v[j][0] + v[j][1] * v[j][1]) + (v[j][2] * v[j][2] + v[j][3] * v[j][3]); }
        const float rstd = 1.0f / sqrtf(wave_sum(s2) * (1.0f / DM) + LN_EPS);
#pragma unroll
        for (int j = 0; j < 4; ++j) orow[64 * j] = v[j] * rstd * gg[j] + bb[j];
    }
}

__global__ void __launch_bounds__(NTHR, 2) fwd_megakernel(Params p) {
    extern __shared__ __attribute__((aligned(16))) unsigned char lds_raw[];
    LAS unsigned char* lds = (LAS unsigned char*)lds_raw;
    cg::grid_group grid = cg::this_grid();
#define IDS() int tid_ = threadIdx.x; asm volatile("" : "+v"(tid_)); const int lane = tid_ & 63, wave = __builtin_amdgcn_readfirstlane(tid_ >> 6); \
    const int G = gridDim.x, gw = blockIdx.x * 8 + wave, NGW = G * 8; (void)lane; (void)gw; (void)NGW; (void)G;
    { IDS(); phase0(p, lds, gw, NGW, wave, lane); }
    grid.sync();
    {
        IDS();
        pg8::SchedPlain S; S.init(TT, 3072, G, (int)blockIdx.x);
        pg8::EpiProj E{(bf16_t*)(p.ws + WS_P), (const float*)(p.ws + WS_ROPE)};
        pg8::gemm_phase<pg8::EpiProj, pg8::SchedPlain>(lds, (const bf16_t*)(p.ws + WS_XB), (const bf16_t*)(p.ws + WS_WI), DM, S, E);
    }
    grid.sync();
    conv_phase(p);
    { IDS(); attn_phase(p, lds, gw, NGW, wave, lane); }
    grid.sync();
    { IDS(); ssd_state_phase(p, lds, wave, lane); }
    grid.sync();
    ssd_scan_phase(p);
    grid.sync();
    { IDS(); ssd_out_phase(p, lds, wave, lane); }
    grid.sync();
    { IDS(); gate_phase(p, gw, NGW, lane); }
    grid.sync();
    { IDS(); expert_weights_phase(p, lds, gw, NGW, wave, lane); }
    __syncthreads();
    {
        IDS();
        pg8::SchedPlain S; S.init(TT, DM, G, (int)blockIdx.x);
        pg8::EpiOut E{p};
        pg8::gemm_phase<pg8::EpiOut, pg8::SchedPlain>(lds, (const bf16_t*)(p.ws + WS_MIX), (const bf16_t*)(p.ws + WS_WO), DM, S, E);
    }
    grid.sync();
    { IDS(); ln1_router_phase(p, lds, gw, NGW, lane); }
    grid.sync();
    { IDS(); select_phase(p, lds, wave, lane); }
    grid.sync();
#pragma unroll 1
    for (int rnd = 0; rnd < 2; ++rnd) {
        {
            IDS();
            const int* idx = (const int*)(p.ws + WS_IDX) + rnd * 8 * SLOTS_E;
            pg8::SchedGrouped<22, true> S{G, (int)blockIdx.x, idx};
            pg8::EpiGU E{(bf16_t*)(p.ws + WS_HID)};
            pg8::gemm_phase<pg8::EpiGU, pg8::SchedGrouped<22, true>>(lds, (const bf16_t*)(p.ws + WS_X1B), (const bf16_t*)(p.ws + (rnd ? WS_WGU1 : WS_WGU0)), DM, S, E);
        }
        grid.sync();
        {
            IDS();
            const int* idx = (const int*)(p.ws + WS_IDX) + rnd * 8 * SLOTS_E;
            const float* gate = (const float*)(p.ws + WS_GATE) + rnd * 8 * SLOTS_E;
            pg8::SchedGrouped<4, false> S{G, (int)blockIdx.x, idx};
            pg8::EpiDown E{(bf16_t*)(p.ws + WS_EO) + (size_t)rnd * 8 * SLOTS_E * DM, gate};
            pg8::gemm_phase<pg8::EpiDown, pg8::SchedGrouped<4, false>>(lds, (const bf16_t*)(p.ws + WS_HID), (const bf16_t*)(p.ws + WS_WD) + (size_t)rnd * 8 * 1024 * FF, FF, S, E);
        }
        grid.sync();
    }
    { IDS(); ln2_phase(p, gw, NGW, lane); }
#undef IDS
}

extern "C" void kernel_launch(void* const* d_in, const int* in_sizes, int n_in, void* d_out, int out_size, void* d_ws, size_t ws_size, hipStream_t stream) {
    static int grid_blocks = 0;
    if (grid_blocks == 0) {
        if (n_in != 18 || ws_size < WS_END || out_size != TT * DM) { fprintf(stderr, "kernel_launch: unexpected shapes (n_in %d out %d ws %zu)\n", n_in, out_size, ws_size); grid_blocks = -1; return; }
        int dev = 0, cus = 0, per_cu = 0;
        hipGetDevice(&dev);
        hipDeviceGetAttribute(&cus, hipDeviceAttributeMultiprocessorCount, dev);
        if (hipFuncSetAttribute((const void*)fwd_megakernel, hipFuncAttributeMaxDynamicSharedMemorySize, LDS_BYTES) != hipSuccess) { fprintf(stderr, "kernel_launch: hipFuncSetAttribute failed\n"); }
        hipOccupancyMaxActiveBlocksPerMultiprocessor(&per_cu, (const void*)fwd_megakernel, NTHR, LDS_BYTES);
        if (per_cu < 1) per_cu = 1;
        (void)hipGetLastError();
        grid_blocks = cus * per_cu;
    }
    if (grid_blocks < 0) return;
    Params p{};
    for (int i = 0; i < 18; ++i) p.in[i] = (const float*)d_in[i];
    p.out = (float*)d_out; p.ws = (unsigned char*)d_ws;
    void* args[] = {&p};
    hipError_t e = hipLaunchCooperativeKernel((void*)fwd_megakernel, dim3(grid_blocks), dim3(NTHR), args, LDS_BYTES, stream);
    if (e != hipSuccess) fprintf(stderr, "cooperative launch failed: %s (grid %d)\n", hipGetErrorString(e), grid_blocks);
}
```

```cpp
#include <hip/hip_runtime.h>
#include <hip/hip_cooperative_groups.h>
#include <cstdio>
#include <cstdint>
namespace cg = cooperative_groups;

#define DI __device__ __forceinline__
#define LAS __attribute__((address_space(3)))
typedef unsigned short bf16_t;
typedef short bf16x8 __attribute__((ext_vector_type(8)));
typedef short s16x4 __attribute__((ext_vector_type(4)));
typedef float f32x4 __attribute__((ext_vector_type(4)));
typedef unsigned u32x4 __attribute__((ext_vector_type(4)));
typedef unsigned u32x2 __attribute__((ext_vector_type(2)));

constexpr int TT = 49152;
constexpr int TP = 32768;
constexpr int DM = 1024;
constexpr int INW = 3088;
constexpr int FF = 2816;
constexpr int NE = 16;
constexpr int SLOTS_E = 6144;
constexpr float ALPHA = 1.189207115002721f;
constexpr float LN_EPS = 1e-5f, RMS_EPS = 1e-5f;

constexpr size_t MiB = 1u << 20;
constexpr size_t TILE_ELEMS = (size_t)TT * 256;
constexpr size_t TILE_BYTES = TILE_ELEMS * 2;
constexpr size_t WS_WI = 0;
constexpr size_t WS_WO = 6 * MiB;
constexpr size_t WS_DT = 8 * MiB;
constexpr size_t WS_ROPE = 11 * MiB;
constexpr size_t WS_AFF = 12 * MiB;
constexpr size_t WS_IDX = 15 * MiB;
constexpr size_t WS_GATE = 15 * MiB + 512 * 1024;
constexpr size_t WS_P = 20 * MiB;
constexpr size_t WS_XC = 308 * MiB;
constexpr size_t WS_XB = 404 * MiB;
constexpr size_t WS_MIX = WS_XB;
constexpr size_t WS_YF = WS_P + 8 * TILE_BYTES;
constexpr size_t WS_YB = WS_P + 10 * TILE_BYTES;
constexpr size_t WS_INV = 16 * MiB;
constexpr size_t WS_WD = 20 * MiB;
constexpr size_t WS_WGU1 = 108 * MiB;
constexpr size_t WS_WGU0 = 196 * MiB;
constexpr size_t WS_EO = 212 * MiB;
constexpr size_t WS_X1B = 308 * MiB;
constexpr size_t WS_HID = 404 * MiB;
constexpr size_t WS_END = 668 * MiB;

constexpr int LDS_BYTES = 147456;
constexpr int NTHR = 512;

DI unsigned f2bf(float f) { unsigned u = __float_as_uint(f); return (u + 0x7fffu + ((u >> 16) & 1u)) >> 16; }
DI unsigned pk2(float lo, float hi) { return f2bf(lo) | (f2bf(hi) << 16); }
DI float bflo(unsigned u) { return __uint_as_float(u << 16); }
DI float bfhi(unsigned u) { return __uint_as_float(u & 0xffff0000u); }
DI float wave_sum(float v) {
#pragma unroll
    for (int o = 1; o < 64; o <<= 1) v += __shfl_xor(v, o);
    return v;
}
DI void st_tr8_pair(LAS bf16_t* base, int stride, int colpair, int lane, const u32x4 v) {
    const unsigned px = __shfl_xor(v.x, 1), py = __shfl_xor(v.y, 1), pz = __shfl_xor(v.z, 1), pw = __shfl_xor(v.w, 1);
    const bool odd = (lane & 1) != 0;
    const unsigned d0 = odd ? ((px >> 16) | (v.x & 0xffff0000u)) : ((v.x & 0xffffu) | (px << 16));
    const unsigned d1 = odd ? ((py >> 16) | (v.y & 0xffff0000u)) : ((v.y & 0xffffu) | (py << 16));
    const unsigned d2 = odd ? ((pz >> 16) | (v.z & 0xffff0000u)) : ((v.z & 0xffffu) | (pz << 16));
    const unsigned d3 = odd ? ((pw >> 16) | (v.w & 0xffff0000u)) : ((v.w & 0xffffu) | (pw << 16));
    LAS unsigned* wp = (LAS unsigned*)(base + (odd ? stride : 0)) + colpair;
    wp[0] = d0; wp[stride] = d1; wp[2 * stride] = d2; wp[3 * stride] = d3;
}
DI float silu_f(float x) { return x / (1.0f + __expf(-x)); }
#define LDS_WAIT() asm volatile("s_waitcnt lgkmcnt(0)" ::: "memory")

struct Params { const float* in[18]; float* out; unsigned char* ws; };

DI const float* xrow_ptr(const Params& p, int t) { return t < TP ? p.in[0] + (size_t)t * DM : p.in[1] + (size_t)(t - TP) * DM; }

namespace pg8 {
constexpr int BM = 256, BK = 64, HALF = 128, HTB = HALF * BK * 2, NXCD = 8, WGM = 8;
DI int lds_byte(int r, int c) { const int st = (r >> 4) * 2 + (c >> 5), rr = r & 15, cc = c & 31, ob = rr * 64 + cc * 2; return st * 1024 + (ob ^ (((ob >> 9) & 1) << 5)); }
DI void stage_rc(int b, int& R, int& C) { const int st = b / 1024, sb = b % 1024, swz = sb ^ (((sb >> 9) & 1) << 5); R = (st >> 1) * 16 + swz / 64; C = (st & 1) * 32 + (swz % 64) / 2; }
DI int perm32(int rho) { const int n = rho >> 4, i = rho & 15; return 8 * (i >> 2) + 4 * n + (i & 3); }

struct Unit { int pm, pn, bt; };

DI int xcd_remap(int L, int nwg) { const int q = nwg / NXCD, r = nwg % NXCD, xcd = L % NXCD, off = L / NXCD; return (xcd < r ? xcd * (q + 1) : r * (q + 1) + (xcd - r) * q) + off; }

struct SchedPlain {
    int nM, nN, nwg, G, c;
    DI void init(int M, int N, int G_, int c_) { nM = M / BM; nN = N / BM; nwg = nM * nN; G = G_; c = c_; }
    DI bool next(int i, Unit& u) const {
        const int L = i * G + c; if (L >= nwg) return false;
        const int wgid = xcd_remap(L, nwg);
        const int nig = WGM * nN, gid = wgid / nig, fm = gid * WGM, gsz = (nM - fm) < WGM ? (nM - fm) : WGM;
        u.pm = fm + ((wgid % nig) % gsz); u.pn = (wgid % nig) / gsz; u.bt = u.pn; return true;
    }
    DI int arow(const Unit& u, int r) const { return u.pm * BM + r; }
};
template <int NPN, bool GATHER> struct SchedGrouped {
    int G, c; const int* idx;
    DI bool next(int i, Unit& u) const {
        constexpr int PER_E = 24 * NPN, NWG = 8 * PER_E;
        const int L = i * G + c; if (L >= NWG) return false;
        const int wgid = xcd_remap(L, NWG);
        const int e = wgid / PER_E, rem = wgid % PER_E;
        const int gid = rem / (8 * NPN), w2 = rem % (8 * NPN);
        u.pm = e * 24 + gid * 8 + (w2 % 8); u.pn = w2 / 8; u.bt = e * NPN + u.pn; return true;
    }
    DI int arow(const Unit& u, int r) const { if (GATHER) return idx[u.pm * BM + r]; else return u.pm * BM + r; }
};

template <class Epi, class Sched>
DI void gemm_phase(LAS unsigned char* lds, const bf16_t* Ag, const bf16_t* Btg, const int K, const Sched& S, const Epi& E) {
    int tid_ = threadIdx.x; asm volatile("" : "+v"(tid_));
    const int tid = tid_, wid = __builtin_amdgcn_readfirstlane(tid >> 6), lane = tid & 63, wr = wid >> 2, wc = wid & 3, fr = lane & 15, fq = lane >> 4;
    const int nt = K / BK;
    int Rr[2], Cc[2]; unsigned voffB[2];
#pragma unroll
    for (int i = 0; i < 2; ++i) { int R, C; stage_rc(tid * 16 + i * 8192, R, C); const int Rb = Epi::PERM ? ((R & ~31) + perm32(R & 31)) : R;
        Rr[i] = R; Cc[i] = C; voffB[i] = (unsigned)(Rb * K + C) * 2u; }
    const unsigned rowbytes = (unsigned)K * 2u;
    const size_t kstep = (size_t)(BK * 2);
    const size_t hstep = (size_t)HALF * K * 2;
    const size_t tstep = 2 * hstep;
    const unsigned ldsw = (unsigned)wid * 1024u;
    const int aoff = lds_byte(wr * 64 + fr, fq * 8), boff = lds_byte(wc * 32 + fr, fq * 8);
#define PG8_SA(b, h) (((b) * 2 + (h)) * HTB)
#define PG8_SB(b, h) ((4 + (b) * 2 + (h)) * HTB)
#define PG8_STAGE(bufoff, gbase, voff) do { _Pragma("unroll") for (int _i = 0; _i < 2; ++_i) \
        __builtin_amdgcn_global_load_lds((const unsigned*)((const char*)(gbase) + (voff)[_i]), (LAS unsigned*)(lds + (bufoff) + ldsw + _i * 8192), 16, 0, 0); } while (0)
#define PG8_STAGEA(bufoff, o0, o1, kb) do { \
        __builtin_amdgcn_global_load_lds((const unsigned*)((const char*)Ag + (size_t)(o0) + (size_t)(kb)), (LAS unsigned*)(lds + (bufoff) + ldsw), 16, 0, 0); \
        __builtin_amdgcn_global_load_lds((const unsigned*)((const char*)Ag + (size_t)(o1) + (size_t)(kb)), (LAS unsigned*)(lds + (bufoff) + ldsw + 8192), 16, 0, 0); } while (0)
#define PG8_LDA(dst, b, h) do { _Pragma("unroll") for (int m = 0; m < 4; ++m) _Pragma("unroll") for (int k = 0; k < 2; ++k) dst[m][k] = *(const LAS bf16x8*)(lds + PG8_SA(b, h) + aoff + m * 2048 + k * 1024); } while (0)
#define PG8_LDB(dst, b, h) do { _Pragma("unroll") for (int n = 0; n < 2; ++n) _Pragma("unroll") for (int k = 0; k < 2; ++k) dst[n][k] = *(const LAS bf16x8*)(lds + PG8_SB(b, h) + boff + n * 2048 + k * 1024); } while (0)
#define PG8_MMA(ai, bj, At, Bt) do { __builtin_amdgcn_s_setprio(1); _Pragma("unroll") for (int m = 0; m < 4; ++m) _Pragma("unroll") for (int n = 0; n < 2; ++n) _Pragma("unroll") for (int k = 0; k < 2; ++k) \
        acc[ai][bj][m][n] = __builtin_amdgcn_mfma_f32_16x16x32_bf16(Bt[n][k], At[m][k], acc[ai][bj][m][n], 0, 0, 0); __builtin_amdgcn_s_setprio(0); } while (0)
#define PG8_WAIT_V(n) asm volatile("s_waitcnt vmcnt(" #n ")" ::: "memory")
#define PG8_WAIT_L(n) asm volatile("s_waitcnt lgkmcnt(" #n ")" ::: "memory")
#define PG8_BAR __builtin_amdgcn_s_barrier()
#define PG8_SCHED __builtin_amdgcn_sched_barrier(0)
#define PG8_OFFS(u, o00, o01, o10, o11) do { \
        o00 = (unsigned)S.arow(u, Rr[0]) * rowbytes + (unsigned)Cc[0] * 2u; o01 = (unsigned)S.arow(u, Rr[1]) * rowbytes + (unsigned)Cc[1] * 2u; \
        o10 = (unsigned)S.arow(u, HALF + Rr[0]) * rowbytes + (unsigned)Cc[0] * 2u; o11 = (unsigned)S.arow(u, HALF + Rr[1]) * rowbytes + (unsigned)Cc[1] * 2u; } while (0)
    Unit cur, nxt; int ui = 0;
    if (!S.next(0, cur)) return;
    f32x4 acc[2][2][4][2];
#pragma unroll
    for (int a = 0; a < 2; ++a)
#pragma unroll
        for (int b = 0; b < 2; ++b)
#pragma unroll
            for (int m = 0; m < 4; ++m)
#pragma unroll
                for (int n = 0; n < 2; ++n) acc[a][b][m][n] = (f32x4){0.f, 0.f, 0.f, 0.f};
    bf16x8 At[4][2], B0[2][2], B1[2][2];
    unsigned c00, c01, c10, c11;
    PG8_OFFS(cur, c00, c01, c10, c11);
    const char* cB = (const char*)Btg + (size_t)cur.bt * tstep;
    PG8_STAGE(PG8_SB(0, 0), cB, voffB); PG8_STAGE(PG8_SB(0, 1), cB + hstep, voffB); PG8_STAGEA(PG8_SA(0, 0), c00, c01, 0); PG8_STAGEA(PG8_SA(0, 1), c10, c11, 0);
    if (wr == 1) PG8_BAR;
    PG8_WAIT_V(2); PG8_BAR;
    PG8_STAGE(PG8_SB(1, 0), cB + kstep, voffB); PG8_STAGEA(PG8_SA(1, 0), c00, c01, kstep); PG8_STAGE(PG8_SB(1, 1), cB + hstep + kstep, voffB);
    PG8_WAIT_V(6); PG8_BAR;
    for (;;) {
        const bool has_next = S.next(ui + 1, nxt);
        const char* nB = has_next ? (const char*)Btg + (size_t)nxt.bt * tstep : cB;
        for (int t = 0; t < nt; t += 2) {
            const bool last = (t == nt - 2);
            const size_t kb1 = (size_t)(t + 1) * kstep;
            const size_t kb2 = last ? 0 : (size_t)(t + 2) * kstep, kb3 = kb2 + kstep;
            const char* b2 = last ? nB : cB + (size_t)(t + 2) * kstep; const char* b3 = b2 + kstep;
            PG8_LDB(B0, 0, 0); PG8_LDB(B1, 0, 1); PG8_SCHED; PG8_LDA(At, 0, 0); PG8_STAGEA(PG8_SA(1, 1), c10, c11, kb1);
            PG8_WAIT_V(8); PG8_WAIT_L(0); PG8_BAR; PG8_MMA(0, 0, At, B0); PG8_MMA(0, 1, At, B1); PG8_BAR; PG8_SCHED;
            if (last && has_next) { PG8_OFFS(nxt, c00, c01, c10, c11); }
            PG8_LDA(At, 0, 1); PG8_STAGE(PG8_SB(0, 0), b2, voffB); PG8_STAGE(PG8_SB(0, 1), b2 + hstep, voffB); PG8_STAGEA(PG8_SA(0, 0), c00, c01, kb2);
            PG8_WAIT_V(8); PG8_WAIT_L(0); PG8_BAR; PG8_MMA(1, 0, At, B0); PG8_MMA(1, 1, At, B1); PG8_BAR; PG8_SCHED;
            PG8_LDB(B0, 1, 0); PG8_LDB(B1, 1, 1); PG8_SCHED; PG8_LDA(At, 1, 0); PG8_STAGEA(PG8_SA(0, 1), c10, c11, kb2);
            PG8_WAIT_V(8); PG8_WAIT_L(0); PG8_BAR; PG8_MMA(0, 0, At, B0); PG8_MMA(0, 1, At, B1); PG8_BAR; PG8_SCHED;
            PG8_LDA(At, 1, 1); PG8_STAGE(PG8_SB(1, 0), b3, voffB); PG8_STAGE(PG8_SB(1, 1), b3 + hstep, voffB); PG8_STAGEA(PG8_SA(1, 0), c00, c01, kb3);
            PG8_WAIT_V(8); PG8_WAIT_L(0); PG8_BAR; PG8_MMA(1, 0, At, B0); PG8_MMA(1, 1, At, B1); PG8_BAR; PG8_SCHED;
        }
        if (wr == 0) PG8_BAR;
        E(acc, cur, wr, wc, fr, fq);
        if (!has_next) break;
#pragma unroll
        for (int a = 0; a < 2; ++a)
#pragma unroll
            for (int b = 0; b < 2; ++b)
#pragma unroll
                for (int m = 0; m < 4; ++m)
#pragma unroll
                    for (int n = 0; n < 2; ++n) acc[a][b][m][n] = (f32x4){0.f, 0.f, 0.f, 0.f};
        cur = nxt; cB = nB; ++ui;
        if (wr == 1) PG8_BAR;
    }
    PG8_WAIT_V(0);
    PG8_BAR;
#undef PG8_SA
#undef PG8_SB
#undef PG8_STAGE
#undef PG8_STAGEA
#undef PG8_LDA
#undef PG8_LDB
#undef PG8_MMA
#undef PG8_WAIT_V
#undef PG8_WAIT_L
#undef PG8_BAR
#undef PG8_SCHED
#undef PG8_OFFS
}

struct EpiProj {
    static constexpr bool PERM = true;
    bf16_t* P; const float* rope;
    DI void operator()(const f32x4 (&acc)[2][2][4][2], const Unit& u, int wr, int wc, int fr, int fq) const {
        bf16_t* base = P + (size_t)u.pn * TILE_ELEMS;
        const bool rot = (u.pn < 4) && ((wc & 1) == 0);
#pragma unroll
        for (int ai = 0; ai < 2; ++ai)
#pragma unroll
            for (int m = 0; m < 4; ++m) {
                const int row = u.pm * BM + ai * HALF + wr * 64 + m * 16 + fr;
                asm volatile("" ::: "memory");
                f32x4 cs0 = {1.f, 1.f, 1.f, 1.f}, cs1 = cs0, sn0 = {0.f, 0.f, 0.f, 0.f}, sn1 = sn0;
                if (rot && fq < 2) {
                    const int s = row < TP ? (row & 4095) : (row & 8191);
                    const f32x4* rp = (const f32x4*)(rope + (size_t)s * 16);
                    cs0 = rp[0]; cs1 = rp[1]; sn0 = rp[2]; sn1 = rp[3];
                    if (fq == 0) { sn0 = -sn0; sn1 = -sn1; }
                }
#pragma unroll
                for (int bj = 0; bj < 2; ++bj) {
                    f32x4 v0 = acc[ai][bj][m][0], v1 = acc[ai][bj][m][1];
                    if (rot) {
                        f32x4 o0, o1;
#pragma unroll
                        for (int j = 0; j < 4; ++j) { o0[j] = __shfl_xor(v0[j], 16); o1[j] = __shfl_xor(v1[j], 16); }
                        if (fq < 2) { v0 = v0 * cs0 + o0 * sn0; v1 = v1 * cs1 + o1 * sn1; }
                    }
                    u32x4 w; w.x = pk2(v0[0], v0[1]); w.y = pk2(v0[2], v0[3]); w.z = pk2(v1[0], v1[1]); w.w = pk2(v1[2], v1[3]);
                    *(u32x4*)(base + (size_t)row * 256 + bj * HALF + wc * 32 + 8 * fq) = w;
                }
            }
    }
};
struct EpiOut {
    static constexpr bool PERM = false;
    Params p;
    DI void operator()(const f32x4 (&acc)[2][2][4][2], const Unit& u, int wr, int wc, int fr, int fq) const {
#pragma unroll
        for (int ai = 0; ai < 2; ++ai)
#pragma unroll
            for (int m = 0; m < 4; ++m) {
                const int row = u.pm * BM + ai * HALF + wr * 64 + m * 16 + fr;
                const float* xr = xrow_ptr(p, row); float* orow = p.out + (size_t)row * DM;
#pragma unroll
                for (int bj = 0; bj < 2; ++bj)
#pragma unroll
                    for (int n = 0; n < 2; ++n) {
                        const int col = u.pn * BM + bj * HALF + wc * 32 + 16 * n + 4 * fq;
                        const f32x4 xv = *(const f32x4*)(xr + col);
                        *(f32x4*)(orow + col) = xv * ALPHA + acc[ai][bj][m][n];
                    }
            }
    }
};
struct EpiGU {
    static constexpr bool PERM = true;
    bf16_t* H;
    DI void operator()(const f32x4 (&acc)[2][2][4][2], const Unit& u, int wr, int wc, int fr, int fq) const {
#pragma unroll
        for (int ai = 0; ai < 2; ++ai)
#pragma unroll
            for (int m = 0; m < 4; ++m) {
                const int row = u.pm * BM + ai * HALF + wr * 64 + m * 16 + fr;
                const f32x4 g0 = acc[ai][0][m][0], g1 = acc[ai][0][m][1], u0 = acc[ai][1][m][0], u1 = acc[ai][1][m][1];
                f32x4 h0, h1;
#pragma unroll
                for (int j = 0; j < 4; ++j) { h0[j] = silu_f(g0[j]) * u0[j]; h1[j] = silu_f(g1[j]) * u1[j]; }
                u32x4 w; w.x = pk2(h0[0], h0[1]); w.y = pk2(h0[2], h0[3]); w.z = pk2(h1[0], h1[1]); w.w = pk2(h1[2], h1[3]);
                *(u32x4*)(H + (size_t)row * FF + u.pn * 128 + wc * 32 + 8 * fq) = w;
            }
    }
};
struct EpiDown {
    static constexpr bool PERM = true;
    bf16_t* eo; const float* gate;
    DI void operator()(const f32x4 (&acc)[2][2][4][2], const Unit& u, int wr, int wc, int fr, int fq) const {
#pragma unroll
        for (int ai = 0; ai < 2; ++ai)
#pragma unroll
            for (int m = 0; m < 4; ++m) {
                const int slot = u.pm * BM + ai * HALF + wr * 64 + m * 16 + fr;
                const float gv = gate[slot];
                bf16_t* orow = eo + (size_t)slot * DM + u.pn * BM + wc * 32 + 8 * fq;
#pragma unroll
                for (int bj = 0; bj < 2; ++bj) {
                    const f32x4 v0 = acc[ai][bj][m][0] * gv, v1 = acc[ai][bj][m][1] * gv;
                    u32x4 w; w.x = pk2(v0[0], v0[1]); w.y = pk2(v0[2], v0[3]); w.z = pk2(v1[0], v1[1]); w.w = pk2(v1[2], v1[3]);
                    *(u32x4*)(orow + bj * HALF) = w;
                }
            }
    }
};
}

DI void transpose_item(const float* W, int ldw, int k0, int n0, bf16_t* WT, int ldt, int drow0, LAS float* scr, int lane) {
#pragma unroll 8
    for (int i = 0; i < 32; ++i) { const int kk = 2 * i + (lane >> 5); scr[kk * 33 + (lane & 31)] = W[(size_t)(k0 + kk) * ldw + n0 + (lane & 31)]; }
    LDS_WAIT();
    const int c = lane & 7;
#pragma unroll
    for (int j = 0; j < 4; ++j) { const int n = (lane >> 3) + 8 * j; const LAS float* s = scr + (8 * c) * 33 + n;
        u32x4 o; o.x = pk2(s[0 * 33], s[1 * 33]); o.y = pk2(s[2 * 33], s[3 * 33]); o.z = pk2(s[4 * 33], s[5 * 33]); o.w = pk2(s[6 * 33], s[7 * 33]);
        *(u32x4*)(WT + (size_t)(drow0 + n) * ldt + k0 + 8 * c) = o; }
    LDS_WAIT();
}

DI void sincos_small(double r, double& s, double& c) {
    const double r2 = r * r; double ss = 1.0, cc = 1.0;
#pragma unroll
    for (int n = 12; n >= 1; --n) { ss = 1.0 - ss * r2 * (1.0 / (double)((2 * n) * (2 * n + 1))); cc = 1.0 - cc * r2 * (1.0 / (double)((2 * n - 1) * (2 * n))); }
    s = r * ss; c = cc;
}

DI void dot16(const f32x4 (&v)[4], const LAS float* wT, int lane, float (&r)[16]) {
#pragma unroll
    for (int e = 0; e < 16; ++e) {
        float a = 0.f;
        if ((e & 1) == 0) asm volatile("" ::: "memory");
#pragma unroll
        for (int j = 0; j < 4; ++j) { const f32x4 w = *(const LAS f32x4*)(wT + e * 1024 + 256 * j + 4 * lane); a += v[j][0] * w[0] + v[j][1] * w[1] + v[j][2] * w[2] + v[j][3] * w[3]; }
        r[e] = wave_sum(a);
    }
}

DI void phase0(const Params& p, LAS unsigned char* lds, int gw, int NGW, int wave, int lane) {
    const int tid = threadIdx.x;
    {
        LAS float* scr = (LAS float*)(lds + wave * 16384);
        for (int it = gw; it < 2048; it += NGW) {
            if (it < 1536) { const int kb = it / 96, nb = it % 96; transpose_item(p.in[2], INW, 64 * kb, 32 * nb, (bf16_t*)(p.ws + WS_WI), DM, 32 * nb, scr, lane); }
            else { const int r = it - 1536, kb = r / 32, nb = r % 32; transpose_item(p.in[9], DM, 64 * kb, 32 * nb, (bf16_t*)(p.ws + WS_WO), DM, 32 * nb, scr, lane); }
        }
    }
    {
        float* rope = (float*)(p.ws + WS_ROPE);
        const float invf[8] = {1.0f, 0.1939227432012558f, 0.03760603070259094f, 0.007292664609849453f, 0.0014142135623842478f, 0.00027424818836152554f, 5.318296098266728e-05f, 1.0313386155758053e-05f};
        for (int id = blockIdx.x * NTHR + tid; id < 8192 * 8; id += gridDim.x * NTHR) {
            const int pos = id >> 3, i = id & 7;
            float inv = invf[0];
#pragma unroll
            for (int k = 1; k < 8; ++k) inv = (i == k) ? invf[k] : inv;
            const float ang = (float)pos * inv;
            const double x = (double)ang; const double kq = rint(x * 0.15915494309189535); const double r = x - kq * 6.283185307179586476925;
            double s, c; sincos_small(r, s, c);
            rope[pos * 16 + i] = (float)c; rope[pos * 16 + 8 + i] = (float)s;
        }
    }
    __syncthreads();
    LAS float* wT = (LAS float*)lds;
    for (int id = tid; id < 16384; id += NTHR) { const int k = id >> 4, e = id & 15; wT[e * 1024 + k] = p.in[2][(size_t)k * INW + 3072 + e]; }
    __syncthreads();
    const float* dtb = p.in[5];
    float bias = 0.f;
    if (lane < 16) bias = dtb[lane];
    bf16_t* xb = (bf16_t*)(p.ws + WS_XB); float* dtout = (float*)(p.ws + WS_DT);
    for (int t = gw; t < TT; t += NGW) {
        const f32x4* xr = (const f32x4*)xrow_ptr(p, t) + lane;
        f32x4 v[4];
#pragma unroll
        for (int j = 0; j < 4; ++j) v[j] = xr[64 * j];
        u32x2* o8 = (u32x2*)(xb + (size_t)t * DM) + lane;
#pragma unroll
        for (int j = 0; j < 4; ++j) { u32x2 w; w.x = pk2(v[j][0], v[j][1]); w.y = pk2(v[j][2], v[j][3]); o8[64 * j] = w; }
        float r[16]; dot16(v, wT, lane, r);
        float mine = 0.f;
#pragma unroll
        for (int e = 0; e < 16; ++e) mine = (lane == e) ? r[e] : mine;
        if (lane < 16) { const float z = mine + bias; dtout[(size_t)t * 16 + lane] = fmaxf(z, 0.f) + log1pf(__expf(-fabsf(z))); }
    }
}

DI void conv_phase(const Params& p) {
    const int tid = blockIdx.x * NTHR + threadIdx.x, nthr = gridDim.x * NTHR;
    const int c = tid & 127, ch = 8 * c, tile = ch >> 8, cit = ch & 255;
    const float* cw = p.in[3]; const float* cb = p.in[4];
    float w[5][8], b[8];
#pragma unroll
    for (int j = 0; j < 5; ++j)
#pragma unroll
        for (int e = 0; e < 8; ++e) w[j][e] = cw[j * 1024 + ch + e];
#pragma unroll
    for (int e = 0; e < 8; ++e) b[e] = cb[ch + e];
    const bf16_t* src = (const bf16_t*)(p.ws + WS_P) + (size_t)(8 + tile) * TILE_ELEMS + cit;
    bf16_t* dst = (bf16_t*)(p.ws + WS_XC) + (size_t)tile * TILE_ELEMS + cit;
    for (int it = tid; it < TT * 128; it += nthr) {
        const int t = it >> 7;
        const int S = t < TP ? 4096 : 8192, s = t & (S - 1);
        float a[8];
#pragma unroll
        for (int e = 0; e < 8; ++e) a[e] = b[e];
#pragma unroll
        for (int j = 0; j < 5; ++j) {
            const int sj = s + j - 2;
            if (sj >= 0 && sj < S) {
                const u32x4 v = *(const u32x4*)(src + (size_t)(t + j - 2) * 256);
                a[0] += bflo(v.x) * w[j][0]; a[1] += bfhi(v.x) * w[j][1]; a[2] += bflo(v.y) * w[j][2]; a[3] += bfhi(v.y) * w[j][3];
                a[4] += bflo(v.z) * w[j][4]; a[5] += bfhi(v.z) * w[j][5]; a[6] += bflo(v.w) * w[j][6]; a[7] += bfhi(v.w) * w[j][7];
            }
        }
        u32x4 o; o.x = pk2(silu_f(a[0]), silu_f(a[1])); o.y = pk2(silu_f(a[2]), silu_f(a[3])); o.z = pk2(silu_f(a[4]), silu_f(a[5])); o.w = pk2(silu_f(a[6]), silu_f(a[7]));
        *(u32x4*)(dst + (size_t)t * 256) = o;
    }
}

DI bf16x8 tr_pair(const LAS bf16_t* lo, const LAS bf16_t* hi) {
    const s16x4 a = __builtin_amdgcn_ds_read_tr16_b64_v4i16((LAS s16x4*)lo), b = __builtin_amdgcn_ds_read_tr16_b64_v4i16((LAS s16x4*)hi);
    return __builtin_shufflevector(a, b, 0, 1, 2, 3, 4, 5, 6, 7);
}
DI void attn_step_params(int sidx, int p0, int& d, int& base, int& nk, int& kbase) {
    const int pi = sidx < 12 ? 0 : (sidx < 18 ? 1 : 2);
    const int st = sidx - (pi == 0 ? 0 : (pi == 1 ? 12 : 18));
    d = 1 << (2 * pi); base = p0 - 64 * d; nk = 240 / d + 129; kbase = 32 * st;
}
DI void attn_phase(const Params& p, LAS unsigned char* lds, int gw, int NGW, int wave, int lane) {
    LAS bf16_t* Vn = (LAS bf16_t*)(lds + wave * 4608);
    const bf16_t* Pb = (const bf16_t*)(p.ws + WS_P);
    bf16_t* mix = (bf16_t*)(p.ws + WS_MIX);
    const int c = lane & 15, q = lane >> 4, qp = (lane & 15) >> 2, pp = lane & 3;
    for (int wi = gw; wi < 24576; wi += NGW) {
        const int head = wi & 7, qg = wi >> 3;
        const int t0 = (qg >> 4) * 256 + (qg & 15);
        const int S = t0 < TP ? 4096 : 8192, sbase = t0 & ~(S - 1), p0 = t0 - sbase;
        const int hoff = (head & 3) * 64;
        const bf16_t* Qt = Pb + (size_t)(0 + (head >> 2)) * TILE_ELEMS + hoff;
        const bf16_t* Kt = Pb + (size_t)(2 + (head >> 2)) * TILE_ELEMS + hoff;
        const bf16_t* Vg = Pb + (size_t)(4 + (head >> 2)) * TILE_ELEMS + hoff;
        bf16x8 qf[2];
        { const bf16_t* qrow = Qt + (size_t)(t0 + 16 * c) * 256; qf[0] = *(const bf16x8*)(qrow + 8 * q); qf[1] = *(const bf16x8*)(qrow + 32 + 8 * q); }
        f32x4 O[4];
#pragma unroll
        for (int d4 = 0; d4 < 4; ++d4) O[d4] = (f32x4){0.f, 0.f, 0.f, 0.f};
        float mrun = -1e30f, lsum = 0.f;
        const int pq = p0 + 16 * c;
        u32x4 vc[4], vn[4]; bf16x8 kc[2][2], kn[2][2];
#define ATT_LOADS(sidx_, V_, K_) do { int d_, base_, nk_, kbase_; attn_step_params(sidx_, p0, d_, base_, nk_, kbase_); \
            _Pragma("unroll") for (int i = 0; i < 4; ++i) { const int id = lane + 64 * i, key = id >> 3, dc = id & 7; \
                int pos = base_ + d_ * (kbase_ + key); pos = pos < 0 ? 0 : (pos > S - 1 ? S - 1 : pos); \
                V_[i] = *(const u32x4*)(Vg + (size_t)(sbase + pos) * 256 + 8 * dc); } \
            _Pragma("unroll") for (int kt = 0; kt < 2; ++kt) { int pos = base_ + d_ * (kbase_ + 16 * kt + c); pos = pos < 0 ? 0 : (pos > S - 1 ? S - 1 : pos); \
                const bf16_t* krow = Kt + (size_t)(sbase + pos) * 256; K_[kt][0] = *(const bf16x8*)(krow + 8 * q); K_[kt][1] = *(const bf16x8*)(krow + 32 + 8 * q); } } while (0)
        ATT_LOADS(0, vc, kc);
        for (int sidx = 0; sidx < 23; ++sidx) {
            if (sidx < 22) ATT_LOADS(sidx + 1, vn, kn);
            int d, base, nk, kbase; attn_step_params(sidx, p0, d, base, nk, kbase);
            const int win = 64 * d;
#pragma unroll
            for (int i = 0; i < 4; ++i) { const int id = lane + 64 * i; *(LAS u32x4*)(Vn + (id >> 3) * 72 + 8 * (id & 7)) = vc[i]; }
            f32x4 sc[2];
#pragma unroll
            for (int kt = 0; kt < 2; ++kt) {
                f32x4 a = {0.f, 0.f, 0.f, 0.f};
                a = __builtin_amdgcn_mfma_f32_16x16x32_bf16(kc[kt][0], qf[0], a, 0, 0, 0);
                a = __builtin_amdgcn_mfma_f32_16x16x32_bf16(kc[kt][1], qf[1], a, 0, 0, 0);
                sc[kt] = a;
            }
            bool valid[2][4]; float mloc = -1e30f;
#pragma unroll
            for (int kt = 0; kt < 2; ++kt)
#pragma unroll
                for (int j = 0; j < 4; ++j) {
                    const int kk = kbase + 16 * kt + 4 * q + j, pk = base + d * kk;
                    int df = pk - pq; df = df < 0 ? -df : df;
                    valid[kt][j] = (kk < nk) && (pk >= 0) && (pk < S) && (df <= win);
                    const float sv = valid[kt][j] ? sc[kt][j] * 0.125f : -1e30f;
                    sc[kt][j] = sv; mloc = fmaxf(mloc, sv);
                }
            mloc = fmaxf(mloc, __shfl_xor(mloc, 16)); mloc = fmaxf(mloc, __shfl_xor(mloc, 32));
            const float mnew = fmaxf(mrun, mloc), alpha = __expf(mrun - mnew);
            mrun = mnew;
            float ps = 0.f; float pv[2][4];
#pragma unroll
            for (int kt = 0; kt < 2; ++kt)
#pragma unroll
                for (int j = 0; j < 4; ++j) { pv[kt][j] = valid[kt][j] ? __expf(sc[kt][j] - mnew) : 0.f; ps += pv[kt][j]; }
            lsum = lsum * alpha + ps;
#pragma unroll
            for (int d4 = 0; d4 < 4; ++d4) O[d4] = O[d4] * alpha;
            u32x4 pw; pw.x = pk2(pv[0][0], pv[0][1]); pw.y = pk2(pv[0][2], pv[0][3]); pw.z = pk2(pv[1][0], pv[1][1]); pw.w = pk2(pv[1][2], pv[1][3]);
            const bf16x8 pf = __builtin_bit_cast(bf16x8, pw);
#pragma unroll
            for (int d4 = 0; d4 < 4; ++d4) {
                const LAS bf16_t* vr = Vn + (4 * q + qp) * 72 + 16 * d4 + 4 * pp;
                const bf16x8 vf = tr_pair(vr, vr + 16 * 72);
                O[d4] = __builtin_amdgcn_mfma_f32_16x16x32_bf16(vf, pf, O[d4], 0, 0, 0);
            }
#pragma unroll
            for (int i = 0; i < 4; ++i) vc[i] = vn[i];
#pragma unroll
            for (int kt = 0; kt < 2; ++kt) { kc[kt][0] = kn[kt][0]; kc[kt][1] = kn[kt][1]; }
        }
#undef ATT_LOADS
        lsum += __shfl_xor(lsum, 16); lsum += __shfl_xor(lsum, 32);
        const float inv = 1.0f / lsum;
        bf16_t* orow = mix + (size_t)(t0 + 16 * c) * DM + head * 64 + 4 * q;
#pragma unroll
        for (int d4 = 0; d4 < 4; ++d4) { u32x2 w; w.x = pk2(O[d4][0] * inv, O[d4][1] * inv); w.y = pk2(O[d4][2] * inv, O[d4][3] * inv); *(u32x2*)(orow + 16 * d4) = w; }
    }
}

constexpr size_t WS_SLOC = WS_P;
constexpr size_t WS_DEC = WS_P + 96 * MiB;
constexpr int N_SSD_ITEMS = 6144;
struct SsdItem { int h, dir, g, tb, ts; float A; };
DI SsdItem ssd_decode(const Params& p, int it) {
    int w, ci; if (it < 4096) { w = it >> 5; ci = it & 31; } else { w = 128 + ((it - 4096) >> 6); ci = (it - 4096) & 63; }
    SsdItem I; const int seq = w >> 4; I.h = (w >> 1) & 7; I.dir = w & 1; I.g = I.h >> 2;
    const int S = seq < 8 ? 4096 : 8192, sbase = seq < 8 ? seq * 4096 : TP + (seq - 8) * 8192;
    I.tb = I.dir ? sbase + S - 1 - 128 * ci : sbase + 128 * ci; I.ts = I.dir ? -1 : 1;
    I.A = -__expf(p.in[6][I.dir * 8 + I.h]);
    return I;
}
#define SSD_TOK(I, l) ((I).tb + (I).ts * (l))
DI void ssd_scan_chunk(float d0, float d1, float A, LAS float* acs, LAS float* dts, int lane) {
    const float v0 = d0 * A, v1 = d1 * A; float ps = v0 + v1;
#pragma unroll
    for (int o = 1; o < 64; o <<= 1) { const float t = __shfl_up(ps, o); if (lane >= o) ps += t; }
    acs[2 * lane] = ps - v1; acs[2 * lane + 1] = ps; dts[2 * lane] = d0; dts[2 * lane + 1] = d1;
}
DI void st_tr8(LAS bf16_t* wp, int stride, const u32x4 v) {
    wp[0 * stride] = (bf16_t)(v.x & 0xffffu); wp[1 * stride] = (bf16_t)(v.x >> 16); wp[2 * stride] = (bf16_t)(v.y & 0xffffu); wp[3 * stride] = (bf16_t)(v.y >> 16);
    wp[4 * stride] = (bf16_t)(v.z & 0xffffu); wp[5 * stride] = (bf16_t)(v.z >> 16); wp[6 * stride] = (bf16_t)(v.w & 0xffffu); wp[7 * stride] = (bf16_t)(v.w >> 16);
}
DI void ssd_state_phase(const Params& p, LAS unsigned char* lds, int wave, int lane) {
    const int tid = threadIdx.x, c = lane & 15, q = lane >> 4, w = wave, qp = (lane & 15) >> 2, pp = lane & 3;
    LAS float* acs = (LAS float*)(lds + 0); LAS float* dts = (LAS float*)(lds + 512);
    LAS bf16_t* Xt2 = (LAS bf16_t*)(lds + 1024); LAS bf16_t* Bt = (LAS bf16_t*)(lds + 1024 + 128 * 144);
    const float* dtb = (const float*)(p.ws + WS_DT);
    const bf16_t* XCb = (const bf16_t*)(p.ws + WS_XC);
    bf16_t* Sl = (bf16_t*)(p.ws + WS_SLOC); float* decv = (float*)(p.ws + WS_DEC);
    int it = blockIdx.x;
    if (it >= N_SSD_ITEMS) return;
    SsdItem I = ssd_decode(p, it);
    float pd0 = 0.f, pd1 = 0.f; u32x4 xv[2], bv[4];
#define SSD_LOADS_A(I) do { \
        if (w == 0) { pd0 = dtb[(size_t)SSD_TOK(I, 2 * lane) * 16 + (I).dir * 8 + (I).h]; pd1 = dtb[(size_t)SSD_TOK(I, 2 * lane + 1) * 16 + (I).dir * 8 + (I).h]; } \
        _Pragma("unroll") for (int i = 0; i < 2; ++i) { const int id = tid + NTHR * i, l = id >> 3, pc = id & 7; \
            xv[i] = *(const u32x4*)(XCb + (size_t)((I).h >> 2) * TILE_ELEMS + (size_t)SSD_TOK(I, l) * 256 + ((I).h & 3) * 64 + 8 * pc); } \
        _Pragma("unroll") for (int i = 0; i < 4; ++i) { const int id = tid + NTHR * i, l = id >> 4, ncn = id & 15; \
            bv[i] = *(const u32x4*)(XCb + 2 * TILE_ELEMS + (size_t)SSD_TOK(I, l) * 256 + (I).g * 128 + 8 * ncn); } } while (0)
    SSD_LOADS_A(I);
    for (; it < N_SSD_ITEMS; it += gridDim.x) {
        if (w == 0) ssd_scan_chunk(pd0, pd1, I.A, acs, dts, lane);
        __syncthreads();
        const float aend = acs[127];
#pragma unroll
        for (int i = 0; i < 2; ++i) {
            const int id = tid + NTHR * i, l = id >> 3, pc = id & 7;
            const float s2 = dts[l] * __expf(aend - acs[l]);
            const u32x4 v = xv[i];
            u32x4 o; o.x = pk2(bflo(v.x) * s2, bfhi(v.x) * s2); o.y = pk2(bflo(v.y) * s2, bfhi(v.y) * s2); o.z = pk2(bflo(v.z) * s2, bfhi(v.z) * s2); o.w = pk2(bflo(v.w) * s2, bfhi(v.w) * s2);
            *(LAS u32x4*)(Xt2 + l * 72 + 8 * pc) = o;
        }
#pragma unroll
        for (int i = 0; i < 4; ++i) { const int id = tid + NTHR * i; *(LAS u32x4*)(Bt + (id >> 4) * 136 + 8 * (id & 15)) = bv[i]; }
        const int itn = it + gridDim.x;
        if (itn < N_SSD_ITEMS) { I = ssd_decode(p, itn); SSD_LOADS_A(I); }
        __syncthreads();
        bf16_t* so = Sl + (size_t)it * 8192 + 16 * w + 4 * q;
#pragma unroll
        for (int pt = 0; pt < 4; ++pt) {
            f32x4 a = {0.f, 0.f, 0.f, 0.f};
#pragma unroll
            for (int ks = 0; ks < 4; ++ks) {
                const LAS bf16_t* br = Bt + (32 * ks + 8 * q + qp) * 136 + 16 * w + 4 * pp;
                const LAS bf16_t* xr = Xt2 + (32 * ks + 8 * q + qp) * 72 + 16 * pt + 4 * pp;
                const bf16x8 bfr = tr_pair(br, br + 4 * 136), xf = tr_pair(xr, xr + 4 * 72);
                a = __builtin_amdgcn_mfma_f32_16x16x32_bf16(bfr, xf, a, 0, 0, 0);
            }
            u32x2 o; o.x = pk2(a[0], a[1]); o.y = pk2(a[2], a[3]);
            *(u32x2*)(so + (16 * pt + c) * 128) = o;
        }
        if (tid == 0) decv[it] = __expf(aend);
    }
#undef SSD_LOADS_A
}
DI void ssd_scan_phase(const Params& p) {
    unsigned* Sl = (unsigned*)(p.ws + WS_SLOC); const float* decv = (const float*)(p.ws + WS_DEC);
    for (int chain = blockIdx.x * NTHR + threadIdx.x; chain < 160 * 4096; chain += gridDim.x * NTHR) {
        const int w = chain >> 12, j = chain & 4095;
        const int nc = w < 128 ? 32 : 64, cb = w < 128 ? 32 * w : 4096 + 64 * (w - 128);
        unsigned* ptr = Sl + (size_t)cb * 4096 + j; const float* dp = decv + cb;
        float s0 = 0.f, s1 = 0.f;
        for (int c0 = 0; c0 < nc; c0 += 8) {
            unsigned v[8]; float d[8];
#pragma unroll
            for (int k = 0; k < 8; ++k) { v[k] = ptr[(size_t)(c0 + k) * 4096]; d[k] = dp[c0 + k]; }
#pragma unroll
            for (int k = 0; k < 8; ++k) { ptr[(size_t)(c0 + k) * 4096] = pk2(s0, s1); s0 = s0 * d[k] + bflo(v[k]); s1 = s1 * d[k] + bfhi(v[k]); }
        }
    }
}
constexpr int SSDC_ACS = 0  , SSDC_XT1 = 2048, SSDC_BN = SSDC_XT1 + 128 * 144, SSDC_SBF = SSDC_BN + 128 * 272, SSDC_END = SSDC_SBF + 64 * 272;
static_assert(SSDC_END <= 131072, "ssd lds");
DI void ssd_out_phase(const Params& p, LAS unsigned char* lds, int wave, int lane) {
    const int tid = threadIdx.x, c = lane & 15, q = lane >> 4, w = wave, qp = (lane & 15) >> 2, pp = lane & 3;
    LAS bf16_t* Xt1 = (LAS bf16_t*)(lds + SSDC_XT1); LAS bf16_t* Bn = (LAS bf16_t*)(lds + SSDC_BN); LAS bf16_t* Sbf = (LAS bf16_t*)(lds + SSDC_SBF);
    const float* dtb = (const float*)(p.ws + WS_DT);
    const bf16_t* XCb = (const bf16_t*)(p.ws + WS_XC);
    const bf16_t* Sl = (const bf16_t*)(p.ws + WS_SLOC);
    int it = blockIdx.x;
    if (it >= N_SSD_ITEMS) return;
    SsdItem I = ssd_decode(p, it);
    float pd0 = 0.f, pd1 = 0.f; u32x4 xv[2], bv[4], sv[2]; bf16x8 Cn[4];
#define SSD_LOADS_C(I, itx) do { \
        if (w == 0) { pd0 = dtb[(size_t)SSD_TOK(I, 2 * lane) * 16 + (I).dir * 8 + (I).h]; pd1 = dtb[(size_t)SSD_TOK(I, 2 * lane + 1) * 16 + (I).dir * 8 + (I).h]; } \
        _Pragma("unroll") for (int i = 0; i < 2; ++i) { const int id = tid + NTHR * i, l = id >> 3, pc = id & 7; \
            xv[i] = *(const u32x4*)(XCb + (size_t)((I).h >> 2) * TILE_ELEMS + (size_t)SSD_TOK(I, l) * 256 + ((I).h & 3) * 64 + 8 * pc); \
            sv[i] = *(const u32x4*)(Sl + (size_t)(itx) * 8192 + (size_t)id * 8); } \
        _Pragma("unroll") for (int i = 0; i < 4; ++i) { const int id = tid + NTHR * i, l = id >> 4, ncn = id & 15; \
            bv[i] = *(const u32x4*)(XCb + 2 * TILE_ELEMS + (size_t)SSD_TOK(I, l) * 256 + (I).g * 128 + 8 * ncn); } \
        { const bf16_t* cr = XCb + 3 * TILE_ELEMS + (size_t)SSD_TOK(I, 16 * w + c) * 256 + (I).g * 128 + 8 * q; \
          _Pragma("unroll") for (int ks = 0; ks < 4; ++ks) Cn[ks] = *(const bf16x8*)(cr + 32 * ks); } } while (0)
    SSD_LOADS_C(I, it);
    int par = 0;
    for (; it < N_SSD_ITEMS; it += gridDim.x, par ^= 1) {
        LAS float* acs = (LAS float*)(lds + SSDC_ACS + par * 1024); LAS float* dts = acs + 128;
        if (w == 0) ssd_scan_chunk(pd0, pd1, I.A, acs, dts, lane);
        __syncthreads();
#pragma unroll
        for (int i = 0; i < 2; ++i) {
            const int id = tid + NTHR * i, l = id >> 3, pc = id & 7;
            const float s1 = dts[l];
            const u32x4 v = xv[i];
            u32x4 o; o.x = pk2(bflo(v.x) * s1, bfhi(v.x) * s1); o.y = pk2(bflo(v.y) * s1, bfhi(v.y) * s1); o.z = pk2(bflo(v.z) * s1, bfhi(v.z) * s1); o.w = pk2(bflo(v.w) * s1, bfhi(v.w) * s1);
            *(LAS u32x4*)(Xt1 + l * 72 + 8 * pc) = o;
            *(LAS u32x4*)(Sbf + (id >> 4) * 136 + 8 * (id & 15)) = sv[i];
        }
#pragma unroll
        for (int i = 0; i < 4; ++i) { const int id = tid + NTHR * i; *(LAS u32x4*)(Bn + (id >> 4) * 136 + 8 * (id & 15)) = bv[i]; }
        bf16x8 Cf[4];
#pragma unroll
        for (int ks = 0; ks < 4; ++ks) Cf[ks] = Cn[ks];
        const SsdItem Ic = I;
        const int itn = it + gridDim.x;
        if (itn < N_SSD_ITEMS) { I = ssd_decode(p, itn); SSD_LOADS_C(I, itn); }
        __syncthreads();
        {
            const int l = 16 * w + c;
            const float al = acs[l];
            f32x4 acc[4];
#pragma unroll
            for (int pt = 0; pt < 4; ++pt) {
                f32x4 a = {0.f, 0.f, 0.f, 0.f};
#pragma unroll
                for (int ks = 0; ks < 4; ++ks) { const bf16x8 sf = *(const LAS bf16x8*)(Sbf + (16 * pt + c) * 136 + 32 * ks + 8 * q); a = __builtin_amdgcn_mfma_f32_16x16x32_bf16(sf, Cf[ks], a, 0, 0, 0); }
                acc[pt] = a * __expf(al);
            }
            const int nsp = (w >> 1) + 1;
            for (int sp = 0; sp < nsp; ++sp) {
                f32x4 M[2];
#pragma unroll
                for (int hh = 0; hh < 2; ++hh) {
                    const int st = 2 * sp + hh;
                    f32x4 G = {0.f, 0.f, 0.f, 0.f};
                    if (st <= w) {
#pragma unroll
                        for (int ks = 0; ks < 4; ++ks) { const bf16x8 bfr = *(const LAS bf16x8*)(Bn + (16 * st + c) * 136 + 32 * ks + 8 * q); G = __builtin_amdgcn_mfma_f32_16x16x32_bf16(bfr, Cf[ks], G, 0, 0, 0); }
#pragma unroll
                        for (int j = 0; j < 4; ++j) { const int s = 16 * st + 4 * q + j; const float e = __expf(al - acs[s]); G[j] = (s <= l) ? G[j] * e : 0.f; }
                    }
                    M[hh] = G;
                }
                u32x4 pw; pw.x = pk2(M[0][0], M[0][1]); pw.y = pk2(M[0][2], M[0][3]); pw.z = pk2(M[1][0], M[1][1]); pw.w = pk2(M[1][2], M[1][3]);
                const bf16x8 pf = __builtin_bit_cast(bf16x8, pw);
#pragma unroll
                for (int pt = 0; pt < 4; ++pt) {
                    const LAS bf16_t* xr = Xt1 + (32 * sp + 4 * q + qp) * 72 + 16 * pt + 4 * pp;
                    const bf16x8 xf = tr_pair(xr, xr + 16 * 72);
                    acc[pt] = __builtin_amdgcn_mfma_f32_16x16x32_bf16(xf, pf, acc[pt], 0, 0, 0);
                }
            }
            bf16_t* yr = (bf16_t*)(p.ws + (Ic.dir ? WS_YB : WS_YF)) + Ic.h * 64 + (size_t)SSD_TOK(Ic, l) * 512 + 4 * q;
#pragma unroll
            for (int pt = 0; pt < 4; ++pt) { u32x2 o; o.x = pk2(acc[pt][0], acc[pt][1]); o.y = pk2(acc[pt][2], acc[pt][3]); *(u32x2*)(yr + 16 * pt) = o; }
        }
    }
#undef SSD_LOADS_C
}

DI void gate_phase(const Params& p, int gw, int NGW, int lane) {
    const bf16_t* yf = (const bf16_t*)(p.ws + WS_YF); const bf16_t* yb = (const bf16_t*)(p.ws + WS_YB);
    const bf16_t* xh = (const bf16_t*)(p.ws + WS_XC) + (size_t)(lane >> 5) * TILE_ELEMS + (8 * lane & 255);
    const bf16_t* zt = (const bf16_t*)(p.ws + WS_P) + (size_t)(6 + (lane >> 5)) * TILE_ELEMS + (8 * lane & 255);
    bf16_t* mix = (bf16_t*)(p.ws + WS_MIX) + 512 + 8 * lane;
    const float D = p.in[7][lane >> 3];
    float nw[8];
#pragma unroll
    for (int e = 0; e < 8; ++e) nw[e] = p.in[8][8 * lane + e];
    for (int t = gw; t < TT; t += NGW) {
        const u32x4 a = *(const u32x4*)(yf + (size_t)t * 512 + 8 * lane), b = *(const u32x4*)(yb + (size_t)t * 512 + 8 * lane);
        const u32x4 x = *(const u32x4*)(xh + (size_t)t * 256), z = *(const u32x4*)(zt + (size_t)t * 256);
        float y[8];
        y[0] = (bflo(a.x) + bflo(b.x) + D * bflo(x.x)) * silu_f(bflo(z.x)); y[1] = (bfhi(a.x) + bfhi(b.x) + D * bfhi(x.x)) * silu_f(bfhi(z.x));
        y[2] = (bflo(a.y) + bflo(b.y) + D * bflo(x.y)) * silu_f(bflo(z.y)); y[3] = (bfhi(a.y) + bfhi(b.y) + D * bfhi(x.y)) * silu_f(bfhi(z.y));
        y[4] = (bflo(a.z) + bflo(b.z) + D * bflo(x.z)) * silu_f(bflo(z.z)); y[5] = (bfhi(a.z) + bfhi(b.z) + D * bfhi(x.z)) * silu_f(bfhi(z.z));
        y[6] = (bflo(a.w) + bflo(b.w) + D * bflo(x.w)) * silu_f(bflo(z.w)); y[7] = (bfhi(a.w) + bfhi(b.w) + D * bfhi(x.w)) * silu_f(bfhi(z.w));
        float ss = 0.f;
#pragma unroll
        for (int e = 0; e < 8; ++e) ss += y[e] * y[e];
        ss = wave_sum(ss);
        const float r = 1.0f / sqrtf(ss * (1.0f / 512.0f) + RMS_EPS);
        u32x4 o; o.x = pk2(y[0] * r * nw[0], y[1] * r * nw[1]); o.y = pk2(y[2] * r * nw[2], y[3] * r * nw[3]); o.z = pk2(y[4] * r * nw[4], y[5] * r * nw[5]); o.w = pk2(y[6] * r * nw[6], y[7] * r * nw[7]);
        *(u32x4*)(mix + (size_t)t * DM) = o;
    }
}

DI void expert_weights_phase(const Params& p, LAS unsigned char* lds, int gw, int NGW, int wave, int lane) {
    LAS float* scr = (LAS float*)(lds + wave * 16384);
    bf16_t* Wd = (bf16_t*)(p.ws + WS_WD);
    for (int it = gw; it < 16 * 4224; it += NGW) {
        const int e = it / 4224, r = it % 4224;
        if (r < 2816) {
            const int isup = r >= 1408, rr = isup ? r - 1408 : r, kb = rr / 88, nb = rr % 88, n0 = 32 * nb;
            const float* W = (isup ? p.in[14] : p.in[13]) + (size_t)e * DM * FF;
            bf16_t* Wgu = (bf16_t*)(p.ws + (e < 8 ? WS_WGU0 : WS_WGU1));
            transpose_item(W, FF, 64 * kb, n0, Wgu, DM, (e & 7) * 5632 + 256 * (n0 >> 7) + (n0 & 127) + (isup ? 128 : 0), scr, lane);
        } else {
            const int rr = r - 2816, kb = rr / 32, nb = rr % 32;
            transpose_item(p.in[15] + (size_t)e * FF * DM, DM, 64 * kb, 32 * nb, Wd, FF, e * 1024 + 32 * nb, scr, lane);
        }
    }
}

DI void ln1_router_phase(const Params& p, LAS unsigned char* lds, int gw, int NGW, int lane) {
    const int tid = threadIdx.x;
    LAS float* wT = (LAS float*)lds;
    for (int id = tid; id < 16384; id += NTHR) { const int k = id >> 4, e = id & 15; wT[e * 1024 + k] = p.in[12][id]; }
    __syncthreads();
    f32x4 gg[4], bb[4];
#pragma unroll
    for (int j = 0; j < 4; ++j) { gg[j] = ((const f32x4*)p.in[10])[64 * j + lane]; bb[j] = ((const f32x4*)p.in[11])[64 * j + lane]; }
    bf16_t* x1b = (bf16_t*)(p.ws + WS_X1B); float* aff = (float*)(p.ws + WS_AFF);
    for (int t = gw; t < TT; t += NGW) {
        f32x4* orow = (f32x4*)(p.out + (size_t)t * DM) + lane;
        f32x4 v[4]; float s = 0.f;
#pragma unroll
        for (int j = 0; j < 4; ++j) { v[j] = orow[64 * j]; s += (v[j][0] + v[j][1]) + (v[j][2] + v[j][3]); }
        const float mean = wave_sum(s) * (1.0f / DM); float s2 = 0.f;
#pragma unroll
        for (int j = 0; j < 4; ++j) { v[j] = v[j] - mean; s2 += (v[j][0] * v[j][0] + v[j][1] * v[j][1]) + (v[j][2] * v[j][2] + v[j][3] * v[j][3]); }
        const float rstd = 1.0f / sqrtf(wave_sum(s2) * (1.0f / DM) + LN_EPS);
        u32x2* o8 = (u32x2*)(x1b + (size_t)t * DM) + lane;
#pragma unroll
        for (int j = 0; j < 4; ++j) {
            v[j] = v[j] * rstd * gg[j] + bb[j];
            orow[64 * j] = v[j] * ALPHA;
            u32x2 w; w.x = pk2(v[j][0], v[j][1]); w.y = pk2(v[j][2], v[j][3]); o8[64 * j] = w;
        }
        float r[16]; dot16(v, wT, lane, r);
        float mx = r[0];
#pragma unroll
        for (int e = 1; e < 16; ++e) mx = fmaxf(mx, r[e]);
        float den = 0.f, mine = 0.f;
#pragma unroll
        for (int e = 0; e < 16; ++e) { const float ex = __expf(r[e] - mx); den += ex; mine = (lane == e) ? ex : mine; }
        if (lane < 16) aff[(size_t)lane * TT + t] = mine / den;
    }
}

DI void select_phase(const Params& p, LAS unsigned char* lds, int wave, int lane) {
    const int wk = blockIdx.x;
    if (wk >= 32) return;
    const int tid = threadIdx.x;
    const int trunk = wk >> 4, e = wk & 15;
    const int Tn = trunk ? 16384 : 32768, tbase = trunk ? TP : 0, cap = Tn / 8;
    const unsigned* col = (const unsigned*)(p.ws + WS_AFF) + (size_t)e * TT + tbase;
    LAS unsigned* hist = (LAS unsigned*)lds;
    LAS unsigned* ctl = (LAS unsigned*)(lds + 1024);
    LAS unsigned* wcnt = (LAS unsigned*)(lds + 2048);
    unsigned prefix = 0, remaining = (unsigned)cap;
    for (int pass = 0; pass < 4; ++pass) {
        const int shift = 24 - 8 * pass;
        for (int i = tid; i < 256; i += NTHR) hist[i] = 0u;
        __syncthreads();
        for (int i = tid; i < Tn; i += NTHR) {
            const unsigned bits = col[i];
            if (pass == 0 || (bits >> (shift + 8)) == prefix) atomicAdd((unsigned*)(hist + ((bits >> shift) & 255u)), 1u);
        }
        __syncthreads();
        if (tid == 0) {
            unsigned cum = 0; int b = 255;
            for (; b > 0; --b) { const unsigned hcnt = hist[b]; if (cum + hcnt >= remaining) break; cum += hcnt; }
            ctl[0] = (prefix << 8) | (unsigned)b; ctl[1] = remaining - cum;
        }
        __syncthreads();
        prefix = ctl[0]; remaining = ctl[1];
        __syncthreads();
    }
    const unsigned thr = prefix, need_eq = remaining;
    int* idx = (int*)(p.ws + WS_IDX) + e * SLOTS_E + (trunk ? 4096 : 0);
    int* inv = (int*)(p.ws + WS_INV) + (size_t)e * TT + tbase;
    const int slot0 = e * SLOTS_E + (trunk ? 4096 : 0);
    float* gate = (float*)(p.ws + WS_GATE) + e * SLOTS_E + (trunk ? 4096 : 0);
    unsigned sel_base = 0, eq_base = 0;
    for (int b0 = 0; b0 < Tn; b0 += NTHR) {
        const unsigned bits = col[b0 + tid];
        const bool gt = bits > thr, eq = bits == thr;
        const unsigned long long meq = __ballot(eq);
        const unsigned eq_before_w = (unsigned)__popcll(meq & ((1ull << lane) - 1ull));
        if (lane == 0) wcnt[wave] = (unsigned)__popcll(meq);
        __syncthreads();
        unsigned eq_off = 0, eq_tot = 0;
#pragma unroll
        for (int w2 = 0; w2 < 8; ++w2) { const unsigned cnt = wcnt[w2]; eq_off += (w2 < wave) ? cnt : 0u; eq_tot += cnt; }
        const bool sel = gt || (eq && (eq_base + eq_off + eq_before_w) < need_eq);
        const unsigned long long msel = __ballot(sel);
        const unsigned sel_before_w = (unsigned)__popcll(msel & ((1ull << lane) - 1ull));
        if (lane == 0) wcnt[8 + wave] = (unsigned)__popcll(msel);
        __syncthreads();
        unsigned sel_off = 0, sel_tot = 0;
#pragma unroll
        for (int w2 = 0; w2 < 8; ++w2) { const unsigned cnt = wcnt[8 + w2]; sel_off += (w2 < wave) ? cnt : 0u; sel_tot += cnt; }
        { const unsigned pos = sel_base + sel_off + sel_before_w; const bool ok = sel && pos < (unsigned)cap;
          if (ok) { idx[pos] = tbase + b0 + tid; gate[pos] = __uint_as_float(bits); }
          inv[b0 + tid] = ok ? slot0 + (int)pos : -1; }
        sel_base += sel_tot; eq_base += eq_tot;
        __syncthreads();
    }
}

DI void ln2_phase(const Params& p, int gw, int NGW, int lane) {
    f32x4 gg[4], bb[4];
#pragma unroll
    for (int j = 0; j < 4; ++j) { gg[j] = ((const f32x4*)p.in[16])[64 * j + lane]; bb[j] = ((const f32x4*)p.in[17])[64 * j + lane]; }
    const int* inv = (const int*)(p.ws + WS_INV); const bf16_t* eo = (const bf16_t*)(p.ws + WS_EO);
    for (int t = gw; t < TT; t += NGW) {
        f32x4* orow = (f32x4*)(p.out + (size_t)t * DM) + lane;
        f32x4 v[4]; float s = 0.f;
#pragma unroll
        for (int j = 0; j < 4; ++j) v[j] = orow[64 * j];
        const int myslot = lane < 16 ? inv[(size_t)lane * TT + t] : -1;
        for (int e = 0; e < 16; ++e) {
            const int sl = __shfl(myslot, e);
            if (sl >= 0) {
                const u32x2* er = (const u32x2*)(eo + (size_t)sl * DM) + lane;
#pragma unroll
                for (int j = 0; j < 4; ++j) { const u32x2 w = er[64 * j]; v[j][0] += bflo(w.x); v[j][1] += bfhi(w.x); v[j][2] += bflo(w.y); v[j][3] += bfhi(w.y); }
            }
        }
#pragma unroll
        for (int j = 0; j < 4; ++j) s += (v[j][0] + v[j][1]) + (v[j][2] + v[j][3]);
        const float mean = wave_sum(s) * (1.0f / DM); float s2 = 0.f;
#pragma unroll
        for (int j = 0; j < 4; ++j) { v[j] = v[j] - mean; s2 += (v[j][0] * v[j][0] + v[j][1] * v[j][1]) + (v[j][2] * v[j][2] + v[j][3] * v[j][3]); }
        const float rstd = 1.0f / sqrtf(wave_sum(s2) * (1.0f / DM) + LN_EPS);
#pragma unroll
        for (int j = 0; j < 4; ++j) orow[64 * j] = v[j] * rstd * gg[j] + bb[j];
    }
}

__global__ void __launch_bounds__(NTHR, 2) fwd_megakernel(Params p) {
    extern __shared__ __attribute__((aligned(16))) unsigned char lds_raw[];
    LAS unsigned char* lds = (LAS unsigned char*)lds_raw;
    cg::grid_group grid = cg::this_grid();
#define IDS() int tid_ = threadIdx.x; asm volatile("" : "+v"(tid_)); const int lane = tid_ & 63, wave = __builtin_amdgcn_readfirstlane(tid_ >> 6); \
    const int G = gridDim.x, gw = blockIdx.x * 8 + wave, NGW = G * 8; (void)lane; (void)gw; (void)NGW; (void)G;
    { IDS(); phase0(p, lds, gw, NGW, wave, lane); }
    grid.sync();
    {
        IDS();
        pg8::SchedPlain S; S.init(TT, 3072, G, (int)blockIdx.x);
        pg8::EpiProj E{(bf16_t*)(p.ws + WS_P), (const float*)(p.ws + WS_ROPE)};
        pg8::gemm_phase<pg8::EpiProj, pg8::SchedPlain>(lds, (const bf16_t*)(p.ws + WS_XB), (const bf16_t*)(p.ws + WS_WI), DM, S, E);
    }
    grid.sync();
    conv_phase(p);
    { IDS(); attn_phase(p, lds, gw, NGW, wave, lane); }
    grid.sync();
    { IDS(); ssd_state_phase(p, lds, wave, lane); }
    grid.sync();
    ssd_scan_phase(p);
    grid.sync();
    { IDS(); ssd_out_phase(p, lds, wave, lane); }
    grid.sync();
    { IDS(); gate_phase(p, gw, NGW, lane); }
    grid.sync();
    { IDS(); expert_weights_phase(p, lds, gw, NGW, wave, lane); }
    __syncthreads();
    {
        IDS();
        pg8::SchedPlain S; S.init(TT, DM, G, (int)blockIdx.x);
        pg8::EpiOut E{p};
        pg8::gemm_phase<pg8::EpiOut, pg8::SchedPlain>(lds, (const bf16_t*)(p.ws + WS_MIX), (const bf16_t*)(p.ws + WS_WO), DM, S, E);
    }
    grid.sync();
    { IDS(); ln1_router_phase(p, lds, gw, NGW, lane); }
    grid.sync();
    { IDS(); select_phase(p, lds, wave, lane); }
    grid.sync();
#pragma unroll 1
    for (int rnd = 0; rnd < 2; ++rnd) {
        {
            IDS();
            const int* idx = (const int*)(p.ws + WS_IDX) + rnd * 8 * SLOTS_E;
            pg8::SchedGrouped<22, true> S{G, (int)blockIdx.x, idx};
            pg8::EpiGU E{(bf16_t*)(p.ws + WS_HID)};
            pg8::gemm_phase<pg8::EpiGU, pg8::SchedGrouped<22, true>>(lds, (const bf16_t*)(p.ws + WS_X1B), (const bf16_t*)(p.ws + (rnd ? WS_WGU1 : WS_WGU0)), DM, S, E);
        }
        grid.sync();
        {
            IDS();
            const int* idx = (const int*)(p.ws + WS_IDX) + rnd * 8 * SLOTS_E;
            const float* gate = (const float*)(p.ws + WS_GATE) + rnd * 8 * SLOTS_E;
            pg8::SchedGrouped<4, false> S{G, (int)blockIdx.x, idx};
            pg8::EpiDown E{(bf16_t*)(p.ws + WS_EO) + (size_t)rnd * 8 * SLOTS_E * DM, gate};
            pg8::gemm_phase<pg8::EpiDown, pg8::SchedGrouped<4, false>>(lds, (const bf16_t*)(p.ws + WS_HID), (const bf16_t*)(p.ws + WS_WD) + (size_t)rnd * 8 * 1024 * FF, FF, S, E);
        }
        grid.sync();
    }
    { IDS(); ln2_phase(p, gw, NGW, lane); }
#undef IDS
}

extern "C" void kernel_launch(void* const* d_in, const int* in_sizes, int n_in, void* d_out, int out_size, void* d_ws, size_t ws_size, hipStream_t stream) {
    static int grid_blocks = 0;
    if (grid_blocks == 0) {
        if (n_in != 18 || ws_size < WS_END || out_size != TT * DM) { fprintf(stderr, "kernel_launch: unexpected shapes (n_in %d out %d ws %zu)\n", n_in, out_size, ws_size); grid_blocks = -1; return; }
        int dev = 0, cus = 0, per_cu = 0;
        hipGetDevice(&dev);
        hipDeviceGetAttribute(&cus, hipDeviceAttributeMultiprocessorCount, dev);
        if (hipFuncSetAttribute((const void*)fwd_megakernel, hipFuncAttributeMaxDynamicSharedMemorySize, LDS_BYTES) != hipSuccess) { fprintf(stderr, "kernel_launch: hipFuncSetAttribute failed\n"); }
        hipOccupancyMaxActiveBlocksPerMultiprocessor(&per_cu, (const void*)fwd_megakernel, NTHR, LDS_BYTES);
        if (per_cu < 1) per_cu = 1;
        (void)hipGetLastError();
        grid_blocks = cus * per_cu;
    }
    if (grid_blocks < 0) return;
    Params p{};
    for (int i = 0; i < 18; ++i) p.in[i] = (const float*)d_in[i];
    p.out = (float*)d_out; p.ws = (unsigned char*)d_ws;
    void* args[] = {&p};
    hipError_t e = hipLaunchCooperativeKernel((void*)fwd_megakernel, dim3(grid_blocks), dim3(NTHR), args, LDS_BYTES, stream);
    if (e != hipSuccess) fprintf(stderr, "cooperative launch failed: %s (grid %d)\n", hipGetErrorString(e), grid_blocks);
}
```

```cpp
#include <hip/hip_runtime.h>
#include <hip/hip_cooperative_groups.h>
#include <cstdio>
#include <cstdint>
namespace cg = cooperative_groups;

#define DI __device__ __forceinline__
#define LAS __attribute__((address_space(3)))
typedef unsigned short bf16_t;
typedef short bf16x8 __attribute__((ext_vector_type(8)));
typedef short s16x4 __attribute__((ext_vector_type(4)));
typedef float f32x4 __attribute__((ext_vector_type(4)));
typedef unsigned u32x4 __attribute__((ext_vector_type(4)));
typedef unsigned u32x2 __attribute__((ext_vector_type(2)));
typedef int i32x4 __attribute__((ext_vector_type(4)));
typedef int i32x8 __attribute__((ext_vector_type(8)));

constexpr int TT = 49152;
constexpr int TP = 32768;
constexpr int DM = 1024;
constexpr int INW = 3088;
constexpr int FF = 2816;
constexpr int NE = 16;
constexpr int SLOTS_E = 6144;
constexpr float ALPHA = 1.189207115002721f;
constexpr float LN_EPS = 1e-5f, RMS_EPS = 1e-5f;

constexpr size_t MiB = 1u << 20;
constexpr size_t TILE_ELEMS = (size_t)TT * 256;
constexpr size_t TILE_BYTES = TILE_ELEMS * 2;
constexpr size_t WS_WI = 0;
constexpr size_t WS_WO = 6 * MiB;
constexpr size_t WS_DT = 8 * MiB;
constexpr size_t WS_ROPE = 11 * MiB;
constexpr size_t WS_AFF = 12 * MiB;
constexpr size_t WS_IDX = 15 * MiB;
constexpr size_t WS_GATE = 15 * MiB + 512 * 1024;
constexpr size_t WS_P = 20 * MiB;
constexpr size_t WS_XC = 308 * MiB;
constexpr size_t WS_XB = 404 * MiB;
constexpr size_t WS_MIX = WS_XB;
constexpr size_t WS_YF = WS_P + 8 * TILE_BYTES;
constexpr size_t WS_YB = WS_P + 10 * TILE_BYTES;
constexpr size_t WS_INV = 16 * MiB;
constexpr size_t WS_WD = 20 * MiB;
constexpr size_t WS_WGU1 = 108 * MiB;
constexpr size_t WS_WGU0 = 196 * MiB;
constexpr size_t WS_EO = 212 * MiB;
constexpr size_t WS_X1B = 308 * MiB;
constexpr size_t WS_HID = 404 * MiB;
constexpr size_t WS_END = 668 * MiB;

constexpr int LDS_BYTES = 147456;
constexpr int NTHR = 512;

DI unsigned f2bf(float f) { unsigned u = __float_as_uint(f); return (u + 0x7fffu + ((u >> 16) & 1u)) >> 16; }
DI unsigned pk2(float lo, float hi) { return f2bf(lo) | (f2bf(hi) << 16); }
DI unsigned pk4_f8(float a, float b, float c, float d) { int w = 0; w = __builtin_amdgcn_cvt_pk_fp8_f32(a, b, w, false); w = __builtin_amdgcn_cvt_pk_fp8_f32(c, d, w, true); return (unsigned)w; }
DI i32x8 cat8(bf16x8 lo, bf16x8 hi) { const i32x4 a = __builtin_bit_cast(i32x4, lo), b = __builtin_bit_cast(i32x4, hi); return __builtin_shufflevector(a, b, 0, 1, 2, 3, 4, 5, 6, 7); }
constexpr float WGU_SCALE = 32.0f, WD_SCALE = 64.0f;
DI float bflo(unsigned u) { return __uint_as_float(u << 16); }
DI float bfhi(unsigned u) { return __uint_as_float(u & 0xffff0000u); }
DI float wave_sum(float v) {
#pragma unroll
    for (int o = 1; o < 64; o <<= 1) v += __shfl_xor(v, o);
    return v;
}
DI void st_tr8_pair(LAS bf16_t* base, int stride, int colpair, int lane, const u32x4 v) {
    const unsigned px = __shfl_xor(v.x, 1), py = __shfl_xor(v.y, 1), pz = __shfl_xor(v.z, 1), pw = __shfl_xor(v.w, 1);
    const bool odd = (lane & 1) != 0;
    const unsigned d0 = odd ? ((px >> 16) | (v.x & 0xffff0000u)) : ((v.x & 0xffffu) | (px << 16));
    const unsigned d1 = odd ? ((py >> 16) | (v.y & 0xffff0000u)) : ((v.y & 0xffffu) | (py << 16));
    const unsigned d2 = odd ? ((pz >> 16) | (v.z & 0xffff0000u)) : ((v.z & 0xffffu) | (pz << 16));
    const unsigned d3 = odd ? ((pw >> 16) | (v.w & 0xffff0000u)) : ((v.w & 0xffffu) | (pw << 16));
    LAS unsigned* wp = (LAS unsigned*)(base + (odd ? stride : 0)) + colpair;
    wp[0] = d0; wp[stride] = d1; wp[2 * stride] = d2; wp[3 * stride] = d3;
}
DI float silu_f(float x) { return x / (1.0f + __expf(-x)); }
#define LDS_WAIT() asm volatile("s_waitcnt lgkmcnt(0)" ::: "memory")

struct Params { const float* in[18]; float* out; unsigned char* ws; };

DI const float* xrow_ptr(const Params& p, int t) { return t < TP ? p.in[0] + (size_t)t * DM : p.in[1] + (size_t)(t - TP) * DM; }

namespace pg8 {
constexpr int BM = 256, BK = 64, HALF = 128, HTB = HALF * BK * 2, NXCD = 8, WGM = 8;
DI int lds_byte(int r, int c) { const int st = (r >> 4) * 2 + (c >> 5), rr = r & 15, cc = c & 31, ob = rr * 64 + cc * 2; return st * 1024 + (ob ^ (((ob >> 9) & 1) << 5)); }
DI void stage_rc(int b, int& R, int& C) { const int st = b / 1024, sb = b % 1024, swz = sb ^ (((sb >> 9) & 1) << 5); R = (st >> 1) * 16 + swz / 64; C = (st & 1) * 32 + (swz % 64) / 2; }
DI int perm32(int rho) { const int n = rho >> 4, i = rho & 15; return 8 * (i >> 2) + 4 * n + (i & 3); }

struct Unit { int pm, pn, bt; };

DI int xcd_remap(int L, int nwg) { const int q = nwg / NXCD, r = nwg % NXCD, xcd = L % NXCD, off = L / NXCD; return (xcd < r ? xcd * (q + 1) : r * (q + 1) + (xcd - r) * q) + off; }

struct SchedPlain {
    int nM, nN, nwg, G, c;
    DI void init(int M, int N, int G_, int c_) { nM = M / BM; nN = N / BM; nwg = nM * nN; G = G_; c = c_; }
    DI bool next(int i, Unit& u) const {
        const int L = i * G + c; if (L >= nwg) return false;
        const int wgid = xcd_remap(L, nwg);
        const int nig = WGM * nN, gid = wgid / nig, fm = gid * WGM, gsz = (nM - fm) < WGM ? (nM - fm) : WGM;
        u.pm = fm + ((wgid % nig) % gsz); u.pn = (wgid % nig) / gsz; u.bt = u.pn; return true;
    }
    DI int arow(const Unit& u, int r) const { return u.pm * BM + r; }
};
template <int NPN, bool GATHER> struct SchedGrouped {
    int G, c; const int* idx;
    DI bool next(int i, Unit& u) const {
        constexpr int PER_E = 24 * NPN, NWG = 8 * PER_E;
        const int L = i * G + c; if (L >= NWG) return false;
        const int wgid = xcd_remap(L, NWG);
        const int e = wgid / PER_E, rem = wgid % PER_E;
        const int gid = rem / (8 * NPN), w2 = rem % (8 * NPN);
        u.pm = e * 24 + gid * 8 + (w2 % 8); u.pn = w2 / 8; u.bt = e * NPN + u.pn; return true;
    }
    DI int arow(const Unit& u, int r) const { if (GATHER) return idx[u.pm * BM + r]; else return u.pm * BM + r; }
};

template <class Epi, class Sched, bool F8 = false>
DI void gemm_phase(LAS unsigned char* lds, const bf16_t* Ag, const bf16_t* Btg, const int K, const Sched& S, const Epi& E) {
    int tid_ = threadIdx.x; asm volatile("" : "+v"(tid_));
    const int tid = tid_, wid = __builtin_amdgcn_readfirstlane(tid >> 6), lane = tid & 63, wr = wid >> 2, wc = wid & 3, fr = lane & 15, fq = lane >> 4;
    const int nt = K / BK;
    int Rr[2], Cc[2]; unsigned voffB[2];
#pragma unroll
    for (int i = 0; i < 2; ++i) { int R, C; stage_rc(tid * 16 + i * 8192, R, C); const int Rb = Epi::PERM ? ((R & ~31) + perm32(R & 31)) : R;
        Rr[i] = R; Cc[i] = C; voffB[i] = (unsigned)(Rb * K + C) * 2u; }
    const unsigned rowbytes = (unsigned)K * 2u;
    const size_t kstep = (size_t)(BK * 2);
    const size_t hstep = (size_t)HALF * K * 2;
    const size_t tstep = 2 * hstep;
    const unsigned ldsw = (unsigned)wid * 1024u;
    const int aoff = lds_byte(wr * 64 + fr, fq * 8), boff = lds_byte(wc * 32 + fr, fq * 8);
#define PG8_SA(b, h) (((b) * 2 + (h)) * HTB)
#define PG8_SB(b, h) ((4 + (b) * 2 + (h)) * HTB)
#define PG8_STAGE(bufoff, gbase, voff) do { _Pragma("unroll") for (int _i = 0; _i < 2; ++_i) \
        __builtin_amdgcn_global_load_lds((const unsigned*)((const char*)(gbase) + (voff)[_i]), (LAS unsigned*)(lds + (bufoff) + ldsw + _i * 8192), 16, 0, 0); } while (0)
#define PG8_STAGEA(bufoff, o0, o1, kb) do { \
        __builtin_amdgcn_global_load_lds((const unsigned*)((const char*)Ag + (size_t)(o0) + (size_t)(kb)), (LAS unsigned*)(lds + (bufoff) + ldsw), 16, 0, 0); \
        __builtin_amdgcn_global_load_lds((const unsigned*)((const char*)Ag + (size_t)(o1) + (size_t)(kb)), (LAS unsigned*)(lds + (bufoff) + ldsw + 8192), 16, 0, 0); } while (0)
#define PG8_LDA(dst, b, h) do { _Pragma("unroll") for (int m = 0; m < 4; ++m) _Pragma("unroll") for (int k = 0; k < 2; ++k) dst[m][k] = *(const LAS bf16x8*)(lds + PG8_SA(b, h) + aoff + m * 2048 + k * 1024); } while (0)
#define PG8_LDB(dst, b, h) do { _Pragma("unroll") for (int n = 0; n < 2; ++n) _Pragma("unroll") for (int k = 0; k < 2; ++k) dst[n][k] = *(const LAS bf16x8*)(lds + PG8_SB(b, h) + boff + n * 2048 + k * 1024); } while (0)
#define PG8_MMA(ai, bj, At, Bt) do { __builtin_amdgcn_s_setprio(1); _Pragma("unroll") for (int m = 0; m < 4; ++m) _Pragma("unroll") for (int n = 0; n < 2; ++n) { \
        if constexpr (F8) { acc[ai][bj][m][n] = __builtin_amdgcn_mfma_scale_f32_16x16x128_f8f6f4(cat8(Bt[n][0], Bt[n][1]), cat8(At[m][0], At[m][1]), acc[ai][bj][m][n], 0, 0, 0, 0x7F7F7F7F, 0, 0x7F7F7F7F); } \
        else { _Pragma("unroll") for (int k = 0; k < 2; ++k) acc[ai][bj][m][n] = __builtin_amdgcn_mfma_f32_16x16x32_bf16(Bt[n][k], At[m][k], acc[ai][bj][m][n], 0, 0, 0); } } \
        __builtin_amdgcn_s_setprio(0); } while (0)
#define PG8_WAIT_V(n) asm volatile("s_waitcnt vmcnt(" #n ")" ::: "memory")
#define PG8_WAIT_L(n) asm volatile("s_waitcnt lgkmcnt(" #n ")" ::: "memory")
#define PG8_BAR __builtin_amdgcn_s_barrier()
#define PG8_SCHED __builtin_amdgcn_sched_barrier(0)
#define PG8_OFFS(u, o00, o01, o10, o11) do { \
        o00 = (unsigned)S.arow(u, Rr[0]) * rowbytes + (unsigned)Cc[0] * 2u; o01 = (unsigned)S.arow(u, Rr[1]) * rowbytes + (unsigned)Cc[1] * 2u; \
        o10 = (unsigned)S.arow(u, HALF + Rr[0]) * rowbytes + (unsigned)Cc[0] * 2u; o11 = (unsigned)S.arow(u, HALF + Rr[1]) * rowbytes + (unsigned)Cc[1] * 2u; } while (0)
    Unit cur, nxt; int ui = 0;
    if (!S.next(0, cur)) return;
    f32x4 acc[2][2][4][2];
#pragma unroll
    for (int a = 0; a < 2; ++a)
#pragma unroll
        for (int b = 0; b < 2; ++b)
#pragma unroll
            for (int m = 0; m < 4; ++m)
#pragma unroll
                for (int n = 0; n < 2; ++n) acc[a][b][m][n] = (f32x4){0.f, 0.f, 0.f, 0.f};
    bf16x8 At[4][2], B0[2][2], B1[2][2];
    unsigned c00, c01, c10, c11;
    PG8_OFFS(cur, c00, c01, c10, c11);
    const char* cB = (const char*)Btg + (size_t)cur.bt * tstep;
    PG8_STAGE(PG8_SB(0, 0), cB, voffB); PG8_STAGE(PG8_SB(0, 1), cB + hstep, voffB); PG8_STAGEA(PG8_SA(0, 0), c00, c01, 0); PG8_STAGEA(PG8_SA(0, 1), c10, c11, 0);
    if (wr == 1) PG8_BAR;
    PG8_WAIT_V(2); PG8_BAR;
    PG8_STAGE(PG8_SB(1, 0), cB + kstep, voffB); PG8_STAGEA(PG8_SA(1, 0), c00, c01, kstep); PG8_STAGE(PG8_SB(1, 1), cB + hstep + kstep, voffB);
    PG8_WAIT_V(6); PG8_BAR;
    for (;;) {
        const bool has_next = S.next(ui + 1, nxt);
        const char* nB = has_next ? (const char*)Btg + (size_t)nxt.bt * tstep : cB;
        for (int t = 0; t < nt; t += 2) {
            const bool last = (t == nt - 2);
            const size_t kb1 = (size_t)(t + 1) * kstep;
            const size_t kb2 = last ? 0 : (size_t)(t + 2) * kstep, kb3 = kb2 + kstep;
            const char* b2 = last ? nB : cB + (size_t)(t + 2) * kstep; const char* b3 = b2 + kstep;
            PG8_LDB(B0, 0, 0); PG8_LDB(B1, 0, 1); PG8_SCHED; PG8_LDA(At, 0, 0); PG8_STAGEA(PG8_SA(1, 1), c10, c11, kb1);
            PG8_WAIT_V(8); PG8_WAIT_L(0); PG8_BAR; PG8_MMA(0, 0, At, B0); PG8_MMA(0, 1, At, B1); PG8_BAR; PG8_SCHED;
            if (last && has_next) { PG8_OFFS(nxt, c00, c01, c10, c11); }
            PG8_LDA(At, 0, 1); PG8_STAGE(PG8_SB(0, 0), b2, voffB); PG8_STAGE(PG8_SB(0, 1), b2 + hstep, voffB); PG8_STAGEA(PG8_SA(0, 0), c00, c01, kb2);
            PG8_WAIT_V(8); PG8_WAIT_L(0); PG8_BAR; PG8_MMA(1, 0, At, B0); PG8_MMA(1, 1, At, B1); PG8_BAR; PG8_SCHED;
            PG8_LDB(B0, 1, 0); PG8_LDB(B1, 1, 1); PG8_SCHED; PG8_LDA(At, 1, 0); PG8_STAGEA(PG8_SA(0, 1), c10, c11, kb2);
            PG8_WAIT_V(8); PG8_WAIT_L(0); PG8_BAR; PG8_MMA(0, 0, At, B0); PG8_MMA(0, 1, At, B1); PG8_BAR; PG8_SCHED;
            PG8_LDA(At, 1, 1); PG8_STAGE(PG8_SB(1, 0), b3, voffB); PG8_STAGE(PG8_SB(1, 1), b3 + hstep, voffB); PG8_STAGEA(PG8_SA(1, 0), c00, c01, kb3);
            PG8_WAIT_V(8); PG8_WAIT_L(0); PG8_BAR; PG8_MMA(1, 0, At, B0); PG8_MMA(1, 1, At, B1); PG8_BAR; PG8_SCHED;
        }
        if (wr == 0) PG8_BAR;
        E(acc, cur, wr, wc, fr, fq);
        if (!has_next) break;
#pragma unroll
        for (int a = 0; a < 2; ++a)
#pragma unroll
            for (int b = 0; b < 2; ++b)
#pragma unroll
                for (int m = 0; m < 4; ++m)
#pragma unroll
                    for (int n = 0; n < 2; ++n) acc[a][b][m][n] = (f32x4){0.f, 0.f, 0.f, 0.f};
        cur = nxt; cB = nB; ++ui;
        if (wr == 1) PG8_BAR;
    }
    PG8_WAIT_V(0);
    PG8_BAR;
#undef PG8_SA
#undef PG8_SB
#undef PG8_STAGE
#undef PG8_STAGEA
#undef PG8_LDA
#undef PG8_LDB
#undef PG8_MMA
#undef PG8_WAIT_V
#undef PG8_WAIT_L
#undef PG8_BAR
#undef PG8_SCHED
#undef PG8_OFFS
}

struct EpiProj {
    static constexpr bool PERM = true;
    bf16_t* P; const float* rope;
    DI void operator()(const f32x4 (&acc)[2][2][4][2], const Unit& u, int wr, int wc, int fr, int fq) const {
        bf16_t* base = P + (size_t)u.pn * TILE_ELEMS;
        const bool rot = (u.pn < 4) && ((wc & 1) == 0);
#pragma unroll
        for (int ai = 0; ai < 2; ++ai)
#pragma unroll
            for (int m = 0; m < 4; ++m) {
                const int row = u.pm * BM + ai * HALF + wr * 64 + m * 16 + fr;
                asm volatile("" ::: "memory");
                f32x4 cs0 = {1.f, 1.f, 1.f, 1.f}, cs1 = cs0, sn0 = {0.f, 0.f, 0.f, 0.f}, sn1 = sn0;
                if (rot && fq < 2) {
                    const int s = row < TP ? (row & 4095) : (row & 8191);
                    const f32x4* rp = (const f32x4*)(rope + (size_t)s * 16);
                    cs0 = rp[0]; cs1 = rp[1]; sn0 = rp[2]; sn1 = rp[3];
                    if (fq == 0) { sn0 = -sn0; sn1 = -sn1; }
                }
#pragma unroll
                for (int bj = 0; bj < 2; ++bj) {
                    f32x4 v0 = acc[ai][bj][m][0], v1 = acc[ai][bj][m][1];
                    if (rot) {
                        f32x4 o0, o1;
#pragma unroll
                        for (int j = 0; j < 4; ++j) { o0[j] = __shfl_xor(v0[j], 16); o1[j] = __shfl_xor(v1[j], 16); }
                        if (fq < 2) { v0 = v0 * cs0 + o0 * sn0; v1 = v1 * cs1 + o1 * sn1; }
                    }
                    u32x4 w; w.x = pk2(v0[0], v0[1]); w.y = pk2(v0[2], v0[3]); w.z = pk2(v1[0], v1[1]); w.w = pk2(v1[2], v1[3]);
                    *(u32x4*)(base + (size_t)row * 256 + bj * HALF + wc * 32 + 8 * fq) = w;
                }
            }
    }
};
struct EpiOut {
    static constexpr bool PERM = false;
    Params p;
    DI void operator()(const f32x4 (&acc)[2][2][4][2], const Unit& u, int wr, int wc, int fr, int fq) const {
#pragma unroll
        for (int ai = 0; ai < 2; ++ai)
#pragma unroll
            for (int m = 0; m < 4; ++m) {
                const int row = u.pm * BM + ai * HALF + wr * 64 + m * 16 + fr;
                const float* xr = xrow_ptr(p, row); float* orow = p.out + (size_t)row * DM;
#pragma unroll
                for (int bj = 0; bj < 2; ++bj)
#pragma unroll
                    for (int n = 0; n < 2; ++n) {
                        const int col = u.pn * BM + bj * HALF + wc * 32 + 16 * n + 4 * fq;
                        const f32x4 xv = *(const f32x4*)(xr + col);
                        *(f32x4*)(orow + col) = xv * ALPHA + acc[ai][bj][m][n];
                    }
            }
    }
};
struct EpiGU {
    static constexpr bool PERM = true;
    unsigned char* H;
    DI void operator()(const f32x4 (&acc)[2][2][4][2], const Unit& u, int wr, int wc, int fr, int fq) const {
#pragma unroll
        for (int ai = 0; ai < 2; ++ai)
#pragma unroll
            for (int m = 0; m < 4; ++m) {
                const int row = u.pm * BM + ai * HALF + wr * 64 + m * 16 + fr;
                const f32x4 g0 = acc[ai][0][m][0], g1 = acc[ai][0][m][1], u0 = acc[ai][1][m][0], u1 = acc[ai][1][m][1];
                f32x4 h0, h1;
#pragma unroll
                for (int j = 0; j < 4; ++j) { h0[j] = silu_f(g0[j] * (1.0f / WGU_SCALE)) * (u0[j] * (1.0f / WGU_SCALE)); h1[j] = silu_f(g1[j] * (1.0f / WGU_SCALE)) * (u1[j] * (1.0f / WGU_SCALE)); }
                u32x2 w; w.x = pk4_f8(h0[0], h0[1], h0[2], h0[3]); w.y = pk4_f8(h1[0], h1[1], h1[2], h1[3]);
                *(u32x2*)(H + (size_t)row * FF + u.pn * 128 + wc * 32 + 8 * fq) = w;
            }
    }
};
struct EpiDown {
    static constexpr bool PERM = true;
    bf16_t* eo; const float* gate;
    DI void operator()(const f32x4 (&acc)[2][2][4][2], const Unit& u, int wr, int wc, int fr, int fq) const {
#pragma unroll
        for (int ai = 0; ai < 2; ++ai)
#pragma unroll
            for (int m = 0; m < 4; ++m) {
                const int slot = u.pm * BM + ai * HALF + wr * 64 + m * 16 + fr;
                const float gv = gate[slot] * (1.0f / WD_SCALE);
                bf16_t* orow = eo + (size_t)slot * DM + u.pn * BM + wc * 32 + 8 * fq;
#pragma unroll
                for (int bj = 0; bj < 2; ++bj) {
                    const f32x4 v0 = acc[ai][bj][m][0] * gv, v1 = acc[ai][bj][m][1] * gv;
                    u32x4 w; w.x = pk2(v0[0], v0[1]); w.y = pk2(v0[2], v0[3]); w.z = pk2(v1[0], v1[1]); w.w = pk2(v1[2], v1[3]);
                    *(u32x4*)(orow + bj * HALF) = w;
                }
            }
    }
};
}

DI void transpose_item(const float* W, int ldw, int k0, int n0, bf16_t* WT, int ldt, int drow0, LAS float* scr, int lane) {
#pragma unroll 8
    for (int i = 0; i < 32; ++i) { const int kk = 2 * i + (lane >> 5); scr[kk * 33 + (lane & 31)] = W[(size_t)(k0 + kk) * ldw + n0 + (lane & 31)]; }
    LDS_WAIT();
    const int c = lane & 7;
#pragma unroll
    for (int j = 0; j < 4; ++j) { const int n = (lane >> 3) + 8 * j; const LAS float* s = scr + (8 * c) * 33 + n;
        u32x4 o; o.x = pk2(s[0 * 33], s[1 * 33]); o.y = pk2(s[2 * 33], s[3 * 33]); o.z = pk2(s[4 * 33], s[5 * 33]); o.w = pk2(s[6 * 33], s[7 * 33]);
        *(u32x4*)(WT + (size_t)(drow0 + n) * ldt + k0 + 8 * c) = o; }
    LDS_WAIT();
}

DI void transpose_item_f8(const float* W, int ldw, int k0, int n0, unsigned char* WT, int ldt, int drow0, float scale, LAS float* scr, int lane) {
#pragma unroll 8
    for (int i = 0; i < 32; ++i) { const int kk = 2 * i + (lane >> 5); scr[kk * 33 + (lane & 31)] = W[(size_t)(k0 + kk) * ldw + n0 + (lane & 31)] * scale; }
    LDS_WAIT();
    const int c = lane & 7;
#pragma unroll
    for (int j = 0; j < 4; ++j) { const int n = (lane >> 3) + 8 * j; const LAS float* sp = scr + (8 * c) * 33 + n;
        u32x2 o; o.x = pk4_f8(sp[0 * 33], sp[1 * 33], sp[2 * 33], sp[3 * 33]); o.y = pk4_f8(sp[4 * 33], sp[5 * 33], sp[6 * 33], sp[7 * 33]);
        *(u32x2*)(WT + (size_t)(drow0 + n) * ldt + k0 + 8 * c) = o; }
    LDS_WAIT();
}

DI void sincos_small(double r, double& s, double& c) {
    const double r2 = r * r; double ss = 1.0, cc = 1.0;
#pragma unroll
    for (int n = 12; n >= 1; --n) { ss = 1.0 - ss * r2 * (1.0 / (double)((2 * n) * (2 * n + 1))); cc = 1.0 - cc * r2 * (1.0 / (double)((2 * n - 1) * (2 * n))); }
    s = r * ss; c = cc;
}

DI void dot16(const f32x4 (&v)[4], const LAS float* wT, int lane, float (&r)[16]) {
#pragma unroll
    for (int e = 0; e < 16; ++e) {
        float a = 0.f;
        if ((e & 1) == 0) asm volatile("" ::: "memory");
#pragma unroll
        for (int j = 0; j < 4; ++j) { const f32x4 w = *(const LAS f32x4*)(wT + e * 1024 + 256 * j + 4 * lane); a += v[j][0] * w[0] + v[j][1] * w[1] + v[j][2] * w[2] + v[j][3] * w[3]; }
        r[e] = wave_sum(a);
    }
}

DI void phase0(const Params& p, LAS unsigned char* lds, int gw, int NGW, int wave, int lane) {
    const int tid = threadIdx.x;
    {
        LAS float* scr = (LAS float*)(lds + wave * 16384);
        for (int it = gw; it < 2048; it += NGW) {
            if (it < 1536) { const int kb = it / 96, nb = it % 96; transpose_item(p.in[2], INW, 64 * kb, 32 * nb, (bf16_t*)(p.ws + WS_WI), DM, 32 * nb, scr, lane); }
            else { const int r = it - 1536, kb = r / 32, nb = r % 32; transpose_item(p.in[9], DM, 64 * kb, 32 * nb, (bf16_t*)(p.ws + WS_WO), DM, 32 * nb, scr, lane); }
        }
    }
    {
        float* rope = (float*)(p.ws + WS_ROPE);
        const float invf[8] = {1.0f, 0.1939227432012558f, 0.03760603070259094f, 0.007292664609849453f, 0.0014142135623842478f, 0.00027424818836152554f, 5.318296098266728e-05f, 1.0313386155758053e-05f};
        for (int id = blockIdx.x * NTHR + tid; id < 8192 * 8; id += gridDim.x * NTHR) {
            const int pos = id >> 3, i = id & 7;
            float inv = invf[0];
#pragma unroll
            for (int k = 1; k < 8; ++k) inv = (i == k) ? invf[k] : inv;
            const float ang = (float)pos * inv;
            const double x = (double)ang; const double kq = rint(x * 0.15915494309189535); const double r = x - kq * 6.283185307179586476925;
            double s, c; sincos_small(r, s, c);
            rope[pos * 16 + i] = (float)c; rope[pos * 16 + 8 + i] = (float)s;
        }
    }
    __syncthreads();
    LAS float* wT = (LAS float*)lds;
    for (int id = tid; id < 16384; id += NTHR) { const int k = id >> 4, e = id & 15; wT[e * 1024 + k] = p.in[2][(size_t)k * INW + 3072 + e]; }
    __syncthreads();
    const float* dtb = p.in[5];
    float bias = 0.f;
    if (lane < 16) bias = dtb[lane];
    bf16_t* xb = (bf16_t*)(p.ws + WS_XB); float* dtout = (float*)(p.ws + WS_DT);
    for (int t = gw; t < TT; t += NGW) {
        const f32x4* xr = (const f32x4*)xrow_ptr(p, t) + lane;
        f32x4 v[4];
#pragma unroll
        for (int j = 0; j < 4; ++j) v[j] = xr[64 * j];
        u32x2* o8 = (u32x2*)(xb + (size_t)t * DM) + lane;
#pragma unroll
        for (int j = 0; j < 4; ++j) { u32x2 w; w.x = pk2(v[j][0], v[j][1]); w.y = pk2(v[j][2], v[j][3]); o8[64 * j] = w; }
        float r[16]; dot16(v, wT, lane, r);
        float mine = 0.f;
#pragma unroll
        for (int e = 0; e < 16; ++e) mine = (lane == e) ? r[e] : mine;
        if (lane < 16) { const float z = mine + bias; dtout[(size_t)t * 16 + lane] = fmaxf(z, 0.f) + log1pf(__expf(-fabsf(z))); }
    }
}

DI void conv_phase(const Params& p) {
    const int tid = blockIdx.x * NTHR + threadIdx.x, nthr = gridDim.x * NTHR;
    const int c = tid & 127, ch = 8 * c, tile = ch >> 8, cit = ch & 255;
    const float* cw = p.in[3]; const float* cb = p.in[4];
    float w[5][8], b[8];
#pragma unroll
    for (int j = 0; j < 5; ++j)
#pragma unroll
        for (int e = 0; e < 8; ++e) w[j][e] = cw[j * 1024 + ch + e];
#pragma unroll
    for (int e = 0; e < 8; ++e) b[e] = cb[ch + e];
    const bf16_t* src = (const bf16_t*)(p.ws + WS_P) + (size_t)(8 + tile) * TILE_ELEMS + cit;
    bf16_t* dst = (bf16_t*)(p.ws + WS_XC) + (size_t)tile * TILE_ELEMS + cit;
    for (int it = tid; it < TT * 128; it += nthr) {
        const int t = it >> 7;
        const int S = t < TP ? 4096 : 8192, s = t & (S - 1);
        float a[8];
#pragma unroll
        for (int e = 0; e < 8; ++e) a[e] = b[e];
#pragma unroll
        for (int j = 0; j < 5; ++j) {
            const int sj = s + j - 2;
            if (sj >= 0 && sj < S) {
                const u32x4 v = *(const u32x4*)(src + (size_t)(t + j - 2) * 256);
                a[0] += bflo(v.x) * w[j][0]; a[1] += bfhi(v.x) * w[j][1]; a[2] += bflo(v.y) * w[j][2]; a[3] += bfhi(v.y) * w[j][3];
                a[4] += bflo(v.z) * w[j][4]; a[5] += bfhi(v.z) * w[j][5]; a[6] += bflo(v.w) * w[j][6]; a[7] += bfhi(v.w) * w[j][7];
            }
        }
        u32x4 o; o.x = pk2(silu_f(a[0]), silu_f(a[1])); o.y = pk2(silu_f(a[2]), silu_f(a[3])); o.z = pk2(silu_f(a[4]), silu_f(a[5])); o.w = pk2(silu_f(a[6]), silu_f(a[7]));
        *(u32x4*)(dst + (size_t)t * 256) = o;
    }
}

DI bf16x8 tr_pair(const LAS bf16_t* lo, const LAS bf16_t* hi) {
    const s16x4 a = __builtin_amdgcn_ds_read_tr16_b64_v4i16((LAS s16x4*)lo), b = __builtin_amdgcn_ds_read_tr16_b64_v4i16((LAS s16x4*)hi);
    return __builtin_shufflevector(a, b, 0, 1, 2, 3, 4, 5, 6, 7);
}
DI void attn_step_params(int sidx, int p0, int& d, int& base, int& nk, int& kbase) {
    const int pi = sidx < 12 ? 0 : (sidx < 18 ? 1 : 2);
    const int st = sidx - (pi == 0 ? 0 : (pi == 1 ? 12 : 18));
    d = 1 << (2 * pi); base = p0 - 64 * d; nk = 240 / d + 129; kbase = 32 * st;
}
DI void attn_phase(const Params& p, LAS unsigned char* lds, int gw, int NGW, int wave, int lane) {
    LAS bf16_t* Vn = (LAS bf16_t*)(lds + wave * 4608);
    const bf16_t* Pb = (const bf16_t*)(p.ws + WS_P);
    bf16_t* mix = (bf16_t*)(p.ws + WS_MIX);
    const int c = lane & 15, q = lane >> 4, qp = (lane & 15) >> 2, pp = lane & 3;
    for (int wi = gw; wi < 24576; wi += NGW) {
        const int head = wi & 7, qg = wi >> 3;
        const int t0 = (qg >> 4) * 256 + (qg & 15);
        const int S = t0 < TP ? 4096 : 8192, sbase = t0 & ~(S - 1), p0 = t0 - sbase;
        const int hoff = (head & 3) * 64;
        const bf16_t* Qt = Pb + (size_t)(0 + (head >> 2)) * TILE_ELEMS + hoff;
        const bf16_t* Kt = Pb + (size_t)(2 + (head >> 2)) * TILE_ELEMS + hoff;
        const bf16_t* Vg = Pb + (size_t)(4 + (head >> 2)) * TILE_ELEMS + hoff;
        bf16x8 qf[2];
        { const bf16_t* qrow = Qt + (size_t)(t0 + 16 * c) * 256; qf[0] = *(const bf16x8*)(qrow + 8 * q); qf[1] = *(const bf16x8*)(qrow + 32 + 8 * q); }
        f32x4 O[4];
#pragma unroll
        for (int d4 = 0; d4 < 4; ++d4) O[d4] = (f32x4){0.f, 0.f, 0.f, 0.f};
        float mrun = -1e30f, lsum = 0.f;
        const int pq = p0 + 16 * c;
        u32x4 vc[4], vn[4]; bf16x8 kc[2][2], kn[2][2];
#define ATT_LOADS(sidx_, V_, K_) do { int d_, base_, nk_, kbase_; attn_step_params(sidx_, p0, d_, base_, nk_, kbase_); \
            _Pragma("unroll") for (int i = 0; i < 4; ++i) { const int id = lane + 64 * i, key = id >> 3, dc = id & 7; \
                int pos = base_ + d_ * (kbase_ + key); pos = pos < 0 ? 0 : (pos > S - 1 ? S - 1 : pos); \
                V_[i] = *(const u32x4*)(Vg + (size_t)(sbase + pos) * 256 + 8 * dc); } \
            _Pragma("unroll") for (int kt = 0; kt < 2; ++kt) { int pos = base_ + d_ * (kbase_ + 16 * kt + c); pos = pos < 0 ? 0 : (pos > S - 1 ? S - 1 : pos); \
                const bf16_t* krow = Kt + (size_t)(sbase + pos) * 256; K_[kt][0] = *(const bf16x8*)(krow + 8 * q); K_[kt][1] = *(const bf16x8*)(krow + 32 + 8 * q); } } while (0)
        ATT_LOADS(0, vc, kc);
        for (int sidx = 0; sidx < 23; ++sidx) {
            if (sidx < 22) ATT_LOADS(sidx + 1, vn, kn);
            int d, base, nk, kbase; attn_step_params(sidx, p0, d, base, nk, kbase);
            const int win = 64 * d;
#pragma unroll
            for (int i = 0; i < 4; ++i) { const int id = lane + 64 * i; *(LAS u32x4*)(Vn + (id >> 3) * 72 + 8 * (id & 7)) = vc[i]; }
            f32x4 sc[2];
#pragma unroll
            for (int kt = 0; kt < 2; ++kt) {
                f32x4 a = {0.f, 0.f, 0.f, 0.f};
                a = __builtin_amdgcn_mfma_f32_16x16x32_bf16(kc[kt][0], qf[0], a, 0, 0, 0);
                a = __builtin_amdgcn_mfma_f32_16x16x32_bf16(kc[kt][1], qf[1], a, 0, 0, 0);
                sc[kt] = a;
            }
            bool valid[2][4]; float mloc = -1e30f;
#pragma unroll
            for (int kt = 0; kt < 2; ++kt)
#pragma unroll
                for (int j = 0; j < 4; ++j) {
                    const int kk = kbase + 16 * kt + 4 * q + j, pk = base + d * kk;
                    int df = pk - pq; df = df < 0 ? -df : df;
                    valid[kt][j] = (kk < nk) && (pk >= 0) && (pk < S) && (df <= win);
                    const float sv = valid[kt][j] ? sc[kt][j] * 0.125f : -1e30f;
                    sc[kt][j] = sv; mloc = fmaxf(mloc, sv);
                }
            mloc = fmaxf(mloc, __shfl_xor(mloc, 16)); mloc = fmaxf(mloc, __shfl_xor(mloc, 32));
            const float mnew = fmaxf(mrun, mloc), alpha = __expf(mrun - mnew);
            mrun = mnew;
            float ps = 0.f; float pv[2][4];
#pragma unroll
            for (int kt = 0; kt < 2; ++kt)
#pragma unroll
                for (int j = 0; j < 4; ++j) { pv[kt][j] = valid[kt][j] ? __expf(sc[kt][j] - mnew) : 0.f; ps += pv[kt][j]; }
            lsum = lsum * alpha + ps;
#pragma unroll
            for (int d4 = 0; d4 < 4; ++d4) O[d4] = O[d4] * alpha;
            u32x4 pw; pw.x = pk2(pv[0][0], pv[0][1]); pw.y = pk2(pv[0][2], pv[0][3]); pw.z = pk2(pv[1][0], pv[1][1]); pw.w = pk2(pv[1][2], pv[1][3]);
            const bf16x8 pf = __builtin_bit_cast(bf16x8, pw);
#pragma unroll
            for (int d4 = 0; d4 < 4; ++d4) {
                const LAS bf16_t* vr = Vn + (4 * q + qp) * 72 + 16 * d4 + 4 * pp;
                const bf16x8 vf = tr_pair(vr, vr + 16 * 72);
                O[d4] = __builtin_amdgcn_mfma_f32_16x16x32_bf16(vf, pf, O[d4], 0, 0, 0);
            }
#pragma unroll
            for (int i = 0; i < 4; ++i) vc[i] = vn[i];
#pragma unroll
            for (int kt = 0; kt < 2; ++kt) { kc[kt][0] = kn[kt][0]; kc[kt][1] = kn[kt][1]; }
        }
#undef ATT_LOADS
        lsum += __shfl_xor(lsum, 16); lsum += __shfl_xor(lsum, 32);
        const float inv = 1.0f / lsum;
        bf16_t* orow = mix + (size_t)(t0 + 16 * c) * DM + head * 64 + 4 * q;
#pragma unroll
        for (int d4 = 0; d4 < 4; ++d4) { u32x2 w; w.x = pk2(O[d4][0] * inv, O[d4][1] * inv); w.y = pk2(O[d4][2] * inv, O[d4][3] * inv); *(u32x2*)(orow + 16 * d4) = w; }
    }
}

constexpr size_t WS_SLOC = WS_P;
constexpr size_t WS_DEC = WS_P + 96 * MiB;
constexpr int N_SSD_ITEMS = 6144;
struct SsdItem { int h, dir, g, tb, ts; float A; };
DI SsdItem ssd_decode(const Params& p, int it) {
    int w, ci; if (it < 4096) { w = it >> 5; ci = it & 31; } else { w = 128 + ((it - 4096) >> 6); ci = (it - 4096) & 63; }
    SsdItem I; const int seq = w >> 4; I.h = (w >> 1) & 7; I.dir = w & 1; I.g = I.h >> 2;
    const int S = seq < 8 ? 4096 : 8192, sbase = seq < 8 ? seq * 4096 : TP + (seq - 8) * 8192;
    I.tb = I.dir ? sbase + S - 1 - 128 * ci : sbase + 128 * ci; I.ts = I.dir ? -1 : 1;
    I.A = -__expf(p.in[6][I.dir * 8 + I.h]);
    return I;
}
#define SSD_TOK(I, l) ((I).tb + (I).ts * (l))
DI void ssd_scan_chunk(float d0, float d1, float A, LAS float* acs, LAS float* dts, int lane) {
    const float v0 = d0 * A, v1 = d1 * A; float ps = v0 + v1;
#pragma unroll
    for (int o = 1; o < 64; o <<= 1) { const float t = __shfl_up(ps, o); if (lane >= o) ps += t; }
    acs[2 * lane] = ps - v1; acs[2 * lane + 1] = ps; dts[2 * lane] = d0; dts[2 * lane + 1] = d1;
}
DI void st_tr8(LAS bf16_t* wp, int stride, const u32x4 v) {
    wp[0 * stride] = (bf16_t)(v.x & 0xffffu); wp[1 * stride] = (bf16_t)(v.x >> 16); wp[2 * stride] = (bf16_t)(v.y & 0xffffu); wp[3 * stride] = (bf16_t)(v.y >> 16);
    wp[4 * stride] = (bf16_t)(v.z & 0xffffu); wp[5 * stride] = (bf16_t)(v.z >> 16); wp[6 * stride] = (bf16_t)(v.w & 0xffffu); wp[7 * stride] = (bf16_t)(v.w >> 16);
}
DI void ssd_state_phase(const Params& p, LAS unsigned char* lds, int wave, int lane) {
    const int tid = threadIdx.x, c = lane & 15, q = lane >> 4, w = wave, qp = (lane & 15) >> 2, pp = lane & 3;
    LAS float* acs = (LAS float*)(lds + 0); LAS float* dts = (LAS float*)(lds + 512);
    LAS bf16_t* Xt2 = (LAS bf16_t*)(lds + 1024); LAS bf16_t* Bt = (LAS bf16_t*)(lds + 1024 + 128 * 144);
    const float* dtb = (const float*)(p.ws + WS_DT);
    const bf16_t* XCb = (const bf16_t*)(p.ws + WS_XC);
    bf16_t* Sl = (bf16_t*)(p.ws + WS_SLOC); float* decv = (float*)(p.ws + WS_DEC);
    int it = blockIdx.x;
    if (it >= N_SSD_ITEMS) return;
    SsdItem I = ssd_decode(p, it);
    float pd0 = 0.f, pd1 = 0.f; u32x4 xv[2], bv[4];
#define SSD_LOADS_A(I) do { \
        if (w == 0) { pd0 = dtb[(size_t)SSD_TOK(I, 2 * lane) * 16 + (I).dir * 8 + (I).h]; pd1 = dtb[(size_t)SSD_TOK(I, 2 * lane + 1) * 16 + (I).dir * 8 + (I).h]; } \
        _Pragma("unroll") for (int i = 0; i < 2; ++i) { const int id = tid + NTHR * i, l = id >> 3, pc = id & 7; \
            xv[i] = *(const u32x4*)(XCb + (size_t)((I).h >> 2) * TILE_ELEMS + (size_t)SSD_TOK(I, l) * 256 + ((I).h & 3) * 64 + 8 * pc); } \
        _Pragma("unroll") for (int i = 0; i < 4; ++i) { const int id = tid + NTHR * i, l = id >> 4, ncn = id & 15; \
            bv[i] = *(const u32x4*)(XCb + 2 * TILE_ELEMS + (size_t)SSD_TOK(I, l) * 256 + (I).g * 128 + 8 * ncn); } } while (0)
    SSD_LOADS_A(I);
    for (; it < N_SSD_ITEMS; it += gridDim.x) {
        if (w == 0) ssd_scan_chunk(pd0, pd1, I.A, acs, dts, lane);
        __syncthreads();
        const float aend = acs[127];
#pragma unroll
        for (int i = 0; i < 2; ++i) {
            const int id = tid + NTHR * i, l = id >> 3, pc = id & 7;
            const float s2 = dts[l] * __expf(aend - acs[l]);
            const u32x4 v = xv[i];
            u32x4 o; o.x = pk2(bflo(v.x) * s2, bfhi(v.x) * s2); o.y = pk2(bflo(v.y) * s2, bfhi(v.y) * s2); o.z = pk2(bflo(v.z) * s2, bfhi(v.z) * s2); o.w = pk2(bflo(v.w) * s2, bfhi(v.w) * s2);
            *(LAS u32x4*)(Xt2 + l * 72 + 8 * pc) = o;
        }
#pragma unroll
        for (int i = 0; i < 4; ++i) { const int id = tid + NTHR * i; *(LAS u32x4*)(Bt + (id >> 4) * 136 + 8 * (id & 15)) = bv[i]; }
        const int itn = it + gridDim.x;
        if (itn < N_SSD_ITEMS) { I = ssd_decode(p, itn); SSD_LOADS_A(I); }
        __syncthreads();
        bf16_t* so = Sl + (size_t)it * 8192 + 16 * w + 4 * q;
#pragma unroll
        for (int pt = 0; pt < 4; ++pt) {
            f32x4 a = {0.f, 0.f, 0.f, 0.f};
#pragma unroll
            for (int ks = 0; ks < 4; ++ks) {
                const LAS bf16_t* br = Bt + (32 * ks + 8 * q + qp) * 136 + 16 * w + 4 * pp;
                const LAS bf16_t* xr = Xt2 + (32 * ks + 8 * q + qp) * 72 + 16 * pt + 4 * pp;
                const bf16x8 bfr = tr_pair(br, br + 4 * 136), xf = tr_pair(xr, xr + 4 * 72);
                a = __builtin_amdgcn_mfma_f32_16x16x32_bf16(bfr, xf, a, 0, 0, 0);
            }
            u32x2 o; o.x = pk2(a[0], a[1]); o.y = pk2(a[2], a[3]);
            *(u32x2*)(so + (16 * pt + c) * 128) = o;
        }
        if (tid == 0) decv[it] = __expf(aend);
    }
#undef SSD_LOADS_A
}
DI void ssd_scan_phase(const Params& p) {
    unsigned* Sl = (unsigned*)(p.ws + WS_SLOC); const float* decv = (const float*)(p.ws + WS_DEC);
    for (int chain = blockIdx.x * NTHR + threadIdx.x; chain < 160 * 4096; chain += gridDim.x * NTHR) {
        const int w = chain >> 12, j = chain & 4095;
        const int nc = w < 128 ? 32 : 64, cb = w < 128 ? 32 * w : 4096 + 64 * (w - 128);
        unsigned* ptr = Sl + (size_t)cb * 4096 + j; const float* dp = decv + cb;
        float s0 = 0.f, s1 = 0.f;
        for (int c0 = 0; c0 < nc; c0 += 8) {
            unsigned v[8]; float d[8];
#pragma unroll
            for (int k = 0; k < 8; ++k) { v[k] = ptr[(size_t)(c0 + k) * 4096]; d[k] = dp[c0 + k]; }
#pragma unroll
            for (int k = 0; k < 8; ++k) { ptr[(size_t)(c0 + k) * 4096] = pk2(s0, s1); s0 = s0 * d[k] + bflo(v[k]); s1 = s1 * d[k] + bfhi(v[k]); }
        }
    }
}
constexpr int SSDC_ACS = 0  , SSDC_XT1 = 2048, SSDC_BN = SSDC_XT1 + 128 * 144, SSDC_SBF = SSDC_BN + 128 * 272, SSDC_END = SSDC_SBF + 64 * 272;
static_assert(SSDC_END <= 131072, "ssd lds");
DI void ssd_out_phase(const Params& p, LAS unsigned char* lds, int wave, int lane) {
    const int tid = threadIdx.x, c = lane & 15, q = lane >> 4, w = wave, qp = (lane & 15) >> 2, pp = lane & 3;
    LAS bf16_t* Xt1 = (LAS bf16_t*)(lds + SSDC_XT1); LAS bf16_t* Bn = (LAS bf16_t*)(lds + SSDC_BN); LAS bf16_t* Sbf = (LAS bf16_t*)(lds + SSDC_SBF);
    const float* dtb = (const float*)(p.ws + WS_DT);
    const bf16_t* XCb = (const bf16_t*)(p.ws + WS_XC);
    const bf16_t* Sl = (const bf16_t*)(p.ws + WS_SLOC);
    int it = blockIdx.x;
    if (it >= N_SSD_ITEMS) return;
    SsdItem I = ssd_decode(p, it);
    float pd0 = 0.f, pd1 = 0.f; u32x4 xv[2], bv[4], sv[2]; bf16x8 Cn[4];
#define SSD_LOADS_C(I, itx) do { \
        if (w == 0) { pd0 = dtb[(size_t)SSD_TOK(I, 2 * lane) * 16 + (I).dir * 8 + (I).h]; pd1 = dtb[(size_t)SSD_TOK(I, 2 * lane + 1) * 16 + (I).dir * 8 + (I).h]; } \
        _Pragma("unroll") for (int i = 0; i < 2; ++i) { const int id = tid + NTHR * i, l = id >> 3, pc = id & 7; \
            xv[i] = *(const u32x4*)(XCb + (size_t)((I).h >> 2) * TILE_ELEMS + (size_t)SSD_TOK(I, l) * 256 + ((I).h & 3) * 64 + 8 * pc); \
            sv[i] = *(const u32x4*)(Sl + (size_t)(itx) * 8192 + (size_t)id * 8); } \
        _Pragma("unroll") for (int i = 0; i < 4; ++i) { const int id = tid + NTHR * i, l = id >> 4, ncn = id & 15; \
            bv[i] = *(const u32x4*)(XCb + 2 * TILE_ELEMS + (size_t)SSD_TOK(I, l) * 256 + (I).g * 128 + 8 * ncn); } \
        { const bf16_t* cr = XCb + 3 * TILE_ELEMS + (size_t)SSD_TOK(I, 16 * w + c) * 256 + (I).g * 128 + 8 * q; \
          _Pragma("unroll") for (int ks = 0; ks < 4; ++ks) Cn[ks] = *(const bf16x8*)(cr + 32 * ks); } } while (0)
    SSD_LOADS_C(I, it);
    int par = 0;
    for (; it < N_SSD_ITEMS; it += gridDim.x, par ^= 1) {
        LAS float* acs = (LAS float*)(lds + SSDC_ACS + par * 1024); LAS float* dts = acs + 128;
        if (w == 0) ssd_scan_chunk(pd0, pd1, I.A, acs, dts, lane);
        __syncthreads();
#pragma unroll
        for (int i = 0; i < 2; ++i) {
            const int id = tid + NTHR * i, l = id >> 3, pc = id & 7;
            const float s1 = dts[l];
            const u32x4 v = xv[i];
            u32x4 o; o.x = pk2(bflo(v.x) * s1, bfhi(v.x) * s1); o.y = pk2(bflo(v.y) * s1, bfhi(v.y) * s1); o.z = pk2(bflo(v.z) * s1, bfhi(v.z) * s1); o.w = pk2(bflo(v.w) * s1, bfhi(v.w) * s1);
            *(LAS u32x4*)(Xt1 + l * 72 + 8 * pc) = o;
            *(LAS u32x4*)(Sbf + (id >> 4) * 136 + 8 * (id & 15)) = sv[i];
        }
#pragma unroll
        for (int i = 0; i < 4; ++i) { const int id = tid + NTHR * i; *(LAS u32x4*)(Bn + (id >> 4) * 136 + 8 * (id & 15)) = bv[i]; }
        bf16x8 Cf[4];
#pragma unroll
        for (int ks = 0; ks < 4; ++ks) Cf[ks] = Cn[ks];
        const SsdItem Ic = I;
        const int itn = it + gridDim.x;
        if (itn < N_SSD_ITEMS) { I = ssd_decode(p, itn); SSD_LOADS_C(I, itn); }
        __syncthreads();
        {
            const int l = 16 * w + c;
            const float al = acs[l];
            f32x4 acc[4];
#pragma unroll
            for (int pt = 0; pt < 4; ++pt) {
                f32x4 a = {0.f, 0.f, 0.f, 0.f};
#pragma unroll
                for (int ks = 0; ks < 4; ++ks) { const bf16x8 sf = *(const LAS bf16x8*)(Sbf + (16 * pt + c) * 136 + 32 * ks + 8 * q); a = __builtin_amdgcn_mfma_f32_16x16x32_bf16(sf, Cf[ks], a, 0, 0, 0); }
                acc[pt] = a * __expf(al);
            }
            const int nsp = (w >> 1) + 1;
            for (int sp = 0; sp < nsp; ++sp) {
                f32x4 M[2];
#pragma unroll
                for (int hh = 0; hh < 2; ++hh) {
                    const int st = 2 * sp + hh;
                    f32x4 G = {0.f, 0.f, 0.f, 0.f};
                    if (st <= w) {
#pragma unroll
                        for (int ks = 0; ks < 4; ++ks) { const bf16x8 bfr = *(const LAS bf16x8*)(Bn + (16 * st + c) * 136 + 32 * ks + 8 * q); G = __builtin_amdgcn_mfma_f32_16x16x32_bf16(bfr, Cf[ks], G, 0, 0, 0); }
#pragma unroll
                        for (int j = 0; j < 4; ++j) { const int s = 16 * st + 4 * q + j; const float e = __expf(al - acs[s]); G[j] = (s <= l) ? G[j] * e : 0.f; }
                    }
                    M[hh] = G;
                }
                u32x4 pw; pw.x = pk2(M[0][0], M[0][1]); pw.y = pk2(M[0][2], M[0][3]); pw.z = pk2(M[1][0], M[1][1]); pw.w = pk2(M[1][2], M[1][3]);
                const bf16x8 pf = __builtin_bit_cast(bf16x8, pw);
#pragma unroll
                for (int pt = 0; pt < 4; ++pt) {
                    const LAS bf16_t* xr = Xt1 + (32 * sp + 4 * q + qp) * 72 + 16 * pt + 4 * pp;
                    const bf16x8 xf = tr_pair(xr, xr + 16 * 72);
                    acc[pt] = __builtin_amdgcn_mfma_f32_16x16x32_bf16(xf, pf, acc[pt], 0, 0, 0);
                }
            }
            bf16_t* yr = (bf16_t*)(p.ws + (Ic.dir ? WS_YB : WS_YF)) + Ic.h * 64 + (size_t)SSD_TOK(Ic, l) * 512 + 4 * q;
#pragma unroll
            for (int pt = 0; pt < 4; ++pt) { u32x2 o; o.x = pk2(acc[pt][0], acc[pt][1]); o.y = pk2(acc[pt][2], acc[pt][3]); *(u32x2*)(yr + 16 * pt) = o; }
        }
    }
#undef SSD_LOADS_C
}

DI void gate_phase(const Params& p, int gw, int NGW, int lane) {
    const bf16_t* yf = (const bf16_t*)(p.ws + WS_YF); const bf16_t* yb = (const bf16_t*)(p.ws + WS_YB);
    const bf16_t* xh = (const bf16_t*)(p.ws + WS_XC) + (size_t)(lane >> 5) * TILE_ELEMS + (8 * lane & 255);
    const bf16_t* zt = (const bf16_t*)(p.ws + WS_P) + (size_t)(6 + (lane >> 5)) * TILE_ELEMS + (8 * lane & 255);
    bf16_t* mix = (bf16_t*)(p.ws + WS_MIX) + 512 + 8 * lane;
    const float D = p.in[7][lane >> 3];
    float nw[8];
#pragma unroll
    for (int e = 0; e < 8; ++e) nw[e] = p.in[8][8 * lane + e];
    for (int t = gw; t < TT; t += NGW) {
        const u32x4 a = *(const u32x4*)(yf + (size_t)t * 512 + 8 * lane), b = *(const u32x4*)(yb + (size_t)t * 512 + 8 * lane);
        const u32x4 x = *(const u32x4*)(xh + (size_t)t * 256), z = *(const u32x4*)(zt + (size_t)t * 256);
        float y[8];
        y[0] = (bflo(a.x) + bflo(b.x) + D * bflo(x.x)) * silu_f(bflo(z.x)); y[1] = (bfhi(a.x) + bfhi(b.x) + D * bfhi(x.x)) * silu_f(bfhi(z.x));
        y[2] = (bflo(a.y) + bflo(b.y) + D * bflo(x.y)) * silu_f(bflo(z.y)); y[3] = (bfhi(a.y) + bfhi(b.y) + D * bfhi(x.y)) * silu_f(bfhi(z.y));
        y[4] = (bflo(a.z) + bflo(b.z) + D * bflo(x.z)) * silu_f(bflo(z.z)); y[5] = (bfhi(a.z) + bfhi(b.z) + D * bfhi(x.z)) * silu_f(bfhi(z.z));
        y[6] = (bflo(a.w) + bflo(b.w) + D * bflo(x.w)) * silu_f(bflo(z.w)); y[7] = (bfhi(a.w) + bfhi(b.w) + D * bfhi(x.w)) * silu_f(bfhi(z.w));
        float ss = 0.f;
#pragma unroll
        for (int e = 0; e < 8; ++e) ss += y[e] * y[e];
        ss = wave_sum(ss);
        const float r = 1.0f / sqrtf(ss * (1.0f / 512.0f) + RMS_EPS);
        u32x4 o; o.x = pk2(y[0] * r * nw[0], y[1] * r * nw[1]); o.y = pk2(y[2] * r * nw[2], y[3] * r * nw[3]); o.z = pk2(y[4] * r * nw[4], y[5] * r * nw[5]); o.w = pk2(y[6] * r * nw[6], y[7] * r * nw[7]);
        *(u32x4*)(mix + (size_t)t * DM) = o;
    }
}

DI void expert_weights_phase(const Params& p, LAS unsigned char* lds, int gw, int NGW, int wave, int lane) {
    LAS float* scr = (LAS float*)(lds + wave * 16384);
    unsigned char* Wd = p.ws + WS_WD;
    for (int it = gw; it < 16 * 4224; it += NGW) {
        const int e = it / 4224, r = it % 4224;
        if (r < 2816) {
            const int isup = r >= 1408, rr = isup ? r - 1408 : r, kb = rr / 88, nb = rr % 88, n0 = 32 * nb;
            const float* W = (isup ? p.in[14] : p.in[13]) + (size_t)e * DM * FF;
            unsigned char* Wgu = p.ws + (e < 8 ? WS_WGU0 : WS_WGU1);
            transpose_item_f8(W, FF, 64 * kb, n0, Wgu, DM, (e & 7) * 5632 + 256 * (n0 >> 7) + (n0 & 127) + (isup ? 128 : 0), WGU_SCALE, scr, lane);
        } else {
            const int rr = r - 2816, kb = rr / 32, nb = rr % 32;
            transpose_item_f8(p.in[15] + (size_t)e * FF * DM, DM, 64 * kb, 32 * nb, Wd, FF, e * 1024 + 32 * nb, WD_SCALE, scr, lane);
        }
    }
}

DI void ln1_router_phase(const Params& p, LAS unsigned char* lds, int gw, int NGW, int lane) {
    const int tid = threadIdx.x;
    LAS float* wT = (LAS float*)lds;
    for (int id = tid; id < 16384; id += NTHR) { const int k = id >> 4, e = id & 15; wT[e * 1024 + k] = p.in[12][id]; }
    __syncthreads();
    f32x4 gg[4], bb[4];
#pragma unroll
    for (int j = 0; j < 4; ++j) { gg[j] = ((const f32x4*)p.in[10])[64 * j + lane]; bb[j] = ((const f32x4*)p.in[11])[64 * j + lane]; }
    unsigned char* x1b = p.ws + WS_X1B; float* aff = (float*)(p.ws + WS_AFF);
    for (int t = gw; t < TT; t += NGW) {
        f32x4* orow = (f32x4*)(p.out + (size_t)t * DM) + lane;
        f32x4 v[4]; float s = 0.f;
#pragma unroll
        for (int j = 0; j < 4; ++j) { v[j] = orow[64 * j]; s += (v[j][0] + v[j][1]) + (v[j][2] + v[j][3]); }
        const float mean = wave_sum(s) * (1.0f / DM); float s2 = 0.f;
#pragma unroll
        for (int j = 0; j < 4; ++j) { v[j] = v[j] - mean; s2 += (v[j][0] * v[j][0] + v[j][1] * v[j][1]) + (v[j][2] * v[j][2] + v[j][3] * v[j][3]); }
        const float rstd = 1.0f / sqrtf(wave_sum(s2) * (1.0f / DM) + LN_EPS);
        unsigned* o4 = (unsigned*)(x1b + (size_t)t * DM) + lane;
#pragma unroll
        for (int j = 0; j < 4; ++j) {
            v[j] = v[j] * rstd * gg[j] + bb[j];
            orow[64 * j] = v[j] * ALPHA;
            o4[64 * j] = pk4_f8(v[j][0], v[j][1], v[j][2], v[j][3]);
        }
        float r[16]; dot16(v, wT, lane, r);
        float mx = r[0];
#pragma unroll
        for (int e = 1; e < 16; ++e) mx = fmaxf(mx, r[e]);
        float den = 0.f, mine = 0.f;
#pragma unroll
        for (int e = 0; e < 16; ++e) { const float ex = __expf(r[e] - mx); den += ex; mine = (lane == e) ? ex : mine; }
        if (lane < 16) aff[(size_t)lane * TT + t] = mine / den;
    }
}

DI void select_phase(const Params& p, LAS unsigned char* lds, int wave, int lane) {
    const int wk = blockIdx.x;
    if (wk >= 32) return;
    const int tid = threadIdx.x;
    const int trunk = wk >> 4, e = wk & 15;
    const int Tn = trunk ? 16384 : 32768, tbase = trunk ? TP : 0, cap = Tn / 8;
    const unsigned* col = (const unsigned*)(p.ws + WS_AFF) + (size_t)e * TT + tbase;
    LAS unsigned* hist = (LAS unsigned*)lds;
    LAS unsigned* ctl = (LAS unsigned*)(lds + 1024);
    LAS unsigned* wcnt = (LAS unsigned*)(lds + 2048);
    unsigned prefix = 0, remaining = (unsigned)cap;
    for (int pass = 0; pass < 4; ++pass) {
        const int shift = 24 - 8 * pass;
        for (int i = tid; i < 256; i += NTHR) hist[i] = 0u;
        __syncthreads();
        for (int i = tid; i < Tn; i += NTHR) {
            const unsigned bits = col[i];
            if (pass == 0 || (bits >> (shift + 8)) == prefix) atomicAdd((unsigned*)(hist + ((bits >> shift) & 255u)), 1u);
        }
        __syncthreads();
        if (tid == 0) {
            unsigned cum = 0; int b = 255;
            for (; b > 0; --b) { const unsigned hcnt = hist[b]; if (cum + hcnt >= remaining) break; cum += hcnt; }
            ctl[0] = (prefix << 8) | (unsigned)b; ctl[1] = remaining - cum;
        }
        __syncthreads();
        prefix = ctl[0]; remaining = ctl[1];
        __syncthreads();
    }
    const unsigned thr = prefix, need_eq = remaining;
    int* idx = (int*)(p.ws + WS_IDX) + e * SLOTS_E + (trunk ? 4096 : 0);
    int* inv = (int*)(p.ws + WS_INV) + (size_t)e * TT + tbase;
    const int slot0 = e * SLOTS_E + (trunk ? 4096 : 0);
    float* gate = (float*)(p.ws + WS_GATE) + e * SLOTS_E + (trunk ? 4096 : 0);
    unsigned sel_base = 0, eq_base = 0;
    for (int b0 = 0; b0 < Tn; b0 += NTHR) {
        const unsigned bits = col[b0 + tid];
        const bool gt = bits > thr, eq = bits == thr;
        const unsigned long long meq = __ballot(eq);
        const unsigned eq_before_w = (unsigned)__popcll(meq & ((1ull << lane) - 1ull));
        if (lane == 0) wcnt[wave] = (unsigned)__popcll(meq);
        __syncthreads();
        unsigned eq_off = 0, eq_tot = 0;
#pragma unroll
        for (int w2 = 0; w2 < 8; ++w2) { const unsigned cnt = wcnt[w2]; eq_off += (w2 < wave) ? cnt : 0u; eq_tot += cnt; }
        const bool sel = gt || (eq && (eq_base + eq_off + eq_before_w) < need_eq);
        const unsigned long long msel = __ballot(sel);
        const unsigned sel_before_w = (unsigned)__popcll(msel & ((1ull << lane) - 1ull));
        if (lane == 0) wcnt[8 + wave] = (unsigned)__popcll(msel);
        __syncthreads();
        unsigned sel_off = 0, sel_tot = 0;
#pragma unroll
        for (int w2 = 0; w2 < 8; ++w2) { const unsigned cnt = wcnt[8 + w2]; sel_off += (w2 < wave) ? cnt : 0u; sel_tot += cnt; }
        { const unsigned pos = sel_base + sel_off + sel_before_w; const bool ok = sel && pos < (unsigned)cap;
          if (ok) { idx[pos] = tbase + b0 + tid; gate[pos] = __uint_as_float(bits); }
          inv[b0 + tid] = ok ? slot0 + (int)pos : -1; }
        sel_base += sel_tot; eq_base += eq_tot;
        __syncthreads();
    }
}

DI void ln2_phase(const Params& p, int gw, int NGW, int lane) {
    f32x4 gg[4], bb[4];
#pragma unroll
    for (int j = 0; j < 4; ++j) { gg[j] = ((const f32x4*)p.in[16])[64 * j + lane]; bb[j] = ((const f32x4*)p.in[17])[64 * j + lane]; }
    const int* inv = (const int*)(p.ws + WS_INV); const bf16_t* eo = (const bf16_t*)(p.ws + WS_EO);
    for (int t = gw; t < TT; t += NGW) {
        f32x4* orow = (f32x4*)(p.out + (size_t)t * DM) + lane;
        f32x4 v[4]; float s = 0.f;
#pragma unroll
        for (int j = 0; j < 4; ++j) v[j] = orow[64 * j];
        const int myslot = lane < 16 ? inv[(size_t)lane * TT + t] : -1;
        for (int e = 0; e < 16; ++e) {
            const int sl = __shfl(myslot, e);
            if (sl >= 0) {
                const u32x2* er = (const u32x2*)(eo + (size_t)sl * DM) + lane;
#pragma unroll
                for (int j = 0; j < 4; ++j) { const u32x2 w = er[64 * j]; v[j][0] += bflo(w.x); v[j][1] += bfhi(w.x); v[j][2] += bflo(w.y); v[j][3] += bfhi(w.y); }
            }
        }
#pragma unroll
        for (int j = 0; j < 4; ++j) s += (v[j][0] + v[j][1]) + (v[j][2] + v[j][3]);
        const float mean = wave_sum(s) * (1.0f / DM); float s2 = 0.f;
#pragma unroll
        for (int j = 0; j < 4; ++j) { v[j] = v[j] - mean; s2 += (v[j][0] * v[j][0] + v[j][1] * v[j][1]) + (v[j][2] * v[j][2] + v[j][3] * v[j][3]); }
        const float rstd = 1.0f / sqrtf(wave_sum(s2) * (1.0f / DM) + LN_EPS);
#pragma unroll
        for (int j = 0; j < 4; ++j) orow[64 * j] = v[j] * rstd * gg[j] + bb[j];
    }
}

__global__ void __launch_bounds__(NTHR, 2) fwd_megakernel(Params p) {
    extern __shared__ __attribute__((aligned(16))) unsigned char lds_raw[];
    LAS unsigned char* lds = (LAS unsigned char*)lds_raw;
    cg::grid_group grid = cg::this_grid();
#define IDS() int tid_ = threadIdx.x; asm volatile("" : "+v"(tid_)); const int lane = tid_ & 63, wave = __builtin_amdgcn_readfirstlane(tid_ >> 6); \
    const int G = gridDim.x, gw = blockIdx.x * 8 + wave, NGW = G * 8; (void)lane; (void)gw; (void)NGW; (void)G;
    { IDS(); phase0(p, lds, gw, NGW, wave, lane); }
    grid.sync();
    {
        IDS();
        pg8::SchedPlain S; S.init(TT, 3072, G, (int)blockIdx.x);
        pg8::EpiProj E{(bf16_t*)(p.ws + WS_P), (const float*)(p.ws + WS_ROPE)};
        pg8::gemm_phase<pg8::EpiProj, pg8::SchedPlain>(lds, (const bf16_t*)(p.ws + WS_XB), (const bf16_t*)(p.ws + WS_WI), DM, S, E);
    }
    grid.sync();
    conv_phase(p);
    { IDS(); attn_phase(p, lds, gw, NGW, wave, lane); }
    grid.sync();
    { IDS(); ssd_state_phase(p, lds, wave, lane); }
    grid.sync();
    ssd_scan_phase(p);
    grid.sync();
    { IDS(); ssd_out_phase(p, lds, wave, lane); }
    grid.sync();
    { IDS(); gate_phase(p, gw, NGW, lane); }
    grid.sync();
    { IDS(); expert_weights_phase(p, lds, gw, NGW, wave, lane); }
    __syncthreads();
    {
        IDS();
        pg8::SchedPlain S; S.init(TT, DM, G, (int)blockIdx.x);
        pg8::EpiOut E{p};
        pg8::gemm_phase<pg8::EpiOut, pg8::SchedPlain>(lds, (const bf16_t*)(p.ws + WS_MIX), (const bf16_t*)(p.ws + WS_WO), DM, S, E);
    }
    grid.sync();
    { IDS(); ln1_router_phase(p, lds, gw, NGW, lane); }
    grid.sync();
    { IDS(); select_phase(p, lds, wave, lane); }
    grid.sync();
#pragma unroll 1
    for (int rnd = 0; rnd < 2; ++rnd) {
        {
            IDS();
            const int* idx = (const int*)(p.ws + WS_IDX) + rnd * 8 * SLOTS_E;
            pg8::SchedGrouped<22, true> S{G, (int)blockIdx.x, idx};
            pg8::EpiGU E{p.ws + WS_HID};
            pg8::gemm_phase<pg8::EpiGU, pg8::SchedGrouped<22, true>, true>(lds, (const bf16_t*)(p.ws + WS_X1B), (const bf16_t*)(p.ws + (rnd ? WS_WGU1 : WS_WGU0)), DM / 2, S, E);
        }
        grid.sync();
        {
            IDS();
            const int* idx = (const int*)(p.ws + WS_IDX) + rnd * 8 * SLOTS_E;
            const float* gate = (const float*)(p.ws + WS_GATE) + rnd * 8 * SLOTS_E;
            pg8::SchedGrouped<4, false> S{G, (int)blockIdx.x, idx};
            pg8::EpiDown E{(bf16_t*)(p.ws + WS_EO) + (size_t)rnd * 8 * SLOTS_E * DM, gate};
            pg8::gemm_phase<pg8::EpiDown, pg8::SchedGrouped<4, false>, true>(lds, (const bf16_t*)(p.ws + WS_HID), (const bf16_t*)(p.ws + WS_WD + (size_t)rnd * 8 * 1024 * FF), FF / 2, S, E);
        }
        grid.sync();
    }
    { IDS(); ln2_phase(p, gw, NGW, lane); }
#undef IDS
}

extern "C" void kernel_launch(void* const* d_in, const int* in_sizes, int n_in, void* d_out, int out_size, void* d_ws, size_t ws_size, hipStream_t stream) {
    static int grid_blocks = 0;
    if (grid_blocks == 0) {
        if (n_in != 18 || ws_size < WS_END || out_size != TT * DM) { fprintf(stderr, "kernel_launch: unexpected shapes (n_in %d out %d ws %zu)\n", n_in, out_size, ws_size); grid_blocks = -1; return; }
        int dev = 0, cus = 0, per_cu = 0;
        hipGetDevice(&dev);
        hipDeviceGetAttribute(&cus, hipDeviceAttributeMultiprocessorCount, dev);
        if (hipFuncSetAttribute((const void*)fwd_megakernel, hipFuncAttributeMaxDynamicSharedMemorySize, LDS_BYTES) != hipSuccess) { fprintf(stderr, "kernel_launch: hipFuncSetAttribute failed\n"); }
        hipOccupancyMaxActiveBlocksPerMultiprocessor(&per_cu, (const void*)fwd_megakernel, NTHR, LDS_BYTES);
        if (per_cu < 1) per_cu = 1;
        (void)hipGetLastError();
        grid_blocks = cus * per_cu;
    }
    if (grid_blocks < 0) return;
    Params p{};
    for (int i = 0; i < 18; ++i) p.in[i] = (const float*)d_in[i];
    p.out = (float*)d_out; p.ws = (unsigned char*)d_ws;
    void* args[] = {&p};
    hipError_t e = hipLaunchCooperativeKernel((void*)fwd_megakernel, dim3(grid_blocks), dim3(NTHR), args, LDS_BYTES, stream);
    if (e != hipSuccess) fprintf(stderr, "cooperative launch failed: %s (grid %d)\n", hipGetErrorString(e), grid_blocks);
}
```

```cpp
#include <hip/hip_runtime.h>
#include <hip/hip_cooperative_groups.h>
#include <cstdio>
#include <cstdint>
namespace cg = cooperative_groups;

#define DI __device__ __forceinline__
#define LAS __attribute__((address_space(3)))
typedef unsigned short bf16_t;
typedef short bf16x8 __attribute__((ext_vector_type(8)));
typedef short s16x4 __attribute__((ext_vector_type(4)));
typedef float f32x4 __attribute__((ext_vector_type(4)));
typedef unsigned u32x4 __attribute__((ext_vector_type(4)));
typedef unsigned u32x2 __attribute__((ext_vector_type(2)));
typedef int i32x4 __attribute__((ext_vector_type(4)));
typedef int i32x8 __attribute__((ext_vector_type(8)));

constexpr int TT = 49152;
constexpr int TP = 32768;
constexpr int DM = 1024;
constexpr int INW = 3088;
constexpr int FF = 2816;
constexpr int NE = 16;
constexpr int SLOTS_E = 6144;
constexpr float ALPHA = 1.189207115002721f;
constexpr float LN_EPS = 1e-5f, RMS_EPS = 1e-5f;

constexpr size_t MiB = 1u << 20;
constexpr size_t TILE_ELEMS = (size_t)TT * 256;
constexpr size_t TILE_BYTES = TILE_ELEMS * 2;
constexpr size_t WS_WI = 0;
constexpr size_t WS_WO = 6 * MiB;
constexpr size_t WS_DT = 8 * MiB;
constexpr size_t WS_ROPE = 11 * MiB;
constexpr size_t WS_AFF = 12 * MiB;
constexpr size_t WS_IDX = 15 * MiB;
constexpr size_t WS_GATE = 15 * MiB + 512 * 1024;
constexpr size_t WS_P = 20 * MiB;
constexpr size_t WS_XC = 308 * MiB;
constexpr size_t WS_XB = 404 * MiB;
constexpr size_t WS_MIX = WS_XB;
constexpr size_t WS_YF = WS_P + 8 * TILE_BYTES;
constexpr size_t WS_YB = WS_P + 10 * TILE_BYTES;
constexpr size_t WS_INV = 16 * MiB;
constexpr size_t WS_WD = 20 * MiB;
constexpr size_t WS_WGU = 108 * MiB;
constexpr size_t WS_EO = 212 * MiB;
constexpr size_t WS_X1B = 308 * MiB;
constexpr size_t WS_HID = 404 * MiB;
constexpr size_t WS_END = 668 * MiB;

constexpr int LDS_BYTES = 147456;
constexpr int NTHR = 512;

DI unsigned f2bf(float f) { unsigned u = __float_as_uint(f); return (u + 0x7fffu + ((u >> 16) & 1u)) >> 16; }
DI unsigned pk2(float lo, float hi) { return f2bf(lo) | (f2bf(hi) << 16); }
DI unsigned pk4_f8(float a, float b, float c, float d) { int w = 0; w = __builtin_amdgcn_cvt_pk_fp8_f32(a, b, w, false); w = __builtin_amdgcn_cvt_pk_fp8_f32(c, d, w, true); return (unsigned)w; }
DI i32x8 cat8(bf16x8 lo, bf16x8 hi) { const i32x4 a = __builtin_bit_cast(i32x4, lo), b = __builtin_bit_cast(i32x4, hi); return __builtin_shufflevector(a, b, 0, 1, 2, 3, 4, 5, 6, 7); }
constexpr float WGU_SCALE = 32.0f, WD_SCALE = 64.0f;
DI float bflo(unsigned u) { return __uint_as_float(u << 16); }
DI float bfhi(unsigned u) { return __uint_as_float(u & 0xffff0000u); }
DI float wave_sum(float v) {
#pragma unroll
    for (int o = 1; o < 64; o <<= 1) v += __shfl_xor(v, o);
    return v;
}
DI void st_tr8_pair(LAS bf16_t* base, int stride, int colpair, int lane, const u32x4 v) {
    const unsigned px = __shfl_xor(v.x, 1), py = __shfl_xor(v.y, 1), pz = __shfl_xor(v.z, 1), pw = __shfl_xor(v.w, 1);
    const bool odd = (lane & 1) != 0;
    const unsigned d0 = odd ? ((px >> 16) | (v.x & 0xffff0000u)) : ((v.x & 0xffffu) | (px << 16));
    const unsigned d1 = odd ? ((py >> 16) | (v.y & 0xffff0000u)) : ((v.y & 0xffffu) | (py << 16));
    const unsigned d2 = odd ? ((pz >> 16) | (v.z & 0xffff0000u)) : ((v.z & 0xffffu) | (pz << 16));
    const unsigned d3 = odd ? ((pw >> 16) | (v.w & 0xffff0000u)) : ((v.w & 0xffffu) | (pw << 16));
    LAS unsigned* wp = (LAS unsigned*)(base + (odd ? stride : 0)) + colpair;
    wp[0] = d0; wp[stride] = d1; wp[2 * stride] = d2; wp[3 * stride] = d3;
}
DI float silu_f(float x) { return x / (1.0f + __expf(-x)); }
#define LDS_WAIT() asm volatile("s_waitcnt lgkmcnt(0)" ::: "memory")

struct Params { const float* in[18]; float* out; unsigned char* ws; };
DI int lane_id() { int l = (int)__builtin_amdgcn_mbcnt_hi(~0u, __builtin_amdgcn_mbcnt_lo(~0u, 0u)); asm volatile("" : "+v"(l)); return l; }
#define TIDX(wave_) ((wave_) * 64 + lane_id())

DI const float* xrow_ptr(const Params& p, int t) { return t < TP ? p.in[0] + (size_t)t * DM : p.in[1] + (size_t)(t - TP) * DM; }

namespace pg8 {
constexpr int BM = 256, BK = 64, HALF = 128, HTB = HALF * BK * 2, NXCD = 8, WGM = 8;
DI int lds_byte(int r, int c) { const int st = (r >> 4) * 2 + (c >> 5), rr = r & 15, cc = c & 31, ob = rr * 64 + cc * 2; return st * 1024 + (ob ^ (((ob >> 9) & 1) << 5)); }
DI void stage_rc(int b, int& R, int& C) { const int st = b / 1024, sb = b % 1024, swz = sb ^ (((sb >> 9) & 1) << 5); R = (st >> 1) * 16 + swz / 64; C = (st & 1) * 32 + (swz % 64) / 2; }
DI int perm32(int rho) { const int n = rho >> 4, i = rho & 15; return 8 * (i >> 2) + 4 * n + (i & 3); }

struct Unit { int pm, pn, bt; };

DI int xcd_remap(int L, int nwg) { const int q = nwg / NXCD, r = nwg % NXCD, xcd = L % NXCD, off = L / NXCD; return (xcd < r ? xcd * (q + 1) : r * (q + 1) + (xcd - r) * q) + off; }

struct SchedPlain {
    int nM, nN, nwg, G, c;
    DI void init(int M, int N, int G_, int c_) { nM = M / BM; nN = N / BM; nwg = nM * nN; G = G_; c = c_; }
    DI bool next(int i, Unit& u) const {
        const int L = i * G + c; if (L >= nwg) return false;
        const int wgid = xcd_remap(L, nwg);
        const int nig = WGM * nN, gid = wgid / nig, fm = gid * WGM, gsz = (nM - fm) < WGM ? (nM - fm) : WGM;
        u.pm = fm + ((wgid % nig) % gsz); u.pn = (wgid % nig) / gsz; u.bt = u.pn; return true;
    }
    DI int arow(const Unit& u, int r) const { return u.pm * BM + r; }
};
template <int NPN, bool GATHER> struct SchedGrouped {
    int G, c; const int* idx;
    DI bool next(int i, Unit& u) const {
        constexpr int PER_E = 24 * NPN, NWG = NE * PER_E;
        const int L = i * G + c; if (L >= NWG) return false;
        const int wgid = xcd_remap(L, NWG);
        const int e = wgid / PER_E, rem = wgid % PER_E;
        const int gid = rem / (8 * NPN), w2 = rem % (8 * NPN);
        u.pm = e * 24 + gid * 8 + (w2 % 8); u.pn = w2 / 8; u.bt = e * NPN + u.pn; return true;
    }
    DI int arow(const Unit& u, int r) const { if (GATHER) return idx[u.pm * BM + r]; else return u.pm * BM + r; }
};

template <class Epi, class Sched, bool F8 = false>
DI void gemm_phase(LAS unsigned char* lds, const bf16_t* Ag, const bf16_t* Btg, const int K, const Sched& S, const Epi& E, const int wave_in) {
    const int tid = TIDX(wave_in), wid = wave_in, lane = tid & 63, wr = wid >> 2, wc = wid & 3, fr = lane & 15, fq = lane >> 4;
    const int nt = K / BK;
    unsigned voffB[2];
#pragma unroll
    for (int i = 0; i < 2; ++i) { int R, C; stage_rc(tid * 16 + i * 8192, R, C); const int Rb = Epi::PERM ? ((R & ~31) + perm32(R & 31)) : R;
        voffB[i] = (unsigned)(Rb * K + C) * 2u; }
    const unsigned rowbytes = (unsigned)K * 2u;
    const size_t kstep = (size_t)(BK * 2);
    const size_t hstep = (size_t)HALF * K * 2;
    const size_t tstep = 2 * hstep;
    const unsigned ldsw = (unsigned)wid * 1024u;
    const int aoff = lds_byte(wr * 64 + fr, fq * 8), boff = lds_byte(wc * 32 + fr, fq * 8);
#define PG8_SA(b, h) (((b) * 2 + (h)) * HTB)
#define PG8_SB(b, h) ((4 + (b) * 2 + (h)) * HTB)
#define PG8_STAGE(bufoff, gbase, voff) do { _Pragma("unroll") for (int _i = 0; _i < 2; ++_i) \
        __builtin_amdgcn_global_load_lds((const unsigned*)((const char*)(gbase) + (voff)[_i]), (LAS unsigned*)(lds + (bufoff) + ldsw + _i * 8192), 16, 0, 0); } while (0)
#define PG8_STAGEA(bufoff, o0, o1, kb) do { \
        __builtin_amdgcn_global_load_lds((const unsigned*)((const char*)Ag + (size_t)(o0) + (size_t)(kb)), (LAS unsigned*)(lds + (bufoff) + ldsw), 16, 0, 0); \
        __builtin_amdgcn_global_load_lds((const unsigned*)((const char*)Ag + (size_t)(o1) + (size_t)(kb)), (LAS unsigned*)(lds + (bufoff) + ldsw + 8192), 16, 0, 0); } while (0)
#define PG8_LDA(dst, b, h) do { _Pragma("unroll") for (int m = 0; m < 4; ++m) _Pragma("unroll") for (int k = 0; k < 2; ++k) dst[m][k] = *(const LAS bf16x8*)(lds + PG8_SA(b, h) + aoff + m * 2048 + k * 1024); } while (0)
#define PG8_LDB(dst, b, h) do { _Pragma("unroll") for (int n = 0; n < 2; ++n) _Pragma("unroll") for (int k = 0; k < 2; ++k) dst[n][k] = *(const LAS bf16x8*)(lds + PG8_SB(b, h) + boff + n * 2048 + k * 1024); } while (0)
#define PG8_MMA(ai, bj, At, Bt) do { __builtin_amdgcn_s_setprio(1); _Pragma("unroll") for (int m = 0; m < 4; ++m) _Pragma("unroll") for (int n = 0; n < 2; ++n) { \
        if constexpr (F8) { acc[ai][bj][m][n] = __builtin_amdgcn_mfma_scale_f32_16x16x128_f8f6f4(cat8(Bt[n][0], Bt[n][1]), cat8(At[m][0], At[m][1]), acc[ai][bj][m][n], 0, 0, 0, 0, 0, 0); } \
        else { _Pragma("unroll") for (int k = 0; k < 2; ++k) acc[ai][bj][m][n] = __builtin_amdgcn_mfma_f32_16x16x32_bf16(Bt[n][k], At[m][k], acc[ai][bj][m][n], 0, 0, 0); } } \
        __builtin_amdgcn_s_setprio(0); } while (0)
#define PG8_WAIT_V(n) asm volatile("s_waitcnt vmcnt(" #n ")" ::: "memory")
#define PG8_WAIT_L(n) asm volatile("s_waitcnt lgkmcnt(" #n ")" ::: "memory")
#define PG8_BAR __builtin_amdgcn_s_barrier()
#define PG8_SCHED __builtin_amdgcn_sched_barrier(0)
#define PG8_OFFS(u, o00, o01, o10, o11) do { int R0_, C0_, R1_, C1_; const int t2_ = TIDX(wid); stage_rc(t2_ * 16, R0_, C0_); stage_rc(t2_ * 16 + 8192, R1_, C1_); \
        o00 = (unsigned)S.arow(u, R0_) * rowbytes + (unsigned)C0_ * 2u; o01 = (unsigned)S.arow(u, R1_) * rowbytes + (unsigned)C1_ * 2u; \
        o10 = (unsigned)S.arow(u, HALF + R0_) * rowbytes + (unsigned)C0_ * 2u; o11 = (unsigned)S.arow(u, HALF + R1_) * rowbytes + (unsigned)C1_ * 2u; } while (0)
    Unit cur, nxt; int ui = 0;
    if (!S.next(0, cur)) return;
    f32x4 acc[2][2][4][2];
#pragma unroll
    for (int a = 0; a < 2; ++a)
#pragma unroll
        for (int b = 0; b < 2; ++b)
#pragma unroll
            for (int m = 0; m < 4; ++m)
#pragma unroll
                for (int n = 0; n < 2; ++n) acc[a][b][m][n] = (f32x4){0.f, 0.f, 0.f, 0.f};
    bf16x8 At[4][2], B0[2][2], B1[2][2];
    unsigned c00, c01, c10, c11;
    PG8_OFFS(cur, c00, c01, c10, c11);
    const char* cB = (const char*)Btg + (size_t)cur.bt * tstep;
    PG8_STAGE(PG8_SB(0, 0), cB, voffB); PG8_STAGE(PG8_SB(0, 1), cB + hstep, voffB); PG8_STAGEA(PG8_SA(0, 0), c00, c01, 0); PG8_STAGEA(PG8_SA(0, 1), c10, c11, 0);
    if (wr == 1) PG8_BAR;
    PG8_WAIT_V(2); PG8_BAR;
    PG8_STAGE(PG8_SB(1, 0), cB + kstep, voffB); PG8_STAGEA(PG8_SA(1, 0), c00, c01, kstep); PG8_STAGE(PG8_SB(1, 1), cB + hstep + kstep, voffB);
    PG8_WAIT_V(6); PG8_BAR;
    for (;;) {
        const bool has_next = S.next(ui + 1, nxt);
        const char* nB = has_next ? (const char*)Btg + (size_t)nxt.bt * tstep : cB;
        for (int t = 0; t < nt; t += 2) {
            const bool last = (t == nt - 2);
            const size_t kb1 = (size_t)(t + 1) * kstep;
            const size_t kb2 = last ? 0 : (size_t)(t + 2) * kstep, kb3 = kb2 + kstep;
            const char* b2 = last ? nB : cB + (size_t)(t + 2) * kstep; const char* b3 = b2 + kstep;
            PG8_LDB(B0, 0, 0); PG8_LDB(B1, 0, 1); PG8_SCHED; PG8_LDA(At, 0, 0); PG8_STAGEA(PG8_SA(1, 1), c10, c11, kb1);
            PG8_WAIT_V(8); PG8_WAIT_L(0); PG8_BAR; PG8_MMA(0, 0, At, B0); PG8_MMA(0, 1, At, B1); PG8_BAR; PG8_SCHED;
            if (last && has_next) { PG8_OFFS(nxt, c00, c01, c10, c11); }
            PG8_LDA(At, 0, 1); PG8_STAGE(PG8_SB(0, 0), b2, voffB); PG8_STAGE(PG8_SB(0, 1), b2 + hstep, voffB); PG8_STAGEA(PG8_SA(0, 0), c00, c01, kb2);
            PG8_WAIT_V(8); PG8_WAIT_L(0); PG8_BAR; PG8_MMA(1, 0, At, B0); PG8_MMA(1, 1, At, B1); PG8_BAR; PG8_SCHED;
            PG8_LDB(B0, 1, 0); PG8_LDB(B1, 1, 1); PG8_SCHED; PG8_LDA(At, 1, 0); PG8_STAGEA(PG8_SA(0, 1), c10, c11, kb2);
            PG8_WAIT_V(8); PG8_WAIT_L(0); PG8_BAR; PG8_MMA(0, 0, At, B0); PG8_MMA(0, 1, At, B1); PG8_BAR; PG8_SCHED;
            PG8_LDA(At, 1, 1); PG8_STAGE(PG8_SB(1, 0), b3, voffB); PG8_STAGE(PG8_SB(1, 1), b3 + hstep, voffB); PG8_STAGEA(PG8_SA(1, 0), c00, c01, kb3);
            PG8_WAIT_V(8); PG8_WAIT_L(0); PG8_BAR; PG8_MMA(1, 0, At, B0); PG8_MMA(1, 1, At, B1); PG8_BAR; PG8_SCHED;
        }
        if (wr == 0) PG8_BAR;
        { const int l2 = lane_id(); E(acc, cur, wr, wc, l2 & 15, l2 >> 4); }
        if (!has_next) break;
#pragma unroll
        for (int a = 0; a < 2; ++a)
#pragma unroll
            for (int b = 0; b < 2; ++b)
#pragma unroll
                for (int m = 0; m < 4; ++m)
#pragma unroll
                    for (int n = 0; n < 2; ++n) acc[a][b][m][n] = (f32x4){0.f, 0.f, 0.f, 0.f};
        cur = nxt; cB = nB; ++ui;
        if (wr == 1) PG8_BAR;
    }
    PG8_WAIT_V(0);
    PG8_BAR;
#undef PG8_SA
#undef PG8_SB
#undef PG8_STAGE
#undef PG8_STAGEA
#undef PG8_LDA
#undef PG8_LDB
#undef PG8_MMA
#undef PG8_WAIT_V
#undef PG8_WAIT_L
#undef PG8_BAR
#undef PG8_SCHED
#undef PG8_OFFS
}

struct EpiProj {
    static constexpr bool PERM = true;
    bf16_t* P; const float* rope;
    DI void operator()(const f32x4 (&acc)[2][2][4][2], const Unit& u, int wr, int wc, int fr, int fq) const {
        bf16_t* base = P + (size_t)u.pn * TILE_ELEMS;
        const bool rot = (u.pn < 4) && ((wc & 1) == 0);
#pragma unroll
        for (int ai = 0; ai < 2; ++ai)
#pragma unroll
            for (int m = 0; m < 4; ++m) {
                const int row = u.pm * BM + ai * HALF + wr * 64 + m * 16 + fr;
                asm volatile("" ::: "memory");
                f32x4 cs0 = {1.f, 1.f, 1.f, 1.f}, cs1 = cs0, sn0 = {0.f, 0.f, 0.f, 0.f}, sn1 = sn0;
                if (rot && fq < 2) {
                    const int s = row < TP ? (row & 4095) : (row & 8191);
                    const f32x4* rp = (const f32x4*)(rope + (size_t)s * 16);
                    cs0 = rp[0]; cs1 = rp[1]; sn0 = rp[2]; sn1 = rp[3];
                    if (fq == 0) { sn0 = -sn0; sn1 = -sn1; }
                }
#pragma unroll
                for (int bj = 0; bj < 2; ++bj) {
                    f32x4 v0 = acc[ai][bj][m][0], v1 = acc[ai][bj][m][1];
                    if (rot) {
                        f32x4 o0, o1;
#pragma unroll
                        for (int j = 0; j < 4; ++j) { o0[j] = __shfl_xor(v0[j], 16); o1[j] = __shfl_xor(v1[j], 16); }
                        if (fq < 2) { v0 = v0 * cs0 + o0 * sn0; v1 = v1 * cs1 + o1 * sn1; }
                    }
                    u32x4 w; w.x = pk2(v0[0], v0[1]); w.y = pk2(v0[2], v0[3]); w.z = pk2(v1[0], v1[1]); w.w = pk2(v1[2], v1[3]);
                    *(u32x4*)(base + (size_t)row * 256 + bj * HALF + wc * 32 + 8 * fq) = w;
                }
            }
    }
};
struct EpiOut {
    static constexpr bool PERM = false;
    Params p;
    DI void operator()(const f32x4 (&acc)[2][2][4][2], const Unit& u, int wr, int wc, int fr, int fq) const {
#pragma unroll
        for (int ai = 0; ai < 2; ++ai)
#pragma unroll
            for (int m = 0; m < 4; ++m) {
                const int row = u.pm * BM + ai * HALF + wr * 64 + m * 16 + fr;
                const float* xr = xrow_ptr(p, row); float* orow = p.out + (size_t)row * DM;
#pragma unroll
                for (int bj = 0; bj < 2; ++bj)
#pragma unroll
                    for (int n = 0; n < 2; ++n) {
                        const int col = u.pn * BM + bj * HALF + wc * 32 + 16 * n + 4 * fq;
                        const f32x4 xv = *(const f32x4*)(xr + col);
                        *(f32x4*)(orow + col) = xv * ALPHA + acc[ai][bj][m][n];
                    }
            }
    }
};
struct EpiGU {
    static constexpr bool PERM = true;
    unsigned char* H;
    DI void operator()(const f32x4 (&acc)[2][2][4][2], const Unit& u, int wr, int wc, int fr, int fq) const {
#pragma unroll
        for (int ai = 0; ai < 2; ++ai)
#pragma unroll
            for (int m = 0; m < 4; ++m) {
                const int row = u.pm * BM + ai * HALF + wr * 64 + m * 16 + fr;
                const f32x4 g0 = acc[ai][0][m][0], g1 = acc[ai][0][m][1], u0 = acc[ai][1][m][0], u1 = acc[ai][1][m][1];
                f32x4 h0, h1;
#pragma unroll
                for (int j = 0; j < 4; ++j) { h0[j] = silu_f(g0[j] * (1.0f / WGU_SCALE)) * (u0[j] * (1.0f / WGU_SCALE)); h1[j] = silu_f(g1[j] * (1.0f / WGU_SCALE)) * (u1[j] * (1.0f / WGU_SCALE)); }
                u32x2 w; w.x = pk4_f8(h0[0], h0[1], h0[2], h0[3]); w.y = pk4_f8(h1[0], h1[1], h1[2], h1[3]);
                *(u32x2*)(H + (size_t)row * FF + u.pn * 128 + wc * 32 + 8 * fq) = w;
            }
    }
};
struct EpiDown {
    static constexpr bool PERM = true;
    bf16_t* eo; const float* gate;
    DI void operator()(const f32x4 (&acc)[2][2][4][2], const Unit& u, int wr, int wc, int fr, int fq) const {
#pragma unroll
        for (int ai = 0; ai < 2; ++ai)
#pragma unroll
            for (int m = 0; m < 4; ++m) {
                const int slot = u.pm * BM + ai * HALF + wr * 64 + m * 16 + fr;
                const float gv = gate[slot] * (1.0f / WD_SCALE);
                bf16_t* orow = eo + (size_t)slot * DM + u.pn * BM + wc * 32 + 8 * fq;
#pragma unroll
                for (int bj = 0; bj < 2; ++bj) {
                    const f32x4 v0 = acc[ai][bj][m][0] * gv, v1 = acc[ai][bj][m][1] * gv;
                    u32x4 w; w.x = pk2(v0[0], v0[1]); w.y = pk2(v0[2], v0[3]); w.z = pk2(v1[0], v1[1]); w.w = pk2(v1[2], v1[3]);
                    *(u32x4*)(orow + bj * HALF) = w;
                }
            }
    }
};
}

DI void transpose_item(const float* W, int ldw, int k0, int n0, bf16_t* WT, int ldt, int drow0, LAS float* scr, int lane) {
#pragma unroll 8
    for (int i = 0; i < 32; ++i) { const int kk = 2 * i + (lane >> 5); scr[kk * 33 + (lane & 31)] = W[(size_t)(k0 + kk) * ldw + n0 + (lane & 31)]; }
    LDS_WAIT();
    const int c = lane & 7;
#pragma unroll
    for (int j = 0; j < 4; ++j) { const int n = (lane >> 3) + 8 * j; const LAS float* s = scr + (8 * c) * 33 + n;
        u32x4 o; o.x = pk2(s[0 * 33], s[1 * 33]); o.y = pk2(s[2 * 33], s[3 * 33]); o.z = pk2(s[4 * 33], s[5 * 33]); o.w = pk2(s[6 * 33], s[7 * 33]);
        *(u32x4*)(WT + (size_t)(drow0 + n) * ldt + k0 + 8 * c) = o; }
    LDS_WAIT();
}

DI void transpose_item_f8(const float* W, int ldw, int k0, int n0, unsigned char* WT, int ldt, int drow0, float scale, LAS float* scr, int lane) {
#pragma unroll 8
    for (int i = 0; i < 32; ++i) { const int kk = 2 * i + (lane >> 5); scr[kk * 33 + (lane & 31)] = W[(size_t)(k0 + kk) * ldw + n0 + (lane & 31)] * scale; }
    LDS_WAIT();
    const int c = lane & 7;
#pragma unroll
    for (int j = 0; j < 4; ++j) { const int n = (lane >> 3) + 8 * j; const LAS float* sp = scr + (8 * c) * 33 + n;
        u32x2 o; o.x = pk4_f8(sp[0 * 33], sp[1 * 33], sp[2 * 33], sp[3 * 33]); o.y = pk4_f8(sp[4 * 33], sp[5 * 33], sp[6 * 33], sp[7 * 33]);
        *(u32x2*)(WT + (size_t)(drow0 + n) * ldt + k0 + 8 * c) = o; }
    LDS_WAIT();
}

DI void sincos_small(double r, double& s, double& c) {
    const double r2 = r * r; double ss = 1.0, cc = 1.0;
#pragma unroll
    for (int n = 12; n >= 1; --n) { ss = 1.0 - ss * r2 * (1.0 / (double)((2 * n) * (2 * n + 1))); cc = 1.0 - cc * r2 * (1.0 / (double)((2 * n - 1) * (2 * n))); }
    s = r * ss; c = cc;
}

DI void dot16(const f32x4 (&v)[4], const LAS float* wT, int lane, float (&r)[16]) {
#pragma unroll
    for (int e = 0; e < 16; ++e) {
        float a = 0.f;
        if ((e & 1) == 0) asm volatile("" ::: "memory");
#pragma unroll
        for (int j = 0; j < 4; ++j) { const f32x4 w = *(const LAS f32x4*)(wT + e * 1024 + 256 * j + 4 * lane); a += v[j][0] * w[0] + v[j][1] * w[1] + v[j][2] * w[2] + v[j][3] * w[3]; }
        r[e] = wave_sum(a);
    }
}

DI void phase0(const Params& p, LAS unsigned char* lds, int gw, int NGW, int wave, int lane) {
    const int tid = TIDX(wave);
    {
        LAS float* scr = (LAS float*)(lds + wave * 16384);
        for (int it = gw; it < 2048; it += NGW) {
            if (it < 1536) { const int kb = it / 96, nb = it % 96; transpose_item(p.in[2], INW, 64 * kb, 32 * nb, (bf16_t*)(p.ws + WS_WI), DM, 32 * nb, scr, lane); }
            else { const int r = it - 1536, kb = r / 32, nb = r % 32; transpose_item(p.in[9], DM, 64 * kb, 32 * nb, (bf16_t*)(p.ws + WS_WO), DM, 32 * nb, scr, lane); }
        }
    }
    {
        float* rope = (float*)(p.ws + WS_ROPE);
        const float invf[8] = {1.0f, 0.1939227432012558f, 0.03760603070259094f, 0.007292664609849453f, 0.0014142135623842478f, 0.00027424818836152554f, 5.318296098266728e-05f, 1.0313386155758053e-05f};
        for (int id = blockIdx.x * NTHR + tid; id < 8192 * 8; id += gridDim.x * NTHR) {
            const int pos = id >> 3, i = id & 7;
            float inv = invf[0];
#pragma unroll
            for (int k = 1; k < 8; ++k) inv = (i == k) ? invf[k] : inv;
            const float ang = (float)pos * inv;
            const double x = (double)ang; const double kq = rint(x * 0.15915494309189535); const double r = x - kq * 6.283185307179586476925;
            double s, c; sincos_small(r, s, c);
            rope[pos * 16 + i] = (float)c; rope[pos * 16 + 8 + i] = (float)s;
        }
    }
    __syncthreads();
    LAS float* wT = (LAS float*)lds;
    for (int id = tid; id < 16384; id += NTHR) { const int k = id >> 4, e = id & 15; wT[e * 1024 + k] = p.in[2][(size_t)k * INW + 3072 + e]; }
    __syncthreads();
    const float* dtb = p.in[5];
    float bias = 0.f;
    if (lane < 16) bias = dtb[lane];
    bf16_t* xb = (bf16_t*)(p.ws + WS_XB); float* dtout = (float*)(p.ws + WS_DT);
    for (int t = gw; t < TT; t += NGW) {
        const f32x4* xr = (const f32x4*)xrow_ptr(p, t) + lane;
        f32x4 v[4];
#pragma unroll
        for (int j = 0; j < 4; ++j) v[j] = xr[64 * j];
        u32x2* o8 = (u32x2*)(xb + (size_t)t * DM) + lane;
#pragma unroll
        for (int j = 0; j < 4; ++j) { u32x2 w; w.x = pk2(v[j][0], v[j][1]); w.y = pk2(v[j][2], v[j][3]); o8[64 * j] = w; }
        float r[16]; dot16(v, wT, lane, r);
        float mine = 0.f;
#pragma unroll
        for (int e = 0; e < 16; ++e) mine = (lane == e) ? r[e] : mine;
        if (lane < 16) { const float z = mine + bias; dtout[(size_t)t * 16 + lane] = fmaxf(z, 0.f) + log1pf(__expf(-fabsf(z))); }
    }
}

DI void conv_phase(const Params& p, int wave) {
    const int tid = blockIdx.x * NTHR + TIDX(wave), nthr = gridDim.x * NTHR;
    const int c = tid & 127, ch = 8 * c, tile = ch >> 8, cit = ch & 255;
    const float* cw = p.in[3]; const float* cb = p.in[4];
    float w[5][8], b[8];
#pragma unroll
    for (int j = 0; j < 5; ++j)
#pragma unroll
        for (int e = 0; e < 8; ++e) w[j][e] = cw[j * 1024 + ch + e];
#pragma unroll
    for (int e = 0; e < 8; ++e) b[e] = cb[ch + e];
    const bf16_t* src = (const bf16_t*)(p.ws + WS_P) + (size_t)(8 + tile) * TILE_ELEMS + cit;
    bf16_t* dst = (bf16_t*)(p.ws + WS_XC) + (size_t)tile * TILE_ELEMS + cit;
    for (int it = tid; it < TT * 128; it += nthr) {
        const int t = it >> 7;
        const int S = t < TP ? 4096 : 8192, s = t & (S - 1);
        float a[8];
#pragma unroll
        for (int e = 0; e < 8; ++e) a[e] = b[e];
#pragma unroll
        for (int j = 0; j < 5; ++j) {
            const int sj = s + j - 2;
            if (sj >= 0 && sj < S) {
                const u32x4 v = *(const u32x4*)(src + (size_t)(t + j - 2) * 256);
                a[0] += bflo(v.x) * w[j][0]; a[1] += bfhi(v.x) * w[j][1]; a[2] += bflo(v.y) * w[j][2]; a[3] += bfhi(v.y) * w[j][3];
                a[4] += bflo(v.z) * w[j][4]; a[5] += bfhi(v.z) * w[j][5]; a[6] += bflo(v.w) * w[j][6]; a[7] += bfhi(v.w) * w[j][7];
            }
        }
        u32x4 o; o.x = pk2(silu_f(a[0]), silu_f(a[1])); o.y = pk2(silu_f(a[2]), silu_f(a[3])); o.z = pk2(silu_f(a[4]), silu_f(a[5])); o.w = pk2(silu_f(a[6]), silu_f(a[7]));
        *(u32x4*)(dst + (size_t)t * 256) = o;
    }
}

DI bf16x8 tr_pair(const LAS bf16_t* lo, const LAS bf16_t* hi) {
    const s16x4 a = __builtin_amdgcn_ds_read_tr16_b64_v4i16((LAS s16x4*)lo), b = __builtin_amdgcn_ds_read_tr16_b64_v4i16((LAS s16x4*)hi);
    return __builtin_shufflevector(a, b, 0, 1, 2, 3, 4, 5, 6, 7);
}
DI void attn_step_params(int sidx, int p0, int& d, int& base, int& nk, int& kbase) {
    const int pi = sidx < 12 ? 0 : (sidx < 18 ? 1 : 2);
    const int st = sidx - (pi == 0 ? 0 : (pi == 1 ? 12 : 18));
    d = 1 << (2 * pi); base = p0 - 64 * d; nk = 240 / d + 129; kbase = 32 * st;
}
DI void attn_phase(const Params& p, LAS unsigned char* lds, int gw, int NGW, int wave, int lane) {
    LAS bf16_t* Vn = (LAS bf16_t*)(lds + wave * 4608);
    const bf16_t* Pb = (const bf16_t*)(p.ws + WS_P);
    bf16_t* mix = (bf16_t*)(p.ws + WS_MIX);
    const int c = lane & 15, q = lane >> 4, qp = (lane & 15) >> 2, pp = lane & 3;
    for (int wi = gw; wi < 24576; wi += NGW) {
        const int head = wi & 7, qg = wi >> 3;
        const int t0 = (qg >> 4) * 256 + (qg & 15);
        const int S = t0 < TP ? 4096 : 8192, sbase = t0 & ~(S - 1), p0 = t0 - sbase;
        const int hoff = (head & 3) * 64;
        const bf16_t* Qt = Pb + (size_t)(0 + (head >> 2)) * TILE_ELEMS + hoff;
        const bf16_t* Kt = Pb + (size_t)(2 + (head >> 2)) * TILE_ELEMS + hoff;
        const bf16_t* Vg = Pb + (size_t)(4 + (head >> 2)) * TILE_ELEMS + hoff;
        bf16x8 qf[2];
        { const bf16_t* qrow = Qt + (size_t)(t0 + 16 * c) * 256; qf[0] = *(const bf16x8*)(qrow + 8 * q); qf[1] = *(const bf16x8*)(qrow + 32 + 8 * q); }
        f32x4 O[4];
#pragma unroll
        for (int d4 = 0; d4 < 4; ++d4) O[d4] = (f32x4){0.f, 0.f, 0.f, 0.f};
        float mrun = -1e30f, lsum = 0.f;
        const int pq = p0 + 16 * c;
        u32x4 vc[4], vn[4]; bf16x8 kc[2][2], kn[2][2];
#define ATT_LOADS(sidx_, V_, K_) do { int d_, base_, nk_, kbase_; attn_step_params(sidx_, p0, d_, base_, nk_, kbase_); \
            _Pragma("unroll") for (int i = 0; i < 4; ++i) { const int id = lane + 64 * i, key = id >> 3, dc = id & 7; \
                int pos = base_ + d_ * (kbase_ + key); pos = pos < 0 ? 0 : (pos > S - 1 ? S - 1 : pos); \
                V_[i] = *(const u32x4*)(Vg + (size_t)(sbase + pos) * 256 + 8 * dc); } \
            _Pragma("unroll") for (int kt = 0; kt < 2; ++kt) { int pos = base_ + d_ * (kbase_ + 16 * kt + c); pos = pos < 0 ? 0 : (pos > S - 1 ? S - 1 : pos); \
                const bf16_t* krow = Kt + (size_t)(sbase + pos) * 256; K_[kt][0] = *(const bf16x8*)(krow + 8 * q); K_[kt][1] = *(const bf16x8*)(krow + 32 + 8 * q); } } while (0)
        ATT_LOADS(0, vc, kc);
        for (int sidx = 0; sidx < 23; ++sidx) {
            if (sidx < 22) ATT_LOADS(sidx + 1, vn, kn);
            int d, base, nk, kbase; attn_step_params(sidx, p0, d, base, nk, kbase);
            const int win = 64 * d;
#pragma unroll
            for (int i = 0; i < 4; ++i) { const int id = lane + 64 * i; *(LAS u32x4*)(Vn + (id >> 3) * 72 + 8 * (id & 7)) = vc[i]; }
            f32x4 sc[2];
#pragma unroll
            for (int kt = 0; kt < 2; ++kt) {
                f32x4 a = {0.f, 0.f, 0.f, 0.f};
                a = __builtin_amdgcn_mfma_f32_16x16x32_bf16(kc[kt][0], qf[0], a, 0, 0, 0);
                a = __builtin_amdgcn_mfma_f32_16x16x32_bf16(kc[kt][1], qf[1], a, 0, 0, 0);
                sc[kt] = a;
            }
            bool valid[2][4]; float mloc = -1e30f;
#pragma unroll
            for (int kt = 0; kt < 2; ++kt)
#pragma unroll
                for (int j = 0; j < 4; ++j) {
                    const int kk = kbase + 16 * kt + 4 * q + j, pk = base + d * kk;
                    int df = pk - pq; df = df < 0 ? -df : df;
                    valid[kt][j] = (kk < nk) && (pk >= 0) && (pk < S) && (df <= win);
                    const float sv = valid[kt][j] ? sc[kt][j] * 0.125f : -1e30f;
                    sc[kt][j] = sv; mloc = fmaxf(mloc, sv);
                }
            mloc = fmaxf(mloc, __shfl_xor(mloc, 16)); mloc = fmaxf(mloc, __shfl_xor(mloc, 32));
            const float mnew = fmaxf(mrun, mloc), alpha = __expf(mrun - mnew);
            mrun = mnew;
            float ps = 0.f; float pv[2][4];
#pragma unroll
            for (int kt = 0; kt < 2; ++kt)
#pragma unroll
                for (int j = 0; j < 4; ++j) { pv[kt][j] = valid[kt][j] ? __expf(sc[kt][j] - mnew) : 0.f; ps += pv[kt][j]; }
            lsum = lsum * alpha + ps;
#pragma unroll
            for (int d4 = 0; d4 < 4; ++d4) O[d4] = O[d4] * alpha;
            u32x4 pw; pw.x = pk2(pv[0][0], pv[0][1]); pw.y = pk2(pv[0][2], pv[0][3]); pw.z = pk2(pv[1][0], pv[1][1]); pw.w = pk2(pv[1][2], pv[1][3]);
            const bf16x8 pf = __builtin_bit_cast(bf16x8, pw);
#pragma unroll
            for (int d4 = 0; d4 < 4; ++d4) {
                const LAS bf16_t* vr = Vn + (4 * q + qp) * 72 + 16 * d4 + 4 * pp;
                const bf16x8 vf = tr_pair(vr, vr + 16 * 72);
                O[d4] = __builtin_amdgcn_mfma_f32_16x16x32_bf16(vf, pf, O[d4], 0, 0, 0);
            }
#pragma unroll
            for (int i = 0; i < 4; ++i) vc[i] = vn[i];
#pragma unroll
            for (int kt = 0; kt < 2; ++kt) { kc[kt][0] = kn[kt][0]; kc[kt][1] = kn[kt][1]; }
        }
#undef ATT_LOADS
        lsum += __shfl_xor(lsum, 16); lsum += __shfl_xor(lsum, 32);
        const float inv = 1.0f / lsum;
        bf16_t* orow = mix + (size_t)(t0 + 16 * c) * DM + head * 64 + 4 * q;
#pragma unroll
        for (int d4 = 0; d4 < 4; ++d4) { u32x2 w; w.x = pk2(O[d4][0] * inv, O[d4][1] * inv); w.y = pk2(O[d4][2] * inv, O[d4][3] * inv); *(u32x2*)(orow + 16 * d4) = w; }
    }
}

constexpr size_t WS_SLOC = WS_P;
constexpr size_t WS_DEC = WS_P + 96 * MiB;
constexpr int N_SSD_ITEMS = 6144;
struct SsdItem { int h, dir, g, tb, ts; float A; };
DI SsdItem ssd_decode(const Params& p, int it) {
    int w, ci; if (it < 4096) { w = it >> 5; ci = it & 31; } else { w = 128 + ((it - 4096) >> 6); ci = (it - 4096) & 63; }
    SsdItem I; const int seq = w >> 4; I.h = (w >> 1) & 7; I.dir = w & 1; I.g = I.h >> 2;
    const int S = seq < 8 ? 4096 : 8192, sbase = seq < 8 ? seq * 4096 : TP + (seq - 8) * 8192;
    I.tb = I.dir ? sbase + S - 1 - 128 * ci : sbase + 128 * ci; I.ts = I.dir ? -1 : 1;
    I.A = -__expf(p.in[6][I.dir * 8 + I.h]);
    return I;
}
#define SSD_TOK(I, l) ((I).tb + (I).ts * (l))
DI void ssd_scan_chunk(float d0, float d1, float A, LAS float* acs, LAS float* dts, int lane) {
    const float v0 = d0 * A, v1 = d1 * A; float ps = v0 + v1;
#pragma unroll
    for (int o = 1; o < 64; o <<= 1) { const float t = __shfl_up(ps, o); if (lane >= o) ps += t; }
    acs[2 * lane] = ps - v1; acs[2 * lane + 1] = ps; dts[2 * lane] = d0; dts[2 * lane + 1] = d1;
}
DI void st_tr8(LAS bf16_t* wp, int stride, const u32x4 v) {
    wp[0 * stride] = (bf16_t)(v.x & 0xffffu); wp[1 * stride] = (bf16_t)(v.x >> 16); wp[2 * stride] = (bf16_t)(v.y & 0xffffu); wp[3 * stride] = (bf16_t)(v.y >> 16);
    wp[4 * stride] = (bf16_t)(v.z & 0xffffu); wp[5 * stride] = (bf16_t)(v.z >> 16); wp[6 * stride] = (bf16_t)(v.w & 0xffffu); wp[7 * stride] = (bf16_t)(v.w >> 16);
}
DI void ssd_state_phase(const Params& p, LAS unsigned char* lds, int wave, int lane) {
    const int tid = TIDX(wave), c = lane & 15, q = lane >> 4, w = wave, qp = (lane & 15) >> 2, pp = lane & 3;
    LAS float* acs = (LAS float*)(lds + 0); LAS float* dts = (LAS float*)(lds + 512);
    LAS bf16_t* Xt2 = (LAS bf16_t*)(lds + 1024); LAS bf16_t* Bt = (LAS bf16_t*)(lds + 1024 + 128 * 144);
    const float* dtb = (const float*)(p.ws + WS_DT);
    const bf16_t* XCb = (const bf16_t*)(p.ws + WS_XC);
    bf16_t* Sl = (bf16_t*)(p.ws + WS_SLOC); float* decv = (float*)(p.ws + WS_DEC);
    int it = blockIdx.x;
    if (it >= N_SSD_ITEMS) return;
    SsdItem I = ssd_decode(p, it);
    float pd0 = 0.f, pd1 = 0.f; u32x4 xv[2], bv[4];
#define SSD_LOADS_A(I) do { \
        if (w == 0) { pd0 = dtb[(size_t)SSD_TOK(I, 2 * lane) * 16 + (I).dir * 8 + (I).h]; pd1 = dtb[(size_t)SSD_TOK(I, 2 * lane + 1) * 16 + (I).dir * 8 + (I).h]; } \
        _Pragma("unroll") for (int i = 0; i < 2; ++i) { const int id = tid + NTHR * i, l = id >> 3, pc = id & 7; \
            xv[i] = *(const u32x4*)(XCb + (size_t)((I).h >> 2) * TILE_ELEMS + (size_t)SSD_TOK(I, l) * 256 + ((I).h & 3) * 64 + 8 * pc); } \
        _Pragma("unroll") for (int i = 0; i < 4; ++i) { const int id = tid + NTHR * i, l = id >> 4, ncn = id & 15; \
            bv[i] = *(const u32x4*)(XCb + 2 * TILE_ELEMS + (size_t)SSD_TOK(I, l) * 256 + (I).g * 128 + 8 * ncn); } } while (0)
    SSD_LOADS_A(I);
    for (; it < N_SSD_ITEMS; it += gridDim.x) {
        if (w == 0) ssd_scan_chunk(pd0, pd1, I.A, acs, dts, lane);
        __syncthreads();
        const float aend = acs[127];
#pragma unroll
        for (int i = 0; i < 2; ++i) {
            const int id = tid + NTHR * i, l = id >> 3, pc = id & 7;
            const float s2 = dts[l] * __expf(aend - acs[l]);
            const u32x4 v = xv[i];
            u32x4 o; o.x = pk2(bflo(v.x) * s2, bfhi(v.x) * s2); o.y = pk2(bflo(v.y) * s2, bfhi(v.y) * s2); o.z = pk2(bflo(v.z) * s2, bfhi(v.z) * s2); o.w = pk2(bflo(v.w) * s2, bfhi(v.w) * s2);
            *(LAS u32x4*)(Xt2 + l * 72 + 8 * pc) = o;
        }
#pragma unroll
        for (int i = 0; i < 4; ++i) { const int id = tid + NTHR * i; *(LAS u32x4*)(Bt + (id >> 4) * 136 + 8 * (id & 15)) = bv[i]; }
        const int itn = it + gridDim.x;
        if (itn < N_SSD_ITEMS) { I = ssd_decode(p, itn); SSD_LOADS_A(I); }
        __syncthreads();
        bf16_t* so = Sl + (size_t)it * 8192 + 16 * w + 4 * q;
#pragma unroll
        for (int pt = 0; pt < 4; ++pt) {
            f32x4 a = {0.f, 0.f, 0.f, 0.f};
#pragma unroll
            for (int ks = 0; ks < 4; ++ks) {
                const LAS bf16_t* br = Bt + (32 * ks + 8 * q + qp) * 136 + 16 * w + 4 * pp;
                const LAS bf16_t* xr = Xt2 + (32 * ks + 8 * q + qp) * 72 + 16 * pt + 4 * pp;
                const bf16x8 bfr = tr_pair(br, br + 4 * 136), xf = tr_pair(xr, xr + 4 * 72);
                a = __builtin_amdgcn_mfma_f32_16x16x32_bf16(bfr, xf, a, 0, 0, 0);
            }
            u32x2 o; o.x = pk2(a[0], a[1]); o.y = pk2(a[2], a[3]);
            *(u32x2*)(so + (16 * pt + c) * 128) = o;
        }
        if (tid == 0) decv[it] = __expf(aend);
    }
#undef SSD_LOADS_A
}
DI void ssd_scan_phase(const Params& p, int wave) {
    unsigned* Sl = (unsigned*)(p.ws + WS_SLOC); const float* decv = (const float*)(p.ws + WS_DEC);
    for (int chain = blockIdx.x * NTHR + TIDX(wave); chain < 160 * 4096; chain += gridDim.x * NTHR) {
        const int w = chain >> 12, j = chain & 4095;
        const int nc = w < 128 ? 32 : 64, cb = w < 128 ? 32 * w : 4096 + 64 * (w - 128);
        unsigned* ptr = Sl + (size_t)cb * 4096 + j; const float* dp = decv + cb;
        float s0 = 0.f, s1 = 0.f;
        for (int c0 = 0; c0 < nc; c0 += 8) {
            unsigned v[8]; float d[8];
#pragma unroll
            for (int k = 0; k < 8; ++k) { v[k] = ptr[(size_t)(c0 + k) * 4096]; d[k] = dp[c0 + k]; }
#pragma unroll
            for (int k = 0; k < 8; ++k) { ptr[(size_t)(c0 + k) * 4096] = pk2(s0, s1); s0 = s0 * d[k] + bflo(v[k]); s1 = s1 * d[k] + bfhi(v[k]); }
        }
    }
}
constexpr int SSDC_ACS = 0  , SSDC_XT1 = 2048, SSDC_BN = SSDC_XT1 + 128 * 144, SSDC_SBF = SSDC_BN + 128 * 272, SSDC_END = SSDC_SBF + 64 * 272;
static_assert(SSDC_END <= 131072, "ssd lds");
DI void ssd_out_phase(const Params& p, LAS unsigned char* lds, int wave, int lane) {
    const int tid = TIDX(wave), c = lane & 15, q = lane >> 4, w = wave, qp = (lane & 15) >> 2, pp = lane & 3;
    LAS bf16_t* Xt1 = (LAS bf16_t*)(lds + SSDC_XT1); LAS bf16_t* Bn = (LAS bf16_t*)(lds + SSDC_BN); LAS bf16_t* Sbf = (LAS bf16_t*)(lds + SSDC_SBF);
    const float* dtb = (const float*)(p.ws + WS_DT);
    const bf16_t* XCb = (const bf16_t*)(p.ws + WS_XC);
    const bf16_t* Sl = (const bf16_t*)(p.ws + WS_SLOC);
    int it = blockIdx.x;
    if (it >= N_SSD_ITEMS) return;
    SsdItem I = ssd_decode(p, it);
    float pd0 = 0.f, pd1 = 0.f; u32x4 xv[2], bv[4], sv[2]; bf16x8 Cn[4];
#define SSD_LOADS_C(I, itx) do { \
        if (w == 0) { pd0 = dtb[(size_t)SSD_TOK(I, 2 * lane) * 16 + (I).dir * 8 + (I).h]; pd1 = dtb[(size_t)SSD_TOK(I, 2 * lane + 1) * 16 + (I).dir * 8 + (I).h]; } \
        _Pragma("unroll") for (int i = 0; i < 2; ++i) { const int id = tid + NTHR * i, l = id >> 3, pc = id & 7; \
            xv[i] = *(const u32x4*)(XCb + (size_t)((I).h >> 2) * TILE_ELEMS + (size_t)SSD_TOK(I, l) * 256 + ((I).h & 3) * 64 + 8 * pc); \
            sv[i] = *(const u32x4*)(Sl + (size_t)(itx) * 8192 + (size_t)id * 8); } \
        _Pragma("unroll") for (int i = 0; i < 4; ++i) { const int id = tid + NTHR * i, l = id >> 4, ncn = id & 15; \
            bv[i] = *(const u32x4*)(XCb + 2 * TILE_ELEMS + (size_t)SSD_TOK(I, l) * 256 + (I).g * 128 + 8 * ncn); } \
        { const bf16_t* cr = XCb + 3 * TILE_ELEMS + (size_t)SSD_TOK(I, 16 * w + c) * 256 + (I).g * 128 + 8 * q; \
          _Pragma("unroll") for (int ks = 0; ks < 4; ++ks) Cn[ks] = *(const bf16x8*)(cr + 32 * ks); } } while (0)
    SSD_LOADS_C(I, it);
    int par = 0;
    for (; it < N_SSD_ITEMS; it += gridDim.x, par ^= 1) {
        LAS float* acs = (LAS float*)(lds + SSDC_ACS + par * 1024); LAS float* dts = acs + 128;
        if (w == 0) ssd_scan_chunk(pd0, pd1, I.A, acs, dts, lane);
        __syncthreads();
#pragma unroll
        for (int i = 0; i < 2; ++i) {
            const int id = tid + NTHR * i, l = id >> 3, pc = id & 7;
            const float s1 = dts[l];
            const u32x4 v = xv[i];
            u32x4 o; o.x = pk2(bflo(v.x) * s1, bfhi(v.x) * s1); o.y = pk2(bflo(v.y) * s1, bfhi(v.y) * s1); o.z = pk2(bflo(v.z) * s1, bfhi(v.z) * s1); o.w = pk2(bflo(v.w) * s1, bfhi(v.w) * s1);
            *(LAS u32x4*)(Xt1 + l * 72 + 8 * pc) = o;
            *(LAS u32x4*)(Sbf + (id >> 4) * 136 + 8 * (id & 15)) = sv[i];
        }
#pragma unroll
        for (int i = 0; i < 4; ++i) { const int id = tid + NTHR * i; *(LAS u32x4*)(Bn + (id >> 4) * 136 + 8 * (id & 15)) = bv[i]; }
        bf16x8 Cf[4];
#pragma unroll
        for (int ks = 0; ks < 4; ++ks) Cf[ks] = Cn[ks];
        const SsdItem Ic = I;
        const int itn = it + gridDim.x;
        if (itn < N_SSD_ITEMS) { I = ssd_decode(p, itn); SSD_LOADS_C(I, itn); }
        __syncthreads();
        {
            const int l = 16 * w + c;
            const float al = acs[l];
            f32x4 acc[4];
#pragma unroll
            for (int pt = 0; pt < 4; ++pt) {
                f32x4 a = {0.f, 0.f, 0.f, 0.f};
#pragma unroll
                for (int ks = 0; ks < 4; ++ks) { const bf16x8 sf = *(const LAS bf16x8*)(Sbf + (16 * pt + c) * 136 + 32 * ks + 8 * q); a = __builtin_amdgcn_mfma_f32_16x16x32_bf16(sf, Cf[ks], a, 0, 0, 0); }
                acc[pt] = a * __expf(al);
            }
            const int nsp = (w >> 1) + 1;
            for (int sp = 0; sp < nsp; ++sp) {
                f32x4 M[2];
#pragma unroll
                for (int hh = 0; hh < 2; ++hh) {
                    const int st = 2 * sp + hh;
                    f32x4 G = {0.f, 0.f, 0.f, 0.f};
                    if (st <= w) {
#pragma unroll
                        for (int ks = 0; ks < 4; ++ks) { const bf16x8 bfr = *(const LAS bf16x8*)(Bn + (16 * st + c) * 136 + 32 * ks + 8 * q); G = __builtin_amdgcn_mfma_f32_16x16x32_bf16(bfr, Cf[ks], G, 0, 0, 0); }
#pragma unroll
                        for (int j = 0; j < 4; ++j) { const int s = 16 * st + 4 * q + j; const float e = __expf(al - acs[s]); G[j] = (s <= l) ? G[j] * e : 0.f; }
                    }
                    M[hh] = G;
                }
                u32x4 pw; pw.x = pk2(M[0][0], M[0][1]); pw.y = pk2(M[0][2], M[0][3]); pw.z = pk2(M[1][0], M[1][1]); pw.w = pk2(M[1][2], M[1][3]);
                const bf16x8 pf = __builtin_bit_cast(bf16x8, pw);
#pragma unroll
                for (int pt = 0; pt < 4; ++pt) {
                    const LAS bf16_t* xr = Xt1 + (32 * sp + 4 * q + qp) * 72 + 16 * pt + 4 * pp;
                    const bf16x8 xf = tr_pair(xr, xr + 16 * 72);
                    acc[pt] = __builtin_amdgcn_mfma_f32_16x16x32_bf16(xf, pf, acc[pt], 0, 0, 0);
                }
            }
            bf16_t* yr = (bf16_t*)(p.ws + (Ic.dir ? WS_YB : WS_YF)) + Ic.h * 64 + (size_t)SSD_TOK(Ic, l) * 512 + 4 * q;
#pragma unroll
            for (int pt = 0; pt < 4; ++pt) { u32x2 o; o.x = pk2(acc[pt][0], acc[pt][1]); o.y = pk2(acc[pt][2], acc[pt][3]); *(u32x2*)(yr + 16 * pt) = o; }
        }
    }
#undef SSD_LOADS_C
}

DI void gate_phase(const Params& p, int gw, int NGW, int lane) {
    const bf16_t* yf = (const bf16_t*)(p.ws + WS_YF); const bf16_t* yb = (const bf16_t*)(p.ws + WS_YB);
    const bf16_t* xh = (const bf16_t*)(p.ws + WS_XC) + (size_t)(lane >> 5) * TILE_ELEMS + (8 * lane & 255);
    const bf16_t* zt = (const bf16_t*)(p.ws + WS_P) + (size_t)(6 + (lane >> 5)) * TILE_ELEMS + (8 * lane & 255);
    bf16_t* mix = (bf16_t*)(p.ws + WS_MIX) + 512 + 8 * lane;
    const float D = p.in[7][lane >> 3];
    float nw[8];
#pragma unroll
    for (int e = 0; e < 8; ++e) nw[e] = p.in[8][8 * lane + e];
    for (int t = gw; t < TT; t += NGW) {
        const u32x4 a = *(const u32x4*)(yf + (size_t)t * 512 + 8 * lane), b = *(const u32x4*)(yb + (size_t)t * 512 + 8 * lane);
        const u32x4 x = *(const u32x4*)(xh + (size_t)t * 256), z = *(const u32x4*)(zt + (size_t)t * 256);
        float y[8];
        y[0] = (bflo(a.x) + bflo(b.x) + D * bflo(x.x)) * silu_f(bflo(z.x)); y[1] = (bfhi(a.x) + bfhi(b.x) + D * bfhi(x.x)) * silu_f(bfhi(z.x));
        y[2] = (bflo(a.y) + bflo(b.y) + D * bflo(x.y)) * silu_f(bflo(z.y)); y[3] = (bfhi(a.y) + bfhi(b.y) + D * bfhi(x.y)) * silu_f(bfhi(z.y));
        y[4] = (bflo(a.z) + bflo(b.z) + D * bflo(x.z)) * silu_f(bflo(z.z)); y[5] = (bfhi(a.z) + bfhi(b.z) + D * bfhi(x.z)) * silu_f(bfhi(z.z));
        y[6] = (bflo(a.w) + bflo(b.w) + D * bflo(x.w)) * silu_f(bflo(z.w)); y[7] = (bfhi(a.w) + bfhi(b.w) + D * bfhi(x.w)) * silu_f(bfhi(z.w));
        float ss = 0.f;
#pragma unroll
        for (int e = 0; e < 8; ++e) ss += y[e] * y[e];
        ss = wave_sum(ss);
        const float r = 1.0f / sqrtf(ss * (1.0f / 512.0f) + RMS_EPS);
        u32x4 o; o.x = pk2(y[0] * r * nw[0], y[1] * r * nw[1]); o.y = pk2(y[2] * r * nw[2], y[3] * r * nw[3]); o.z = pk2(y[4] * r * nw[4], y[5] * r * nw[5]); o.w = pk2(y[6] * r * nw[6], y[7] * r * nw[7]);
        *(u32x4*)(mix + (size_t)t * DM) = o;
    }
}

DI void expert_gu_weights_phase(const Params& p, LAS unsigned char* lds, int gw, int NGW, int wave, int lane) {
    LAS float* scr = (LAS float*)(lds + wave * 16384);
    for (int it = gw; it < 16 * 2816; it += NGW) {
        const int e = it / 2816, r = it % 2816;
        const int isup = r >= 1408, rr = isup ? r - 1408 : r, kb = rr / 88, nb = rr % 88, n0 = 32 * nb;
        const float* W = (isup ? p.in[14] : p.in[13]) + (size_t)e * DM * FF;
        transpose_item_f8(W, FF, 64 * kb, n0, p.ws + WS_WGU, DM, e * 5632 + 256 * (n0 >> 7) + (n0 & 127) + (isup ? 128 : 0), WGU_SCALE, scr, lane);
    }
}
DI void expert_down_weights(const Params& p, LAS unsigned char* lds, int vw, int NVW, int wave, int lane) {
    LAS float* scr = (LAS float*)(lds + 4096 + wave * 16384);
    for (int it = vw; it < 16 * 1408; it += NVW) {
        const int e = it / 1408, rr = it % 1408, kb = rr / 32, nb = rr % 32;
        transpose_item_f8(p.in[15] + (size_t)e * FF * DM, DM, 64 * kb, 32 * nb, p.ws + WS_WD, FF, e * 1024 + 32 * nb, WD_SCALE, scr, lane);
    }
}

DI void ln1_router_phase(const Params& p, LAS unsigned char* lds, int gw, int NGW, int wave, int lane) {
    const int tid = TIDX(wave);
    LAS float* wT = (LAS float*)lds;
    for (int id = tid; id < 16384; id += NTHR) { const int k = id >> 4, e = id & 15; wT[e * 1024 + k] = p.in[12][id]; }
    __syncthreads();
    f32x4 gg[4], bb[4];
#pragma unroll
    for (int j = 0; j < 4; ++j) { gg[j] = ((const f32x4*)p.in[10])[64 * j + lane]; bb[j] = ((const f32x4*)p.in[11])[64 * j + lane]; }
    unsigned char* x1b = p.ws + WS_X1B; float* aff = (float*)(p.ws + WS_AFF);
    for (int t = gw; t < TT; t += NGW) {
        f32x4* orow = (f32x4*)(p.out + (size_t)t * DM) + lane;
        f32x4 v[4]; float s = 0.f;
#pragma unroll
        for (int j = 0; j < 4; ++j) { v[j] = orow[64 * j]; s += (v[j][0] + v[j][1]) + (v[j][2] + v[j][3]); }
        const float mean = wave_sum(s) * (1.0f / DM); float s2 = 0.f;
#pragma unroll
        for (int j = 0; j < 4; ++j) { v[j] = v[j] - mean; s2 += (v[j][0] * v[j][0] + v[j][1] * v[j][1]) + (v[j][2] * v[j][2] + v[j][3] * v[j][3]); }
        const float rstd = 1.0f / sqrtf(wave_sum(s2) * (1.0f / DM) + LN_EPS);
        unsigned* o4 = (unsigned*)(x1b + (size_t)t * DM) + lane;
#pragma unroll
        for (int j = 0; j < 4; ++j) {
            v[j] = v[j] * rstd * gg[j] + bb[j];
            orow[64 * j] = v[j] * ALPHA;
            o4[64 * j] = pk4_f8(v[j][0], v[j][1], v[j][2], v[j][3]);
        }
        float r[16]; dot16(v, wT, lane, r);
        float mx = r[0];
#pragma unroll
        for (int e = 1; e < 16; ++e) mx = fmaxf(mx, r[e]);
        float den = 0.f, mine = 0.f;
#pragma unroll
        for (int e = 0; e < 16; ++e) { const float ex = __expf(r[e] - mx); den += ex; mine = (lane == e) ? ex : mine; }
        if (lane < 16) aff[(size_t)lane * TT + t] = mine / den;
    }
}

DI void select_phase(const Params& p, LAS unsigned char* lds, int wave, int lane) {
    const int wk = blockIdx.x;
    if (wk >= 32) { expert_down_weights(p, lds, (wk - 32) * 8 + wave, ((int)gridDim.x - 32) * 8, wave, lane); return; }
    const int tid = TIDX(wave);
    const int trunk = wk >> 4, e = wk & 15;
    const int Tn = trunk ? 16384 : 32768, tbase = trunk ? TP : 0, cap = Tn / 8;
    const unsigned* col = (const unsigned*)(p.ws + WS_AFF) + (size_t)e * TT + tbase;
    LAS unsigned* hist = (LAS unsigned*)lds;
    LAS unsigned* ctl = (LAS unsigned*)(lds + 1024);
    LAS unsigned* wcnt = (LAS unsigned*)(lds + 2048);
    unsigned prefix = 0, remaining = (unsigned)cap;
    for (int pass = 0; pass < 4; ++pass) {
        const int shift = 24 - 8 * pass;
        for (int i = tid; i < 256; i += NTHR) hist[i] = 0u;
        __syncthreads();
        for (int i = tid; i < Tn; i += NTHR) {
            const unsigned bits = col[i];
            if (pass == 0 || (bits >> (shift + 8)) == prefix) atomicAdd((unsigned*)(hist + ((bits >> shift) & 255u)), 1u);
        }
        __syncthreads();
        if (tid == 0) {
            unsigned cum = 0; int b = 255;
            for (; b > 0; --b) { const unsigned hcnt = hist[b]; if (cum + hcnt >= remaining) break; cum += hcnt; }
            ctl[0] = (prefix << 8) | (unsigned)b; ctl[1] = remaining - cum;
        }
        __syncthreads();
        prefix = ctl[0]; remaining = ctl[1];
        __syncthreads();
    }
    const unsigned thr = prefix, need_eq = remaining;
    int* idx = (int*)(p.ws + WS_IDX) + e * SLOTS_E + (trunk ? 4096 : 0);
    int* inv = (int*)(p.ws + WS_INV) + (size_t)e * TT + tbase;
    const int slot0 = e * SLOTS_E + (trunk ? 4096 : 0);
    float* gate = (float*)(p.ws + WS_GATE) + e * SLOTS_E + (trunk ? 4096 : 0);
    unsigned sel_base = 0, eq_base = 0;
    for (int b0 = 0; b0 < Tn; b0 += NTHR) {
        const unsigned bits = col[b0 + tid];
        const bool gt = bits > thr, eq = bits == thr;
        const unsigned long long meq = __ballot(eq);
        const unsigned eq_before_w = (unsigned)__popcll(meq & ((1ull << lane) - 1ull));
        if (lane == 0) wcnt[wave] = (unsigned)__popcll(meq);
        __syncthreads();
        unsigned eq_off = 0, eq_tot = 0;
#pragma unroll
        for (int w2 = 0; w2 < 8; ++w2) { const unsigned cnt = wcnt[w2]; eq_off += (w2 < wave) ? cnt : 0u; eq_tot += cnt; }
        const bool sel = gt || (eq && (eq_base + eq_off + eq_before_w) < need_eq);
        const unsigned long long msel = __ballot(sel);
        const unsigned sel_before_w = (unsigned)__popcll(msel & ((1ull << lane) - 1ull));
        if (lane == 0) wcnt[8 + wave] = (unsigned)__popcll(msel);
        __syncthreads();
        unsigned sel_off = 0, sel_tot = 0;
#pragma unroll
        for (int w2 = 0; w2 < 8; ++w2) { const unsigned cnt = wcnt[8 + w2]; sel_off += (w2 < wave) ? cnt : 0u; sel_tot += cnt; }
        { const unsigned pos = sel_base + sel_off + sel_before_w; const bool ok = sel && pos < (unsigned)cap;
          if (ok) { idx[pos] = tbase + b0 + tid; gate[pos] = __uint_as_float(bits); }
          inv[b0 + tid] = ok ? slot0 + (int)pos : -1; }
        sel_base += sel_tot; eq_base += eq_tot;
        __syncthreads();
    }
}

DI void ln2_phase(const Params& p, int gw, int NGW, int lane) {
    f32x4 gg[4], bb[4];
#pragma unroll
    for (int j = 0; j < 4; ++j) { gg[j] = ((const f32x4*)p.in[16])[64 * j + lane]; bb[j] = ((const f32x4*)p.in[17])[64 * j + lane]; }
    const int* inv = (const int*)(p.ws + WS_INV); const bf16_t* eo = (const bf16_t*)(p.ws + WS_EO);
    for (int t = gw; t < TT; t += NGW) {
        f32x4* orow = (f32x4*)(p.out + (size_t)t * DM) + lane;
        f32x4 v[4]; float s = 0.f;
#pragma unroll
        for (int j = 0; j < 4; ++j) v[j] = orow[64 * j];
        const int myslot = lane < 16 ? inv[(size_t)lane * TT + t] : -1;
        for (int e = 0; e < 16; ++e) {
            const int sl = __shfl(myslot, e);
            if (sl >= 0) {
                const u32x2* er = (const u32x2*)(eo + (size_t)sl * DM) + lane;
#pragma unroll
                for (int j = 0; j < 4; ++j) { const u32x2 w = er[64 * j]; v[j][0] += bflo(w.x); v[j][1] += bfhi(w.x); v[j][2] += bflo(w.y); v[j][3] += bfhi(w.y); }
            }
        }
#pragma unroll
        for (int j = 0; j < 4; ++j) s += (v[j][0] + v[j][1]) + (v[j][2] + v[j][3]);
        const float mean = wave_sum(s) * (1.0f / DM); float s2 = 0.f;
#pragma unroll
        for (int j = 0; j < 4; ++j) { v[j] = v[j] - mean; s2 += (v[j][0] * v[j][0] + v[j][1] * v[j][1]) + (v[j][2] * v[j][2] + v[j][3] * v[j][3]); }
        const float rstd = 1.0f / sqrtf(wave_sum(s2) * (1.0f / DM) + LN_EPS);
#pragma unroll
        for (int j = 0; j < 4; ++j) orow[64 * j] = v[j] * rstd * gg[j] + bb[j];
    }
}

__global__ void __launch_bounds__(NTHR, 2) fwd_megakernel(Params p) {
    extern __shared__ __attribute__((aligned(16))) unsigned char lds_raw[];
    LAS unsigned char* lds = (LAS unsigned char*)lds_raw;
    cg::grid_group grid = cg::this_grid();
    const int wave_k = __builtin_amdgcn_readfirstlane((int)threadIdx.x >> 6);
#define IDS() const int lane = lane_id(), wave = wave_k; \
    const int G = gridDim.x, gw = blockIdx.x * 8 + wave, NGW = G * 8; (void)lane; (void)gw; (void)NGW; (void)G;
    { IDS(); phase0(p, lds, gw, NGW, wave, lane); }
    grid.sync();
    {
        IDS();
        pg8::SchedPlain S; S.init(TT, 3072, G, (int)blockIdx.x);
        pg8::EpiProj E{(bf16_t*)(p.ws + WS_P), (const float*)(p.ws + WS_ROPE)};
        pg8::gemm_phase<pg8::EpiProj, pg8::SchedPlain>(lds, (const bf16_t*)(p.ws + WS_XB), (const bf16_t*)(p.ws + WS_WI), DM, S, E, wave);
    }
    grid.sync();
    conv_phase(p, wave_k);
    { IDS(); attn_phase(p, lds, gw, NGW, wave, lane); }
    grid.sync();
    { IDS(); ssd_state_phase(p, lds, wave, lane); }
    grid.sync();
    ssd_scan_phase(p, wave_k);
    grid.sync();
    { IDS(); ssd_out_phase(p, lds, wave, lane); }
    grid.sync();
    { IDS(); gate_phase(p, gw, NGW, lane); }
    grid.sync();
    { IDS(); expert_gu_weights_phase(p, lds, gw, NGW, wave, lane); }
    __syncthreads();
    {
        IDS();
        pg8::SchedPlain S; S.init(TT, DM, G, (int)blockIdx.x);
        pg8::EpiOut E{p};
        pg8::gemm_phase<pg8::EpiOut, pg8::SchedPlain>(lds, (const bf16_t*)(p.ws + WS_MIX), (const bf16_t*)(p.ws + WS_WO), DM, S, E, wave);
    }
    grid.sync();
    { IDS(); ln1_router_phase(p, lds, gw, NGW, wave, lane); }
    grid.sync();
    { IDS(); select_phase(p, lds, wave, lane); }
    grid.sync();
    {
        IDS();
        const int* idx = (const int*)(p.ws + WS_IDX);
        pg8::SchedGrouped<22, true> S{G, (int)blockIdx.x, idx};
        pg8::EpiGU E{p.ws + WS_HID};
        pg8::gemm_phase<pg8::EpiGU, pg8::SchedGrouped<22, true>, true>(lds, (const bf16_t*)(p.ws + WS_X1B), (const bf16_t*)(p.ws + WS_WGU), DM / 2, S, E, wave);
    }
    grid.sync();
    {
        IDS();
        const int* idx = (const int*)(p.ws + WS_IDX);
        const float* gate = (const float*)(p.ws + WS_GATE);
        pg8::SchedGrouped<4, false> S{G, (int)blockIdx.x, idx};
        pg8::EpiDown E{(bf16_t*)(p.ws + WS_EO), gate};
        pg8::gemm_phase<pg8::EpiDown, pg8::SchedGrouped<4, false>, true>(lds, (const bf16_t*)(p.ws + WS_HID), (const bf16_t*)(p.ws + WS_WD), FF / 2, S, E, wave);
    }
    grid.sync();
    { IDS(); ln2_phase(p, gw, NGW, lane); }
#undef IDS
}

extern "C" void kernel_launch(void* const* d_in, const int* in_sizes, int n_in, void* d_out, int out_size, void* d_ws, size_t ws_size, hipStream_t stream) {
    static int grid_blocks = 0;
    if (grid_blocks == 0) {
        if (n_in != 18 || ws_size < WS_END || out_size != TT * DM) { fprintf(stderr, "kernel_launch: unexpected shapes (n_in %d out %d ws %zu)\n", n_in, out_size, ws_size); grid_blocks = -1; return; }
        int dev = 0, cus = 0, per_cu = 0;
        hipGetDevice(&dev);
        hipDeviceGetAttribute(&cus, hipDeviceAttributeMultiprocessorCount, dev);
        if (hipFuncSetAttribute((const void*)fwd_megakernel, hipFuncAttributeMaxDynamicSharedMemorySize, LDS_BYTES) != hipSuccess) { fprintf(stderr, "kernel_launch: hipFuncSetAttribute failed\n"); }
        hipOccupancyMaxActiveBlocksPerMultiprocessor(&per_cu, (const void*)fwd_megakernel, NTHR, LDS_BYTES);
        if (per_cu < 1) per_cu = 1;
        (void)hipGetLastError();
        grid_blocks = cus * per_cu;
    }
    if (grid_blocks < 0) return;
    Params p{};
    for (int i = 0; i < 18; ++i) p.in[i] = (const float*)d_in[i];
    p.out = (float*)d_out; p.ws = (unsigned char*)d_ws;
    void* args[] = {&p};
    hipError_t e = hipLaunchCooperativeKernel((void*)fwd_megakernel, dim3(grid_blocks), dim3(NTHR), args, LDS_BYTES, stream);
    if (e != hipSuccess) fprintf(stderr, "cooperative launch failed: %s (grid %d)\n", hipGetErrorString(e), grid_blocks);
}
```

```cpp
#include <hip/hip_runtime.h>
#include <hip/hip_cooperative_groups.h>
#include <cstdio>
#include <cstdint>
namespace cg = cooperative_groups;

#define DI __device__ __forceinline__
#define LAS __attribute__((address_space(3)))
typedef unsigned short bf16_t;
typedef short bf16x8 __attribute__((ext_vector_type(8)));
typedef short s16x4 __attribute__((ext_vector_type(4)));
typedef float f32x4 __attribute__((ext_vector_type(4)));
typedef unsigned u32x4 __attribute__((ext_vector_type(4)));
typedef unsigned u32x2 __attribute__((ext_vector_type(2)));
typedef int i32x4 __attribute__((ext_vector_type(4)));
typedef int i32x8 __attribute__((ext_vector_type(8)));

constexpr int TT = 49152;
constexpr int TP = 32768;
constexpr int DM = 1024;
constexpr int INW = 3088;
constexpr int FF = 2816;
constexpr int NE = 16;
constexpr int SLOTS_E = 6144;
constexpr float ALPHA = 1.189207115002721f;
constexpr float LN_EPS = 1e-5f, RMS_EPS = 1e-5f;

constexpr size_t MiB = 1u << 20;
constexpr size_t TILE_ELEMS = (size_t)TT * 256;
constexpr size_t TILE_BYTES = TILE_ELEMS * 2;
constexpr size_t WS_WI = 0;
constexpr size_t WS_WO = 6 * MiB;
constexpr size_t WS_DT = 8 * MiB;
constexpr size_t WS_ROPE = 11 * MiB;
constexpr size_t WS_AFF = 12 * MiB;
constexpr size_t WS_IDX = 15 * MiB;
constexpr size_t WS_GATE = 15 * MiB + 512 * 1024;
constexpr size_t WS_P = 20 * MiB;
constexpr size_t WS_XC = 308 * MiB;
constexpr size_t WS_XB = 404 * MiB;
constexpr size_t WS_MIX = WS_XB;
constexpr size_t WS_YF = WS_P + 8 * TILE_BYTES;
constexpr size_t WS_YB = WS_P + 10 * TILE_BYTES;
constexpr size_t WS_INV = 16 * MiB;
constexpr size_t WS_WD = 20 * MiB;
constexpr size_t WS_WGU = 108 * MiB;
constexpr size_t WS_EO = 212 * MiB;
constexpr size_t WS_X1B = 308 * MiB;
constexpr size_t WS_HID = 404 * MiB;
constexpr size_t WS_END = 668 * MiB;

constexpr int LDS_BYTES = 147456;
constexpr int NTHR = 512;

DI unsigned f2bf(float f) { unsigned u = __float_as_uint(f); return (u + 0x7fffu + ((u >> 16) & 1u)) >> 16; }
DI unsigned pk2(float lo, float hi) { return f2bf(lo) | (f2bf(hi) << 16); }
DI unsigned pk4_f8(float a, float b, float c, float d) { int w = 0; w = __builtin_amdgcn_cvt_pk_fp8_f32(a, b, w, false); w = __builtin_amdgcn_cvt_pk_fp8_f32(c, d, w, true); return (unsigned)w; }
DI i32x8 cat8(bf16x8 lo, bf16x8 hi) { const i32x4 a = __builtin_bit_cast(i32x4, lo), b = __builtin_bit_cast(i32x4, hi); return __builtin_shufflevector(a, b, 0, 1, 2, 3, 4, 5, 6, 7); }
constexpr float WGU_SCALE = 32.0f, WD_SCALE = 64.0f;
DI float bflo(unsigned u) { return __uint_as_float(u << 16); }
DI float bfhi(unsigned u) { return __uint_as_float(u & 0xffff0000u); }
DI float wave_sum(float v) {
#pragma unroll
    for (int o = 1; o < 64; o <<= 1) v += __shfl_xor(v, o);
    return v;
}
DI void st_tr8_pair(LAS bf16_t* base, int stride, int colpair, int lane, const u32x4 v) {
    const unsigned px = __shfl_xor(v.x, 1), py = __shfl_xor(v.y, 1), pz = __shfl_xor(v.z, 1), pw = __shfl_xor(v.w, 1);
    const bool odd = (lane & 1) != 0;
    const unsigned d0 = odd ? ((px >> 16) | (v.x & 0xffff0000u)) : ((v.x & 0xffffu) | (px << 16));
    const unsigned d1 = odd ? ((py >> 16) | (v.y & 0xffff0000u)) : ((v.y & 0xffffu) | (py << 16));
    const unsigned d2 = odd ? ((pz >> 16) | (v.z & 0xffff0000u)) : ((v.z & 0xffffu) | (pz << 16));
    const unsigned d3 = odd ? ((pw >> 16) | (v.w & 0xffff0000u)) : ((v.w & 0xffffu) | (pw << 16));
    LAS unsigned* wp = (LAS unsigned*)(base + (odd ? stride : 0)) + colpair;
    wp[0] = d0; wp[stride] = d1; wp[2 * stride] = d2; wp[3 * stride] = d3;
}
DI float silu_f(float x) { return x / (1.0f + __expf(-x)); }
#define LDS_WAIT() asm volatile("s_waitcnt lgkmcnt(0)" ::: "memory")

struct Params { const float* in[18]; float* out; unsigned char* ws; };
DI int lane_id() { int l = (int)__builtin_amdgcn_mbcnt_hi(~0u, __builtin_amdgcn_mbcnt_lo(~0u, 0u)); asm volatile("" : "+v"(l)); return l; }
#define TIDX(wave_) ((wave_) * 64 + lane_id())

DI const float* xrow_ptr(const Params& p, int t) { return t < TP ? p.in[0] + (size_t)t * DM : p.in[1] + (size_t)(t - TP) * DM; }

namespace pg8 {
constexpr int BM = 256, BK = 64, HALF = 128, HTB = HALF * BK * 2, NXCD = 8, WGM = 8;
DI int lds_byte(int r, int c) { const int st = (r >> 4) * 2 + (c >> 5), rr = r & 15, cc = c & 31, ob = rr * 64 + cc * 2; return st * 1024 + (ob ^ (((ob >> 9) & 1) << 5)); }
DI void stage_rc(int b, int& R, int& C) { const int st = b / 1024, sb = b % 1024, swz = sb ^ (((sb >> 9) & 1) << 5); R = (st >> 1) * 16 + swz / 64; C = (st & 1) * 32 + (swz % 64) / 2; }
DI int perm32(int rho) { const int n = rho >> 4, i = rho & 15; return 8 * (i >> 2) + 4 * n + (i & 3); }

struct Unit { int pm, pn, bt; };

DI int xcd_remap(int L, int nwg) { const int q = nwg / NXCD, r = nwg % NXCD, xcd = L % NXCD, off = L / NXCD; return (xcd < r ? xcd * (q + 1) : r * (q + 1) + (xcd - r) * q) + off; }

struct SchedPlain {
    int nM, nN, nwg, G, c;
    DI void init(int M, int N, int G_, int c_) { nM = M / BM; nN = N / BM; nwg = nM * nN; G = G_; c = c_; }
    DI bool next(int i, Unit& u) const {
        const int L = i * G + c; if (L >= nwg) return false;
        const int wgid = xcd_remap(L, nwg);
        const int nig = WGM * nN, gid = wgid / nig, fm = gid * WGM, gsz = (nM - fm) < WGM ? (nM - fm) : WGM;
        u.pm = fm + ((wgid % nig) % gsz); u.pn = (wgid % nig) / gsz; u.bt = u.pn; return true;
    }
    DI int arow(const Unit& u, int r) const { return u.pm * BM + r; }
};
template <int NPN, bool GATHER> struct SchedGrouped {
    int G, c; const int* idx;
    DI bool next(int i, Unit& u) const {
        constexpr int PER_E = 24 * NPN, NWG = NE * PER_E;
        const int L = i * G + c; if (L >= NWG) return false;
        const int wgid = xcd_remap(L, NWG);
        const int e = wgid / PER_E, rem = wgid % PER_E;
        const int gid = rem / (8 * NPN), w2 = rem % (8 * NPN);
        u.pm = e * 24 + gid * 8 + (w2 % 8); u.pn = w2 / 8; u.bt = e * NPN + u.pn; return true;
    }
    DI int arow(const Unit& u, int r) const { if (GATHER) return idx[u.pm * BM + r]; else return u.pm * BM + r; }
};

template <class Epi, class Sched, bool F8 = false>
DI void gemm_phase(LAS unsigned char* lds, const bf16_t* Ag, const bf16_t* Btg, const int K, const Sched& S, const Epi& E, const int wave_in) {
    const int tid = TIDX(wave_in), wid = wave_in, lane = tid & 63, wr = wid >> 2, wc = wid & 3, fr = lane & 15, fq = lane >> 4;
    const int nt = K / BK;
    unsigned voffB[2];
#pragma unroll
    for (int i = 0; i < 2; ++i) { int R, C; stage_rc(tid * 16 + i * 8192, R, C); const int Rb = Epi::PERM ? ((R & ~31) + perm32(R & 31)) : R;
        voffB[i] = (unsigned)(Rb * K + C) * 2u; }
    const unsigned rowbytes = (unsigned)K * 2u;
    const size_t kstep = (size_t)(BK * 2);
    const size_t hstep = (size_t)HALF * K * 2;
    const size_t tstep = 2 * hstep;
    const unsigned ldsw = (unsigned)wid * 1024u;
    const int aoff = lds_byte(wr * 64 + fr, fq * 8), boff = lds_byte(wc * 32 + fr, fq * 8);
#define PG8_SA(b, h) (((b) * 2 + (h)) * HTB)
#define PG8_SB(b, h) ((4 + (b) * 2 + (h)) * HTB)
#define PG8_STAGE(bufoff, gbase, voff) do { _Pragma("unroll") for (int _i = 0; _i < 2; ++_i) \
        __builtin_amdgcn_global_load_lds((const unsigned*)((const char*)(gbase) + (voff)[_i]), (LAS unsigned*)(lds + (bufoff) + ldsw + _i * 8192), 16, 0, 0); } while (0)
#define PG8_STAGEA(bufoff, o0, o1, kb) do { \
        __builtin_amdgcn_global_load_lds((const unsigned*)((const char*)Ag + (size_t)(o0) + (size_t)(kb)), (LAS unsigned*)(lds + (bufoff) + ldsw), 16, 0, 0); \
        __builtin_amdgcn_global_load_lds((const unsigned*)((const char*)Ag + (size_t)(o1) + (size_t)(kb)), (LAS unsigned*)(lds + (bufoff) + ldsw + 8192), 16, 0, 0); } while (0)
#define PG8_LDA(dst, b, h) do { _Pragma("unroll") for (int m = 0; m < 4; ++m) _Pragma("unroll") for (int k = 0; k < 2; ++k) dst[m][k] = *(const LAS bf16x8*)(lds + PG8_SA(b, h) + aoff + m * 2048 + k * 1024); } while (0)
#define PG8_LDB(dst, b, h) do { _Pragma("unroll") for (int n = 0; n < 2; ++n) _Pragma("unroll") for (int k = 0; k < 2; ++k) dst[n][k] = *(const LAS bf16x8*)(lds + PG8_SB(b, h) + boff + n * 2048 + k * 1024); } while (0)
#define PG8_MMA(ai, bj, At, Bt) do { __builtin_amdgcn_s_setprio(1); _Pragma("unroll") for (int m = 0; m < 4; ++m) _Pragma("unroll") for (int n = 0; n < 2; ++n) { \
        if constexpr (F8) { acc[ai][bj][m][n] = __builtin_amdgcn_mfma_scale_f32_16x16x128_f8f6f4(cat8(Bt[n][0], Bt[n][1]), cat8(At[m][0], At[m][1]), acc[ai][bj][m][n], 0, 0, 0, 0, 0, 0); } \
        else { _Pragma("unroll") for (int k = 0; k < 2; ++k) acc[ai][bj][m][n] = __builtin_amdgcn_mfma_f32_16x16x32_bf16(Bt[n][k], At[m][k], acc[ai][bj][m][n], 0, 0, 0); } } \
        __builtin_amdgcn_s_setprio(0); } while (0)
#define PG8_WAIT_V(n) asm volatile("s_waitcnt vmcnt(" #n ")" ::: "memory")
#define PG8_WAIT_L(n) asm volatile("s_waitcnt lgkmcnt(" #n ")" ::: "memory")
#define PG8_BAR __builtin_amdgcn_s_barrier()
#define PG8_SCHED __builtin_amdgcn_sched_barrier(0)
#define PG8_OFFS(u, o00, o01, o10, o11) do { int R0_, C0_, R1_, C1_; const int t2_ = TIDX(wid); stage_rc(t2_ * 16, R0_, C0_); stage_rc(t2_ * 16 + 8192, R1_, C1_); \
        o00 = (unsigned)S.arow(u, R0_) * rowbytes + (unsigned)C0_ * 2u; o01 = (unsigned)S.arow(u, R1_) * rowbytes + (unsigned)C1_ * 2u; \
        o10 = (unsigned)S.arow(u, HALF + R0_) * rowbytes + (unsigned)C0_ * 2u; o11 = (unsigned)S.arow(u, HALF + R1_) * rowbytes + (unsigned)C1_ * 2u; } while (0)
    Unit cur, nxt; int ui = 0;
    if (!S.next(0, cur)) return;
    f32x4 acc[2][2][4][2];
#pragma unroll
    for (int a = 0; a < 2; ++a)
#pragma unroll
        for (int b = 0; b < 2; ++b)
#pragma unroll
            for (int m = 0; m < 4; ++m)
#pragma unroll
                for (int n = 0; n < 2; ++n) acc[a][b][m][n] = (f32x4){0.f, 0.f, 0.f, 0.f};
    bf16x8 At[4][2], B0[2][2], B1[2][2];
    unsigned c00, c01, c10, c11;
    PG8_OFFS(cur, c00, c01, c10, c11);
    const char* cB = (const char*)Btg + (size_t)cur.bt * tstep;
    PG8_STAGE(PG8_SB(0, 0), cB, voffB); PG8_STAGE(PG8_SB(0, 1), cB + hstep, voffB); PG8_STAGEA(PG8_SA(0, 0), c00, c01, 0); PG8_STAGEA(PG8_SA(0, 1), c10, c11, 0);
    if (wr == 1) PG8_BAR;
    PG8_WAIT_V(2); PG8_BAR;
    PG8_STAGE(PG8_SB(1, 0), cB + kstep, voffB); PG8_STAGEA(PG8_SA(1, 0), c00, c01, kstep); PG8_STAGE(PG8_SB(1, 1), cB + hstep + kstep, voffB);
    PG8_WAIT_V(6); PG8_BAR;
    for (;;) {
        const bool has_next = S.next(ui + 1, nxt);
        const char* nB = has_next ? (const char*)Btg + (size_t)nxt.bt * tstep : cB;
        for (int t = 0; t < nt; t += 2) {
            const bool last = (t == nt - 2);
            const size_t kb1 = (size_t)(t + 1) * kstep;
            const size_t kb2 = last ? 0 : (size_t)(t + 2) * kstep, kb3 = kb2 + kstep;
            const char* b2 = last ? nB : cB + (size_t)(t + 2) * kstep; const char* b3 = b2 + kstep;
            PG8_LDB(B0, 0, 0); PG8_LDB(B1, 0, 1); PG8_SCHED; PG8_LDA(At, 0, 0); PG8_STAGEA(PG8_SA(1, 1), c10, c11, kb1);
            PG8_WAIT_V(8); PG8_WAIT_L(0); PG8_BAR; PG8_MMA(0, 0, At, B0); PG8_MMA(0, 1, At, B1); PG8_BAR; PG8_SCHED;
            if (last && has_next) { PG8_OFFS(nxt, c00, c01, c10, c11); }
            PG8_LDA(At, 0, 1); PG8_STAGE(PG8_SB(0, 0), b2, voffB); PG8_STAGE(PG8_SB(0, 1), b2 + hstep, voffB); PG8_STAGEA(PG8_SA(0, 0), c00, c01, kb2);
            PG8_WAIT_V(8); PG8_WAIT_L(0); PG8_BAR; PG8_MMA(1, 0, At, B0); PG8_MMA(1, 1, At, B1); PG8_BAR; PG8_SCHED;
            PG8_LDB(B0, 1, 0); PG8_LDB(B1, 1, 1); PG8_SCHED; PG8_LDA(At, 1, 0); PG8_STAGEA(PG8_SA(0, 1), c10, c11, kb2);
            PG8_WAIT_V(8); PG8_WAIT_L(0); PG8_BAR; PG8_MMA(0, 0, At, B0); PG8_MMA(0, 1, At, B1); PG8_BAR; PG8_SCHED;
            PG8_LDA(At, 1, 1); PG8_STAGE(PG8_SB(1, 0), b3, voffB); PG8_STAGE(PG8_SB(1, 1), b3 + hstep, voffB); PG8_STAGEA(PG8_SA(1, 0), c00, c01, kb3);
            PG8_WAIT_V(8); PG8_WAIT_L(0); PG8_BAR; PG8_MMA(1, 0, At, B0); PG8_MMA(1, 1, At, B1); PG8_BAR; PG8_SCHED;
        }
        if (wr == 0) PG8_BAR;
        { const int l2 = lane_id(); E(acc, cur, wr, wc, l2 & 15, l2 >> 4); }
        if (!has_next) break;
#pragma unroll
        for (int a = 0; a < 2; ++a)
#pragma unroll
            for (int b = 0; b < 2; ++b)
#pragma unroll
                for (int m = 0; m < 4; ++m)
#pragma unroll
                    for (int n = 0; n < 2; ++n) acc[a][b][m][n] = (f32x4){0.f, 0.f, 0.f, 0.f};
        cur = nxt; cB = nB; ++ui;
        if (wr == 1) PG8_BAR;
    }
    PG8_WAIT_V(0);
    PG8_BAR;
#undef PG8_SA
#undef PG8_SB
#undef PG8_STAGE
#undef PG8_STAGEA
#undef PG8_LDA
#undef PG8_LDB
#undef PG8_MMA
#undef PG8_WAIT_V
#undef PG8_WAIT_L
#undef PG8_BAR
#undef PG8_SCHED
#undef PG8_OFFS
}

struct EpiProj {
    static constexpr bool PERM = true;
    bf16_t* P; const float* rope;
    DI void operator()(const f32x4 (&acc)[2][2][4][2], const Unit& u, int wr, int wc, int fr, int fq) const {
        bf16_t* base = P + (size_t)u.pn * TILE_ELEMS;
        const bool rot = (u.pn < 4) && ((wc & 1) == 0);
#pragma unroll
        for (int ai = 0; ai < 2; ++ai)
#pragma unroll
            for (int m = 0; m < 4; ++m) {
                const int row = u.pm * BM + ai * HALF + wr * 64 + m * 16 + fr;
                asm volatile("" ::: "memory");
                f32x4 cs0 = {1.f, 1.f, 1.f, 1.f}, cs1 = cs0, sn0 = {0.f, 0.f, 0.f, 0.f}, sn1 = sn0;
                if (rot && fq < 2) {
                    const int s = row < TP ? (row & 4095) : (row & 8191);
                    const f32x4* rp = (const f32x4*)(rope + (size_t)s * 16);
                    cs0 = rp[0]; cs1 = rp[1]; sn0 = rp[2]; sn1 = rp[3];
                    if (fq == 0) { sn0 = -sn0; sn1 = -sn1; }
                }
#pragma unroll
                for (int bj = 0; bj < 2; ++bj) {
                    f32x4 v0 = acc[ai][bj][m][0], v1 = acc[ai][bj][m][1];
                    if (rot) {
                        f32x4 o0, o1;
#pragma unroll
                        for (int j = 0; j < 4; ++j) { o0[j] = __shfl_xor(v0[j], 16); o1[j] = __shfl_xor(v1[j], 16); }
                        if (fq < 2) { v0 = v0 * cs0 + o0 * sn0; v1 = v1 * cs1 + o1 * sn1; }
                    }
                    u32x4 w; w.x = pk2(v0[0], v0[1]); w.y = pk2(v0[2], v0[3]); w.z = pk2(v1[0], v1[1]); w.w = pk2(v1[2], v1[3]);
                    *(u32x4*)(base + (size_t)row * 256 + bj * HALF + wc * 32 + 8 * fq) = w;
                }
            }
    }
};
struct EpiOut {
    static constexpr bool PERM = false;
    Params p;
    DI void operator()(const f32x4 (&acc)[2][2][4][2], const Unit& u, int wr, int wc, int fr, int fq) const {
#pragma unroll
        for (int ai = 0; ai < 2; ++ai)
#pragma unroll
            for (int m = 0; m < 4; ++m) {
                const int row = u.pm * BM + ai * HALF + wr * 64 + m * 16 + fr;
                const float* xr = xrow_ptr(p, row); float* orow = p.out + (size_t)row * DM;
#pragma unroll
                for (int bj = 0; bj < 2; ++bj)
#pragma unroll
                    for (int n = 0; n < 2; ++n) {
                        const int col = u.pn * BM + bj * HALF + wc * 32 + 16 * n + 4 * fq;
                        const f32x4 xv = *(const f32x4*)(xr + col);
                        *(f32x4*)(orow + col) = xv * ALPHA + acc[ai][bj][m][n];
                    }
            }
    }
};
struct EpiGU {
    static constexpr bool PERM = true;
    unsigned char* H;
    DI void operator()(const f32x4 (&acc)[2][2][4][2], const Unit& u, int wr, int wc, int fr, int fq) const {
#pragma unroll
        for (int ai = 0; ai < 2; ++ai)
#pragma unroll
            for (int m = 0; m < 4; ++m) {
                const int row = u.pm * BM + ai * HALF + wr * 64 + m * 16 + fr;
                const f32x4 g0 = acc[ai][0][m][0], g1 = acc[ai][0][m][1], u0 = acc[ai][1][m][0], u1 = acc[ai][1][m][1];
                f32x4 h0, h1;
#pragma unroll
                for (int j = 0; j < 4; ++j) { h0[j] = silu_f(g0[j] * (1.0f / WGU_SCALE)) * (u0[j] * (1.0f / WGU_SCALE)); h1[j] = silu_f(g1[j] * (1.0f / WGU_SCALE)) * (u1[j] * (1.0f / WGU_SCALE)); }
                u32x2 w; w.x = pk4_f8(h0[0], h0[1], h0[2], h0[3]); w.y = pk4_f8(h1[0], h1[1], h1[2], h1[3]);
                *(u32x2*)(H + (size_t)row * FF + u.pn * 128 + wc * 32 + 8 * fq) = w;
            }
    }
};
struct EpiDown {
    static constexpr bool PERM = true;
    bf16_t* eo; const float* gate;
    DI void operator()(const f32x4 (&acc)[2][2][4][2], const Unit& u, int wr, int wc, int fr, int fq) const {
#pragma unroll
        for (int ai = 0; ai < 2; ++ai)
#pragma unroll
            for (int m = 0; m < 4; ++m) {
                const int slot = u.pm * BM + ai * HALF + wr * 64 + m * 16 + fr;
                const float gv = gate[slot] * (1.0f / WD_SCALE);
                bf16_t* orow = eo + (size_t)slot * DM + u.pn * BM + wc * 32 + 8 * fq;
#pragma unroll
                for (int bj = 0; bj < 2; ++bj) {
                    const f32x4 v0 = acc[ai][bj][m][0] * gv, v1 = acc[ai][bj][m][1] * gv;
                    u32x4 w; w.x = pk2(v0[0], v0[1]); w.y = pk2(v0[2], v0[3]); w.z = pk2(v1[0], v1[1]); w.w = pk2(v1[2], v1[3]);
                    *(u32x4*)(orow + bj * HALF) = w;
                }
            }
    }
};
}

DI void transpose_item(const float* W, int ldw, int k0, int n0, bf16_t* WT, int ldt, int drow0, LAS float* scr, int lane) {
#pragma unroll 8
    for (int i = 0; i < 32; ++i) { const int kk = 2 * i + (lane >> 5); scr[kk * 33 + (lane & 31)] = W[(size_t)(k0 + kk) * ldw + n0 + (lane & 31)]; }
    LDS_WAIT();
    const int c = lane & 7;
#pragma unroll
    for (int j = 0; j < 4; ++j) { const int n = (lane >> 3) + 8 * j; const LAS float* s = scr + (8 * c) * 33 + n;
        u32x4 o; o.x = pk2(s[0 * 33], s[1 * 33]); o.y = pk2(s[2 * 33], s[3 * 33]); o.z = pk2(s[4 * 33], s[5 * 33]); o.w = pk2(s[6 * 33], s[7 * 33]);
        *(u32x4*)(WT + (size_t)(drow0 + n) * ldt + k0 + 8 * c) = o; }
    LDS_WAIT();
}

DI void transpose_item_f8(const float* W, int ldw, int k0, int n0, unsigned char* WT, int ldt, int drow0, float scale, LAS float* scr, int lane) {
#pragma unroll 8
    for (int i = 0; i < 32; ++i) { const int kk = 2 * i + (lane >> 5); scr[kk * 33 + (lane & 31)] = W[(size_t)(k0 + kk) * ldw + n0 + (lane & 31)] * scale; }
    LDS_WAIT();
    const int c = lane & 7;
#pragma unroll
    for (int j = 0; j < 4; ++j) { const int n = (lane >> 3) + 8 * j; const LAS float* sp = scr + (8 * c) * 33 + n;
        u32x2 o; o.x = pk4_f8(sp[0 * 33], sp[1 * 33], sp[2 * 33], sp[3 * 33]); o.y = pk4_f8(sp[4 * 33], sp[5 * 33], sp[6 * 33], sp[7 * 33]);
        *(u32x2*)(WT + (size_t)(drow0 + n) * ldt + k0 + 8 * c) = o; }
    LDS_WAIT();
}

DI void sincos_small(double r, double& s, double& c) {
    const double r2 = r * r; double ss = 1.0, cc = 1.0;
#pragma unroll
    for (int n = 12; n >= 1; --n) { ss = 1.0 - ss * r2 * (1.0 / (double)((2 * n) * (2 * n + 1))); cc = 1.0 - cc * r2 * (1.0 / (double)((2 * n - 1) * (2 * n))); }
    s = r * ss; c = cc;
}

DI void dot16(const f32x4 (&v)[4], const LAS float* wT, int lane, float (&r)[16]) {
#pragma unroll
    for (int e = 0; e < 16; ++e) {
        float a = 0.f;
        if ((e & 1) == 0) asm volatile("" ::: "memory");
#pragma unroll
        for (int j = 0; j < 4; ++j) { const f32x4 w = *(const LAS f32x4*)(wT + e * 1024 + 256 * j + 4 * lane); a += v[j][0] * w[0] + v[j][1] * w[1] + v[j][2] * w[2] + v[j][3] * w[3]; }
        r[e] = wave_sum(a);
    }
}

DI void phase0(const Params& p, LAS unsigned char* lds, int gw, int NGW, int wave, int lane) {
    const int tid = TIDX(wave);
    {
        LAS float* scr = (LAS float*)(lds + wave * 16384);
        for (int it = gw; it < 2048; it += NGW) {
            if (it < 1536) { const int kb = it / 96, nb = it % 96; transpose_item(p.in[2], INW, 64 * kb, 32 * nb, (bf16_t*)(p.ws + WS_WI), DM, 32 * nb, scr, lane); }
            else { const int r = it - 1536, kb = r / 32, nb = r % 32; transpose_item(p.in[9], DM, 64 * kb, 32 * nb, (bf16_t*)(p.ws + WS_WO), DM, 32 * nb, scr, lane); }
        }
    }
    {
        float* rope = (float*)(p.ws + WS_ROPE);
        const float invf[8] = {1.0f, 0.1939227432012558f, 0.03760603070259094f, 0.007292664609849453f, 0.0014142135623842478f, 0.00027424818836152554f, 5.318296098266728e-05f, 1.0313386155758053e-05f};
        for (int id = blockIdx.x * NTHR + tid; id < 8192 * 8; id += gridDim.x * NTHR) {
            const int pos = id >> 3, i = id & 7;
            float inv = invf[0];
#pragma unroll
            for (int k = 1; k < 8; ++k) inv = (i == k) ? invf[k] : inv;
            const float ang = (float)pos * inv;
            const double x = (double)ang; const double kq = rint(x * 0.15915494309189535); const double r = x - kq * 6.283185307179586476925;
            double s, c; sincos_small(r, s, c);
            rope[pos * 16 + i] = (float)c; rope[pos * 16 + 8 + i] = (float)s;
        }
    }
    __syncthreads();
    LAS float* wT = (LAS float*)lds;
    for (int id = tid; id < 16384; id += NTHR) { const int k = id >> 4, e = id & 15; wT[e * 1024 + k] = p.in[2][(size_t)k * INW + 3072 + e]; }
    __syncthreads();
    const float* dtb = p.in[5];
    float bias = 0.f;
    if (lane < 16) bias = dtb[lane];
    bf16_t* xb = (bf16_t*)(p.ws + WS_XB); float* dtout = (float*)(p.ws + WS_DT);
    for (int t = gw; t < TT; t += NGW) {
        const f32x4* xr = (const f32x4*)xrow_ptr(p, t) + lane;
        f32x4 v[4];
#pragma unroll
        for (int j = 0; j < 4; ++j) v[j] = xr[64 * j];
        u32x2* o8 = (u32x2*)(xb + (size_t)t * DM) + lane;
#pragma unroll
        for (int j = 0; j < 4; ++j) { u32x2 w; w.x = pk2(v[j][0], v[j][1]); w.y = pk2(v[j][2], v[j][3]); o8[64 * j] = w; }
        float r[16]; dot16(v, wT, lane, r);
        float mine = 0.f;
#pragma unroll
        for (int e = 0; e < 16; ++e) mine = (lane == e) ? r[e] : mine;
        if (lane < 16) { const float z = mine + bias; dtout[(size_t)t * 16 + lane] = fmaxf(z, 0.f) + log1pf(__expf(-fabsf(z))); }
    }
}

DI void conv_phase(const Params& p, int wave) {
    const int tid = blockIdx.x * NTHR + TIDX(wave), nthr = gridDim.x * NTHR;
    const int c = tid & 127, ch = 8 * c, tile = ch >> 8, cit = ch & 255;
    const float* cw = p.in[3]; const float* cb = p.in[4];
    float w[5][8], b[8];
#pragma unroll
    for (int j = 0; j < 5; ++j)
#pragma unroll
        for (int e = 0; e < 8; ++e) w[j][e] = cw[j * 1024 + ch + e];
#pragma unroll
    for (int e = 0; e < 8; ++e) b[e] = cb[ch + e];
    const bf16_t* src = (const bf16_t*)(p.ws + WS_P) + (size_t)(8 + tile) * TILE_ELEMS + cit;
    bf16_t* dst = (bf16_t*)(p.ws + WS_XC) + (size_t)tile * TILE_ELEMS + cit;
    for (int it = tid; it < TT * 128; it += nthr) {
        const int t = it >> 7;
        const int S = t < TP ? 4096 : 8192, s = t & (S - 1);
        float a[8];
#pragma unroll
        for (int e = 0; e < 8; ++e) a[e] = b[e];
#pragma unroll
        for (int j = 0; j < 5; ++j) {
            const int sj = s + j - 2;
            if (sj >= 0 && sj < S) {
                const u32x4 v = *(const u32x4*)(src + (size_t)(t + j - 2) * 256);
                a[0] += bflo(v.x) * w[j][0]; a[1] += bfhi(v.x) * w[j][1]; a[2] += bflo(v.y) * w[j][2]; a[3] += bfhi(v.y) * w[j][3];
                a[4] += bflo(v.z) * w[j][4]; a[5] += bfhi(v.z) * w[j][5]; a[6] += bflo(v.w) * w[j][6]; a[7] += bfhi(v.w) * w[j][7];
            }
        }
        u32x4 o; o.x = pk2(silu_f(a[0]), silu_f(a[1])); o.y = pk2(silu_f(a[2]), silu_f(a[3])); o.z = pk2(silu_f(a[4]), silu_f(a[5])); o.w = pk2(silu_f(a[6]), silu_f(a[7]));
        *(u32x4*)(dst + (size_t)t * 256) = o;
    }
}

DI bf16x8 tr_pair(const LAS bf16_t* lo, const LAS bf16_t* hi) {
    const s16x4 a = __builtin_amdgcn_ds_read_tr16_b64_v4i16((LAS s16x4*)lo), b = __builtin_amdgcn_ds_read_tr16_b64_v4i16((LAS s16x4*)hi);
    return __builtin_shufflevector(a, b, 0, 1, 2, 3, 4, 5, 6, 7);
}
DI void attn_step_params(int sidx, int p0, int& d, int& base, int& nk, int& kbase, bool& actA, bool& actB) {
    const int pi = sidx < 12 ? 0 : (sidx < 18 ? 1 : 2);
    const int st = sidx - (pi == 0 ? 0 : (pi == 1 ? 12 : (sidx < 23 ? 18 : 23)));
    d = 1 << (2 * pi); base = p0 - 64 * d + (sidx >= 23 ? 8 : 0); nk = pi == 0 ? 377 : (pi == 1 ? 191 : 144); kbase = 32 * st;
    actA = sidx < 23; actB = sidx < 18 || sidx >= 23;
}
DI void attn_phase(const Params& p, LAS unsigned char* lds, int gw, int NGW, int wave, int lane) {
    LAS bf16_t* Vn = (LAS bf16_t*)(lds + wave * 4608);
    const bf16_t* Pb = (const bf16_t*)(p.ws + WS_P);
    bf16_t* mix = (bf16_t*)(p.ws + WS_MIX);
    const int c = lane & 15, q = lane >> 4, qp = (lane & 15) >> 2, pp = lane & 3;
    for (int wi = gw; wi < 12288; wi += NGW) {
        const int head = wi & 7, qg = wi >> 3;
        const int t0 = (qg >> 3) * 256 + (qg & 7);
        const int S = t0 < TP ? 4096 : 8192, sbase = t0 & ~(S - 1), p0 = t0 - sbase;
        const int hoff = (head & 3) * 64;
        const bf16_t* Qt = Pb + (size_t)(0 + (head >> 2)) * TILE_ELEMS + hoff;
        const bf16_t* Kt = Pb + (size_t)(2 + (head >> 2)) * TILE_ELEMS + hoff;
        const bf16_t* Vg = Pb + (size_t)(4 + (head >> 2)) * TILE_ELEMS + hoff;
        bf16x8 qf[2][2];
#pragma unroll
        for (int X = 0; X < 2; ++X) { const bf16_t* qrow = Qt + (size_t)(t0 + 8 * X + 16 * c) * 256; qf[X][0] = *(const bf16x8*)(qrow + 8 * q); qf[X][1] = *(const bf16x8*)(qrow + 32 + 8 * q); }
        f32x4 O[2][4];
#pragma unroll
        for (int X = 0; X < 2; ++X)
#pragma unroll
            for (int d4 = 0; d4 < 4; ++d4) O[X][d4] = (f32x4){0.f, 0.f, 0.f, 0.f};
        float mrun[2] = {-1e30f, -1e30f}, lsum[2] = {0.f, 0.f};
        u32x4 vc[4], vn[4]; bf16x8 kc[2][2], kn[2][2];
#define ATT_LOADS(sidx_, V_, K_) do { int d_, base_, nk_, kbase_; bool a_, b_; attn_step_params(sidx_, p0, d_, base_, nk_, kbase_, a_, b_); \
            _Pragma("unroll") for (int i = 0; i < 4; ++i) { const int id = lane + 64 * i, key = id >> 3, dc = id & 7; \
                int pos = base_ + d_ * (kbase_ + key); pos = pos < 0 ? 0 : (pos > S - 1 ? S - 1 : pos); \
                V_[i] = *(const u32x4*)(Vg + (size_t)(sbase + pos) * 256 + 8 * dc); } \
            _Pragma("unroll") for (int kt = 0; kt < 2; ++kt) { int pos = base_ + d_ * (kbase_ + 16 * kt + c); pos = pos < 0 ? 0 : (pos > S - 1 ? S - 1 : pos); \
                const bf16_t* krow = Kt + (size_t)(sbase + pos) * 256; K_[kt][0] = *(const bf16x8*)(krow + 8 * q); K_[kt][1] = *(const bf16x8*)(krow + 32 + 8 * q); } } while (0)
        ATT_LOADS(0, vc, kc);
        for (int sidx = 0; sidx < 28; ++sidx) {
            if (sidx < 27) ATT_LOADS(sidx + 1, vn, kn);
            int d, base, nk, kbase; bool act[2]; attn_step_params(sidx, p0, d, base, nk, kbase, act[0], act[1]);
            const int win = 64 * d;
#pragma unroll
            for (int i = 0; i < 4; ++i) { const int id = lane + 64 * i; *(LAS u32x4*)(Vn + (id >> 3) * 72 + 8 * (id & 7)) = vc[i]; }
            bf16x8 vf[4];
#pragma unroll
            for (int d4 = 0; d4 < 4; ++d4) { const LAS bf16_t* vr = Vn + (4 * q + qp) * 72 + 16 * d4 + 4 * pp; vf[d4] = tr_pair(vr, vr + 16 * 72); }
#pragma unroll
            for (int X = 0; X < 2; ++X) {
                if (act[X]) {
                    const int pq = p0 + 8 * X + 16 * c;
                    f32x4 sc[2];
#pragma unroll
                    for (int kt = 0; kt < 2; ++kt) {
                        f32x4 a = {0.f, 0.f, 0.f, 0.f};
                        a = __builtin_amdgcn_mfma_f32_16x16x32_bf16(kc[kt][0], qf[X][0], a, 0, 0, 0);
                        a = __builtin_amdgcn_mfma_f32_16x16x32_bf16(kc[kt][1], qf[X][1], a, 0, 0, 0);
                        sc[kt] = a;
                    }
                    bool valid[2][4]; float mloc = -1e30f;
#pragma unroll
                    for (int kt = 0; kt < 2; ++kt)
#pragma unroll
                        for (int j = 0; j < 4; ++j) {
                            const int kk = kbase + 16 * kt + 4 * q + j, pk = base + d * kk;
                            int df = pk - pq; df = df < 0 ? -df : df;
                            valid[kt][j] = (kk < nk) && (pk >= 0) && (pk < S) && (df <= win);
                            const float sv = valid[kt][j] ? sc[kt][j] * 0.125f : -1e30f;
                            sc[kt][j] = sv; mloc = fmaxf(mloc, sv);
                        }
                    mloc = fmaxf(mloc, __shfl_xor(mloc, 16)); mloc = fmaxf(mloc, __shfl_xor(mloc, 32));
                    const float mnew = fmaxf(mrun[X], mloc), alpha = __expf(mrun[X] - mnew);
                    mrun[X] = mnew;
                    float ps = 0.f; float pv[2][4];
#pragma unroll
                    for (int kt = 0; kt < 2; ++kt)
#pragma unroll
                        for (int j = 0; j < 4; ++j) { pv[kt][j] = valid[kt][j] ? __expf(sc[kt][j] - mnew) : 0.f; ps += pv[kt][j]; }
                    lsum[X] = lsum[X] * alpha + ps;
                    u32x4 pw; pw.x = pk2(pv[0][0], pv[0][1]); pw.y = pk2(pv[0][2], pv[0][3]); pw.z = pk2(pv[1][0], pv[1][1]); pw.w = pk2(pv[1][2], pv[1][3]);
                    const bf16x8 pf = __builtin_bit_cast(bf16x8, pw);
#pragma unroll
                    for (int d4 = 0; d4 < 4; ++d4) O[X][d4] = __builtin_amdgcn_mfma_f32_16x16x32_bf16(vf[d4], pf, O[X][d4] * alpha, 0, 0, 0);
                }
            }
#pragma unroll
            for (int i = 0; i < 4; ++i) vc[i] = vn[i];
#pragma unroll
            for (int kt = 0; kt < 2; ++kt) { kc[kt][0] = kn[kt][0]; kc[kt][1] = kn[kt][1]; }
        }
#undef ATT_LOADS
#pragma unroll
        for (int X = 0; X < 2; ++X) {
            float l = lsum[X]; l += __shfl_xor(l, 16); l += __shfl_xor(l, 32);
            const float inv = 1.0f / l;
            bf16_t* orow = mix + (size_t)(t0 + 8 * X + 16 * c) * DM + head * 64 + 4 * q;
#pragma unroll
            for (int d4 = 0; d4 < 4; ++d4) { u32x2 w; w.x = pk2(O[X][d4][0] * inv, O[X][d4][1] * inv); w.y = pk2(O[X][d4][2] * inv, O[X][d4][3] * inv); *(u32x2*)(orow + 16 * d4) = w; }
        }
    }
}

constexpr size_t WS_SLOC = WS_P;
constexpr size_t WS_DEC = WS_P + 96 * MiB;
constexpr int N_SSD_ITEMS = 6144;
struct SsdItem { int h, dir, g, tb, ts; float A; };
DI SsdItem ssd_decode(const Params& p, int it) {
    int w, ci; if (it < 4096) { w = it >> 5; ci = it & 31; } else { w = 128 + ((it - 4096) >> 6); ci = (it - 4096) & 63; }
    SsdItem I; const int seq = w >> 4; I.h = (w >> 1) & 7; I.dir = w & 1; I.g = I.h >> 2;
    const int S = seq < 8 ? 4096 : 8192, sbase = seq < 8 ? seq * 4096 : TP + (seq - 8) * 8192;
    I.tb = I.dir ? sbase + S - 1 - 128 * ci : sbase + 128 * ci; I.ts = I.dir ? -1 : 1;
    I.A = -__expf(p.in[6][I.dir * 8 + I.h]);
    return I;
}
#define SSD_TOK(I, l) ((I).tb + (I).ts * (l))
DI void ssd_scan_chunk(float d0, float d1, float A, LAS float* acs, LAS float* dts, int lane) {
    const float v0 = d0 * A, v1 = d1 * A; float ps = v0 + v1;
#pragma unroll
    for (int o = 1; o < 64; o <<= 1) { const float t = __shfl_up(ps, o); if (lane >= o) ps += t; }
    acs[2 * lane] = ps - v1; acs[2 * lane + 1] = ps; dts[2 * lane] = d0; dts[2 * lane + 1] = d1;
}
DI void st_tr8(LAS bf16_t* wp, int stride, const u32x4 v) {
    wp[0 * stride] = (bf16_t)(v.x & 0xffffu); wp[1 * stride] = (bf16_t)(v.x >> 16); wp[2 * stride] = (bf16_t)(v.y & 0xffffu); wp[3 * stride] = (bf16_t)(v.y >> 16);
    wp[4 * stride] = (bf16_t)(v.z & 0xffffu); wp[5 * stride] = (bf16_t)(v.z >> 16); wp[6 * stride] = (bf16_t)(v.w & 0xffffu); wp[7 * stride] = (bf16_t)(v.w >> 16);
}
DI void ssd_state_phase(const Params& p, LAS unsigned char* lds, int wave, int lane) {
    const int tid = TIDX(wave), c = lane & 15, q = lane >> 4, w = wave, qp = (lane & 15) >> 2, pp = lane & 3;
    LAS float* acs = (LAS float*)(lds + 0); LAS float* dts = (LAS float*)(lds + 512);
    LAS bf16_t* Xt2 = (LAS bf16_t*)(lds + 1024); LAS bf16_t* Bt = (LAS bf16_t*)(lds + 1024 + 128 * 144);
    const float* dtb = (const float*)(p.ws + WS_DT);
    const bf16_t* XCb = (const bf16_t*)(p.ws + WS_XC);
    bf16_t* Sl = (bf16_t*)(p.ws + WS_SLOC); float* decv = (float*)(p.ws + WS_DEC);
    int it = (gridDim.x % 8 == 0) ? ((int)blockIdx.x % 8) * ((int)gridDim.x / 8) + (int)blockIdx.x / 8 : (int)blockIdx.x;
    if (it >= N_SSD_ITEMS) return;
    SsdItem I = ssd_decode(p, it);
    float pd0 = 0.f, pd1 = 0.f; u32x4 xv[2], bv[4];
#define SSD_LOADS_A(I) do { \
        if (w == 0) { pd0 = dtb[(size_t)SSD_TOK(I, 2 * lane) * 16 + (I).dir * 8 + (I).h]; pd1 = dtb[(size_t)SSD_TOK(I, 2 * lane + 1) * 16 + (I).dir * 8 + (I).h]; } \
        _Pragma("unroll") for (int i = 0; i < 2; ++i) { const int id = tid + NTHR * i, l = id >> 3, pc = id & 7; \
            xv[i] = *(const u32x4*)(XCb + (size_t)((I).h >> 2) * TILE_ELEMS + (size_t)SSD_TOK(I, l) * 256 + ((I).h & 3) * 64 + 8 * pc); } \
        _Pragma("unroll") for (int i = 0; i < 4; ++i) { const int id = tid + NTHR * i, l = id >> 4, ncn = id & 15; \
            bv[i] = *(const u32x4*)(XCb + 2 * TILE_ELEMS + (size_t)SSD_TOK(I, l) * 256 + (I).g * 128 + 8 * ncn); } } while (0)
    SSD_LOADS_A(I);
    for (; it < N_SSD_ITEMS; it += gridDim.x) {
        if (w == 0) ssd_scan_chunk(pd0, pd1, I.A, acs, dts, lane);
        __syncthreads();
        const float aend = acs[127];
#pragma unroll
        for (int i = 0; i < 2; ++i) {
            const int id = tid + NTHR * i, l = id >> 3, pc = id & 7;
            const float s2 = dts[l] * __expf(aend - acs[l]);
            const u32x4 v = xv[i];
            u32x4 o; o.x = pk2(bflo(v.x) * s2, bfhi(v.x) * s2); o.y = pk2(bflo(v.y) * s2, bfhi(v.y) * s2); o.z = pk2(bflo(v.z) * s2, bfhi(v.z) * s2); o.w = pk2(bflo(v.w) * s2, bfhi(v.w) * s2);
            *(LAS u32x4*)(Xt2 + l * 72 + 8 * pc) = o;
        }
#pragma unroll
        for (int i = 0; i < 4; ++i) { const int id = tid + NTHR * i; *(LAS u32x4*)(Bt + (id >> 4) * 136 + 8 * (id & 15)) = bv[i]; }
        const int itn = it + gridDim.x;
        if (itn < N_SSD_ITEMS) { I = ssd_decode(p, itn); SSD_LOADS_A(I); }
        __syncthreads();
        bf16_t* so = Sl + (size_t)it * 8192 + 16 * w + 4 * q;
#pragma unroll
        for (int pt = 0; pt < 4; ++pt) {
            f32x4 a = {0.f, 0.f, 0.f, 0.f};
#pragma unroll
            for (int ks = 0; ks < 4; ++ks) {
                const LAS bf16_t* br = Bt + (32 * ks + 8 * q + qp) * 136 + 16 * w + 4 * pp;
                const LAS bf16_t* xr = Xt2 + (32 * ks + 8 * q + qp) * 72 + 16 * pt + 4 * pp;
                const bf16x8 bfr = tr_pair(br, br + 4 * 136), xf = tr_pair(xr, xr + 4 * 72);
                a = __builtin_amdgcn_mfma_f32_16x16x32_bf16(bfr, xf, a, 0, 0, 0);
            }
            u32x2 o; o.x = pk2(a[0], a[1]); o.y = pk2(a[2], a[3]);
            *(u32x2*)(so + (16 * pt + c) * 128) = o;
        }
        if (tid == 0) decv[it] = __expf(aend);
    }
#undef SSD_LOADS_A
}
DI void ssd_scan_phase(const Params& p, int wave) {
    unsigned* Sl = (unsigned*)(p.ws + WS_SLOC); const float* decv = (const float*)(p.ws + WS_DEC);
    for (int chain = blockIdx.x * NTHR + TIDX(wave); chain < 160 * 4096; chain += gridDim.x * NTHR) {
        const int w = chain >> 12, j = chain & 4095;
        const int nc = w < 128 ? 32 : 64, cb = w < 128 ? 32 * w : 4096 + 64 * (w - 128);
        unsigned* ptr = Sl + (size_t)cb * 4096 + j; const float* dp = decv + cb;
        float s0 = 0.f, s1 = 0.f;
        for (int c0 = 0; c0 < nc; c0 += 8) {
            unsigned v[8]; float d[8];
#pragma unroll
            for (int k = 0; k < 8; ++k) { v[k] = ptr[(size_t)(c0 + k) * 4096]; d[k] = dp[c0 + k]; }
#pragma unroll
            for (int k = 0; k < 8; ++k) { ptr[(size_t)(c0 + k) * 4096] = pk2(s0, s1); s0 = s0 * d[k] + bflo(v[k]); s1 = s1 * d[k] + bfhi(v[k]); }
        }
    }
}
constexpr int SSDC_ACS = 0  , SSDC_XT1 = 2048, SSDC_BN = SSDC_XT1 + 128 * 144, SSDC_SBF = SSDC_BN + 128 * 272, SSDC_END = SSDC_SBF + 64 * 272;
static_assert(SSDC_END <= 131072, "ssd lds");
DI void ssd_out_phase(const Params& p, LAS unsigned char* lds, int wave, int lane) {
    const int tid = TIDX(wave), c = lane & 15, q = lane >> 4, w = wave, qp = (lane & 15) >> 2, pp = lane & 3;
    LAS bf16_t* Xt1 = (LAS bf16_t*)(lds + SSDC_XT1); LAS bf16_t* Bn = (LAS bf16_t*)(lds + SSDC_BN); LAS bf16_t* Sbf = (LAS bf16_t*)(lds + SSDC_SBF);
    const float* dtb = (const float*)(p.ws + WS_DT);
    const bf16_t* XCb = (const bf16_t*)(p.ws + WS_XC);
    const bf16_t* Sl = (const bf16_t*)(p.ws + WS_SLOC);
    int it = (gridDim.x % 8 == 0) ? ((int)blockIdx.x % 8) * ((int)gridDim.x / 8) + (int)blockIdx.x / 8 : (int)blockIdx.x;
    if (it >= N_SSD_ITEMS) return;
    SsdItem I = ssd_decode(p, it);
    float pd0 = 0.f, pd1 = 0.f; u32x4 xv[2], bv[4], sv[2]; bf16x8 Cn[4];
#define SSD_LOADS_C(I, itx) do { \
        if (w == 0) { pd0 = dtb[(size_t)SSD_TOK(I, 2 * lane) * 16 + (I).dir * 8 + (I).h]; pd1 = dtb[(size_t)SSD_TOK(I, 2 * lane + 1) * 16 + (I).dir * 8 + (I).h]; } \
        _Pragma("unroll") for (int i = 0; i < 2; ++i) { const int id = tid + NTHR * i, l = id >> 3, pc = id & 7; \
            xv[i] = *(const u32x4*)(XCb + (size_t)((I).h >> 2) * TILE_ELEMS + (size_t)SSD_TOK(I, l) * 256 + ((I).h & 3) * 64 + 8 * pc); \
            sv[i] = *(const u32x4*)(Sl + (size_t)(itx) * 8192 + (size_t)id * 8); } \
        _Pragma("unroll") for (int i = 0; i < 4; ++i) { const int id = tid + NTHR * i, l = id >> 4, ncn = id & 15; \
            bv[i] = *(const u32x4*)(XCb + 2 * TILE_ELEMS + (size_t)SSD_TOK(I, l) * 256 + (I).g * 128 + 8 * ncn); } \
        { const bf16_t* cr = XCb + 3 * TILE_ELEMS + (size_t)SSD_TOK(I, 16 * w + c) * 256 + (I).g * 128 + 8 * q; \
          _Pragma("unroll") for (int ks = 0; ks < 4; ++ks) Cn[ks] = *(const bf16x8*)(cr + 32 * ks); } } while (0)
    SSD_LOADS_C(I, it);
    int par = 0;
    for (; it < N_SSD_ITEMS; it += gridDim.x, par ^= 1) {
        LAS float* acs = (LAS float*)(lds + SSDC_ACS + par * 1024); LAS float* dts = acs + 128;
        if (w == 0) ssd_scan_chunk(pd0, pd1, I.A, acs, dts, lane);
        __syncthreads();
#pragma unroll
        for (int i = 0; i < 2; ++i) {
            const int id = tid + NTHR * i, l = id >> 3, pc = id & 7;
            const float s1 = dts[l];
            const u32x4 v = xv[i];
            u32x4 o; o.x = pk2(bflo(v.x) * s1, bfhi(v.x) * s1); o.y = pk2(bflo(v.y) * s1, bfhi(v.y) * s1); o.z = pk2(bflo(v.z) * s1, bfhi(v.z) * s1); o.w = pk2(bflo(v.w) * s1, bfhi(v.w) * s1);
            *(LAS u32x4*)(Xt1 + l * 72 + 8 * pc) = o;
            *(LAS u32x4*)(Sbf + (id >> 4) * 136 + 8 * (id & 15)) = sv[i];
        }
#pragma unroll
        for (int i = 0; i < 4; ++i) { const int id = tid + NTHR * i; *(LAS u32x4*)(Bn + (id >> 4) * 136 + 8 * (id & 15)) = bv[i]; }
        bf16x8 Cf[4];
#pragma unroll
        for (int ks = 0; ks < 4; ++ks) Cf[ks] = Cn[ks];
        const SsdItem Ic = I;
        const int itn = it + gridDim.x;
        if (itn < N_SSD_ITEMS) { I = ssd_decode(p, itn); SSD_LOADS_C(I, itn); }
        __syncthreads();
        {
            const int l = 16 * w + c;
            const float al = acs[l];
            f32x4 acc[4];
#pragma unroll
            for (int pt = 0; pt < 4; ++pt) {
                f32x4 a = {0.f, 0.f, 0.f, 0.f};
#pragma unroll
                for (int ks = 0; ks < 4; ++ks) { const bf16x8 sf = *(const LAS bf16x8*)(Sbf + (16 * pt + c) * 136 + 32 * ks + 8 * q); a = __builtin_amdgcn_mfma_f32_16x16x32_bf16(sf, Cf[ks], a, 0, 0, 0); }
                acc[pt] = a * __expf(al);
            }
            const int nsp = (w >> 1) + 1;
            for (int sp = 0; sp < nsp; ++sp) {
                f32x4 M[2];
#pragma unroll
                for (int hh = 0; hh < 2; ++hh) {
                    const int st = 2 * sp + hh;
                    f32x4 G = {0.f, 0.f, 0.f, 0.f};
                    if (st <= w) {
#pragma unroll
                        for (int ks = 0; ks < 4; ++ks) { const bf16x8 bfr = *(const LAS bf16x8*)(Bn + (16 * st + c) * 136 + 32 * ks + 8 * q); G = __builtin_amdgcn_mfma_f32_16x16x32_bf16(bfr, Cf[ks], G, 0, 0, 0); }
#pragma unroll
                        for (int j = 0; j < 4; ++j) { const int s = 16 * st + 4 * q + j; const float e = __expf(al - acs[s]); G[j] = (s <= l) ? G[j] * e : 0.f; }
                    }
                    M[hh] = G;
                }
                u32x4 pw; pw.x = pk2(M[0][0], M[0][1]); pw.y = pk2(M[0][2], M[0][3]); pw.z = pk2(M[1][0], M[1][1]); pw.w = pk2(M[1][2], M[1][3]);
                const bf16x8 pf = __builtin_bit_cast(bf16x8, pw);
#pragma unroll
                for (int pt = 0; pt < 4; ++pt) {
                    const LAS bf16_t* xr = Xt1 + (32 * sp + 4 * q + qp) * 72 + 16 * pt + 4 * pp;
                    const bf16x8 xf = tr_pair(xr, xr + 16 * 72);
                    acc[pt] = __builtin_amdgcn_mfma_f32_16x16x32_bf16(xf, pf, acc[pt], 0, 0, 0);
                }
            }
            bf16_t* yr = (bf16_t*)(p.ws + (Ic.dir ? WS_YB : WS_YF)) + Ic.h * 64 + (size_t)SSD_TOK(Ic, l) * 512 + 4 * q;
#pragma unroll
            for (int pt = 0; pt < 4; ++pt) { u32x2 o; o.x = pk2(acc[pt][0], acc[pt][1]); o.y = pk2(acc[pt][2], acc[pt][3]); *(u32x2*)(yr + 16 * pt) = o; }
        }
    }
#undef SSD_LOADS_C
}

DI void gate_phase(const Params& p, int gw, int NGW, int lane) {
    const bf16_t* yf = (const bf16_t*)(p.ws + WS_YF); const bf16_t* yb = (const bf16_t*)(p.ws + WS_YB);
    const bf16_t* xh = (const bf16_t*)(p.ws + WS_XC) + (size_t)(lane >> 5) * TILE_ELEMS + (8 * lane & 255);
    const bf16_t* zt = (const bf16_t*)(p.ws + WS_P) + (size_t)(6 + (lane >> 5)) * TILE_ELEMS + (8 * lane & 255);
    bf16_t* mix = (bf16_t*)(p.ws + WS_MIX) + 512 + 8 * lane;
    const float D = p.in[7][lane >> 3];
    float nw[8];
#pragma unroll
    for (int e = 0; e < 8; ++e) nw[e] = p.in[8][8 * lane + e];
    for (int t = gw; t < TT; t += NGW) {
        const u32x4 a = *(const u32x4*)(yf + (size_t)t * 512 + 8 * lane), b = *(const u32x4*)(yb + (size_t)t * 512 + 8 * lane);
        const u32x4 x = *(const u32x4*)(xh + (size_t)t * 256), z = *(const u32x4*)(zt + (size_t)t * 256);
        float y[8];
        y[0] = (bflo(a.x) + bflo(b.x) + D * bflo(x.x)) * silu_f(bflo(z.x)); y[1] = (bfhi(a.x) + bfhi(b.x) + D * bfhi(x.x)) * silu_f(bfhi(z.x));
        y[2] = (bflo(a.y) + bflo(b.y) + D * bflo(x.y)) * silu_f(bflo(z.y)); y[3] = (bfhi(a.y) + bfhi(b.y) + D * bfhi(x.y)) * silu_f(bfhi(z.y));
        y[4] = (bflo(a.z) + bflo(b.z) + D * bflo(x.z)) * silu_f(bflo(z.z)); y[5] = (bfhi(a.z) + bfhi(b.z) + D * bfhi(x.z)) * silu_f(bfhi(z.z));
        y[6] = (bflo(a.w) + bflo(b.w) + D * bflo(x.w)) * silu_f(bflo(z.w)); y[7] = (bfhi(a.w) + bfhi(b.w) + D * bfhi(x.w)) * silu_f(bfhi(z.w));
        float ss = 0.f;
#pragma unroll
        for (int e = 0; e < 8; ++e) ss += y[e] * y[e];
        ss = wave_sum(ss);
        const float r = 1.0f / sqrtf(ss * (1.0f / 512.0f) + RMS_EPS);
        u32x4 o; o.x = pk2(y[0] * r * nw[0], y[1] * r * nw[1]); o.y = pk2(y[2] * r * nw[2], y[3] * r * nw[3]); o.z = pk2(y[4] * r * nw[4], y[5] * r * nw[5]); o.w = pk2(y[6] * r * nw[6], y[7] * r * nw[7]);
        *(u32x4*)(mix + (size_t)t * DM) = o;
    }
}

DI void expert_gu_weights_phase(const Params& p, LAS unsigned char* lds, int gw, int NGW, int wave, int lane) {
    LAS float* scr = (LAS float*)(lds + wave * 16384);
    for (int it = gw; it < 16 * 2816; it += NGW) {
        const int e = it / 2816, r = it % 2816;
        const int isup = r >= 1408, rr = isup ? r - 1408 : r, kb = rr / 88, nb = rr % 88, n0 = 32 * nb;
        const float* W = (isup ? p.in[14] : p.in[13]) + (size_t)e * DM * FF;
        transpose_item_f8(W, FF, 64 * kb, n0, p.ws + WS_WGU, DM, e * 5632 + 256 * (n0 >> 7) + (n0 & 127) + (isup ? 128 : 0), WGU_SCALE, scr, lane);
    }
}
DI void expert_down_weights(const Params& p, LAS unsigned char* lds, int vw, int NVW, int wave, int lane) {
    LAS float* scr = (LAS float*)(lds + 4096 + wave * 16384);
    for (int it = vw; it < 16 * 1408; it += NVW) {
        const int e = it / 1408, rr = it % 1408, kb = rr / 32, nb = rr % 32;
        transpose_item_f8(p.in[15] + (size_t)e * FF * DM, DM, 64 * kb, 32 * nb, p.ws + WS_WD, FF, e * 1024 + 32 * nb, WD_SCALE, scr, lane);
    }
}

DI void ln1_router_phase(const Params& p, LAS unsigned char* lds, int gw, int NGW, int wave, int lane) {
    const int tid = TIDX(wave);
    LAS float* wT = (LAS float*)lds;
    for (int id = tid; id < 16384; id += NTHR) { const int k = id >> 4, e = id & 15; wT[e * 1024 + k] = p.in[12][id]; }
    __syncthreads();
    f32x4 gg[4], bb[4];
#pragma unroll
    for (int j = 0; j < 4; ++j) { gg[j] = ((const f32x4*)p.in[10])[64 * j + lane]; bb[j] = ((const f32x4*)p.in[11])[64 * j + lane]; }
    unsigned char* x1b = p.ws + WS_X1B; float* aff = (float*)(p.ws + WS_AFF);
    for (int t = gw; t < TT; t += NGW) {
        f32x4* orow = (f32x4*)(p.out + (size_t)t * DM) + lane;
        f32x4 v[4]; float s = 0.f;
#pragma unroll
        for (int j = 0; j < 4; ++j) { v[j] = orow[64 * j]; s += (v[j][0] + v[j][1]) + (v[j][2] + v[j][3]); }
        const float mean = wave_sum(s) * (1.0f / DM); float s2 = 0.f;
#pragma unroll
        for (int j = 0; j < 4; ++j) { v[j] = v[j] - mean; s2 += (v[j][0] * v[j][0] + v[j][1] * v[j][1]) + (v[j][2] * v[j][2] + v[j][3] * v[j][3]); }
        const float rstd = 1.0f / sqrtf(wave_sum(s2) * (1.0f / DM) + LN_EPS);
        unsigned* o4 = (unsigned*)(x1b + (size_t)t * DM) + lane;
#pragma unroll
        for (int j = 0; j < 4; ++j) {
            v[j] = v[j] * rstd * gg[j] + bb[j];
            orow[64 * j] = v[j] * ALPHA;
            o4[64 * j] = pk4_f8(v[j][0], v[j][1], v[j][2], v[j][3]);
        }
        float r[16]; dot16(v, wT, lane, r);
        float mx = r[0];
#pragma unroll
        for (int e = 1; e < 16; ++e) mx = fmaxf(mx, r[e]);
        float den = 0.f, mine = 0.f;
#pragma unroll
        for (int e = 0; e < 16; ++e) { const float ex = __expf(r[e] - mx); den += ex; mine = (lane == e) ? ex : mine; }
        if (lane < 16) aff[(size_t)lane * TT + t] = mine / den;
    }
}

DI void select_phase(const Params& p, LAS unsigned char* lds, int wave, int lane) {
    const int wk = blockIdx.x;
    if (wk >= 32) { expert_down_weights(p, lds, (wk - 32) * 8 + wave, ((int)gridDim.x - 32) * 8, wave, lane); return; }
    const int tid = TIDX(wave);
    const int trunk = wk >> 4, e = wk & 15;
    const int Tn = trunk ? 16384 : 32768, tbase = trunk ? TP : 0, cap = Tn / 8;
    const unsigned* col = (const unsigned*)(p.ws + WS_AFF) + (size_t)e * TT + tbase;
    LAS unsigned* hist = (LAS unsigned*)lds;
    LAS unsigned* ctl = (LAS unsigned*)(lds + 1024);
    LAS unsigned* wcnt = (LAS unsigned*)(lds + 2048);
    unsigned prefix = 0, remaining = (unsigned)cap;
    for (int pass = 0; pass < 4; ++pass) {
        const int shift = 24 - 8 * pass;
        for (int i = tid; i < 256; i += NTHR) hist[i] = 0u;
        __syncthreads();
        for (int i = tid; i < Tn; i += NTHR) {
            const unsigned bits = col[i];
            if (pass == 0 || (bits >> (shift + 8)) == prefix) atomicAdd((unsigned*)(hist + ((bits >> shift) & 255u)), 1u);
        }
        __syncthreads();
        if (tid == 0) {
            unsigned cum = 0; int b = 255;
            for (; b > 0; --b) { const unsigned hcnt = hist[b]; if (cum + hcnt >= remaining) break; cum += hcnt; }
            ctl[0] = (prefix << 8) | (unsigned)b; ctl[1] = remaining - cum;
        }
        __syncthreads();
        prefix = ctl[0]; remaining = ctl[1];
        __syncthreads();
    }
    const unsigned thr = prefix, need_eq = remaining;
    int* idx = (int*)(p.ws + WS_IDX) + e * SLOTS_E + (trunk ? 4096 : 0);
    int* inv = (int*)(p.ws + WS_INV) + (size_t)e * TT + tbase;
    const int slot0 = e * SLOTS_E + (trunk ? 4096 : 0);
    float* gate = (float*)(p.ws + WS_GATE) + e * SLOTS_E + (trunk ? 4096 : 0);
    unsigned sel_base = 0, eq_base = 0;
    for (int b0 = 0; b0 < Tn; b0 += NTHR) {
        const unsigned bits = col[b0 + tid];
        const bool gt = bits > thr, eq = bits == thr;
        const unsigned long long meq = __ballot(eq);
        const unsigned eq_before_w = (unsigned)__popcll(meq & ((1ull << lane) - 1ull));
        if (lane == 0) wcnt[wave] = (unsigned)__popcll(meq);
        __syncthreads();
        unsigned eq_off = 0, eq_tot = 0;
#pragma unroll
        for (int w2 = 0; w2 < 8; ++w2) { const unsigned cnt = wcnt[w2]; eq_off += (w2 < wave) ? cnt : 0u; eq_tot += cnt; }
        const bool sel = gt || (eq && (eq_base + eq_off + eq_before_w) < need_eq);
        const unsigned long long msel = __ballot(sel);
        const unsigned sel_before_w = (unsigned)__popcll(msel & ((1ull << lane) - 1ull));
        if (lane == 0) wcnt[8 + wave] = (unsigned)__popcll(msel);
        __syncthreads();
        unsigned sel_off = 0, sel_tot = 0;
#pragma unroll
        for (int w2 = 0; w2 < 8; ++w2) { const unsigned cnt = wcnt[8 + w2]; sel_off += (w2 < wave) ? cnt : 0u; sel_tot += cnt; }
        { const unsigned pos = sel_base + sel_off + sel_before_w; const bool ok = sel && pos < (unsigned)cap;
          if (ok) { idx[pos] = tbase + b0 + tid; gate[pos] = __uint_as_float(bits); }
          inv[b0 + tid] = ok ? slot0 + (int)pos : -1; }
        sel_base += sel_tot; eq_base += eq_tot;
        __syncthreads();
    }
}

DI void ln2_phase(const Params& p, int gw, int NGW, int lane) {
    f32x4 gg[4], bb[4];
#pragma unroll
    for (int j = 0; j < 4; ++j) { gg[j] = ((const f32x4*)p.in[16])[64 * j + lane]; bb[j] = ((const f32x4*)p.in[17])[64 * j + lane]; }
    const int* inv = (const int*)(p.ws + WS_INV); const bf16_t* eo = (const bf16_t*)(p.ws + WS_EO);
    for (int t = gw; t < TT; t += NGW) {
        f32x4* orow = (f32x4*)(p.out + (size_t)t * DM) + lane;
        f32x4 v[4]; float s = 0.f;
#pragma unroll
        for (int j = 0; j < 4; ++j) v[j] = orow[64 * j];
        const int myslot = lane < 16 ? inv[(size_t)lane * TT + t] : -1;
        for (int e = 0; e < 16; ++e) {
            const int sl = __shfl(myslot, e);
            if (sl >= 0) {
                const u32x2* er = (const u32x2*)(eo + (size_t)sl * DM) + lane;
#pragma unroll
                for (int j = 0; j < 4; ++j) { const u32x2 w = er[64 * j]; v[j][0] += bflo(w.x); v[j][1] += bfhi(w.x); v[j][2] += bflo(w.y); v[j][3] += bfhi(w.y); }
            }
        }
#pragma unroll
        for (int j = 0; j < 4; ++j) s += (v[j][0] + v[j][1]) + (v[j][2] + v[j][3]);
        const float mean = wave_sum(s) * (1.0f / DM); float s2 = 0.f;
#pragma unroll
        for (int j = 0; j < 4; ++j) { v[j] = v[j] - mean; s2 += (v[j][0] * v[j][0] + v[j][1] * v[j][1]) + (v[j][2] * v[j][2] + v[j][3] * v[j][3]); }
        const float rstd = 1.0f / sqrtf(wave_sum(s2) * (1.0f / DM) + LN_EPS);
#pragma unroll
        for (int j = 0; j < 4; ++j) orow[64 * j] = v[j] * rstd * gg[j] + bb[j];
    }
}

__global__ void __launch_bounds__(NTHR, 2) fwd_megakernel(Params p) {
    extern __shared__ __attribute__((aligned(16))) unsigned char lds_raw[];
    LAS unsigned char* lds = (LAS unsigned char*)lds_raw;
    cg::grid_group grid = cg::this_grid();
    const int wave_k = __builtin_amdgcn_readfirstlane((int)threadIdx.x >> 6);
#define IDS() const int lane = lane_id(), wave = wave_k; \
    const int G = gridDim.x, gw = blockIdx.x * 8 + wave, NGW = G * 8; (void)lane; (void)gw; (void)NGW; (void)G;
    { IDS(); phase0(p, lds, gw, NGW, wave, lane); }
    grid.sync();
    {
        IDS();
        pg8::SchedPlain S; S.init(TT, 3072, G, (int)blockIdx.x);
        pg8::EpiProj E{(bf16_t*)(p.ws + WS_P), (const float*)(p.ws + WS_ROPE)};
        pg8::gemm_phase<pg8::EpiProj, pg8::SchedPlain>(lds, (const bf16_t*)(p.ws + WS_XB), (const bf16_t*)(p.ws + WS_WI), DM, S, E, wave);
    }
    grid.sync();
    conv_phase(p, wave_k);
    { IDS(); const int vcu = (G % 8 == 0) ? ((int)blockIdx.x % 8) * (G / 8) + (int)blockIdx.x / 8 : (int)blockIdx.x;
      attn_phase(p, lds, vcu * 8 + wave, NGW, wave, lane); }
    grid.sync();
    { IDS(); ssd_state_phase(p, lds, wave, lane); }
    grid.sync();
    ssd_scan_phase(p, wave_k);
    grid.sync();
    { IDS(); ssd_out_phase(p, lds, wave, lane); }
    grid.sync();
    { IDS(); gate_phase(p, gw, NGW, lane); }
    grid.sync();
    { IDS(); expert_gu_weights_phase(p, lds, gw, NGW, wave, lane); }
    __syncthreads();
    {
        IDS();
        pg8::SchedPlain S; S.init(TT, DM, G, (int)blockIdx.x);
        pg8::EpiOut E{p};
        pg8::gemm_phase<pg8::EpiOut, pg8::SchedPlain>(lds, (const bf16_t*)(p.ws + WS_MIX), (const bf16_t*)(p.ws + WS_WO), DM, S, E, wave);
    }
    grid.sync();
    { IDS(); ln1_router_phase(p, lds, gw, NGW, wave, lane); }
    grid.sync();
    { IDS(); select_phase(p, lds, wave, lane); }
    grid.sync();
    {
        IDS();
        const int* idx = (const int*)(p.ws + WS_IDX);
        pg8::SchedGrouped<22, true> S{G, (int)blockIdx.x, idx};
        pg8::EpiGU E{p.ws + WS_HID};
        pg8::gemm_phase<pg8::EpiGU, pg8::SchedGrouped<22, true>, true>(lds, (const bf16_t*)(p.ws + WS_X1B), (const bf16_t*)(p.ws + WS_WGU), DM / 2, S, E, wave);
    }
    grid.sync();
    {
        IDS();
        const int* idx = (const int*)(p.ws + WS_IDX);
        const float* gate = (const float*)(p.ws + WS_GATE);
        pg8::SchedGrouped<4, false> S{G, (int)blockIdx.x, idx};
        pg8::EpiDown E{(bf16_t*)(p.ws + WS_EO), gate};
        pg8::gemm_phase<pg8::EpiDown, pg8::SchedGrouped<4, false>, true>(lds, (const bf16_t*)(p.ws + WS_HID), (const bf16_t*)(p.ws + WS_WD), FF / 2, S, E, wave);
    }
    grid.sync();
    { IDS(); ln2_phase(p, gw, NGW, lane); }
#undef IDS
}

extern "C" void kernel_launch(void* const* d_in, const int* in_sizes, int n_in, void* d_out, int out_size, void* d_ws, size_t ws_size, hipStream_t stream) {
    static int grid_blocks = 0;
    if (grid_blocks == 0) {
        if (n_in != 18 || ws_size < WS_END || out_size != TT * DM) { fprintf(stderr, "kernel_launch: unexpected shapes (n_in %d out %d ws %zu)\n", n_in, out_size, ws_size); grid_blocks = -1; return; }
        int dev = 0, cus = 0, per_cu = 0;
        hipGetDevice(&dev);
        hipDeviceGetAttribute(&cus, hipDeviceAttributeMultiprocessorCount, dev);
        if (hipFuncSetAttribute((const void*)fwd_megakernel, hipFuncAttributeMaxDynamicSharedMemorySize, LDS_BYTES) != hipSuccess) { fprintf(stderr, "kernel_launch: hipFuncSetAttribute failed\n"); }
        hipOccupancyMaxActiveBlocksPerMultiprocessor(&per_cu, (const void*)fwd_megakernel, NTHR, LDS_BYTES);
        if (per_cu < 1) per_cu = 1;
        (void)hipGetLastError();
        grid_blocks = cus * per_cu;
    }
    if (grid_blocks < 0) return;
    Params p{};
    for (int i = 0; i < 18; ++i) p.in[i] = (const float*)d_in[i];
    p.out = (float*)d_out; p.ws = (unsigned char*)d_ws;
    void* args[] = {&p};
    hipError_t e = hipLaunchCooperativeKernel((void*)fwd_megakernel, dim3(grid_blocks), dim3(NTHR), args, LDS_BYTES, stream);
    if (e != hipSuccess) fprintf(stderr, "cooperative launch failed: %s (grid %d)\n", hipGetErrorString(e), grid_blocks);
}
```

```cpp
#include <hip/hip_runtime.h>
#include <hip/hip_cooperative_groups.h>
#include <cstdio>
#include <cstdint>
namespace cg = cooperative_groups;

#define DI __device__ __forceinline__
#define LAS __attribute__((address_space(3)))
typedef unsigned short bf16_t;
typedef short bf16x8 __attribute__((ext_vector_type(8)));
typedef short s16x4 __attribute__((ext_vector_type(4)));
typedef float f32x4 __attribute__((ext_vector_type(4)));
typedef unsigned u32x4 __attribute__((ext_vector_type(4)));
typedef unsigned u32x2 __attribute__((ext_vector_type(2)));
typedef int i32x4 __attribute__((ext_vector_type(4)));
typedef int i32x8 __attribute__((ext_vector_type(8)));

constexpr int TT = 49152;
constexpr int TP = 32768;
constexpr int DM = 1024;
constexpr int INW = 3088;
constexpr int FF = 2816;
constexpr int NE = 16;
constexpr int SLOTS_E = 6144;
constexpr float ALPHA = 1.189207115002721f;
constexpr float LN_EPS = 1e-5f, RMS_EPS = 1e-5f;

constexpr size_t MiB = 1u << 20;
constexpr size_t TILE_ELEMS = (size_t)TT * 256;
constexpr size_t TILE_BYTES = TILE_ELEMS * 2;
constexpr size_t WS_WI = 0;
constexpr size_t WS_WO = 6 * MiB;
constexpr size_t WS_DT = 8 * MiB;
constexpr size_t WS_ROPE = 11 * MiB;
constexpr size_t WS_AFF = 12 * MiB;
constexpr size_t WS_IDX = 15 * MiB;
constexpr size_t WS_GATE = 15 * MiB + 512 * 1024;
constexpr size_t WS_P = 20 * MiB;
constexpr size_t WS_XC = 308 * MiB;
constexpr size_t WS_XB = 404 * MiB;
constexpr size_t WS_MIX = WS_XB;
constexpr size_t WS_YF = WS_P + 8 * TILE_BYTES;
constexpr size_t WS_YB = WS_P + 10 * TILE_BYTES;
constexpr size_t WS_INV = 16 * MiB;
constexpr size_t WS_WD = 20 * MiB;
constexpr size_t WS_WGU = 108 * MiB;
constexpr size_t WS_EO = 212 * MiB;
constexpr size_t WS_X1B = 308 * MiB;
constexpr size_t WS_HID = 404 * MiB;
constexpr size_t WS_END = 668 * MiB;

constexpr int LDS_BYTES = 147456;
constexpr int NTHR = 512;

DI unsigned f2bf(float f) { unsigned u = __float_as_uint(f); return (u + 0x7fffu + ((u >> 16) & 1u)) >> 16; }
DI unsigned pk2(float lo, float hi) { return f2bf(lo) | (f2bf(hi) << 16); }
DI unsigned pk4_f8(float a, float b, float c, float d) { int w = 0; w = __builtin_amdgcn_cvt_pk_fp8_f32(a, b, w, false); w = __builtin_amdgcn_cvt_pk_fp8_f32(c, d, w, true); return (unsigned)w; }
DI i32x8 cat8(bf16x8 lo, bf16x8 hi) { const i32x4 a = __builtin_bit_cast(i32x4, lo), b = __builtin_bit_cast(i32x4, hi); return __builtin_shufflevector(a, b, 0, 1, 2, 3, 4, 5, 6, 7); }
constexpr float WGU_SCALE = 32.0f, WD_SCALE = 64.0f;
DI float bflo(unsigned u) { return __uint_as_float(u << 16); }
DI float bfhi(unsigned u) { return __uint_as_float(u & 0xffff0000u); }
DI float wave_sum(float v) {
#pragma unroll
    for (int o = 1; o < 64; o <<= 1) v += __shfl_xor(v, o);
    return v;
}
DI void st_tr8_pair(LAS bf16_t* base, int stride, int colpair, int lane, const u32x4 v) {
    const unsigned px = __shfl_xor(v.x, 1), py = __shfl_xor(v.y, 1), pz = __shfl_xor(v.z, 1), pw = __shfl_xor(v.w, 1);
    const bool odd = (lane & 1) != 0;
    const unsigned d0 = odd ? ((px >> 16) | (v.x & 0xffff0000u)) : ((v.x & 0xffffu) | (px << 16));
    const unsigned d1 = odd ? ((py >> 16) | (v.y & 0xffff0000u)) : ((v.y & 0xffffu) | (py << 16));
    const unsigned d2 = odd ? ((pz >> 16) | (v.z & 0xffff0000u)) : ((v.z & 0xffffu) | (pz << 16));
    const unsigned d3 = odd ? ((pw >> 16) | (v.w & 0xffff0000u)) : ((v.w & 0xffffu) | (pw << 16));
    LAS unsigned* wp = (LAS unsigned*)(base + (odd ? stride : 0)) + colpair;
    wp[0] = d0; wp[stride] = d1; wp[2 * stride] = d2; wp[3 * stride] = d3;
}
DI float silu_f(float x) { return x / (1.0f + __expf(-x)); }
#define LDS_WAIT() asm volatile("s_waitcnt lgkmcnt(0)" ::: "memory")

struct Params { const float* in[18]; float* out; unsigned char* ws; };
DI int lane_id() { int l = (int)__builtin_amdgcn_mbcnt_hi(~0u, __builtin_amdgcn_mbcnt_lo(~0u, 0u)); asm volatile("" : "+v"(l)); return l; }
#define TIDX(wave_) ((wave_) * 64 + lane_id())

DI const float* xrow_ptr(const Params& p, int t) { return t < TP ? p.in[0] + (size_t)t * DM : p.in[1] + (size_t)(t - TP) * DM; }

namespace pg8 {
constexpr int BM = 256, BK = 64, HALF = 128, HTB = HALF * BK * 2, NXCD = 8, WGM = 8;
DI int lds_byte(int r, int c) { const int st = (r >> 4) * 2 + (c >> 5), rr = r & 15, cc = c & 31, ob = rr * 64 + cc * 2; return st * 1024 + (ob ^ (((ob >> 9) & 1) << 5)); }
DI void stage_rc(int b, int& R, int& C) { const int st = b / 1024, sb = b % 1024, swz = sb ^ (((sb >> 9) & 1) << 5); R = (st >> 1) * 16 + swz / 64; C = (st & 1) * 32 + (swz % 64) / 2; }
DI int perm32(int rho) { const int n = rho >> 4, i = rho & 15; return 8 * (i >> 2) + 4 * n + (i & 3); }

struct Unit { int pm, pn, bt; };

DI int xcd_remap(int L, int nwg) { const int q = nwg / NXCD, r = nwg % NXCD, xcd = L % NXCD, off = L / NXCD; return (xcd < r ? xcd * (q + 1) : r * (q + 1) + (xcd - r) * q) + off; }

struct SchedPlain {
    int nM, nN, nwg, G, c;
    DI void init(int M, int N, int G_, int c_) { nM = M / BM; nN = N / BM; nwg = nM * nN; G = G_; c = c_; }
    DI bool next(int i, Unit& u) const {
        const int L = i * G + c; if (L >= nwg) return false;
        const int wgid = xcd_remap(L, nwg);
        const int nig = WGM * nN, gid = wgid / nig, fm = gid * WGM, gsz = (nM - fm) < WGM ? (nM - fm) : WGM;
        u.pm = fm + ((wgid % nig) % gsz); u.pn = (wgid % nig) / gsz; u.bt = u.pn; return true;
    }
    DI int arow(const Unit& u, int r) const { return u.pm * BM + r; }
};
template <int NPN, bool GATHER> struct SchedGrouped {
    int G, c; const int* idx;
    DI bool next(int i, Unit& u) const {
        constexpr int PER_E = 24 * NPN, NWG = NE * PER_E;
        const int L = i * G + c; if (L >= NWG) return false;
        const int wgid = xcd_remap(L, NWG);
        const int e = wgid / PER_E, rem = wgid % PER_E;
        const int gid = rem / (8 * NPN), w2 = rem % (8 * NPN);
        u.pm = e * 24 + gid * 8 + (w2 % 8); u.pn = w2 / 8; u.bt = e * NPN + u.pn; return true;
    }
    DI int arow(const Unit& u, int r) const { if (GATHER) return idx[u.pm * BM + r]; else return u.pm * BM + r; }
};

template <class Epi, class Sched, bool F8 = false>
DI void gemm_phase(LAS unsigned char* lds, const bf16_t* Ag, const bf16_t* Btg, const int K, const Sched& S, const Epi& E, const int wave_in) {
    const int tid = TIDX(wave_in), wid = wave_in, lane = tid & 63, wr = wid >> 2, wc = wid & 3, fr = lane & 15, fq = lane >> 4;
    const int nt = K / BK;
    unsigned voffB[2];
#pragma unroll
    for (int i = 0; i < 2; ++i) { int R, C; stage_rc(tid * 16 + i * 8192, R, C); const int Rb = Epi::PERM ? ((R & ~31) + perm32(R & 31)) : R;
        voffB[i] = (unsigned)(Rb * K + C) * 2u; }
    const unsigned rowbytes = (unsigned)K * 2u;
    const size_t kstep = (size_t)(BK * 2);
    const size_t hstep = (size_t)HALF * K * 2;
    const size_t tstep = 2 * hstep;
    const unsigned ldsw = (unsigned)wid * 1024u;
    const int aoff = lds_byte(wr * 64 + fr, fq * 8), boff = lds_byte(wc * 32 + fr, fq * 8);
#define PG8_SA(b, h) (((b) * 2 + (h)) * HTB)
#define PG8_SB(b, h) ((4 + (b) * 2 + (h)) * HTB)
#define PG8_STAGE(bufoff, gbase, voff) do { _Pragma("unroll") for (int _i = 0; _i < 2; ++_i) \
        __builtin_amdgcn_global_load_lds((const unsigned*)((const char*)(gbase) + (voff)[_i]), (LAS unsigned*)(lds + (bufoff) + ldsw + _i * 8192), 16, 0, 0); } while (0)
#define PG8_STAGEA(bufoff, o0, o1, kb) do { \
        __builtin_amdgcn_global_load_lds((const unsigned*)((const char*)Ag + (size_t)(o0) + (size_t)(kb)), (LAS unsigned*)(lds + (bufoff) + ldsw), 16, 0, 0); \
        __builtin_amdgcn_global_load_lds((const unsigned*)((const char*)Ag + (size_t)(o1) + (size_t)(kb)), (LAS unsigned*)(lds + (bufoff) + ldsw + 8192), 16, 0, 0); } while (0)
#define PG8_LDA(dst, b, h) do { _Pragma("unroll") for (int m = 0; m < 4; ++m) _Pragma("unroll") for (int k = 0; k < 2; ++k) dst[m][k] = *(const LAS bf16x8*)(lds + PG8_SA(b, h) + aoff + m * 2048 + k * 1024); } while (0)
#define PG8_LDB(dst, b, h) do { _Pragma("unroll") for (int n = 0; n < 2; ++n) _Pragma("unroll") for (int k = 0; k < 2; ++k) dst[n][k] = *(const LAS bf16x8*)(lds + PG8_SB(b, h) + boff + n * 2048 + k * 1024); } while (0)
#define PG8_MMA(ai, bj, At, Bt) do { __builtin_amdgcn_s_setprio(1); _Pragma("unroll") for (int m = 0; m < 4; ++m) _Pragma("unroll") for (int n = 0; n < 2; ++n) { \
        if constexpr (F8) { acc[ai][bj][m][n] = __builtin_amdgcn_mfma_scale_f32_16x16x128_f8f6f4(cat8(Bt[n][0], Bt[n][1]), cat8(At[m][0], At[m][1]), acc[ai][bj][m][n], 0, 0, 0, 0, 0, 0); } \
        else { _Pragma("unroll") for (int k = 0; k < 2; ++k) acc[ai][bj][m][n] = __builtin_amdgcn_mfma_f32_16x16x32_bf16(Bt[n][k], At[m][k], acc[ai][bj][m][n], 0, 0, 0); } } \
        __builtin_amdgcn_s_setprio(0); } while (0)
#define PG8_WAIT_V(n) asm volatile("s_waitcnt vmcnt(" #n ")" ::: "memory")
#define PG8_WAIT_L(n) asm volatile("s_waitcnt lgkmcnt(" #n ")" ::: "memory")
#define PG8_BAR __builtin_amdgcn_s_barrier()
#define PG8_SCHED __builtin_amdgcn_sched_barrier(0)
#define PG8_OFFS(u, o00, o01, o10, o11) do { int R0_, C0_, R1_, C1_; const int t2_ = TIDX(wid); stage_rc(t2_ * 16, R0_, C0_); stage_rc(t2_ * 16 + 8192, R1_, C1_); \
        o00 = (unsigned)S.arow(u, R0_) * rowbytes + (unsigned)C0_ * 2u; o01 = (unsigned)S.arow(u, R1_) * rowbytes + (unsigned)C1_ * 2u; \
        o10 = (unsigned)S.arow(u, HALF + R0_) * rowbytes + (unsigned)C0_ * 2u; o11 = (unsigned)S.arow(u, HALF + R1_) * rowbytes + (unsigned)C1_ * 2u; } while (0)
    Unit cur, nxt; int ui = 0;
    if (!S.next(0, cur)) return;
    f32x4 acc[2][2][4][2];
#pragma unroll
    for (int a = 0; a < 2; ++a)
#pragma unroll
        for (int b = 0; b < 2; ++b)
#pragma unroll
            for (int m = 0; m < 4; ++m)
#pragma unroll
                for (int n = 0; n < 2; ++n) acc[a][b][m][n] = (f32x4){0.f, 0.f, 0.f, 0.f};
    bf16x8 At[4][2], B0[2][2], B1[2][2];
    unsigned c00, c01, c10, c11;
    PG8_OFFS(cur, c00, c01, c10, c11);
    const char* cB = (const char*)Btg + (size_t)cur.bt * tstep;
    PG8_STAGE(PG8_SB(0, 0), cB, voffB); PG8_STAGE(PG8_SB(0, 1), cB + hstep, voffB); PG8_STAGEA(PG8_SA(0, 0), c00, c01, 0); PG8_STAGEA(PG8_SA(0, 1), c10, c11, 0);
    if (wr == 1) PG8_BAR;
    PG8_WAIT_V(2); PG8_BAR;
    PG8_STAGE(PG8_SB(1, 0), cB + kstep, voffB); PG8_STAGEA(PG8_SA(1, 0), c00, c01, kstep); PG8_STAGE(PG8_SB(1, 1), cB + hstep + kstep, voffB);
    PG8_WAIT_V(6); PG8_BAR;
    for (;;) {
        const bool has_next = S.next(ui + 1, nxt);
        const char* nB = has_next ? (const char*)Btg + (size_t)nxt.bt * tstep : cB;
        for (int t = 0; t < nt; t += 2) {
            const bool last = (t == nt - 2);
            const size_t kb1 = (size_t)(t + 1) * kstep;
            const size_t kb2 = last ? 0 : (size_t)(t + 2) * kstep, kb3 = kb2 + kstep;
            const char* b2 = last ? nB : cB + (size_t)(t + 2) * kstep; const char* b3 = b2 + kstep;
            PG8_LDB(B0, 0, 0); PG8_LDB(B1, 0, 1); PG8_SCHED; PG8_LDA(At, 0, 0); PG8_STAGEA(PG8_SA(1, 1), c10, c11, kb1);
            PG8_WAIT_V(8); PG8_WAIT_L(0); PG8_BAR; PG8_MMA(0, 0, At, B0); PG8_MMA(0, 1, At, B1); PG8_BAR; PG8_SCHED;
            if (last && has_next) { PG8_OFFS(nxt, c00, c01, c10, c11); }
            PG8_LDA(At, 0, 1); PG8_STAGE(PG8_SB(0, 0), b2, voffB); PG8_STAGE(PG8_SB(0, 1), b2 + hstep, voffB); PG8_STAGEA(PG8_SA(0, 0), c00, c01, kb2);
            PG8_WAIT_V(8); PG8_WAIT_L(0); PG8_BAR; PG8_MMA(1, 0, At, B0); PG8_MMA(1, 1, At, B1); PG8_BAR; PG8_SCHED;
            PG8_LDB(B0, 1, 0); PG8_LDB(B1, 1, 1); PG8_SCHED; PG8_LDA(At, 1, 0); PG8_STAGEA(PG8_SA(0, 1), c10, c11, kb2);
            PG8_WAIT_V(8); PG8_WAIT_L(0); PG8_BAR; PG8_MMA(0, 0, At, B0); PG8_MMA(0, 1, At, B1); PG8_BAR; PG8_SCHED;
            PG8_LDA(At, 1, 1); PG8_STAGE(PG8_SB(1, 0), b3, voffB); PG8_STAGE(PG8_SB(1, 1), b3 + hstep, voffB); PG8_STAGEA(PG8_SA(1, 0), c00, c01, kb3);
            PG8_WAIT_V(8); PG8_WAIT_L(0); PG8_BAR; PG8_MMA(1, 0, At, B0); PG8_MMA(1, 1, At, B1); PG8_BAR; PG8_SCHED;
        }
        if (wr == 0) PG8_BAR;
        { const int l2 = lane_id(); E(acc, cur, wr, wc, l2 & 15, l2 >> 4); }
        if (!has_next) break;
#pragma unroll
        for (int a = 0; a < 2; ++a)
#pragma unroll
            for (int b = 0; b < 2; ++b)
#pragma unroll
                for (int m = 0; m < 4; ++m)
#pragma unroll
                    for (int n = 0; n < 2; ++n) acc[a][b][m][n] = (f32x4){0.f, 0.f, 0.f, 0.f};
        cur = nxt; cB = nB; ++ui;
        if (wr == 1) PG8_BAR;
    }
    PG8_WAIT_V(0);
    PG8_BAR;
#undef PG8_SA
#undef PG8_SB
#undef PG8_STAGE
#undef PG8_STAGEA
#undef PG8_LDA
#undef PG8_LDB
#undef PG8_MMA
#undef PG8_WAIT_V
#undef PG8_WAIT_L
#undef PG8_BAR
#undef PG8_SCHED
#undef PG8_OFFS
}

struct EpiProj {
    static constexpr bool PERM = true;
    bf16_t* P; const float* rope;
    DI void operator()(const f32x4 (&acc)[2][2][4][2], const Unit& u, int wr, int wc, int fr, int fq) const {
        bf16_t* base = P + (size_t)u.pn * TILE_ELEMS;
        const bool rot = (u.pn < 4) && ((wc & 1) == 0);
#pragma unroll
        for (int ai = 0; ai < 2; ++ai)
#pragma unroll
            for (int m = 0; m < 4; ++m) {
                const int row = u.pm * BM + ai * HALF + wr * 64 + m * 16 + fr;
                asm volatile("" ::: "memory");
                f32x4 cs0 = {1.f, 1.f, 1.f, 1.f}, cs1 = cs0, sn0 = {0.f, 0.f, 0.f, 0.f}, sn1 = sn0;
                if (rot && fq < 2) {
                    const int s = row < TP ? (row & 4095) : (row & 8191);
                    const f32x4* rp = (const f32x4*)(rope + (size_t)s * 16);
                    cs0 = rp[0]; cs1 = rp[1]; sn0 = rp[2]; sn1 = rp[3];
                    if (fq == 0) { sn0 = -sn0; sn1 = -sn1; }
                }
#pragma unroll
                for (int bj = 0; bj < 2; ++bj) {
                    f32x4 v0 = acc[ai][bj][m][0], v1 = acc[ai][bj][m][1];
                    if (rot) {
                        f32x4 o0, o1;
#pragma unroll
                        for (int j = 0; j < 4; ++j) { o0[j] = __shfl_xor(v0[j], 16); o1[j] = __shfl_xor(v1[j], 16); }
                        if (fq < 2) { v0 = v0 * cs0 + o0 * sn0; v1 = v1 * cs1 + o1 * sn1; }
                    }
                    u32x4 w; w.x = pk2(v0[0], v0[1]); w.y = pk2(v0[2], v0[3]); w.z = pk2(v1[0], v1[1]); w.w = pk2(v1[2], v1[3]);
                    *(u32x4*)(base + (size_t)row * 256 + bj * HALF + wc * 32 + 8 * fq) = w;
                }
            }
    }
};
struct EpiOut {
    static constexpr bool PERM = false;
    Params p;
    DI void operator()(const f32x4 (&acc)[2][2][4][2], const Unit& u, int wr, int wc, int fr, int fq) const {
#pragma unroll
        for (int ai = 0; ai < 2; ++ai)
#pragma unroll
            for (int m = 0; m < 4; ++m) {
                const int row = u.pm * BM + ai * HALF + wr * 64 + m * 16 + fr;
                const float* xr = xrow_ptr(p, row); float* orow = p.out + (size_t)row * DM;
#pragma unroll
                for (int bj = 0; bj < 2; ++bj)
#pragma unroll
                    for (int n = 0; n < 2; ++n) {
                        const int col = u.pn * BM + bj * HALF + wc * 32 + 16 * n + 4 * fq;
                        const f32x4 xv = *(const f32x4*)(xr + col);
                        *(f32x4*)(orow + col) = xv * ALPHA + acc[ai][bj][m][n];
                    }
            }
    }
};
struct EpiGU {
    static constexpr bool PERM = true;
    unsigned char* H;
    DI void operator()(const f32x4 (&acc)[2][2][4][2], const Unit& u, int wr, int wc, int fr, int fq) const {
#pragma unroll
        for (int ai = 0; ai < 2; ++ai)
#pragma unroll
            for (int m = 0; m < 4; ++m) {
                const int row = u.pm * BM + ai * HALF + wr * 64 + m * 16 + fr;
                const f32x4 g0 = acc[ai][0][m][0], g1 = acc[ai][0][m][1], u0 = acc[ai][1][m][0], u1 = acc[ai][1][m][1];
                f32x4 h0, h1;
#pragma unroll
                for (int j = 0; j < 4; ++j) { h0[j] = silu_f(g0[j] * (1.0f / WGU_SCALE)) * (u0[j] * (1.0f / WGU_SCALE)); h1[j] = silu_f(g1[j] * (1.0f / WGU_SCALE)) * (u1[j] * (1.0f / WGU_SCALE)); }
                u32x2 w; w.x = pk4_f8(h0[0], h0[1], h0[2], h0[3]); w.y = pk4_f8(h1[0], h1[1], h1[2], h1[3]);
                *(u32x2*)(H + (size_t)row * FF + u.pn * 128 + wc * 32 + 8 * fq) = w;
            }
    }
};
struct EpiDown {
    static constexpr bool PERM = true;
    bf16_t* eo; const float* gate;
    DI void operator()(const f32x4 (&acc)[2][2][4][2], const Unit& u, int wr, int wc, int fr, int fq) const {
#pragma unroll
        for (int ai = 0; ai < 2; ++ai)
#pragma unroll
            for (int m = 0; m < 4; ++m) {
                const int slot = u.pm * BM + ai * HALF + wr * 64 + m * 16 + fr;
                const float gv = gate[slot] * (1.0f / WD_SCALE);
                bf16_t* orow = eo + (size_t)slot * DM + u.pn * BM + wc * 32 + 8 * fq;
#pragma unroll
                for (int bj = 0; bj < 2; ++bj) {
                    const f32x4 v0 = acc[ai][bj][m][0] * gv, v1 = acc[ai][bj][m][1] * gv;
                    u32x4 w; w.x = pk2(v0[0], v0[1]); w.y = pk2(v0[2], v0[3]); w.z = pk2(v1[0], v1[1]); w.w = pk2(v1[2], v1[3]);
                    *(u32x4*)(orow + bj * HALF) = w;
                }
            }
    }
};
}

DI void transpose_item(const float* W, int ldw, int k0, int n0, bf16_t* WT, int ldt, int drow0, LAS float* scr, int lane) {
#pragma unroll 8
    for (int i = 0; i < 32; ++i) { const int kk = 2 * i + (lane >> 5); scr[kk * 33 + (lane & 31)] = W[(size_t)(k0 + kk) * ldw + n0 + (lane & 31)]; }
    LDS_WAIT();
    const int c = lane & 7;
#pragma unroll
    for (int j = 0; j < 4; ++j) { const int n = (lane >> 3) + 8 * j; const LAS float* s = scr + (8 * c) * 33 + n;
        u32x4 o; o.x = pk2(s[0 * 33], s[1 * 33]); o.y = pk2(s[2 * 33], s[3 * 33]); o.z = pk2(s[4 * 33], s[5 * 33]); o.w = pk2(s[6 * 33], s[7 * 33]);
        *(u32x4*)(WT + (size_t)(drow0 + n) * ldt + k0 + 8 * c) = o; }
    LDS_WAIT();
}

DI void transpose_item_f8(const float* W, int ldw, int k0, int n0, unsigned char* WT, int ldt, int drow0, float scale, LAS float* scr, int lane) {
#pragma unroll 8
    for (int i = 0; i < 32; ++i) { const int kk = 2 * i + (lane >> 5); scr[kk * 33 + (lane & 31)] = W[(size_t)(k0 + kk) * ldw + n0 + (lane & 31)] * scale; }
    LDS_WAIT();
    const int c = lane & 7;
#pragma unroll
    for (int j = 0; j < 4; ++j) { const int n = (lane >> 3) + 8 * j; const LAS float* sp = scr + (8 * c) * 33 + n;
        u32x2 o; o.x = pk4_f8(sp[0 * 33], sp[1 * 33], sp[2 * 33], sp[3 * 33]); o.y = pk4_f8(sp[4 * 33], sp[5 * 33], sp[6 * 33], sp[7 * 33]);
        *(u32x2*)(WT + (size_t)(drow0 + n) * ldt + k0 + 8 * c) = o; }
    LDS_WAIT();
}

DI void sincos_small(double r, double& s, double& c) {
    const double r2 = r * r; double ss = 1.0, cc = 1.0;
#pragma unroll
    for (int n = 12; n >= 1; --n) { ss = 1.0 - ss * r2 * (1.0 / (double)((2 * n) * (2 * n + 1))); cc = 1.0 - cc * r2 * (1.0 / (double)((2 * n - 1) * (2 * n))); }
    s = r * ss; c = cc;
}

DI void dot16(const f32x4 (&v)[4], const LAS float* wT, int lane, float (&r)[16]) {
#pragma unroll
    for (int e = 0; e < 16; ++e) {
        float a = 0.f;
        if ((e & 1) == 0) asm volatile("" ::: "memory");
#pragma unroll
        for (int j = 0; j < 4; ++j) { const f32x4 w = *(const LAS f32x4*)(wT + e * 1024 + 256 * j + 4 * lane); a += v[j][0] * w[0] + v[j][1] * w[1] + v[j][2] * w[2] + v[j][3] * w[3]; }
        r[e] = wave_sum(a);
    }
}

DI void phase0(const Params& p, LAS unsigned char* lds, int gw, int NGW, int wave, int lane) {
    const int tid = TIDX(wave);
    {
        LAS float* scr = (LAS float*)(lds + wave * 16384);
        for (int it = gw; it < 2048; it += NGW) {
            if (it < 1536) { const int kb = it / 96, nb = it % 96; transpose_item(p.in[2], INW, 64 * kb, 32 * nb, (bf16_t*)(p.ws + WS_WI), DM, 32 * nb, scr, lane); }
            else { const int r = it - 1536, kb = r / 32, nb = r % 32; transpose_item(p.in[9], DM, 64 * kb, 32 * nb, (bf16_t*)(p.ws + WS_WO), DM, 32 * nb, scr, lane); }
        }
    }
    {
        float* rope = (float*)(p.ws + WS_ROPE);
        const float invf[8] = {1.0f, 0.1939227432012558f, 0.03760603070259094f, 0.007292664609849453f, 0.0014142135623842478f, 0.00027424818836152554f, 5.318296098266728e-05f, 1.0313386155758053e-05f};
        for (int id = blockIdx.x * NTHR + tid; id < 8192 * 8; id += gridDim.x * NTHR) {
            const int pos = id >> 3, i = id & 7;
            float inv = invf[0];
#pragma unroll
            for (int k = 1; k < 8; ++k) inv = (i == k) ? invf[k] : inv;
            const float ang = (float)pos * inv;
            const double x = (double)ang; const double kq = rint(x * 0.15915494309189535); const double r = x - kq * 6.283185307179586476925;
            double s, c; sincos_small(r, s, c);
            rope[pos * 16 + i] = (float)c; rope[pos * 16 + 8 + i] = (float)s;
        }
    }
    __syncthreads();
    LAS float* wT = (LAS float*)lds;
    for (int id = tid; id < 16384; id += NTHR) { const int k = id >> 4, e = id & 15; wT[e * 1024 + k] = p.in[2][(size_t)k * INW + 3072 + e]; }
    __syncthreads();
    const float* dtb = p.in[5];
    float bias = 0.f;
    if (lane < 16) bias = dtb[lane];
    bf16_t* xb = (bf16_t*)(p.ws + WS_XB); float* dtout = (float*)(p.ws + WS_DT);
    for (int t = gw; t < TT; t += NGW) {
        const f32x4* xr = (const f32x4*)xrow_ptr(p, t) + lane;
        f32x4 v[4];
#pragma unroll
        for (int j = 0; j < 4; ++j) v[j] = xr[64 * j];
        u32x2* o8 = (u32x2*)(xb + (size_t)t * DM) + lane;
#pragma unroll
        for (int j = 0; j < 4; ++j) { u32x2 w; w.x = pk2(v[j][0], v[j][1]); w.y = pk2(v[j][2], v[j][3]); o8[64 * j] = w; }
        float r[16]; dot16(v, wT, lane, r);
        float mine = 0.f;
#pragma unroll
        for (int e = 0; e < 16; ++e) mine = (lane == e) ? r[e] : mine;
        if (lane < 16) { const float z = mine + bias; dtout[(size_t)t * 16 + lane] = fmaxf(z, 0.f) + log1pf(__expf(-fabsf(z))); }
    }
}

DI void conv_phase(const Params& p, int wave) {
    const int tid = blockIdx.x * NTHR + TIDX(wave), nthr = gridDim.x * NTHR;
    const int c = tid & 127, ch = 8 * c, tile = ch >> 8, cit = ch & 255;
    const float* cw = p.in[3]; const float* cb = p.in[4];
    float w[5][8], b[8];
#pragma unroll
    for (int j = 0; j < 5; ++j)
#pragma unroll
        for (int e = 0; e < 8; ++e) w[j][e] = cw[j * 1024 + ch + e];
#pragma unroll
    for (int e = 0; e < 8; ++e) b[e] = cb[ch + e];
    const bf16_t* src = (const bf16_t*)(p.ws + WS_P) + (size_t)(8 + tile) * TILE_ELEMS + cit;
    bf16_t* dst = (bf16_t*)(p.ws + WS_XC) + (size_t)tile * TILE_ELEMS + cit;
    for (int it = tid; it < TT * 128; it += nthr) {
        const int t = it >> 7;
        const int S = t < TP ? 4096 : 8192, s = t & (S - 1);
        float a[8];
#pragma unroll
        for (int e = 0; e < 8; ++e) a[e] = b[e];
#pragma unroll
        for (int j = 0; j < 5; ++j) {
            const int sj = s + j - 2;
            if (sj >= 0 && sj < S) {
                const u32x4 v = *(const u32x4*)(src + (size_t)(t + j - 2) * 256);
                a[0] += bflo(v.x) * w[j][0]; a[1] += bfhi(v.x) * w[j][1]; a[2] += bflo(v.y) * w[j][2]; a[3] += bfhi(v.y) * w[j][3];
                a[4] += bflo(v.z) * w[j][4]; a[5] += bfhi(v.z) * w[j][5]; a[6] += bflo(v.w) * w[j][6]; a[7] += bfhi(v.w) * w[j][7];
            }
        }
        u32x4 o; o.x = pk2(silu_f(a[0]), silu_f(a[1])); o.y = pk2(silu_f(a[2]), silu_f(a[3])); o.z = pk2(silu_f(a[4]), silu_f(a[5])); o.w = pk2(silu_f(a[6]), silu_f(a[7]));
        *(u32x4*)(dst + (size_t)t * 256) = o;
    }
}

DI bf16x8 tr_pair(const LAS bf16_t* lo, const LAS bf16_t* hi) {
    const s16x4 a = __builtin_amdgcn_ds_read_tr16_b64_v4i16((LAS s16x4*)lo), b = __builtin_amdgcn_ds_read_tr16_b64_v4i16((LAS s16x4*)hi);
    return __builtin_shufflevector(a, b, 0, 1, 2, 3, 4, 5, 6, 7);
}
DI void attn_step_params(int sidx, int p0, int& d, int& base, int& nk, int& kbase, bool& actA, bool& actB) {
    const int pi = sidx < 12 ? 0 : (sidx < 18 ? 1 : 2);
    const int st = sidx - (pi == 0 ? 0 : (pi == 1 ? 12 : (sidx < 23 ? 18 : 23)));
    d = 1 << (2 * pi); base = p0 - 64 * d + (sidx >= 23 ? 8 : 0); nk = pi == 0 ? 377 : (pi == 1 ? 191 : 144); kbase = 32 * st;
    actA = sidx < 23; actB = sidx < 18 || sidx >= 23;
}
DI void attn_phase(const Params& p, LAS unsigned char* lds, int gw, int NGW, int wave, int lane) {
    LAS bf16_t* Vn = (LAS bf16_t*)(lds + wave * 4608);
    const bf16_t* Pb = (const bf16_t*)(p.ws + WS_P);
    bf16_t* mix = (bf16_t*)(p.ws + WS_MIX);
    const int c = lane & 15, q = lane >> 4, qp = (lane & 15) >> 2, pp = lane & 3;
    for (int wi = gw; wi < 12288; wi += NGW) {
        const int head = wi & 7, qg = wi >> 3;
        const int t0 = (qg >> 3) * 256 + (qg & 7);
        const int S = t0 < TP ? 4096 : 8192, sbase = t0 & ~(S - 1), p0 = t0 - sbase;
        const int hoff = (head & 3) * 64;
        const bf16_t* Qt = Pb + (size_t)(0 + (head >> 2)) * TILE_ELEMS + hoff;
        const bf16_t* Kt = Pb + (size_t)(2 + (head >> 2)) * TILE_ELEMS + hoff;
        const bf16_t* Vg = Pb + (size_t)(4 + (head >> 2)) * TILE_ELEMS + hoff;
        bf16x8 qf[2][2];
#pragma unroll
        for (int X = 0; X < 2; ++X) { const bf16_t* qrow = Qt + (size_t)(t0 + 8 * X + 16 * c) * 256; qf[X][0] = *(const bf16x8*)(qrow + 8 * q); qf[X][1] = *(const bf16x8*)(qrow + 32 + 8 * q); }
        f32x4 O[2][4];
#pragma unroll
        for (int X = 0; X < 2; ++X)
#pragma unroll
            for (int d4 = 0; d4 < 4; ++d4) O[X][d4] = (f32x4){0.f, 0.f, 0.f, 0.f};
        float mrun[2] = {-1e30f, -1e30f}, lsum[2] = {0.f, 0.f};
        u32x4 vc[4], vn[4]; bf16x8 kc[2][2], kn[2][2];
#define ATT_LOADS(sidx_, V_, K_) do { int d_, base_, nk_, kbase_; bool a_, b_; attn_step_params(sidx_, p0, d_, base_, nk_, kbase_, a_, b_); \
            _Pragma("unroll") for (int i = 0; i < 4; ++i) { const int id = lane + 64 * i, key = id >> 3, dc = id & 7; \
                int pos = base_ + d_ * (kbase_ + key); pos = pos < 0 ? 0 : (pos > S - 1 ? S - 1 : pos); \
                V_[i] = *(const u32x4*)(Vg + (size_t)(sbase + pos) * 256 + 8 * dc); } \
            _Pragma("unroll") for (int kt = 0; kt < 2; ++kt) { int pos = base_ + d_ * (kbase_ + 16 * kt + c); pos = pos < 0 ? 0 : (pos > S - 1 ? S - 1 : pos); \
                const bf16_t* krow = Kt + (size_t)(sbase + pos) * 256; K_[kt][0] = *(const bf16x8*)(krow + 8 * q); K_[kt][1] = *(const bf16x8*)(krow + 32 + 8 * q); } } while (0)
        ATT_LOADS(0, vc, kc);
        for (int sidx = 0; sidx < 28; ++sidx) {
            if (sidx < 27) ATT_LOADS(sidx + 1, vn, kn);
            int d, base, nk, kbase; bool act[2]; attn_step_params(sidx, p0, d, base, nk, kbase, act[0], act[1]);
            const int win = 64 * d;
#pragma unroll
            for (int i = 0; i < 4; ++i) { const int id = lane + 64 * i; *(LAS u32x4*)(Vn + (id >> 3) * 72 + 8 * (id & 7)) = vc[i]; }
            bf16x8 vf[4];
#pragma unroll
            for (int d4 = 0; d4 < 4; ++d4) { const LAS bf16_t* vr = Vn + (4 * q + qp) * 72 + 16 * d4 + 4 * pp; vf[d4] = tr_pair(vr, vr + 16 * 72); }
#pragma unroll
            for (int X = 0; X < 2; ++X) {
                if (act[X]) {
                    const int pq = p0 + 8 * X + 16 * c;
                    f32x4 sc[2];
#pragma unroll
                    for (int kt = 0; kt < 2; ++kt) {
                        f32x4 a = {0.f, 0.f, 0.f, 0.f};
                        a = __builtin_amdgcn_mfma_f32_16x16x32_bf16(kc[kt][0], qf[X][0], a, 0, 0, 0);
                        a = __builtin_amdgcn_mfma_f32_16x16x32_bf16(kc[kt][1], qf[X][1], a, 0, 0, 0);
                        sc[kt] = a;
                    }
                    bool valid[2][4]; float mloc = -1e30f;
#pragma unroll
                    for (int kt = 0; kt < 2; ++kt)
#pragma unroll
                        for (int j = 0; j < 4; ++j) {
                            const int kk = kbase + 16 * kt + 4 * q + j, pk = base + d * kk;
                            int df = pk - pq; df = df < 0 ? -df : df;
                            valid[kt][j] = (kk < nk) && (pk >= 0) && (pk < S) && (df <= win);
                            const float sv = valid[kt][j] ? sc[kt][j] * 0.125f : -1e30f;
                            sc[kt][j] = sv; mloc = fmaxf(mloc, sv);
                        }
                    mloc = fmaxf(mloc, __shfl_xor(mloc, 16)); mloc = fmaxf(mloc, __shfl_xor(mloc, 32));
                    const float mnew = fmaxf(mrun[X], mloc), alpha = __expf(mrun[X] - mnew);
                    mrun[X] = mnew;
                    float ps = 0.f; float pv[2][4];
#pragma unroll
                    for (int kt = 0; kt < 2; ++kt)
#pragma unroll
                        for (int j = 0; j < 4; ++j) { pv[kt][j] = valid[kt][j] ? __expf(sc[kt][j] - mnew) : 0.f; ps += pv[kt][j]; }
                    lsum[X] = lsum[X] * alpha + ps;
                    u32x4 pw; pw.x = pk2(pv[0][0], pv[0][1]); pw.y = pk2(pv[0][2], pv[0][3]); pw.z = pk2(pv[1][0], pv[1][1]); pw.w = pk2(pv[1][2], pv[1][3]);
                    const bf16x8 pf = __builtin_bit_cast(bf16x8, pw);
#pragma unroll
                    for (int d4 = 0; d4 < 4; ++d4) O[X][d4] = __builtin_amdgcn_mfma_f32_16x16x32_bf16(vf[d4], pf, O[X][d4] * alpha, 0, 0, 0);
                }
            }
#pragma unroll
            for (int i = 0; i < 4; ++i) vc[i] = vn[i];
#pragma unroll
            for (int kt = 0; kt < 2; ++kt) { kc[kt][0] = kn[kt][0]; kc[kt][1] = kn[kt][1]; }
        }
#undef ATT_LOADS
#pragma unroll
        for (int X = 0; X < 2; ++X) {
            float l = lsum[X]; l += __shfl_xor(l, 16); l += __shfl_xor(l, 32);
            const float inv = 1.0f / l;
            bf16_t* orow = mix + (size_t)(t0 + 8 * X + 16 * c) * DM + head * 64 + 4 * q;
#pragma unroll
            for (int d4 = 0; d4 < 4; ++d4) { u32x2 w; w.x = pk2(O[X][d4][0] * inv, O[X][d4][1] * inv); w.y = pk2(O[X][d4][2] * inv, O[X][d4][3] * inv); *(u32x2*)(orow + 16 * d4) = w; }
        }
    }
}

constexpr size_t WS_SLOC = WS_P;
constexpr size_t WS_DEC = WS_P + 96 * MiB;
constexpr int N_SSD_ITEMS = 6144;
struct SsdItem { int h, dir, g, tb, ts; float A; };
DI SsdItem ssd_decode(const Params& p, int it) {
    int w, ci; if (it < 4096) { w = it >> 5; ci = it & 31; } else { w = 128 + ((it - 4096) >> 6); ci = (it - 4096) & 63; }
    SsdItem I; const int seq = w >> 4; I.h = (w >> 1) & 7; I.dir = w & 1; I.g = I.h >> 2;
    const int S = seq < 8 ? 4096 : 8192, sbase = seq < 8 ? seq * 4096 : TP + (seq - 8) * 8192;
    I.tb = I.dir ? sbase + S - 1 - 128 * ci : sbase + 128 * ci; I.ts = I.dir ? -1 : 1;
    I.A = -__expf(p.in[6][I.dir * 8 + I.h]);
    return I;
}
#define SSD_TOK(I, l) ((I).tb + (I).ts * (l))
DI void ssd_scan_chunk(float d0, float d1, float A, LAS float* acs, LAS float* dts, int lane) {
    const float v0 = d0 * A, v1 = d1 * A; float ps = v0 + v1;
#pragma unroll
    for (int o = 1; o < 64; o <<= 1) { const float t = __shfl_up(ps, o); if (lane >= o) ps += t; }
    acs[2 * lane] = ps - v1; acs[2 * lane + 1] = ps; dts[2 * lane] = d0; dts[2 * lane + 1] = d1;
}
DI void st_tr8(LAS bf16_t* wp, int stride, const u32x4 v) {
    wp[0 * stride] = (bf16_t)(v.x & 0xffffu); wp[1 * stride] = (bf16_t)(v.x >> 16); wp[2 * stride] = (bf16_t)(v.y & 0xffffu); wp[3 * stride] = (bf16_t)(v.y >> 16);
    wp[4 * stride] = (bf16_t)(v.z & 0xffffu); wp[5 * stride] = (bf16_t)(v.z >> 16); wp[6 * stride] = (bf16_t)(v.w & 0xffffu); wp[7 * stride] = (bf16_t)(v.w >> 16);
}
DI void ssd_state_phase(const Params& p, LAS unsigned char* lds, int wave, int lane) {
    const int tid = TIDX(wave), c = lane & 15, q = lane >> 4, w = wave, qp = (lane & 15) >> 2, pp = lane & 3;
    LAS float* acs = (LAS float*)(lds + 0); LAS float* dts = (LAS float*)(lds + 512);
    LAS bf16_t* Xt2 = (LAS bf16_t*)(lds + 1024); LAS bf16_t* Bt = (LAS bf16_t*)(lds + 1024 + 128 * 144);
    const float* dtb = (const float*)(p.ws + WS_DT);
    const bf16_t* XCb = (const bf16_t*)(p.ws + WS_XC);
    bf16_t* Sl = (bf16_t*)(p.ws + WS_SLOC); float* decv = (float*)(p.ws + WS_DEC);
    int it = (gridDim.x % 8 == 0) ? ((int)blockIdx.x % 8) * ((int)gridDim.x / 8) + (int)blockIdx.x / 8 : (int)blockIdx.x;
    if (it >= N_SSD_ITEMS) return;
    SsdItem I = ssd_decode(p, it);
    float pd0 = 0.f, pd1 = 0.f; u32x4 xv[2], bv[4];
#define SSD_LOADS_A(I) do { \
        if (w == 0) { pd0 = dtb[(size_t)SSD_TOK(I, 2 * lane) * 16 + (I).dir * 8 + (I).h]; pd1 = dtb[(size_t)SSD_TOK(I, 2 * lane + 1) * 16 + (I).dir * 8 + (I).h]; } \
        _Pragma("unroll") for (int i = 0; i < 2; ++i) { const int id = tid + NTHR * i, l = id >> 3, pc = id & 7; \
            xv[i] = *(const u32x4*)(XCb + (size_t)((I).h >> 2) * TILE_ELEMS + (size_t)SSD_TOK(I, l) * 256 + ((I).h & 3) * 64 + 8 * pc); } \
        _Pragma("unroll") for (int i = 0; i < 4; ++i) { const int id = tid + NTHR * i, l = id >> 4, ncn = id & 15; \
            bv[i] = *(const u32x4*)(XCb + 2 * TILE_ELEMS + (size_t)SSD_TOK(I, l) * 256 + (I).g * 128 + 8 * ncn); } } while (0)
    SSD_LOADS_A(I);
    for (; it < N_SSD_ITEMS; it += gridDim.x) {
        if (w == 0) ssd_scan_chunk(pd0, pd1, I.A, acs, dts, lane);
        __syncthreads();
        const float aend = acs[127];
#pragma unroll
        for (int i = 0; i < 2; ++i) {
            const int id = tid + NTHR * i, l = id >> 3, pc = id & 7;
            const float s2 = dts[l] * __expf(aend - acs[l]);
            const u32x4 v = xv[i];
            u32x4 o; o.x = pk2(bflo(v.x) * s2, bfhi(v.x) * s2); o.y = pk2(bflo(v.y) * s2, bfhi(v.y) * s2); o.z = pk2(bflo(v.z) * s2, bfhi(v.z) * s2); o.w = pk2(bflo(v.w) * s2, bfhi(v.w) * s2);
            *(LAS u32x4*)(Xt2 + l * 72 + 8 * pc) = o;
        }
#pragma unroll
        for (int i = 0; i < 4; ++i) { const int id = tid + NTHR * i; *(LAS u32x4*)(Bt + (id >> 4) * 136 + 8 * (id & 15)) = bv[i]; }
        const int itn = it + gridDim.x;
        if (itn < N_SSD_ITEMS) { I = ssd_decode(p, itn); SSD_LOADS_A(I); }
        __syncthreads();
        bf16_t* so = Sl + (size_t)it * 8192 + 16 * w + 4 * q;
#pragma unroll
        for (int pt = 0; pt < 4; ++pt) {
            f32x4 a = {0.f, 0.f, 0.f, 0.f};
#pragma unroll
            for (int ks = 0; ks < 4; ++ks) {
                const LAS bf16_t* br = Bt + (32 * ks + 8 * q + qp) * 136 + 16 * w + 4 * pp;
                const LAS bf16_t* xr = Xt2 + (32 * ks + 8 * q + qp) * 72 + 16 * pt + 4 * pp;
                const bf16x8 bfr = tr_pair(br, br + 4 * 136), xf = tr_pair(xr, xr + 4 * 72);
                a = __builtin_amdgcn_mfma_f32_16x16x32_bf16(bfr, xf, a, 0, 0, 0);
            }
            u32x2 o; o.x = pk2(a[0], a[1]); o.y = pk2(a[2], a[3]);
            *(u32x2*)(so + (16 * pt + c) * 128) = o;
        }
        if (tid == 0) decv[it] = __expf(aend);
    }
#undef SSD_LOADS_A
}
DI void ssd_scan_phase(const Params& p, int wave) {
    unsigned* Sl = (unsigned*)(p.ws + WS_SLOC); const float* decv = (const float*)(p.ws + WS_DEC);
    for (int chain = blockIdx.x * NTHR + TIDX(wave); chain < 160 * 4096; chain += gridDim.x * NTHR) {
        const int w = chain >> 12, j = chain & 4095;
        const int nc = w < 128 ? 32 : 64, cb = w < 128 ? 32 * w : 4096 + 64 * (w - 128);
        unsigned* ptr = Sl + (size_t)cb * 4096 + j; const float* dp = decv + cb;
        float s0 = 0.f, s1 = 0.f;
        for (int c0 = 0; c0 < nc; c0 += 8) {
            unsigned v[8]; float d[8];
#pragma unroll
            for (int k = 0; k < 8; ++k) { v[k] = ptr[(size_t)(c0 + k) * 4096]; d[k] = dp[c0 + k]; }
#pragma unroll
            for (int k = 0; k < 8; ++k) { ptr[(size_t)(c0 + k) * 4096] = pk2(s0, s1); s0 = s0 * d[k] + bflo(v[k]); s1 = s1 * d[k] + bfhi(v[k]); }
        }
    }
}
constexpr int SSDC_ACS = 0  , SSDC_XT1 = 2048, SSDC_BN = SSDC_XT1 + 128 * 144, SSDC_SBF = SSDC_BN + 128 * 272, SSDC_END = SSDC_SBF + 64 * 272;
static_assert(SSDC_END <= 131072, "ssd lds");
DI void ssd_out_phase(const Params& p, LAS unsigned char* lds, int wave, int lane) {
    const int tid = TIDX(wave), c = lane & 15, q = lane >> 4, w = wave, qp = (lane & 15) >> 2, pp = lane & 3;
    LAS bf16_t* Xt1 = (LAS bf16_t*)(lds + SSDC_XT1); LAS bf16_t* Bn = (LAS bf16_t*)(lds + SSDC_BN); LAS bf16_t* Sbf = (LAS bf16_t*)(lds + SSDC_SBF);
    const float* dtb = (const float*)(p.ws + WS_DT);
    const bf16_t* XCb = (const bf16_t*)(p.ws + WS_XC);
    const bf16_t* Sl = (const bf16_t*)(p.ws + WS_SLOC);
    int it = (gridDim.x % 8 == 0) ? ((int)blockIdx.x % 8) * ((int)gridDim.x / 8) + (int)blockIdx.x / 8 : (int)blockIdx.x;
    if (it >= N_SSD_ITEMS) return;
    SsdItem I = ssd_decode(p, it);
    float pd0 = 0.f, pd1 = 0.f; u32x4 xv[2], bv[4], sv[2]; bf16x8 Cn[4];
#define SSD_LOADS_C(I, itx) do { \
        if (w == 0) { pd0 = dtb[(size_t)SSD_TOK(I, 2 * lane) * 16 + (I).dir * 8 + (I).h]; pd1 = dtb[(size_t)SSD_TOK(I, 2 * lane + 1) * 16 + (I).dir * 8 + (I).h]; } \
        _Pragma("unroll") for (int i = 0; i < 2; ++i) { const int id = tid + NTHR * i, l = id >> 3, pc = id & 7; \
            xv[i] = *(const u32x4*)(XCb + (size_t)((I).h >> 2) * TILE_ELEMS + (size_t)SSD_TOK(I, l) * 256 + ((I).h & 3) * 64 + 8 * pc); \
            sv[i] = *(const u32x4*)(Sl + (size_t)(itx) * 8192 + (size_t)id * 8); } \
        _Pragma("unroll") for (int i = 0; i < 4; ++i) { const int id = tid + NTHR * i, l = id >> 4, ncn = id & 15; \
            bv[i] = *(const u32x4*)(XCb + 2 * TILE_ELEMS + (size_t)SSD_TOK(I, l) * 256 + (I).g * 128 + 8 * ncn); } \
        { const bf16_t* cr = XCb + 3 * TILE_ELEMS + (size_t)SSD_TOK(I, 16 * w + c) * 256 + (I).g * 128 + 8 * q; \
          _Pragma("unroll") for (int ks = 0; ks < 4; ++ks) Cn[ks] = *(const bf16x8*)(cr + 32 * ks); } } while (0)
    SSD_LOADS_C(I, it);
    int par = 0;
    for (; it < N_SSD_ITEMS; it += gridDim.x, par ^= 1) {
        LAS float* acs = (LAS float*)(lds + SSDC_ACS + par * 1024); LAS float* dts = acs + 128;
        if (w == 0) ssd_scan_chunk(pd0, pd1, I.A, acs, dts, lane);
        __syncthreads();
#pragma unroll
        for (int i = 0; i < 2; ++i) {
            const int id = tid + NTHR * i, l = id >> 3, pc = id & 7;
            const float s1 = dts[l];
            const u32x4 v = xv[i];
            u32x4 o; o.x = pk2(bflo(v.x) * s1, bfhi(v.x) * s1); o.y = pk2(bflo(v.y) * s1, bfhi(v.y) * s1); o.z = pk2(bflo(v.z) * s1, bfhi(v.z) * s1); o.w = pk2(bflo(v.w) * s1, bfhi(v.w) * s1);
            *(LAS u32x4*)(Xt1 + l * 72 + 8 * pc) = o;
            *(LAS u32x4*)(Sbf + (id >> 4) * 136 + 8 * (id & 15)) = sv[i];
        }
#pragma unroll
        for (int i = 0; i < 4; ++i) { const int id = tid + NTHR * i; *(LAS u32x4*)(Bn + (id >> 4) * 136 + 8 * (id & 15)) = bv[i]; }
        bf16x8 Cf[4];
#pragma unroll
        for (int ks = 0; ks < 4; ++ks) Cf[ks] = Cn[ks];
        const SsdItem Ic = I;
        const int itn = it + gridDim.x;
        if (itn < N_SSD_ITEMS) { I = ssd_decode(p, itn); SSD_LOADS_C(I, itn); }
        __syncthreads();
        {
            const int l = 16 * w + c;
            const float al = acs[l];
            f32x4 acc[4];
#pragma unroll
            for (int pt = 0; pt < 4; ++pt) {
                f32x4 a = {0.f, 0.f, 0.f, 0.f};
#pragma unroll
                for (int ks = 0; ks < 4; ++ks) { const bf16x8 sf = *(const LAS bf16x8*)(Sbf + (16 * pt + c) * 136 + 32 * ks + 8 * q); a = __builtin_amdgcn_mfma_f32_16x16x32_bf16(sf, Cf[ks], a, 0, 0, 0); }
                acc[pt] = a * __expf(al);
            }
            const int nsp = (w >> 1) + 1;
            for (int sp = 0; sp < nsp; ++sp) {
                f32x4 M[2];
#pragma unroll
                for (int hh = 0; hh < 2; ++hh) {
                    const int st = 2 * sp + hh;
                    f32x4 G = {0.f, 0.f, 0.f, 0.f};
                    if (st <= w) {
#pragma unroll
                        for (int ks = 0; ks < 4; ++ks) { const bf16x8 bfr = *(const LAS bf16x8*)(Bn + (16 * st + c) * 136 + 32 * ks + 8 * q); G = __builtin_amdgcn_mfma_f32_16x16x32_bf16(bfr, Cf[ks], G, 0, 0, 0); }
#pragma unroll
                        for (int j = 0; j < 4; ++j) { const int s = 16 * st + 4 * q + j; const float e = __expf(al - acs[s]); G[j] = (s <= l) ? G[j] * e : 0.f; }
                    }
                    M[hh] = G;
                }
                u32x4 pw; pw.x = pk2(M[0][0], M[0][1]); pw.y = pk2(M[0][2], M[0][3]); pw.z = pk2(M[1][0], M[1][1]); pw.w = pk2(M[1][2], M[1][3]);
                const bf16x8 pf = __builtin_bit_cast(bf16x8, pw);
#pragma unroll
                for (int pt = 0; pt < 4; ++pt) {
                    const LAS bf16_t* xr = Xt1 + (32 * sp + 4 * q + qp) * 72 + 16 * pt + 4 * pp;
                    const bf16x8 xf = tr_pair(xr, xr + 16 * 72);
                    acc[pt] = __builtin_amdgcn_mfma_f32_16x16x32_bf16(xf, pf, acc[pt], 0, 0, 0);
                }
            }
            bf16_t* yr = (bf16_t*)(p.ws + (Ic.dir ? WS_YB : WS_YF)) + Ic.h * 64 + (size_t)SSD_TOK(Ic, l) * 512 + 4 * q;
#pragma unroll
            for (int pt = 0; pt < 4; ++pt) { u32x2 o; o.x = pk2(acc[pt][0], acc[pt][1]); o.y = pk2(acc[pt][2], acc[pt][3]); *(u32x2*)(yr + 16 * pt) = o; }
        }
    }
#undef SSD_LOADS_C
}

DI void gate_phase(const Params& p, int gw, int NGW, int lane) {
    const bf16_t* yf = (const bf16_t*)(p.ws + WS_YF); const bf16_t* yb = (const bf16_t*)(p.ws + WS_YB);
    const bf16_t* xh = (const bf16_t*)(p.ws + WS_XC) + (size_t)(lane >> 5) * TILE_ELEMS + (8 * lane & 255);
    const bf16_t* zt = (const bf16_t*)(p.ws + WS_P) + (size_t)(6 + (lane >> 5)) * TILE_ELEMS + (8 * lane & 255);
    bf16_t* mix = (bf16_t*)(p.ws + WS_MIX) + 512 + 8 * lane;
    const float D = p.in[7][lane >> 3];
    float nw[8];
#pragma unroll
    for (int e = 0; e < 8; ++e) nw[e] = p.in[8][8 * lane + e];
    for (int t = gw; t < TT; t += NGW) {
        const u32x4 a = *(const u32x4*)(yf + (size_t)t * 512 + 8 * lane), b = *(const u32x4*)(yb + (size_t)t * 512 + 8 * lane);
        const u32x4 x = *(const u32x4*)(xh + (size_t)t * 256), z = *(const u32x4*)(zt + (size_t)t * 256);
        float y[8];
        y[0] = (bflo(a.x) + bflo(b.x) + D * bflo(x.x)) * silu_f(bflo(z.x)); y[1] = (bfhi(a.x) + bfhi(b.x) + D * bfhi(x.x)) * silu_f(bfhi(z.x));
        y[2] = (bflo(a.y) + bflo(b.y) + D * bflo(x.y)) * silu_f(bflo(z.y)); y[3] = (bfhi(a.y) + bfhi(b.y) + D * bfhi(x.y)) * silu_f(bfhi(z.y));
        y[4] = (bflo(a.z) + bflo(b.z) + D * bflo(x.z)) * silu_f(bflo(z.z)); y[5] = (bfhi(a.z) + bfhi(b.z) + D * bfhi(x.z)) * silu_f(bfhi(z.z));
        y[6] = (bflo(a.w) + bflo(b.w) + D * bflo(x.w)) * silu_f(bflo(z.w)); y[7] = (bfhi(a.w) + bfhi(b.w) + D * bfhi(x.w)) * silu_f(bfhi(z.w));
        float ss = 0.f;
#pragma unroll
        for (int e = 0; e < 8; ++e) ss += y[e] * y[e];
        ss = wave_sum(ss);
        const float r = 1.0f / sqrtf(ss * (1.0f / 512.0f) + RMS_EPS);
        u32x4 o; o.x = pk2(y[0] * r * nw[0], y[1] * r * nw[1]); o.y = pk2(y[2] * r * nw[2], y[3] * r * nw[3]); o.z = pk2(y[4] * r * nw[4], y[5] * r * nw[5]); o.w = pk2(y[6] * r * nw[6], y[7] * r * nw[7]);
        *(u32x4*)(mix + (size_t)t * DM) = o;
    }
}

DI void expert_gu_weights_phase(const Params& p, LAS unsigned char* lds, int gw, int NGW, int wave, int lane) {
    LAS float* scr = (LAS float*)(lds + wave * 16384);
    for (int it = gw; it < 16 * 2816; it += NGW) {
        const int e = it / 2816, r = it % 2816;
        const int isup = r >= 1408, rr = isup ? r - 1408 : r, kb = rr / 88, nb = rr % 88, n0 = 32 * nb;
        const float* W = (isup ? p.in[14] : p.in[13]) + (size_t)e * DM * FF;
        transpose_item_f8(W, FF, 64 * kb, n0, p.ws + WS_WGU, DM, e * 5632 + 256 * (n0 >> 7) + (n0 & 127) + (isup ? 128 : 0), WGU_SCALE, scr, lane);
    }
}
DI void expert_down_weights(const Params& p, LAS unsigned char* lds, int vw, int NVW, int wave, int lane) {
    LAS float* scr = (LAS float*)(lds + 4096 + wave * 16384);
    for (int it = vw; it < 16 * 1408; it += NVW) {
        const int e = it / 1408, rr = it % 1408, kb = rr / 32, nb = rr % 32;
        transpose_item_f8(p.in[15] + (size_t)e * FF * DM, DM, 64 * kb, 32 * nb, p.ws + WS_WD, FF, e * 1024 + 32 * nb, WD_SCALE, scr, lane);
    }
}

DI void ln1_router_phase(const Params& p, LAS unsigned char* lds, int gw, int NGW, int wave, int lane) {
    const int tid = TIDX(wave);
    LAS float* wT = (LAS float*)lds;
    for (int id = tid; id < 16384; id += NTHR) { const int k = id >> 4, e = id & 15; wT[e * 1024 + k] = p.in[12][id]; }
    __syncthreads();
    f32x4 gg[4], bb[4];
#pragma unroll
    for (int j = 0; j < 4; ++j) { gg[j] = ((const f32x4*)p.in[10])[64 * j + lane]; bb[j] = ((const f32x4*)p.in[11])[64 * j + lane]; }
    unsigned char* x1b = p.ws + WS_X1B; float* aff = (float*)(p.ws + WS_AFF);
    for (int t = gw; t < TT; t += NGW) {
        f32x4* orow = (f32x4*)(p.out + (size_t)t * DM) + lane;
        f32x4 v[4]; float s = 0.f;
#pragma unroll
        for (int j = 0; j < 4; ++j) { v[j] = orow[64 * j]; s += (v[j][0] + v[j][1]) + (v[j][2] + v[j][3]); }
        const float mean = wave_sum(s) * (1.0f / DM); float s2 = 0.f;
#pragma unroll
        for (int j = 0; j < 4; ++j) { v[j] = v[j] - mean; s2 += (v[j][0] * v[j][0] + v[j][1] * v[j][1]) + (v[j][2] * v[j][2] + v[j][3] * v[j][3]); }
        const float rstd = 1.0f / sqrtf(wave_sum(s2) * (1.0f / DM) + LN_EPS);
        unsigned* o4 = (unsigned*)(x1b + (size_t)t * DM) + lane;
#pragma unroll
        for (int j = 0; j < 4; ++j) {
            v[j] = v[j] * rstd * gg[j] + bb[j];
            orow[64 * j] = v[j] * ALPHA;
            o4[64 * j] = pk4_f8(v[j][0], v[j][1], v[j][2], v[j][3]);
        }
        float r[16]; dot16(v, wT, lane, r);
        float mx = r[0];
#pragma unroll
        for (int e = 1; e < 16; ++e) mx = fmaxf(mx, r[e]);
        float den = 0.f, mine = 0.f;
#pragma unroll
        for (int e = 0; e < 16; ++e) { const float ex = __expf(r[e] - mx); den += ex; mine = (lane == e) ? ex : mine; }
        if (lane < 16) aff[(size_t)lane * TT + t] = mine / den;
    }
}

DI void select_phase(const Params& p, LAS unsigned char* lds, int wave, int lane) {
    const int wk = blockIdx.x;
    if (wk >= 32) { expert_down_weights(p, lds, (wk - 32) * 8 + wave, ((int)gridDim.x - 32) * 8, wave, lane); return; }
    const int tid = TIDX(wave);
    const int trunk = wk >> 4, e = wk & 15;
    const int Tn = trunk ? 16384 : 32768, tbase = trunk ? TP : 0, cap = Tn / 8;
    const unsigned* col = (const unsigned*)(p.ws + WS_AFF) + (size_t)e * TT + tbase;
    LAS unsigned* hist = (LAS unsigned*)lds;
    LAS unsigned* ctl = (LAS unsigned*)(lds + 1024);
    LAS unsigned* wcnt = (LAS unsigned*)(lds + 2048);
    unsigned prefix = 0, remaining = (unsigned)cap;
    for (int pass = 0; pass < 4; ++pass) {
        const int shift = 24 - 8 * pass;
        for (int i = tid; i < 256; i += NTHR) hist[i] = 0u;
        __syncthreads();
        for (int i = tid; i < Tn; i += NTHR) {
            const unsigned bits = col[i];
            if (pass == 0 || (bits >> (shift + 8)) == prefix) atomicAdd((unsigned*)(hist + ((bits >> shift) & 255u)), 1u);
        }
        __syncthreads();
        if (tid == 0) {
            unsigned cum = 0; int b = 255;
            for (; b > 0; --b) { const unsigned hcnt = hist[b]; if (cum + hcnt >= remaining) break; cum += hcnt; }
            ctl[0] = (prefix << 8) | (unsigned)b; ctl[1] = remaining - cum;
        }
        __syncthreads();
        prefix = ctl[0]; remaining = ctl[1];
        __syncthreads();
    }
    const unsigned thr = prefix, need_eq = remaining;
    int* idx = (int*)(p.ws + WS_IDX) + e * SLOTS_E + (trunk ? 4096 : 0);
    int* inv = (int*)(p.ws + WS_INV) + (size_t)e * TT + tbase;
    const int slot0 = e * SLOTS_E + (trunk ? 4096 : 0);
    float* gate = (float*)(p.ws + WS_GATE) + e * SLOTS_E + (trunk ? 4096 : 0);
    unsigned sel_base = 0, eq_base = 0;
    for (int b0 = 0; b0 < Tn; b0 += NTHR) {
        const unsigned bits = col[b0 + tid];
        const bool gt = bits > thr, eq = bits == thr;
        const unsigned long long meq = __ballot(eq);
        const unsigned eq_before_w = (unsigned)__popcll(meq & ((1ull << lane) - 1ull));
        if (lane == 0) wcnt[wave] = (unsigned)__popcll(meq);
        __syncthreads();
        unsigned eq_off = 0, eq_tot = 0;
#pragma unroll
        for (int w2 = 0; w2 < 8; ++w2) { const unsigned cnt = wcnt[w2]; eq_off += (w2 < wave) ? cnt : 0u; eq_tot += cnt; }
        const bool sel = gt || (eq && (eq_base + eq_off + eq_before_w) < need_eq);
        const unsigned long long msel = __ballot(sel);
        const unsigned sel_before_w = (unsigned)__popcll(msel & ((1ull << lane) - 1ull));
        if (lane == 0) wcnt[8 + wave] = (unsigned)__popcll(msel);
        __syncthreads();
        unsigned sel_off = 0, sel_tot = 0;
#pragma unroll
        for (int w2 = 0; w2 < 8; ++w2) { const unsigned cnt = wcnt[8 + w2]; sel_off += (w2 < wave) ? cnt : 0u; sel_tot += cnt; }
        { const unsigned pos = sel_base + sel_off + sel_before_w; const bool ok = sel && pos < (unsigned)cap;
          if (ok) { idx[pos] = tbase + b0 + tid; gate[pos] = __uint_as_float(bits); }
          inv[b0 + tid] = ok ? slot0 + (int)pos : -1; }
        sel_base += sel_tot; eq_base += eq_tot;
        __syncthreads();
    }
}

DI void ln2_phase(const Params& p, int gw, int NGW, int lane) {
    f32x4 gg[4], bb[4];
#pragma unroll
    for (int j = 0; j < 4; ++j) { gg[j] = ((const f32x4*)p.in[16])[64 * j + lane]; bb[j] = ((const f32x4*)p.in[17])[64 * j + lane]; }
    const int* inv = (const int*)(p.ws + WS_INV); const bf16_t* eo = (const bf16_t*)(p.ws + WS_EO);
    for (int t = gw; t < TT; t += NGW) {
        f32x4* orow = (f32x4*)(p.out + (size_t)t * DM) + lane;
        f32x4 v[4]; float s = 0.f;
#pragma unroll
        for (int j = 0; j < 4; ++j) v[j] = orow[64 * j];
        const int myslot = lane < 16 ? inv[(size_t)lane * TT + t] : -1;
        for (int e = 0; e < 16; ++e) {
            const int sl = __shfl(myslot, e);
            if (sl >= 0) {
                const u32x2* er = (const u32x2*)(eo + (size_t)sl * DM) + lane;
#pragma unroll
                for (int j = 0; j < 4; ++j) { const u32x2 w = er[64 * j]; v[j][0] += bflo(w.x); v[j][1] += bfhi(w.x); v[j][2] += bflo(w.y); v[j][3] += bfhi(w.y); }
            }
        }
#pragma unroll
        for (int j = 0; j < 4; ++j) s += (v[j][0] + v[j][1]) + (v[j][2] + v[j][3]);
        const float mean = wave_sum(s) * (1.0f / DM); float s2 = 0.f;
#pragma unroll
        for (int j = 0; j < 4; ++j) { v[j] = v[j] - mean; s2 += (v[j][0] * v[j][0] + v[j][1] * v[j][1]) + (v[j][2] * v[j][2] + v[j][3] * v[j][3]); }
        const float rstd = 1.0f / sqrtf(wave_sum(s2) * (1.0f / DM) + LN_EPS);
#pragma unroll
        for (int j = 0; j < 4; ++j) orow[64 * j] = v[j] * rstd * gg[j] + bb[j];
    }
}

constexpr size_t WS_CTL = 19 * MiB;
#define XB_TMO      128
#define XB_XCNT(j)  (256  + 64 * (j))
#define XB_XSUB(j)  (1280 + 64 * (j))
#define XB_XGEN(j)  (2304 + 64 * (j))
#define XB_TOP      3328
#define XB_TOPGEN   3392
#define XCD_BAR_WORDS 3456
#define XB_SPIN_CAP (1u << 18)
DI unsigned xb_ld(unsigned* p)              { return __hip_atomic_load(p, __ATOMIC_RELAXED, __HIP_MEMORY_SCOPE_AGENT); }
DI unsigned xb_add(unsigned* p, unsigned v) { return __hip_atomic_fetch_add(p, v, __ATOMIC_RELAXED, __HIP_MEMORY_SCOPE_AGENT); }
DI unsigned xb_xcc_id() { return (unsigned)__builtin_amdgcn_s_getreg((3 << 11) | 20) & 0xFu; }
#define XB_SPIN(cond, bar) do { unsigned _sp = 0; while (cond) { __builtin_amdgcn_s_sleep(1); \
    if ((++_sp & 255u) == 0u) { if (xb_ld(&(bar)[XB_TMO])) break; if (_sp > XB_SPIN_CAP) { atomicAdd(&(bar)[XB_TMO], 1u); break; } } } } while (0)
struct XcdBarrier { unsigned* bar; unsigned x; volatile LAS unsigned* st; };
DI void xcd_barrier_complete(unsigned* bar, unsigned x, unsigned& nloc, unsigned& nx) {
    const unsigned G = gridDim.x * gridDim.y * gridDim.z;
    unsigned sum, cnt, mine, sp = 0u;
    for (;;) {
        sum = 0u; cnt = 0u; mine = 0u;
#pragma unroll
        for (unsigned j = 0; j < 16; ++j) { const unsigned c = xb_ld(&bar[XB_XCNT(j)]); sum += c; cnt += (c > 0u) ? 1u : 0u; mine = (j == x) ? c : mine; }
        if (sum == G) break;
        __builtin_amdgcn_s_sleep(1);
        if ((++sp & 255u) == 0u) { if (xb_ld(&bar[XB_TMO])) break; if (sp > XB_SPIN_CAP) { atomicAdd(&bar[XB_TMO], 1u); break; } }
    }
    nloc = mine > 0u ? mine : 1u; nx = cnt > 0u ? cnt : 1u;
}
DI void xcd_barrier(const XcdBarrier& b, int wave) {
    asm volatile("s_waitcnt vmcnt(0)" ::: "memory");
    __syncthreads();
    if (wave == 0 && lane_id() == 0) {
        unsigned* bar = b.bar;
        __builtin_amdgcn_s_waitcnt(0);
        unsigned nloc = b.st[0], nx = b.st[1];
        if (nloc == 0u) { xcd_barrier_complete(bar, b.x, nloc, nx); b.st[0] = nloc; b.st[1] = nx; }
        const unsigned old = xb_add(&bar[XB_XSUB(b.x)], 1u);
        const unsigned gen = old / nloc;
        if (old + 1u == (gen + 1u) * nloc) {
            __builtin_amdgcn_fence(__ATOMIC_RELEASE, "agent");
            asm volatile("s_waitcnt vmcnt(0)" ::: "memory");
            const unsigned og = xb_add(&bar[XB_TOP], 1u);
            const unsigned tg = og / nx;
            if (og + 1u == (tg + 1u) * nx) xb_add(&bar[XB_TOPGEN], 1u);
            else XB_SPIN(xb_ld(&bar[XB_TOPGEN]) == tg, bar);
            __builtin_amdgcn_fence(__ATOMIC_ACQUIRE, "agent");
            xb_add(&bar[XB_XGEN(b.x)], 1u);
            asm volatile("s_waitcnt vmcnt(0)" ::: "memory");
        } else {
            XB_SPIN(xb_ld(&bar[XB_XGEN(b.x)]) == gen, bar);
            __builtin_amdgcn_fence(__ATOMIC_ACQUIRE, "agent");
            asm volatile("s_waitcnt vmcnt(0)" ::: "memory");
        }
    }
    __syncthreads();
}

__global__ void __launch_bounds__(NTHR, 2) fwd_megakernel(Params p) {
    extern __shared__ __attribute__((aligned(16))) unsigned char lds_raw[];
    LAS unsigned char* lds = (LAS unsigned char*)lds_raw;
    cg::grid_group grid = cg::this_grid();
    const int wave_k = __builtin_amdgcn_readfirstlane((int)threadIdx.x >> 6);
    XcdBarrier xb; xb.bar = (unsigned*)(p.ws + WS_CTL); xb.x = xb_xcc_id(); xb.st = (volatile LAS unsigned*)(lds + LDS_BYTES - 64);
    if (wave_k == 0 && lane_id() == 0) { xb.st[0] = 0u; xb.st[1] = 0u; (void)xb_add(&xb.bar[XB_XCNT(xb.x)], 1u); }
    __syncthreads();
#define GSYNC() xcd_barrier(xb, wave_k)
#define IDS() const int lane = lane_id(), wave = wave_k; \
    const int G = gridDim.x, gw = blockIdx.x * 8 + wave, NGW = G * 8; (void)lane; (void)gw; (void)NGW; (void)G;
    { IDS(); phase0(p, lds, gw, NGW, wave, lane); }
    grid.sync();
    {
        IDS();
        pg8::SchedPlain S; S.init(TT, 3072, G, (int)blockIdx.x);
        pg8::EpiProj E{(bf16_t*)(p.ws + WS_P), (const float*)(p.ws + WS_ROPE)};
        pg8::gemm_phase<pg8::EpiProj, pg8::SchedPlain>(lds, (const bf16_t*)(p.ws + WS_XB), (const bf16_t*)(p.ws + WS_WI), DM, S, E, wave);
    }
    GSYNC();
    conv_phase(p, wave_k);
    { IDS(); const int vcu = (G % 8 == 0) ? ((int)blockIdx.x % 8) * (G / 8) + (int)blockIdx.x / 8 : (int)blockIdx.x;
      attn_phase(p, lds, vcu * 8 + wave, NGW, wave, lane); }
    GSYNC();
    { IDS(); ssd_state_phase(p, lds, wave, lane); }
    GSYNC();
    ssd_scan_phase(p, wave_k);
    GSYNC();
    { IDS(); ssd_out_phase(p, lds, wave, lane); }
    GSYNC();
    { IDS(); gate_phase(p, gw, NGW, lane); }
    GSYNC();
    { IDS(); expert_gu_weights_phase(p, lds, gw, NGW, wave, lane); }
    __syncthreads();
    {
        IDS();
        pg8::SchedPlain S; S.init(TT, DM, G, (int)blockIdx.x);
        pg8::EpiOut E{p};
        pg8::gemm_phase<pg8::EpiOut, pg8::SchedPlain>(lds, (const bf16_t*)(p.ws + WS_MIX), (const bf16_t*)(p.ws + WS_WO), DM, S, E, wave);
    }
    GSYNC();
    { IDS(); ln1_router_phase(p, lds, gw, NGW, wave, lane); }
    GSYNC();
    { IDS(); select_phase(p, lds, wave, lane); }
    GSYNC();
    {
        IDS();
        const int* idx = (const int*)(p.ws + WS_IDX);
        pg8::SchedGrouped<22, true> S{G, (int)blockIdx.x, idx};
        pg8::EpiGU E{p.ws + WS_HID};
        pg8::gemm_phase<pg8::EpiGU, pg8::SchedGrouped<22, true>, true>(lds, (const bf16_t*)(p.ws + WS_X1B), (const bf16_t*)(p.ws + WS_WGU), DM / 2, S, E, wave);
    }
    GSYNC();
    {
        IDS();
        const int* idx = (const int*)(p.ws + WS_IDX);
        const float* gate = (const float*)(p.ws + WS_GATE);
        pg8::SchedGrouped<4, false> S{G, (int)blockIdx.x, idx};
        pg8::EpiDown E{(bf16_t*)(p.ws + WS_EO), gate};
        pg8::gemm_phase<pg8::EpiDown, pg8::SchedGrouped<4, false>, true>(lds, (const bf16_t*)(p.ws + WS_HID), (const bf16_t*)(p.ws + WS_WD), FF / 2, S, E, wave);
    }
    GSYNC();
    { IDS(); ln2_phase(p, gw, NGW, lane); }
#undef IDS
}

extern "C" void kernel_launch(void* const* d_in, const int* in_sizes, int n_in, void* d_out, int out_size, void* d_ws, size_t ws_size, hipStream_t stream) {
    static int grid_blocks = 0;
    if (grid_blocks == 0) {
        if (n_in != 18 || ws_size < WS_END || out_size != TT * DM) { fprintf(stderr, "kernel_launch: unexpected shapes (n_in %d out %d ws %zu)\n", n_in, out_size, ws_size); grid_blocks = -1; return; }
        int dev = 0, cus = 0, per_cu = 0;
        hipGetDevice(&dev);
        hipDeviceGetAttribute(&cus, hipDeviceAttributeMultiprocessorCount, dev);
        if (hipFuncSetAttribute((const void*)fwd_megakernel, hipFuncAttributeMaxDynamicSharedMemorySize, LDS_BYTES) != hipSuccess) { fprintf(stderr, "kernel_launch: hipFuncSetAttribute failed\n"); }
        hipOccupancyMaxActiveBlocksPerMultiprocessor(&per_cu, (const void*)fwd_megakernel, NTHR, LDS_BYTES);
        if (per_cu < 1) per_cu = 1;
        (void)hipGetLastError();
        grid_blocks = cus * per_cu;
    }
    if (grid_blocks < 0) return;
    Params p{};
    for (int i = 0; i < 18; ++i) p.in[i] = (const float*)d_in[i];
    p.out = (float*)d_out; p.ws = (unsigned char*)d_ws;
    if (hipMemsetAsync((char*)d_ws + WS_CTL, 0, 16384, stream) != hipSuccess) { fprintf(stderr, "kernel_launch: hipMemsetAsync failed\n"); return; }
    void* args[] = {&p};
    hipError_t e = hipLaunchCooperativeKernel((void*)fwd_megakernel, dim3(grid_blocks), dim3(NTHR), args, LDS_BYTES, stream);
    if (e != hipSuccess) fprintf(stderr, "cooperative launch failed: %s (grid %d)\n", hipGetErrorString(e), grid_blocks);
}
```

```cpp
#include <hip/hip_runtime.h>
#include <hip/hip_cooperative_groups.h>
#include <cstdio>
#include <cstdint>
namespace cg = cooperative_groups;

#define DI __device__ __forceinline__
#define LAS __attribute__((address_space(3)))
typedef unsigned short bf16_t;
typedef short bf16x8 __attribute__((ext_vector_type(8)));
typedef short s16x4 __attribute__((ext_vector_type(4)));
typedef float f32x4 __attribute__((ext_vector_type(4)));
typedef unsigned u32x4 __attribute__((ext_vector_type(4)));
typedef unsigned u32x2 __attribute__((ext_vector_type(2)));
typedef int i32x4 __attribute__((ext_vector_type(4)));
typedef int i32x8 __attribute__((ext_vector_type(8)));

constexpr int TT = 49152;
constexpr int TP = 32768;
constexpr int DM = 1024;
constexpr int INW = 3088;
constexpr int FF = 2816;
constexpr int NE = 16;
constexpr int SLOTS_E = 6144;
constexpr float ALPHA = 1.189207115002721f;
constexpr float LN_EPS = 1e-5f, RMS_EPS = 1e-5f;

constexpr size_t MiB = 1u << 20;
constexpr size_t TILE_ELEMS = (size_t)TT * 256;
constexpr size_t TILE_BYTES = TILE_ELEMS * 2;
constexpr size_t WS_WI = 0;
constexpr size_t WS_WO = 6 * MiB;
constexpr size_t WS_DT = 8 * MiB;
constexpr size_t WS_ROPE = 11 * MiB;
constexpr size_t WS_AFF = 12 * MiB;
constexpr size_t WS_IDX = 15 * MiB;
constexpr size_t WS_GATE = 15 * MiB + 512 * 1024;
constexpr size_t WS_P = 20 * MiB;
constexpr size_t WS_XC = 308 * MiB;
constexpr size_t WS_XB = 404 * MiB;
constexpr size_t WS_MIX = WS_XB;
constexpr size_t WS_YF = WS_P + 8 * TILE_BYTES;
constexpr size_t WS_YB = WS_P + 10 * TILE_BYTES;
constexpr size_t WS_INV = 16 * MiB;
constexpr size_t WS_WD = 20 * MiB;
constexpr size_t WS_WGU = 108 * MiB;
constexpr size_t WS_EO = 212 * MiB;
constexpr size_t WS_X1B = 308 * MiB;
constexpr size_t WS_HID = 404 * MiB;
constexpr size_t WS_END = 668 * MiB;

constexpr int LDS_BYTES = 147456;
constexpr int NTHR = 512;

DI unsigned f2bf(float f) { unsigned u = __float_as_uint(f); return (u + 0x7fffu + ((u >> 16) & 1u)) >> 16; }
DI unsigned pk2(float lo, float hi) { return f2bf(lo) | (f2bf(hi) << 16); }
DI unsigned pk4_f8(float a, float b, float c, float d) { int w = 0; w = __builtin_amdgcn_cvt_pk_fp8_f32(a, b, w, false); w = __builtin_amdgcn_cvt_pk_fp8_f32(c, d, w, true); return (unsigned)w; }
DI i32x8 cat8(bf16x8 lo, bf16x8 hi) { const i32x4 a = __builtin_bit_cast(i32x4, lo), b = __builtin_bit_cast(i32x4, hi); return __builtin_shufflevector(a, b, 0, 1, 2, 3, 4, 5, 6, 7); }
constexpr float WGU_SCALE = 32.0f, WD_SCALE = 64.0f;
DI float bflo(unsigned u) { return __uint_as_float(u << 16); }
DI float bfhi(unsigned u) { return __uint_as_float(u & 0xffff0000u); }
DI float wave_sum(float v) {
#pragma unroll
    for (int o = 1; o < 64; o <<= 1) v += __shfl_xor(v, o);
    return v;
}
DI void st_tr8_pair(LAS bf16_t* base, int stride, int colpair, int lane, const u32x4 v) {
    const unsigned px = __shfl_xor(v.x, 1), py = __shfl_xor(v.y, 1), pz = __shfl_xor(v.z, 1), pw = __shfl_xor(v.w, 1);
    const bool odd = (lane & 1) != 0;
    const unsigned d0 = odd ? ((px >> 16) | (v.x & 0xffff0000u)) : ((v.x & 0xffffu) | (px << 16));
    const unsigned d1 = odd ? ((py >> 16) | (v.y & 0xffff0000u)) : ((v.y & 0xffffu) | (py << 16));
    const unsigned d2 = odd ? ((pz >> 16) | (v.z & 0xffff0000u)) : ((v.z & 0xffffu) | (pz << 16));
    const unsigned d3 = odd ? ((pw >> 16) | (v.w & 0xffff0000u)) : ((v.w & 0xffffu) | (pw << 16));
    LAS unsigned* wp = (LAS unsigned*)(base + (odd ? stride : 0)) + colpair;
    wp[0] = d0; wp[stride] = d1; wp[2 * stride] = d2; wp[3 * stride] = d3;
}
DI float silu_f(float x) { return x / (1.0f + __expf(-x)); }
#define LDS_WAIT() asm volatile("s_waitcnt lgkmcnt(0)" ::: "memory")

struct Params { const float* in[18]; float* out; unsigned char* ws; };
DI int lane_id() { int l = (int)__builtin_amdgcn_mbcnt_hi(~0u, __builtin_amdgcn_mbcnt_lo(~0u, 0u)); asm volatile("" : "+v"(l)); return l; }
#define TIDX(wave_) ((wave_) * 64 + lane_id())

DI const float* xrow_ptr(const Params& p, int t) { return t < TP ? p.in[0] + (size_t)t * DM : p.in[1] + (size_t)(t - TP) * DM; }

namespace pg8 {
constexpr int BM = 256, BK = 64, HALF = 128, HTB = HALF * BK * 2, NXCD = 8, WGM = 8;
DI int lds_byte(int r, int c) { const int st = (r >> 4) * 2 + (c >> 5), rr = r & 15, cc = c & 31, ob = rr * 64 + cc * 2; return st * 1024 + (ob ^ (((ob >> 9) & 1) << 5)); }
DI void stage_rc(int b, int& R, int& C) { const int st = b / 1024, sb = b % 1024, swz = sb ^ (((sb >> 9) & 1) << 5); R = (st >> 1) * 16 + swz / 64; C = (st & 1) * 32 + (swz % 64) / 2; }
DI int perm32(int rho) { const int n = rho >> 4, i = rho & 15; return 8 * (i >> 2) + 4 * n + (i & 3); }

struct Unit { int pm, pn, bt; };

DI int xcd_remap(int L, int nwg) { const int q = nwg / NXCD, r = nwg % NXCD, xcd = L % NXCD, off = L / NXCD; return (xcd < r ? xcd * (q + 1) : r * (q + 1) + (xcd - r) * q) + off; }

struct SchedPlain {
    int nM, nN, nwg, G, c;
    DI void init(int M, int N, int G_, int c_) { nM = M / BM; nN = N / BM; nwg = nM * nN; G = G_; c = c_; }
    DI bool next(int i, Unit& u) const {
        const int L = i * G + c; if (L >= nwg) return false;
        const int wgid = xcd_remap(L, nwg);
        const int nig = WGM * nN, gid = wgid / nig, fm = gid * WGM, gsz = (nM - fm) < WGM ? (nM - fm) : WGM;
        u.pm = fm + ((wgid % nig) % gsz); u.pn = (wgid % nig) / gsz; u.bt = u.pn; return true;
    }
    DI int arow(const Unit& u, int r) const { return u.pm * BM + r; }
};
template <int NPN, bool GATHER> struct SchedGrouped {
    int G, c; const int* idx;
    DI bool next(int i, Unit& u) const {
        constexpr int PER_E = 24 * NPN, NWG = NE * PER_E;
        const int L = i * G + c; if (L >= NWG) return false;
        const int wgid = xcd_remap(L, NWG);
        const int e = wgid / PER_E, rem = wgid % PER_E;
        const int gid = rem / (8 * NPN), w2 = rem % (8 * NPN);
        u.pm = e * 24 + gid * 8 + (w2 % 8); u.pn = w2 / 8; u.bt = e * NPN + u.pn; return true;
    }
    DI int arow(const Unit& u, int r) const { if (GATHER) return idx[u.pm * BM + r]; else return u.pm * BM + r; }
};

template <class Epi, class Sched, bool F8 = false>
DI void gemm_phase(LAS unsigned char* lds, const bf16_t* Ag, const bf16_t* Btg, const int K, const Sched& S, const Epi& E, const int wave_in) {
    const int tid = TIDX(wave_in), wid = wave_in, lane = tid & 63, wr = wid >> 2, wc = wid & 3, fr = lane & 15, fq = lane >> 4;
    const int nt = K / BK;
    unsigned voffB[2];
#pragma unroll
    for (int i = 0; i < 2; ++i) { int R, C; stage_rc(tid * 16 + i * 8192, R, C); const int Rb = Epi::PERM ? ((R & ~31) + perm32(R & 31)) : R;
        voffB[i] = (unsigned)(Rb * K + C) * 2u; }
    const unsigned rowbytes = (unsigned)K * 2u;
    const size_t kstep = (size_t)(BK * 2);
    const size_t hstep = (size_t)HALF * K * 2;
    const size_t tstep = 2 * hstep;
    const unsigned ldsw = (unsigned)wid * 1024u;
    const int aoff = lds_byte(wr * 64 + fr, fq * 8), boff = lds_byte(wc * 32 + fr, fq * 8);
#define PG8_SA(b, h) (((b) * 2 + (h)) * HTB)
#define PG8_SB(b, h) ((4 + (b) * 2 + (h)) * HTB)
#define PG8_STAGE(bufoff, gbase, voff) do { _Pragma("unroll") for (int _i = 0; _i < 2; ++_i) \
        __builtin_amdgcn_global_load_lds((const unsigned*)((const char*)(gbase) + (voff)[_i]), (LAS unsigned*)(lds + (bufoff) + ldsw + _i * 8192), 16, 0, 0); } while (0)
#define PG8_STAGEA(bufoff, o0, o1, kb) do { \
        __builtin_amdgcn_global_load_lds((const unsigned*)((const char*)Ag + (size_t)(o0) + (size_t)(kb)), (LAS unsigned*)(lds + (bufoff) + ldsw), 16, 0, 0); \
        __builtin_amdgcn_global_load_lds((const unsigned*)((const char*)Ag + (size_t)(o1) + (size_t)(kb)), (LAS unsigned*)(lds + (bufoff) + ldsw + 8192), 16, 0, 0); } while (0)
#define PG8_LDA(dst, b, h) do { _Pragma("unroll") for (int m = 0; m < 4; ++m) _Pragma("unroll") for (int k = 0; k < 2; ++k) dst[m][k] = *(const LAS bf16x8*)(lds + PG8_SA(b, h) + aoff + m * 2048 + k * 1024); } while (0)
#define PG8_LDB(dst, b, h) do { _Pragma("unroll") for (int n = 0; n < 2; ++n) _Pragma("unroll") for (int k = 0; k < 2; ++k) dst[n][k] = *(const LAS bf16x8*)(lds + PG8_SB(b, h) + boff + n * 2048 + k * 1024); } while (0)
#define PG8_MMA(ai, bj, At, Bt) do { __builtin_amdgcn_s_setprio(1); _Pragma("unroll") for (int m = 0; m < 4; ++m) _Pragma("unroll") for (int n = 0; n < 2; ++n) { \
        if constexpr (F8) { acc[ai][bj][m][n] = __builtin_amdgcn_mfma_scale_f32_16x16x128_f8f6f4(cat8(Bt[n][0], Bt[n][1]), cat8(At[m][0], At[m][1]), acc[ai][bj][m][n], 0, 0, 0, 0, 0, 0); } \
        else { _Pragma("unroll") for (int k = 0; k < 2; ++k) acc[ai][bj][m][n] = __builtin_amdgcn_mfma_f32_16x16x32_bf16(Bt[n][k], At[m][k], acc[ai][bj][m][n], 0, 0, 0); } } \
        __builtin_amdgcn_s_setprio(0); } while (0)
#define PG8_WAIT_V(n) asm volatile("s_waitcnt vmcnt(" #n ")" ::: "memory")
#define PG8_WAIT_L(n) asm volatile("s_waitcnt lgkmcnt(" #n ")" ::: "memory")
#define PG8_BAR __builtin_amdgcn_s_barrier()
#define PG8_SCHED __builtin_amdgcn_sched_barrier(0)
#define PG8_OFFS(u, o00, o01, o10, o11) do { int R0_, C0_, R1_, C1_; const int t2_ = TIDX(wid); stage_rc(t2_ * 16, R0_, C0_); stage_rc(t2_ * 16 + 8192, R1_, C1_); \
        o00 = (unsigned)S.arow(u, R0_) * rowbytes + (unsigned)C0_ * 2u; o01 = (unsigned)S.arow(u, R1_) * rowbytes + (unsigned)C1_ * 2u; \
        o10 = (unsigned)S.arow(u, HALF + R0_) * rowbytes + (unsigned)C0_ * 2u; o11 = (unsigned)S.arow(u, HALF + R1_) * rowbytes + (unsigned)C1_ * 2u; } while (0)
    Unit cur, nxt; int ui = 0;
    if (!S.next(0, cur)) return;
    f32x4 acc[2][2][4][2];
#pragma unroll
    for (int a = 0; a < 2; ++a)
#pragma unroll
        for (int b = 0; b < 2; ++b)
#pragma unroll
            for (int m = 0; m < 4; ++m)
#pragma unroll
                for (int n = 0; n < 2; ++n) acc[a][b][m][n] = (f32x4){0.f, 0.f, 0.f, 0.f};
    bf16x8 At[4][2], B0[2][2], B1[2][2];
    unsigned c00, c01, c10, c11;
    PG8_OFFS(cur, c00, c01, c10, c11);
    const char* cB = (const char*)Btg + (size_t)cur.bt * tstep;
    PG8_STAGE(PG8_SB(0, 0), cB, voffB); PG8_STAGE(PG8_SB(0, 1), cB + hstep, voffB); PG8_STAGEA(PG8_SA(0, 0), c00, c01, 0); PG8_STAGEA(PG8_SA(0, 1), c10, c11, 0);
    if (wr == 1) PG8_BAR;
    PG8_WAIT_V(2); PG8_BAR;
    PG8_STAGE(PG8_SB(1, 0), cB + kstep, voffB); PG8_STAGEA(PG8_SA(1, 0), c00, c01, kstep); PG8_STAGE(PG8_SB(1, 1), cB + hstep + kstep, voffB);
    PG8_WAIT_V(6); PG8_BAR;
    for (;;) {
        const bool has_next = S.next(ui + 1, nxt);
        const char* nB = has_next ? (const char*)Btg + (size_t)nxt.bt * tstep : cB;
        for (int t = 0; t < nt; t += 2) {
            const bool last = (t == nt - 2);
            const size_t kb1 = (size_t)(t + 1) * kstep;
            const size_t kb2 = last ? 0 : (size_t)(t + 2) * kstep, kb3 = kb2 + kstep;
            const char* b2 = last ? nB : cB + (size_t)(t + 2) * kstep; const char* b3 = b2 + kstep;
            PG8_LDB(B0, 0, 0); PG8_LDB(B1, 0, 1); PG8_SCHED; PG8_LDA(At, 0, 0); PG8_STAGEA(PG8_SA(1, 1), c10, c11, kb1);
            PG8_WAIT_V(8); PG8_WAIT_L(0); PG8_BAR; PG8_MMA(0, 0, At, B0); PG8_MMA(0, 1, At, B1); PG8_BAR; PG8_SCHED;
            if (last && has_next) { PG8_OFFS(nxt, c00, c01, c10, c11); }
            PG8_LDA(At, 0, 1); PG8_STAGE(PG8_SB(0, 0), b2, voffB); PG8_STAGE(PG8_SB(0, 1), b2 + hstep, voffB); PG8_STAGEA(PG8_SA(0, 0), c00, c01, kb2);
            PG8_WAIT_V(8); PG8_WAIT_L(0); PG8_BAR; PG8_MMA(1, 0, At, B0); PG8_MMA(1, 1, At, B1); PG8_BAR; PG8_SCHED;
            PG8_LDB(B0, 1, 0); PG8_LDB(B1, 1, 1); PG8_SCHED; PG8_LDA(At, 1, 0); PG8_STAGEA(PG8_SA(0, 1), c10, c11, kb2);
            PG8_WAIT_V(8); PG8_WAIT_L(0); PG8_BAR; PG8_MMA(0, 0, At, B0); PG8_MMA(0, 1, At, B1); PG8_BAR; PG8_SCHED;
            PG8_LDA(At, 1, 1); PG8_STAGE(PG8_SB(1, 0), b3, voffB); PG8_STAGE(PG8_SB(1, 1), b3 + hstep, voffB); PG8_STAGEA(PG8_SA(1, 0), c00, c01, kb3);
            PG8_WAIT_V(8); PG8_WAIT_L(0); PG8_BAR; PG8_MMA(1, 0, At, B0); PG8_MMA(1, 1, At, B1); PG8_BAR; PG8_SCHED;
        }
        if (wr == 0) PG8_BAR;
        { const int l2 = lane_id(); E(acc, cur, wr, wc, l2 & 15, l2 >> 4); }
        if (!has_next) break;
#pragma unroll
        for (int a = 0; a < 2; ++a)
#pragma unroll
            for (int b = 0; b < 2; ++b)
#pragma unroll
                for (int m = 0; m < 4; ++m)
#pragma unroll
                    for (int n = 0; n < 2; ++n) acc[a][b][m][n] = (f32x4){0.f, 0.f, 0.f, 0.f};
        cur = nxt; cB = nB; ++ui;
        if (wr == 1) PG8_BAR;
    }
    PG8_WAIT_V(0);
    PG8_BAR;
#undef PG8_SA
#undef PG8_SB
#undef PG8_STAGE
#undef PG8_STAGEA
#undef PG8_LDA
#undef PG8_LDB
#undef PG8_MMA
#undef PG8_WAIT_V
#undef PG8_WAIT_L
#undef PG8_BAR
#undef PG8_SCHED
#undef PG8_OFFS
}

struct EpiProj {
    static constexpr bool PERM = true;
    bf16_t* P; const float* rope;
    DI void operator()(const f32x4 (&acc)[2][2][4][2], const Unit& u, int wr, int wc, int fr, int fq) const {
        bf16_t* base = P + (size_t)u.pn * TILE_ELEMS;
        const bool rot = (u.pn < 4) && ((wc & 1) == 0);
#pragma unroll
        for (int ai = 0; ai < 2; ++ai)
#pragma unroll
            for (int m = 0; m < 4; ++m) {
                const int row = u.pm * BM + ai * HALF + wr * 64 + m * 16 + fr;
                asm volatile("" ::: "memory");
                f32x4 cs0 = {1.f, 1.f, 1.f, 1.f}, cs1 = cs0, sn0 = {0.f, 0.f, 0.f, 0.f}, sn1 = sn0;
                if (rot && fq < 2) {
                    const int s = row < TP ? (row & 4095) : (row & 8191);
                    const f32x4* rp = (const f32x4*)(rope + (size_t)s * 16);
                    cs0 = rp[0]; cs1 = rp[1]; sn0 = rp[2]; sn1 = rp[3];
                    if (fq == 0) { sn0 = -sn0; sn1 = -sn1; }
                }
#pragma unroll
                for (int bj = 0; bj < 2; ++bj) {
                    f32x4 v0 = acc[ai][bj][m][0], v1 = acc[ai][bj][m][1];
                    if (rot) {
                        f32x4 o0, o1;
#pragma unroll
                        for (int j = 0; j < 4; ++j) { o0[j] = __shfl_xor(v0[j], 16); o1[j] = __shfl_xor(v1[j], 16); }
                        if (fq < 2) { v0 = v0 * cs0 + o0 * sn0; v1 = v1 * cs1 + o1 * sn1; }
                    }
                    u32x4 w; w.x = pk2(v0[0], v0[1]); w.y = pk2(v0[2], v0[3]); w.z = pk2(v1[0], v1[1]); w.w = pk2(v1[2], v1[3]);
                    *(u32x4*)(base + (size_t)row * 256 + bj * HALF + wc * 32 + 8 * fq) = w;
                }
            }
    }
};
struct EpiOut {
    static constexpr bool PERM = false;
    Params p;
    DI void operator()(const f32x4 (&acc)[2][2][4][2], const Unit& u, int wr, int wc, int fr, int fq) const {
#pragma unroll
        for (int ai = 0; ai < 2; ++ai)
#pragma unroll
            for (int m = 0; m < 4; ++m) {
                const int row = u.pm * BM + ai * HALF + wr * 64 + m * 16 + fr;
                const float* xr = xrow_ptr(p, row); float* orow = p.out + (size_t)row * DM;
#pragma unroll
                for (int bj = 0; bj < 2; ++bj)
#pragma unroll
                    for (int n = 0; n < 2; ++n) {
                        const int col = u.pn * BM + bj * HALF + wc * 32 + 16 * n + 4 * fq;
                        const f32x4 xv = *(const f32x4*)(xr + col);
                        *(f32x4*)(orow + col) = xv * ALPHA + acc[ai][bj][m][n];
                    }
            }
    }
};
struct EpiGU {
    static constexpr bool PERM = true;
    unsigned char* H;
    DI void operator()(const f32x4 (&acc)[2][2][4][2], const Unit& u, int wr, int wc, int fr, int fq) const {
#pragma unroll
        for (int ai = 0; ai < 2; ++ai)
#pragma unroll
            for (int m = 0; m < 4; ++m) {
                const int row = u.pm * BM + ai * HALF + wr * 64 + m * 16 + fr;
                const f32x4 g0 = acc[ai][0][m][0], g1 = acc[ai][0][m][1], u0 = acc[ai][1][m][0], u1 = acc[ai][1][m][1];
                f32x4 h0, h1;
#pragma unroll
                for (int j = 0; j < 4; ++j) { h0[j] = silu_f(g0[j] * (1.0f / WGU_SCALE)) * (u0[j] * (1.0f / WGU_SCALE)); h1[j] = silu_f(g1[j] * (1.0f / WGU_SCALE)) * (u1[j] * (1.0f / WGU_SCALE)); }
                u32x2 w; w.x = pk4_f8(h0[0], h0[1], h0[2], h0[3]); w.y = pk4_f8(h1[0], h1[1], h1[2], h1[3]);
                *(u32x2*)(H + (size_t)row * FF + u.pn * 128 + wc * 32 + 8 * fq) = w;
            }
    }
};
struct EpiDown {
    static constexpr bool PERM = true;
    bf16_t* eo; const float* gate;
    DI void operator()(const f32x4 (&acc)[2][2][4][2], const Unit& u, int wr, int wc, int fr, int fq) const {
#pragma unroll
        for (int ai = 0; ai < 2; ++ai)
#pragma unroll
            for (int m = 0; m < 4; ++m) {
                const int slot = u.pm * BM + ai * HALF + wr * 64 + m * 16 + fr;
                const float gv = gate[slot] * (1.0f / WD_SCALE);
                bf16_t* orow = eo + (size_t)slot * DM + u.pn * BM + wc * 32 + 8 * fq;
#pragma unroll
                for (int bj = 0; bj < 2; ++bj) {
                    const f32x4 v0 = acc[ai][bj][m][0] * gv, v1 = acc[ai][bj][m][1] * gv;
                    u32x4 w; w.x = pk2(v0[0], v0[1]); w.y = pk2(v0[2], v0[3]); w.z = pk2(v1[0], v1[1]); w.w = pk2(v1[2], v1[3]);
                    *(u32x4*)(orow + bj * HALF) = w;
                }
            }
    }
};
}

DI void transpose_item(const float* W, int ldw, int k0, int n0, bf16_t* WT, int ldt, int drow0, LAS float* scr, int lane) {
#pragma unroll 8
    for (int i = 0; i < 32; ++i) { const int kk = 2 * i + (lane >> 5); scr[kk * 33 + (lane & 31)] = W[(size_t)(k0 + kk) * ldw + n0 + (lane & 31)]; }
    LDS_WAIT();
    const int c = lane & 7;
#pragma unroll
    for (int j = 0; j < 4; ++j) { const int n = (lane >> 3) + 8 * j; const LAS float* s = scr + (8 * c) * 33 + n;
        u32x4 o; o.x = pk2(s[0 * 33], s[1 * 33]); o.y = pk2(s[2 * 33], s[3 * 33]); o.z = pk2(s[4 * 33], s[5 * 33]); o.w = pk2(s[6 * 33], s[7 * 33]);
        *(u32x4*)(WT + (size_t)(drow0 + n) * ldt + k0 + 8 * c) = o; }
    LDS_WAIT();
}

DI void transpose_item_f8(const float* W, int ldw, int k0, int n0, unsigned char* WT, int ldt, int drow0, float scale, LAS float* scr, int lane) {
#pragma unroll 8
    for (int i = 0; i < 32; ++i) { const int kk = 2 * i + (lane >> 5); scr[kk * 33 + (lane & 31)] = W[(size_t)(k0 + kk) * ldw + n0 + (lane & 31)] * scale; }
    LDS_WAIT();
    const int c = lane & 7;
#pragma unroll
    for (int j = 0; j < 4; ++j) { const int n = (lane >> 3) + 8 * j; const LAS float* sp = scr + (8 * c) * 33 + n;
        u32x2 o; o.x = pk4_f8(sp[0 * 33], sp[1 * 33], sp[2 * 33], sp[3 * 33]); o.y = pk4_f8(sp[4 * 33], sp[5 * 33], sp[6 * 33], sp[7 * 33]);
        *(u32x2*)(WT + (size_t)(drow0 + n) * ldt + k0 + 8 * c) = o; }
    LDS_WAIT();
}

DI void sincos_small(double r, double& s, double& c) {
    const double r2 = r * r; double ss = 1.0, cc = 1.0;
#pragma unroll
    for (int n = 12; n >= 1; --n) { ss = 1.0 - ss * r2 * (1.0 / (double)((2 * n) * (2 * n + 1))); cc = 1.0 - cc * r2 * (1.0 / (double)((2 * n - 1) * (2 * n))); }
    s = r * ss; c = cc;
}

DI void dot16(const f32x4 (&v)[4], const LAS float* wT, int lane, float (&r)[16]) {
#pragma unroll
    for (int e = 0; e < 16; ++e) {
        float a = 0.f;
        if ((e & 1) == 0) asm volatile("" ::: "memory");
#pragma unroll
        for (int j = 0; j < 4; ++j) { const f32x4 w = *(const LAS f32x4*)(wT + e * 1024 + 256 * j + 4 * lane); a += v[j][0] * w[0] + v[j][1] * w[1] + v[j][2] * w[2] + v[j][3] * w[3]; }
        r[e] = wave_sum(a);
    }
}

DI void phase0(const Params& p, LAS unsigned char* lds, int gw, int NGW, int wave, int lane) {
    const int tid = TIDX(wave);
    {
        LAS float* scr = (LAS float*)(lds + wave * 16384);
        for (int it = gw; it < 2048; it += NGW) {
            if (it < 1536) { const int kb = it / 96, nb = it % 96; transpose_item(p.in[2], INW, 64 * kb, 32 * nb, (bf16_t*)(p.ws + WS_WI), DM, 32 * nb, scr, lane); }
            else { const int r = it - 1536, kb = r / 32, nb = r % 32; transpose_item(p.in[9], DM, 64 * kb, 32 * nb, (bf16_t*)(p.ws + WS_WO), DM, 32 * nb, scr, lane); }
        }
    }
    {
        float* rope = (float*)(p.ws + WS_ROPE);
        const float invf[8] = {1.0f, 0.1939227432012558f, 0.03760603070259094f, 0.007292664609849453f, 0.0014142135623842478f, 0.00027424818836152554f, 5.318296098266728e-05f, 1.0313386155758053e-05f};
        for (int id = blockIdx.x * NTHR + tid; id < 8192 * 8; id += gridDim.x * NTHR) {
            const int pos = id >> 3, i = id & 7;
            float inv = invf[0];
#pragma unroll
            for (int k = 1; k < 8; ++k) inv = (i == k) ? invf[k] : inv;
            const float ang = (float)pos * inv;
            const double x = (double)ang; const double kq = rint(x * 0.15915494309189535); const double r = x - kq * 6.283185307179586476925;
            double s, c; sincos_small(r, s, c);
            rope[pos * 16 + i] = (float)c; rope[pos * 16 + 8 + i] = (float)s;
        }
    }
    __syncthreads();
    LAS float* wT = (LAS float*)lds;
    for (int id = tid; id < 16384; id += NTHR) { const int k = id >> 4, e = id & 15; wT[e * 1024 + k] = p.in[2][(size_t)k * INW + 3072 + e]; }
    __syncthreads();
    const float* dtb = p.in[5];
    float bias = 0.f;
    if (lane < 16) bias = dtb[lane];
    bf16_t* xb = (bf16_t*)(p.ws + WS_XB); float* dtout = (float*)(p.ws + WS_DT);
    for (int t = gw; t < TT; t += NGW) {
        const f32x4* xr = (const f32x4*)xrow_ptr(p, t) + lane;
        f32x4 v[4];
#pragma unroll
        for (int j = 0; j < 4; ++j) v[j] = xr[64 * j];
        u32x2* o8 = (u32x2*)(xb + (size_t)t * DM) + lane;
#pragma unroll
        for (int j = 0; j < 4; ++j) { u32x2 w; w.x = pk2(v[j][0], v[j][1]); w.y = pk2(v[j][2], v[j][3]); o8[64 * j] = w; }
        float r[16]; dot16(v, wT, lane, r);
        float mine = 0.f;
#pragma unroll
        for (int e = 0; e < 16; ++e) mine = (lane == e) ? r[e] : mine;
        if (lane < 16) { const float z = mine + bias; dtout[(size_t)t * 16 + lane] = fmaxf(z, 0.f) + log1pf(__expf(-fabsf(z))); }
    }
}

DI void conv_phase(const Params& p, int wave) {
    const int tid = blockIdx.x * NTHR + TIDX(wave), nthr = gridDim.x * NTHR;
    const int c = tid & 127, ch = 8 * c, tile = ch >> 8, cit = ch & 255;
    const float* cw = p.in[3]; const float* cb = p.in[4];
    float w[5][8], b[8];
#pragma unroll
    for (int j = 0; j < 5; ++j)
#pragma unroll
        for (int e = 0; e < 8; ++e) w[j][e] = cw[j * 1024 + ch + e];
#pragma unroll
    for (int e = 0; e < 8; ++e) b[e] = cb[ch + e];
    const bf16_t* src = (const bf16_t*)(p.ws + WS_P) + (size_t)(8 + tile) * TILE_ELEMS + cit;
    bf16_t* dst = (bf16_t*)(p.ws + WS_XC) + (size_t)tile * TILE_ELEMS + cit;
    for (int it = tid; it < TT * 128; it += nthr) {
        const int t = it >> 7;
        const int S = t < TP ? 4096 : 8192, s = t & (S - 1);
        float a[8];
#pragma unroll
        for (int e = 0; e < 8; ++e) a[e] = b[e];
#pragma unroll
        for (int j = 0; j < 5; ++j) {
            const int sj = s + j - 2;
            if (sj >= 0 && sj < S) {
                const u32x4 v = *(const u32x4*)(src + (size_t)(t + j - 2) * 256);
                a[0] += bflo(v.x) * w[j][0]; a[1] += bfhi(v.x) * w[j][1]; a[2] += bflo(v.y) * w[j][2]; a[3] += bfhi(v.y) * w[j][3];
                a[4] += bflo(v.z) * w[j][4]; a[5] += bfhi(v.z) * w[j][5]; a[6] += bflo(v.w) * w[j][6]; a[7] += bfhi(v.w) * w[j][7];
            }
        }
        u32x4 o; o.x = pk2(silu_f(a[0]), silu_f(a[1])); o.y = pk2(silu_f(a[2]), silu_f(a[3])); o.z = pk2(silu_f(a[4]), silu_f(a[5])); o.w = pk2(silu_f(a[6]), silu_f(a[7]));
        *(u32x4*)(dst + (size_t)t * 256) = o;
    }
}

DI bf16x8 tr_pair(const LAS bf16_t* lo, const LAS bf16_t* hi) {
    const s16x4 a = __builtin_amdgcn_ds_read_tr16_b64_v4i16((LAS s16x4*)lo), b = __builtin_amdgcn_ds_read_tr16_b64_v4i16((LAS s16x4*)hi);
    return __builtin_shufflevector(a, b, 0, 1, 2, 3, 4, 5, 6, 7);
}
DI void attn_step_params(int sidx, int p0, int& d, int& base, int& nk, int& kbase, bool& actA, bool& actB) {
    const int pi = sidx < 12 ? 0 : (sidx < 18 ? 1 : 2);
    const int st = sidx - (pi == 0 ? 0 : (pi == 1 ? 12 : (sidx < 23 ? 18 : 23)));
    d = 1 << (2 * pi); base = p0 - 64 * d + (sidx >= 23 ? 8 : 0); nk = pi == 0 ? 377 : (pi == 1 ? 191 : 144); kbase = 32 * st;
    actA = sidx < 23; actB = sidx < 18 || sidx >= 23;
}
DI void attn_phase(const Params& p, LAS unsigned char* lds, int gw, int NGW, int wave, int lane) {
    LAS bf16_t* Vn = (LAS bf16_t*)(lds + wave * 4608);
    const bf16_t* Pb = (const bf16_t*)(p.ws + WS_P);
    bf16_t* mix = (bf16_t*)(p.ws + WS_MIX);
    const int c = lane & 15, q = lane >> 4, qp = (lane & 15) >> 2, pp = lane & 3;
    for (int wi = gw; wi < 12288; wi += NGW) {
        const int head = wi & 7, qg = wi >> 3;
        const int t0 = (qg >> 3) * 256 + (qg & 7);
        const int S = t0 < TP ? 4096 : 8192, sbase = t0 & ~(S - 1), p0 = t0 - sbase;
        const int hoff = (head & 3) * 64;
        const bf16_t* Qt = Pb + (size_t)(0 + (head >> 2)) * TILE_ELEMS + hoff;
        const bf16_t* Kt = Pb + (size_t)(2 + (head >> 2)) * TILE_ELEMS + hoff;
        const bf16_t* Vg = Pb + (size_t)(4 + (head >> 2)) * TILE_ELEMS + hoff;
        bf16x8 qf[2][2];
#pragma unroll
        for (int X = 0; X < 2; ++X) { const bf16_t* qrow = Qt + (size_t)(t0 + 8 * X + 16 * c) * 256; qf[X][0] = *(const bf16x8*)(qrow + 8 * q); qf[X][1] = *(const bf16x8*)(qrow + 32 + 8 * q); }
        f32x4 O[2][4];
#pragma unroll
        for (int X = 0; X < 2; ++X)
#pragma unroll
            for (int d4 = 0; d4 < 4; ++d4) O[X][d4] = (f32x4){0.f, 0.f, 0.f, 0.f};
        float mrun[2] = {-1e30f, -1e30f}, lsum[2] = {0.f, 0.f};
        u32x4 vc[4], vn[4]; bf16x8 kc[2][2], kn[2][2];
#define ATT_LOADS(sidx_, V_, K_) do { int d_, base_, nk_, kbase_; bool a_, b_; attn_step_params(sidx_, p0, d_, base_, nk_, kbase_, a_, b_); \
            _Pragma("unroll") for (int i = 0; i < 4; ++i) { const int id = lane + 64 * i, key = id >> 3, dc = id & 7; \
                int pos = base_ + d_ * (kbase_ + key); pos = pos < 0 ? 0 : (pos > S - 1 ? S - 1 : pos); \
                V_[i] = *(const u32x4*)(Vg + (size_t)(sbase + pos) * 256 + 8 * dc); } \
            _Pragma("unroll") for (int kt = 0; kt < 2; ++kt) { int pos = base_ + d_ * (kbase_ + 16 * kt + c); pos = pos < 0 ? 0 : (pos > S - 1 ? S - 1 : pos); \
                const bf16_t* krow = Kt + (size_t)(sbase + pos) * 256; K_[kt][0] = *(const bf16x8*)(krow + 8 * q); K_[kt][1] = *(const bf16x8*)(krow + 32 + 8 * q); } } while (0)
        ATT_LOADS(0, vc, kc);
        for (int sidx = 0; sidx < 28; ++sidx) {
            if (sidx < 27) ATT_LOADS(sidx + 1, vn, kn);
            int d, base, nk, kbase; bool act[2]; attn_step_params(sidx, p0, d, base, nk, kbase, act[0], act[1]);
            const int win = 64 * d;
#pragma unroll
            for (int i = 0; i < 4; ++i) { const int id = lane + 64 * i; *(LAS u32x4*)(Vn + (id >> 3) * 72 + 8 * (id & 7)) = vc[i]; }
            bf16x8 vf[4];
#pragma unroll
            for (int d4 = 0; d4 < 4; ++d4) { const LAS bf16_t* vr = Vn + (4 * q + qp) * 72 + 16 * d4 + 4 * pp; vf[d4] = tr_pair(vr, vr + 16 * 72); }
#pragma unroll
            for (int X = 0; X < 2; ++X) {
                if (act[X]) {
                    const int pq = p0 + 8 * X + 16 * c;
                    f32x4 sc[2];
#pragma unroll
                    for (int kt = 0; kt < 2; ++kt) {
                        f32x4 a = {0.f, 0.f, 0.f, 0.f};
                        a = __builtin_amdgcn_mfma_f32_16x16x32_bf16(kc[kt][0], qf[X][0], a, 0, 0, 0);
                        a = __builtin_amdgcn_mfma_f32_16x16x32_bf16(kc[kt][1], qf[X][1], a, 0, 0, 0);
                        sc[kt] = a;
                    }
                    bool valid[2][4]; float mloc = -1e30f;
#pragma unroll
                    for (int kt = 0; kt < 2; ++kt)
#pragma unroll
                        for (int j = 0; j < 4; ++j) {
                            const int kk = kbase + 16 * kt + 4 * q + j, pk = base + d * kk;
                            int df = pk - pq; df = df < 0 ? -df : df;
                            valid[kt][j] = (kk < nk) && (pk >= 0) && (pk < S) && (df <= win);
                            const float sv = valid[kt][j] ? sc[kt][j] * 0.125f : -1e30f;
                            sc[kt][j] = sv; mloc = fmaxf(mloc, sv);
                        }
                    mloc = fmaxf(mloc, __shfl_xor(mloc, 16)); mloc = fmaxf(mloc, __shfl_xor(mloc, 32));
                    const float mnew = fmaxf(mrun[X], mloc), alpha = __expf(mrun[X] - mnew);
                    mrun[X] = mnew;
                    float ps = 0.f; float pv[2][4];
#pragma unroll
                    for (int kt = 0; kt < 2; ++kt)
#pragma unroll
                        for (int j = 0; j < 4; ++j) { pv[kt][j] = valid[kt][j] ? __expf(sc[kt][j] - mnew) : 0.f; ps += pv[kt][j]; }
                    lsum[X] = lsum[X] * alpha + ps;
                    u32x4 pw; pw.x = pk2(pv[0][0], pv[0][1]); pw.y = pk2(pv[0][2], pv[0][3]); pw.z = pk2(pv[1][0], pv[1][1]); pw.w = pk2(pv[1][2], pv[1][3]);
                    const bf16x8 pf = __builtin_bit_cast(bf16x8, pw);
#pragma unroll
                    for (int d4 = 0; d4 < 4; ++d4) O[X][d4] = __builtin_amdgcn_mfma_f32_16x16x32_bf16(vf[d4], pf, O[X][d4] * alpha, 0, 0, 0);
                }
            }
#pragma unroll
            for (int i = 0; i < 4; ++i) vc[i] = vn[i];
#pragma unroll
            for (int kt = 0; kt < 2; ++kt) { kc[kt][0] = kn[kt][0]; kc[kt][1] = kn[kt][1]; }
        }
#undef ATT_LOADS
#pragma unroll
        for (int X = 0; X < 2; ++X) {
            float l = lsum[X]; l += __shfl_xor(l, 16); l += __shfl_xor(l, 32);
            const float inv = 1.0f / l;
            bf16_t* orow = mix + (size_t)(t0 + 8 * X + 16 * c) * DM + head * 64 + 4 * q;
#pragma unroll
            for (int d4 = 0; d4 < 4; ++d4) { u32x2 w; w.x = pk2(O[X][d4][0] * inv, O[X][d4][1] * inv); w.y = pk2(O[X][d4][2] * inv, O[X][d4][3] * inv); *(u32x2*)(orow + 16 * d4) = w; }
        }
    }
}

constexpr size_t WS_SLOC = WS_P;
constexpr size_t WS_DEC = WS_P + 96 * MiB;
constexpr int N_SSD_ITEMS = 6144;
struct SsdItem { int h, dir, g, tb, ts; float A; };
DI SsdItem ssd_decode(const Params& p, int it) {
    int w, ci; if (it < 4096) { w = it >> 5; ci = it & 31; } else { w = 128 + ((it - 4096) >> 6); ci = (it - 4096) & 63; }
    SsdItem I; const int seq = w >> 4; I.h = (w >> 1) & 7; I.dir = w & 1; I.g = I.h >> 2;
    const int S = seq < 8 ? 4096 : 8192, sbase = seq < 8 ? seq * 4096 : TP + (seq - 8) * 8192;
    I.tb = I.dir ? sbase + S - 1 - 128 * ci : sbase + 128 * ci; I.ts = I.dir ? -1 : 1;
    I.A = -__expf(p.in[6][I.dir * 8 + I.h]);
    return I;
}
#define SSD_TOK(I, l) ((I).tb + (I).ts * (l))
DI void ssd_scan_chunk(float d0, float d1, float A, LAS float* acs, LAS float* dts, int lane) {
    const float v0 = d0 * A, v1 = d1 * A; float ps = v0 + v1;
#pragma unroll
    for (int o = 1; o < 64; o <<= 1) { const float t = __shfl_up(ps, o); if (lane >= o) ps += t; }
    acs[2 * lane] = ps - v1; acs[2 * lane + 1] = ps; dts[2 * lane] = d0; dts[2 * lane + 1] = d1;
}
DI void st_tr8(LAS bf16_t* wp, int stride, const u32x4 v) {
    wp[0 * stride] = (bf16_t)(v.x & 0xffffu); wp[1 * stride] = (bf16_t)(v.x >> 16); wp[2 * stride] = (bf16_t)(v.y & 0xffffu); wp[3 * stride] = (bf16_t)(v.y >> 16);
    wp[4 * stride] = (bf16_t)(v.z & 0xffffu); wp[5 * stride] = (bf16_t)(v.z >> 16); wp[6 * stride] = (bf16_t)(v.w & 0xffffu); wp[7 * stride] = (bf16_t)(v.w >> 16);
}
DI void ssd_state_phase(const Params& p, LAS unsigned char* lds, int wave, int lane) {
    const int tid = TIDX(wave), c = lane & 15, q = lane >> 4, w = wave, qp = (lane & 15) >> 2, pp = lane & 3;
    LAS float* acs = (LAS float*)(lds + 0); LAS float* dts = (LAS float*)(lds + 512);
    LAS bf16_t* Xt2 = (LAS bf16_t*)(lds + 1024); LAS bf16_t* Bt = (LAS bf16_t*)(lds + 1024 + 128 * 144);
    const float* dtb = (const float*)(p.ws + WS_DT);
    const bf16_t* XCb = (const bf16_t*)(p.ws + WS_XC);
    bf16_t* Sl = (bf16_t*)(p.ws + WS_SLOC); float* decv = (float*)(p.ws + WS_DEC);
    int it = (gridDim.x % 8 == 0) ? ((int)blockIdx.x % 8) * ((int)gridDim.x / 8) + (int)blockIdx.x / 8 : (int)blockIdx.x;
    if (it >= N_SSD_ITEMS) return;
    SsdItem I = ssd_decode(p, it);
    float pd0 = 0.f, pd1 = 0.f; u32x4 xv[2], bv[4];
#define SSD_LOADS_A(I) do { \
        if (w == 0) { pd0 = dtb[(size_t)SSD_TOK(I, 2 * lane) * 16 + (I).dir * 8 + (I).h]; pd1 = dtb[(size_t)SSD_TOK(I, 2 * lane + 1) * 16 + (I).dir * 8 + (I).h]; } \
        _Pragma("unroll") for (int i = 0; i < 2; ++i) { const int id = tid + NTHR * i, l = id >> 3, pc = id & 7; \
            xv[i] = *(const u32x4*)(XCb + (size_t)((I).h >> 2) * TILE_ELEMS + (size_t)SSD_TOK(I, l) * 256 + ((I).h & 3) * 64 + 8 * pc); } \
        _Pragma("unroll") for (int i = 0; i < 4; ++i) { const int id = tid + NTHR * i, l = id >> 4, ncn = id & 15; \
            bv[i] = *(const u32x4*)(XCb + 2 * TILE_ELEMS + (size_t)SSD_TOK(I, l) * 256 + (I).g * 128 + 8 * ncn); } } while (0)
    SSD_LOADS_A(I);
    for (; it < N_SSD_ITEMS; it += gridDim.x) {
        if (w == 0) ssd_scan_chunk(pd0, pd1, I.A, acs, dts, lane);
        __syncthreads();
        const float aend = acs[127];
#pragma unroll
        for (int i = 0; i < 2; ++i) {
            const int id = tid + NTHR * i, l = id >> 3, pc = id & 7;
            const float s2 = dts[l] * __expf(aend - acs[l]);
            const u32x4 v = xv[i];
            u32x4 o; o.x = pk2(bflo(v.x) * s2, bfhi(v.x) * s2); o.y = pk2(bflo(v.y) * s2, bfhi(v.y) * s2); o.z = pk2(bflo(v.z) * s2, bfhi(v.z) * s2); o.w = pk2(bflo(v.w) * s2, bfhi(v.w) * s2);
            *(LAS u32x4*)(Xt2 + l * 72 + 8 * pc) = o;
        }
#pragma unroll
        for (int i = 0; i < 4; ++i) { const int id = tid + NTHR * i; *(LAS u32x4*)(Bt + (id >> 4) * 136 + 8 * (id & 15)) = bv[i]; }
        const int itn = it + gridDim.x;
        if (itn < N_SSD_ITEMS) { I = ssd_decode(p, itn); SSD_LOADS_A(I); }
        __syncthreads();
        bf16_t* so = Sl + (size_t)it * 8192 + 16 * w + 4 * q;
#pragma unroll
        for (int pt = 0; pt < 4; ++pt) {
            f32x4 a = {0.f, 0.f, 0.f, 0.f};
#pragma unroll
            for (int ks = 0; ks < 4; ++ks) {
                const LAS bf16_t* br = Bt + (32 * ks + 8 * q + qp) * 136 + 16 * w + 4 * pp;
                const LAS bf16_t* xr = Xt2 + (32 * ks + 8 * q + qp) * 72 + 16 * pt + 4 * pp;
                const bf16x8 bfr = tr_pair(br, br + 4 * 136), xf = tr_pair(xr, xr + 4 * 72);
                a = __builtin_amdgcn_mfma_f32_16x16x32_bf16(bfr, xf, a, 0, 0, 0);
            }
            u32x2 o; o.x = pk2(a[0], a[1]); o.y = pk2(a[2], a[3]);
            *(u32x2*)(so + (16 * pt + c) * 128) = o;
        }
        if (tid == 0) decv[it] = __expf(aend);
    }
#undef SSD_LOADS_A
}
DI void ssd_scan_phase(const Params& p, int wave) {
    unsigned* Sl = (unsigned*)(p.ws + WS_SLOC); const float* decv = (const float*)(p.ws + WS_DEC);
    for (int chain = blockIdx.x * NTHR + TIDX(wave); chain < 160 * 4096; chain += gridDim.x * NTHR) {
        const int w = chain >> 12, j = chain & 4095;
        const int nc = w < 128 ? 32 : 64, cb = w < 128 ? 32 * w : 4096 + 64 * (w - 128);
        unsigned* ptr = Sl + (size_t)cb * 4096 + j; const float* dp = decv + cb;
        float s0 = 0.f, s1 = 0.f;
        for (int c0 = 0; c0 < nc; c0 += 8) {
            unsigned v[8]; float d[8];
#pragma unroll
            for (int k = 0; k < 8; ++k) { v[k] = ptr[(size_t)(c0 + k) * 4096]; d[k] = dp[c0 + k]; }
#pragma unroll
            for (int k = 0; k < 8; ++k) { ptr[(size_t)(c0 + k) * 4096] = pk2(s0, s1); s0 = s0 * d[k] + bflo(v[k]); s1 = s1 * d[k] + bfhi(v[k]); }
        }
    }
}
constexpr int SSDC_ACS = 0  , SSDC_XT1 = 2048, SSDC_BN = SSDC_XT1 + 128 * 144, SSDC_SBF = SSDC_BN + 128 * 272, SSDC_END = SSDC_SBF + 64 * 272;
static_assert(SSDC_END <= 131072, "ssd lds");
DI void ssd_out_phase(const Params& p, LAS unsigned char* lds, int wave, int lane) {
    const int tid = TIDX(wave), c = lane & 15, q = lane >> 4, w = wave, qp = (lane & 15) >> 2, pp = lane & 3;
    LAS bf16_t* Xt1 = (LAS bf16_t*)(lds + SSDC_XT1); LAS bf16_t* Bn = (LAS bf16_t*)(lds + SSDC_BN); LAS bf16_t* Sbf = (LAS bf16_t*)(lds + SSDC_SBF);
    const float* dtb = (const float*)(p.ws + WS_DT);
    const bf16_t* XCb = (const bf16_t*)(p.ws + WS_XC);
    const bf16_t* Sl = (const bf16_t*)(p.ws + WS_SLOC);
    int it = (gridDim.x % 8 == 0) ? ((int)blockIdx.x % 8) * ((int)gridDim.x / 8) + (int)blockIdx.x / 8 : (int)blockIdx.x;
    if (it >= N_SSD_ITEMS) return;
    SsdItem I = ssd_decode(p, it);
    float pd0 = 0.f, pd1 = 0.f; u32x4 xv[2], bv[4], sv[2]; bf16x8 Cn[4];
#define SSD_LOADS_C(I, itx) do { \
        if (w == 0) { pd0 = dtb[(size_t)SSD_TOK(I, 2 * lane) * 16 + (I).dir * 8 + (I).h]; pd1 = dtb[(size_t)SSD_TOK(I, 2 * lane + 1) * 16 + (I).dir * 8 + (I).h]; } \
        _Pragma("unroll") for (int i = 0; i < 2; ++i) { const int id = tid + NTHR * i, l = id >> 3, pc = id & 7; \
            xv[i] = *(const u32x4*)(XCb + (size_t)((I).h >> 2) * TILE_ELEMS + (size_t)SSD_TOK(I, l) * 256 + ((I).h & 3) * 64 + 8 * pc); \
            sv[i] = *(const u32x4*)(Sl + (size_t)(itx) * 8192 + (size_t)id * 8); } \
        _Pragma("unroll") for (int i = 0; i < 4; ++i) { const int id = tid + NTHR * i, l = id >> 4, ncn = id & 15; \
            bv[i] = *(const u32x4*)(XCb + 2 * TILE_ELEMS + (size_t)SSD_TOK(I, l) * 256 + (I).g * 128 + 8 * ncn); } \
        { const bf16_t* cr = XCb + 3 * TILE_ELEMS + (size_t)SSD_TOK(I, 16 * w + c) * 256 + (I).g * 128 + 8 * q; \
          _Pragma("unroll") for (int ks = 0; ks < 4; ++ks) Cn[ks] = *(const bf16x8*)(cr + 32 * ks); } } while (0)
    SSD_LOADS_C(I, it);
    int par = 0;
    for (; it < N_SSD_ITEMS; it += gridDim.x, par ^= 1) {
        LAS float* acs = (LAS float*)(lds + SSDC_ACS + par * 1024); LAS float* dts = acs + 128;
        if (w == 0) ssd_scan_chunk(pd0, pd1, I.A, acs, dts, lane);
        __syncthreads();
#pragma unroll
        for (int i = 0; i < 2; ++i) {
            const int id = tid + NTHR * i, l = id >> 3, pc = id & 7;
            const float s1 = dts[l];
            const u32x4 v = xv[i];
            u32x4 o; o.x = pk2(bflo(v.x) * s1, bfhi(v.x) * s1); o.y = pk2(bflo(v.y) * s1, bfhi(v.y) * s1); o.z = pk2(bflo(v.z) * s1, bfhi(v.z) * s1); o.w = pk2(bflo(v.w) * s1, bfhi(v.w) * s1);
            *(LAS u32x4*)(Xt1 + l * 72 + 8 * pc) = o;
            *(LAS u32x4*)(Sbf + (id >> 4) * 136 + 8 * (id & 15)) = sv[i];
        }
#pragma unroll
        for (int i = 0; i < 4; ++i) { const int id = tid + NTHR * i; *(LAS u32x4*)(Bn + (id >> 4) * 136 + 8 * (id & 15)) = bv[i]; }
        bf16x8 Cf[4];
#pragma unroll
        for (int ks = 0; ks < 4; ++ks) Cf[ks] = Cn[ks];
        const SsdItem Ic = I;
        const int itn = it + gridDim.x;
        if (itn < N_SSD_ITEMS) { I = ssd_decode(p, itn); SSD_LOADS_C(I, itn); }
        __syncthreads();
        {
            const int l = 16 * w + c;
            const float al = acs[l];
            f32x4 acc[4];
#pragma unroll
            for (int pt = 0; pt < 4; ++pt) {
                f32x4 a = {0.f, 0.f, 0.f, 0.f};
#pragma unroll
                for (int ks = 0; ks < 4; ++ks) { const bf16x8 sf = *(const LAS bf16x8*)(Sbf + (16 * pt + c) * 136 + 32 * ks + 8 * q); a = __builtin_amdgcn_mfma_f32_16x16x32_bf16(sf, Cf[ks], a, 0, 0, 0); }
                acc[pt] = a * __expf(al);
            }
            const int nsp = (w >> 1) + 1;
            for (int sp = 0; sp < nsp; ++sp) {
                f32x4 M[2];
#pragma unroll
                for (int hh = 0; hh < 2; ++hh) {
                    const int st = 2 * sp + hh;
                    f32x4 G = {0.f, 0.f, 0.f, 0.f};
                    if (st <= w) {
#pragma unroll
                        for (int ks = 0; ks < 4; ++ks) { const bf16x8 bfr = *(const LAS bf16x8*)(Bn + (16 * st + c) * 136 + 32 * ks + 8 * q); G = __builtin_amdgcn_mfma_f32_16x16x32_bf16(bfr, Cf[ks], G, 0, 0, 0); }
#pragma unroll
                        for (int j = 0; j < 4; ++j) { const int s = 16 * st + 4 * q + j; const float e = __expf(al - acs[s]); G[j] = (s <= l) ? G[j] * e : 0.f; }
                    }
                    M[hh] = G;
                }
                u32x4 pw; pw.x = pk2(M[0][0], M[0][1]); pw.y = pk2(M[0][2], M[0][3]); pw.z = pk2(M[1][0], M[1][1]); pw.w = pk2(M[1][2], M[1][3]);
                const bf16x8 pf = __builtin_bit_cast(bf16x8, pw);
#pragma unroll
                for (int pt = 0; pt < 4; ++pt) {
                    const LAS bf16_t* xr = Xt1 + (32 * sp + 4 * q + qp) * 72 + 16 * pt + 4 * pp;
                    const bf16x8 xf = tr_pair(xr, xr + 16 * 72);
                    acc[pt] = __builtin_amdgcn_mfma_f32_16x16x32_bf16(xf, pf, acc[pt], 0, 0, 0);
                }
            }
            bf16_t* yr = (bf16_t*)(p.ws + (Ic.dir ? WS_YB : WS_YF)) + Ic.h * 64 + (size_t)SSD_TOK(Ic, l) * 512 + 4 * q;
#pragma unroll
            for (int pt = 0; pt < 4; ++pt) { u32x2 o; o.x = pk2(acc[pt][0], acc[pt][1]); o.y = pk2(acc[pt][2], acc[pt][3]); *(u32x2*)(yr + 16 * pt) = o; }
        }
    }
#undef SSD_LOADS_C
}

DI void gate_phase(const Params& p, int gw, int NGW, int lane) {
    const bf16_t* yf = (const bf16_t*)(p.ws + WS_YF); const bf16_t* yb = (const bf16_t*)(p.ws + WS_YB);
    const bf16_t* xh = (const bf16_t*)(p.ws + WS_XC) + (size_t)(lane >> 5) * TILE_ELEMS + (8 * lane & 255);
    const bf16_t* zt = (const bf16_t*)(p.ws + WS_P) + (size_t)(6 + (lane >> 5)) * TILE_ELEMS + (8 * lane & 255);
    bf16_t* mix = (bf16_t*)(p.ws + WS_MIX) + 512 + 8 * lane;
    const float D = p.in[7][lane >> 3];
    float nw[8];
#pragma unroll
    for (int e = 0; e < 8; ++e) nw[e] = p.in[8][8 * lane + e];
    for (int t = gw; t < TT; t += NGW) {
        const u32x4 a = *(const u32x4*)(yf + (size_t)t * 512 + 8 * lane), b = *(const u32x4*)(yb + (size_t)t * 512 + 8 * lane);
        const u32x4 x = *(const u32x4*)(xh + (size_t)t * 256), z = *(const u32x4*)(zt + (size_t)t * 256);
        float y[8];
        y[0] = (bflo(a.x) + bflo(b.x) + D * bflo(x.x)) * silu_f(bflo(z.x)); y[1] = (bfhi(a.x) + bfhi(b.x) + D * bfhi(x.x)) * silu_f(bfhi(z.x));
        y[2] = (bflo(a.y) + bflo(b.y) + D * bflo(x.y)) * silu_f(bflo(z.y)); y[3] = (bfhi(a.y) + bfhi(b.y) + D * bfhi(x.y)) * silu_f(bfhi(z.y));
        y[4] = (bflo(a.z) + bflo(b.z) + D * bflo(x.z)) * silu_f(bflo(z.z)); y[5] = (bfhi(a.z) + bfhi(b.z) + D * bfhi(x.z)) * silu_f(bfhi(z.z));
        y[6] = (bflo(a.w) + bflo(b.w) + D * bflo(x.w)) * silu_f(bflo(z.w)); y[7] = (bfhi(a.w) + bfhi(b.w) + D * bfhi(x.w)) * silu_f(bfhi(z.w));
        float ss = 0.f;
#pragma unroll
        for (int e = 0; e < 8; ++e) ss += y[e] * y[e];
        ss = wave_sum(ss);
        const float r = 1.0f / sqrtf(ss * (1.0f / 512.0f) + RMS_EPS);
        u32x4 o; o.x = pk2(y[0] * r * nw[0], y[1] * r * nw[1]); o.y = pk2(y[2] * r * nw[2], y[3] * r * nw[3]); o.z = pk2(y[4] * r * nw[4], y[5] * r * nw[5]); o.w = pk2(y[6] * r * nw[6], y[7] * r * nw[7]);
        *(u32x4*)(mix + (size_t)t * DM) = o;
    }
}

DI void expert_gu_weights_phase(const Params& p, LAS unsigned char* lds, int gw, int NGW, int wave, int lane) {
    LAS float* scr = (LAS float*)(lds + wave * 16384);
    for (int it = gw; it < 16 * 2816; it += NGW) {
        const int e = it / 2816, r = it % 2816;
        const int isup = r >= 1408, rr = isup ? r - 1408 : r, kb = rr / 88, nb = rr % 88, n0 = 32 * nb;
        const float* W = (isup ? p.in[14] : p.in[13]) + (size_t)e * DM * FF;
        transpose_item_f8(W, FF, 64 * kb, n0, p.ws + WS_WGU, DM, e * 5632 + 256 * (n0 >> 7) + (n0 & 127) + (isup ? 128 : 0), WGU_SCALE, scr, lane);
    }
}
DI void expert_down_weights(const Params& p, LAS unsigned char* lds, int vw, int NVW, int wave, int lane) {
    LAS float* scr = (LAS float*)(lds + 4096 + wave * 16384);
    for (int it = vw; it < 16 * 1408; it += NVW) {
        const int e = it / 1408, rr = it % 1408, kb = rr / 32, nb = rr % 32;
        transpose_item_f8(p.in[15] + (size_t)e * FF * DM, DM, 64 * kb, 32 * nb, p.ws + WS_WD, FF, e * 1024 + 32 * nb, WD_SCALE, scr, lane);
    }
}

DI void ln1_router_phase(const Params& p, LAS unsigned char* lds, int gw, int NGW, int wave, int lane) {
    const int tid = TIDX(wave);
    LAS float* wT = (LAS float*)lds;
    for (int id = tid; id < 16384; id += NTHR) { const int k = id >> 4, e = id & 15; wT[e * 1024 + k] = p.in[12][id]; }
    __syncthreads();
    f32x4 gg[4], bb[4];
#pragma unroll
    for (int j = 0; j < 4; ++j) { gg[j] = ((const f32x4*)p.in[10])[64 * j + lane]; bb[j] = ((const f32x4*)p.in[11])[64 * j + lane]; }
    unsigned char* x1b = p.ws + WS_X1B; float* aff = (float*)(p.ws + WS_AFF);
    for (int t = gw; t < TT; t += NGW) {
        f32x4* orow = (f32x4*)(p.out + (size_t)t * DM) + lane;
        f32x4 v[4]; float s = 0.f;
#pragma unroll
        for (int j = 0; j < 4; ++j) { v[j] = orow[64 * j]; s += (v[j][0] + v[j][1]) + (v[j][2] + v[j][3]); }
        const float mean = wave_sum(s) * (1.0f / DM); float s2 = 0.f;
#pragma unroll
        for (int j = 0; j < 4; ++j) { v[j] = v[j] - mean; s2 += (v[j][0] * v[j][0] + v[j][1] * v[j][1]) + (v[j][2] * v[j][2] + v[j][3] * v[j][3]); }
        const float rstd = 1.0f / sqrtf(wave_sum(s2) * (1.0f / DM) + LN_EPS);
        unsigned* o4 = (unsigned*)(x1b + (size_t)t * DM) + lane;
#pragma unroll
        for (int j = 0; j < 4; ++j) {
            v[j] = v[j] * rstd * gg[j] + bb[j];
            orow[64 * j] = v[j] * ALPHA;
            o4[64 * j] = pk4_f8(v[j][0], v[j][1], v[j][2], v[j][3]);
        }
        float r[16]; dot16(v, wT, lane, r);
        float mx = r[0];
#pragma unroll
        for (int e = 1; e < 16; ++e) mx = fmaxf(mx, r[e]);
        float den = 0.f, mine = 0.f;
#pragma unroll
        for (int e = 0; e < 16; ++e) { const float ex = __expf(r[e] - mx); den += ex; mine = (lane == e) ? ex : mine; }
        if (lane < 16) aff[(size_t)lane * TT + t] = mine / den;
    }
}

DI void select_phase(const Params& p, LAS unsigned char* lds, int wave, int lane) {
    const int wk = blockIdx.x;
    if (wk >= 32) { expert_down_weights(p, lds, (wk - 32) * 8 + wave, ((int)gridDim.x - 32) * 8, wave, lane); return; }
    const int tid = TIDX(wave);
    const int trunk = wk >> 4, e = wk & 15;
    const int Tn = trunk ? 16384 : 32768, tbase = trunk ? TP : 0, cap = Tn / 8;
    const unsigned* col = (const unsigned*)(p.ws + WS_AFF) + (size_t)e * TT + tbase;
    LAS unsigned* hist = (LAS unsigned*)lds;
    LAS unsigned* ctl = (LAS unsigned*)(lds + 1024);
    LAS unsigned* wcnt = (LAS unsigned*)(lds + 2048);
    unsigned prefix = 0, remaining = (unsigned)cap;
    for (int pass = 0; pass < 4; ++pass) {
        const int shift = 24 - 8 * pass;
        for (int i = tid; i < 256; i += NTHR) hist[i] = 0u;
        __syncthreads();
        for (int i = tid; i < Tn; i += NTHR) {
            const unsigned bits = col[i];
            if (pass == 0 || (bits >> (shift + 8)) == prefix) atomicAdd((unsigned*)(hist + ((bits >> shift) & 255u)), 1u);
        }
        __syncthreads();
        if (wave == 0) {
            const unsigned h0 = hist[4 * lane], h1 = hist[4 * lane + 1], h2 = hist[4 * lane + 2], h3 = hist[4 * lane + 3], tot = h0 + h1 + h2 + h3;
            unsigned v = tot;
#pragma unroll
            for (int o = 1; o < 64; o <<= 1) { const unsigned t = __shfl_down(v, o); if (lane + o < 64) v += t; }
            const unsigned excl = v - tot;
            if (excl < remaining && remaining <= excl + tot) {
                unsigned cum = excl; int b;
                if (cum + h3 >= remaining) b = 3; else { cum += h3; if (cum + h2 >= remaining) b = 2; else { cum += h2; if (cum + h1 >= remaining) b = 1; else { cum += h1; b = 0; } } }
                ctl[0] = (prefix << 8) | (unsigned)(4 * lane + b); ctl[1] = remaining - cum;
            }
        }
        __syncthreads();
        prefix = ctl[0]; remaining = ctl[1];
        __syncthreads();
    }
    const unsigned thr = prefix, need_eq = remaining;
    int* idx = (int*)(p.ws + WS_IDX) + e * SLOTS_E + (trunk ? 4096 : 0);
    int* inv = (int*)(p.ws + WS_INV) + (size_t)e * TT + tbase;
    const int slot0 = e * SLOTS_E + (trunk ? 4096 : 0);
    float* gate = (float*)(p.ws + WS_GATE) + e * SLOTS_E + (trunk ? 4096 : 0);
    unsigned base_gt = 0, base_eq = 0;
    for (int b0 = 0; b0 < Tn; b0 += 4 * NTHR) {
        const u32x4 bits4 = *(const u32x4*)(col + b0 + 4 * tid);
        const unsigned bits[4] = {bits4.x, bits4.y, bits4.z, bits4.w};
        unsigned packed = 0;
#pragma unroll
        for (int j = 0; j < 4; ++j) packed += (bits[j] > thr ? 1u : 0u) + (bits[j] == thr ? 0x10000u : 0u);
        unsigned v = packed;
#pragma unroll
        for (int o = 1; o < 64; o <<= 1) { const unsigned t = __shfl_up(v, o); if (lane >= o) v += t; }
        if (lane == 63) wcnt[wave] = v;
        __syncthreads();
        unsigned off = 0, tot = 0;
#pragma unroll
        for (int w2 = 0; w2 < 8; ++w2) { const unsigned cnt = wcnt[w2]; off += (w2 < wave) ? cnt : 0u; tot += cnt; }
        const unsigned ex = off + (v - packed);
        unsigned gt_before = base_gt + (ex & 0xffffu), eq_before = base_eq + (ex >> 16);
        int invv[4];
#pragma unroll
        for (int j = 0; j < 4; ++j) {
            const bool gt = bits[j] > thr, eq = bits[j] == thr;
            const bool sel = gt || (eq && eq_before < need_eq);
            const unsigned pos = gt_before + (eq_before < need_eq ? eq_before : need_eq);
            const bool ok = sel && pos < (unsigned)cap;
            if (ok) { idx[pos] = tbase + b0 + 4 * tid + j; gate[pos] = __uint_as_float(bits[j]); }
            invv[j] = ok ? slot0 + (int)pos : -1;
            gt_before += gt ? 1u : 0u; eq_before += eq ? 1u : 0u;
        }
        *(i32x4*)(inv + b0 + 4 * tid) = (i32x4){invv[0], invv[1], invv[2], invv[3]};
        base_gt += tot & 0xffffu; base_eq += tot >> 16;
        __syncthreads();
    }
}

DI void ln2_phase(const Params& p, int gw, int NGW, int lane) {
    f32x4 gg[4], bb[4];
#pragma unroll
    for (int j = 0; j < 4; ++j) { gg[j] = ((const f32x4*)p.in[16])[64 * j + lane]; bb[j] = ((const f32x4*)p.in[17])[64 * j + lane]; }
    const int* inv = (const int*)(p.ws + WS_INV); const bf16_t* eo = (const bf16_t*)(p.ws + WS_EO);
    for (int t = gw; t < TT; t += NGW) {
        f32x4* orow = (f32x4*)(p.out + (size_t)t * DM) + lane;
        f32x4 v[4]; float s = 0.f;
#pragma unroll
        for (int j = 0; j < 4; ++j) v[j] = orow[64 * j];
        const int myslot = lane < 16 ? inv[(size_t)lane * TT + t] : -1;
        for (int e = 0; e < 16; ++e) {
            const int sl = __shfl(myslot, e);
            if (sl >= 0) {
                const u32x2* er = (const u32x2*)(eo + (size_t)sl * DM) + lane;
#pragma unroll
                for (int j = 0; j < 4; ++j) { const u32x2 w = er[64 * j]; v[j][0] += bflo(w.x); v[j][1] += bfhi(w.x); v[j][2] += bflo(w.y); v[j][3] += bfhi(w.y); }
            }
        }
#pragma unroll
        for (int j = 0; j < 4; ++j) s += (v[j][0] + v[j][1]) + (v[j][2] + v[j][3]);
        const float mean = wave_sum(s) * (1.0f / DM); float s2 = 0.f;
#pragma unroll
        for (int j = 0; j < 4; ++j) { v[j] = v[j] - mean; s2 += (v[j][0] * v[j][0] + v[j][1] * v[j][1]) + (v[j][2] * v[j][2] + v[j][3] * v[j][3]); }
        const float rstd = 1.0f / sqrtf(wave_sum(s2) * (1.0f / DM) + LN_EPS);
#pragma unroll
        for (int j = 0; j < 4; ++j) orow[64 * j] = v[j] * rstd * gg[j] + bb[j];
    }
}

constexpr size_t WS_CTL = 19 * MiB;
#define XB_TMO      128
#define XB_XCNT(j)  (256  + 64 * (j))
#define XB_XSUB(j)  (1280 + 64 * (j))
#define XB_XGEN(j)  (2304 + 64 * (j))
#define XB_TOP      3328
#define XB_TOPGEN   3392
#define XCD_BAR_WORDS 3456
#define XB_SPIN_CAP (1u << 18)
DI unsigned xb_ld(unsigned* p)              { return __hip_atomic_load(p, __ATOMIC_RELAXED, __HIP_MEMORY_SCOPE_AGENT); }
DI unsigned xb_add(unsigned* p, unsigned v) { return __hip_atomic_fetch_add(p, v, __ATOMIC_RELAXED, __HIP_MEMORY_SCOPE_AGENT); }
DI unsigned xb_xcc_id() { return (unsigned)__builtin_amdgcn_s_getreg((3 << 11) | 20) & 0xFu; }
#define XB_SPIN(cond, bar) do { unsigned _sp = 0; while (cond) { __builtin_amdgcn_s_sleep(1); \
    if ((++_sp & 255u) == 0u) { if (xb_ld(&(bar)[XB_TMO])) break; if (_sp > XB_SPIN_CAP) { atomicAdd(&(bar)[XB_TMO], 1u); break; } } } } while (0)
struct XcdBarrier { unsigned* bar; unsigned x; volatile LAS unsigned* st; };
DI void xcd_barrier_complete(unsigned* bar, unsigned x, unsigned& nloc, unsigned& nx) {
    const unsigned G = gridDim.x * gridDim.y * gridDim.z;
    unsigned sum, cnt, mine, sp = 0u;
    for (;;) {
        sum = 0u; cnt = 0u; mine = 0u;
#pragma unroll
        for (unsigned j = 0; j < 16; ++j) { const unsigned c = xb_ld(&bar[XB_XCNT(j)]); sum += c; cnt += (c > 0u) ? 1u : 0u; mine = (j == x) ? c : mine; }
        if (sum == G) break;
        __builtin_amdgcn_s_sleep(1);
        if ((++sp & 255u) == 0u) { if (xb_ld(&bar[XB_TMO])) break; if (sp > XB_SPIN_CAP) { atomicAdd(&bar[XB_TMO], 1u); break; } }
    }
    nloc = mine > 0u ? mine : 1u; nx = cnt > 0u ? cnt : 1u;
}
DI void xcd_barrier(const XcdBarrier& b, int wave) {
    asm volatile("s_waitcnt vmcnt(0)" ::: "memory");
    __syncthreads();
    if (wave == 0 && lane_id() == 0) {
        unsigned* bar = b.bar;
        __builtin_amdgcn_s_waitcnt(0);
        unsigned nloc = b.st[0], nx = b.st[1];
        if (nloc == 0u) { xcd_barrier_complete(bar, b.x, nloc, nx); b.st[0] = nloc; b.st[1] = nx; }
        const unsigned old = xb_add(&bar[XB_XSUB(b.x)], 1u);
        const unsigned gen = old / nloc;
        if (old + 1u == (gen + 1u) * nloc) {
            __builtin_amdgcn_fence(__ATOMIC_RELEASE, "agent");
            asm volatile("s_waitcnt vmcnt(0)" ::: "memory");
            const unsigned og = xb_add(&bar[XB_TOP], 1u);
            const unsigned tg = og / nx;
            if (og + 1u == (tg + 1u) * nx) xb_add(&bar[XB_TOPGEN], 1u);
            else XB_SPIN(xb_ld(&bar[XB_TOPGEN]) == tg, bar);
            __builtin_amdgcn_fence(__ATOMIC_ACQUIRE, "agent");
            xb_add(&bar[XB_XGEN(b.x)], 1u);
            asm volatile("s_waitcnt vmcnt(0)" ::: "memory");
        } else {
            XB_SPIN(xb_ld(&bar[XB_XGEN(b.x)]) == gen, bar);
            __builtin_amdgcn_fence(__ATOMIC_ACQUIRE, "agent");
            asm volatile("s_waitcnt vmcnt(0)" ::: "memory");
        }
    }
    __syncthreads();
}

__global__ void __launch_bounds__(NTHR, 2) fwd_megakernel(Params p) {
    extern __shared__ __attribute__((aligned(16))) unsigned char lds_raw[];
    LAS unsigned char* lds = (LAS unsigned char*)lds_raw;
    cg::grid_group grid = cg::this_grid();
    const int wave_k = __builtin_amdgcn_readfirstlane((int)threadIdx.x >> 6);
    XcdBarrier xb; xb.bar = (unsigned*)(p.ws + WS_CTL); xb.x = xb_xcc_id(); xb.st = (volatile LAS unsigned*)(lds + LDS_BYTES - 64);
    if (wave_k == 0 && lane_id() == 0) { xb.st[0] = 0u; xb.st[1] = 0u; (void)xb_add(&xb.bar[XB_XCNT(xb.x)], 1u); }
    __syncthreads();
#define GSYNC() xcd_barrier(xb, wave_k)
#define IDS() const int lane = lane_id(), wave = wave_k; \
    const int G = gridDim.x, gw = blockIdx.x * 8 + wave, NGW = G * 8; (void)lane; (void)gw; (void)NGW; (void)G;
    { IDS(); phase0(p, lds, gw, NGW, wave, lane); }
    grid.sync();
    {
        IDS();
        pg8::SchedPlain S; S.init(TT, 3072, G, (int)blockIdx.x);
        pg8::EpiProj E{(bf16_t*)(p.ws + WS_P), (const float*)(p.ws + WS_ROPE)};
        pg8::gemm_phase<pg8::EpiProj, pg8::SchedPlain>(lds, (const bf16_t*)(p.ws + WS_XB), (const bf16_t*)(p.ws + WS_WI), DM, S, E, wave);
    }
    GSYNC();
    conv_phase(p, wave_k);
    { IDS(); const int vcu = (G % 8 == 0) ? ((int)blockIdx.x % 8) * (G / 8) + (int)blockIdx.x / 8 : (int)blockIdx.x;
      attn_phase(p, lds, vcu * 8 + wave, NGW, wave, lane); }
    GSYNC();
    { IDS(); ssd_state_phase(p, lds, wave, lane); }
    GSYNC();
    ssd_scan_phase(p, wave_k);
    GSYNC();
    { IDS(); ssd_out_phase(p, lds, wave, lane); }
    GSYNC();
    { IDS(); gate_phase(p, gw, NGW, lane); }
    GSYNC();
    { IDS(); expert_gu_weights_phase(p, lds, gw, NGW, wave, lane); }
    __syncthreads();
    {
        IDS();
        pg8::SchedPlain S; S.init(TT, DM, G, (int)blockIdx.x);
        pg8::EpiOut E{p};
        pg8::gemm_phase<pg8::EpiOut, pg8::SchedPlain>(lds, (const bf16_t*)(p.ws + WS_MIX), (const bf16_t*)(p.ws + WS_WO), DM, S, E, wave);
    }
    GSYNC();
    { IDS(); ln1_router_phase(p, lds, gw, NGW, wave, lane); }
    GSYNC();
    { IDS(); select_phase(p, lds, wave, lane); }
    GSYNC();
    {
        IDS();
        const int* idx = (const int*)(p.ws + WS_IDX);
        pg8::SchedGrouped<22, true> S{G, (int)blockIdx.x, idx};
        pg8::EpiGU E{p.ws + WS_HID};
        pg8::gemm_phase<pg8::EpiGU, pg8::SchedGrouped<22, true>, true>(lds, (const bf16_t*)(p.ws + WS_X1B), (const bf16_t*)(p.ws + WS_WGU), DM / 2, S, E, wave);
    }
    GSYNC();
    {
        IDS();
        const int* idx = (const int*)(p.ws + WS_IDX);
        const float* gate = (const float*)(p.ws + WS_GATE);
        pg8::SchedGrouped<4, false> S{G, (int)blockIdx.x, idx};
        pg8::EpiDown E{(bf16_t*)(p.ws + WS_EO), gate};
        pg8::gemm_phase<pg8::EpiDown, pg8::SchedGrouped<4, false>, true>(lds, (const bf16_t*)(p.ws + WS_HID), (const bf16_t*)(p.ws + WS_WD), FF / 2, S, E, wave);
    }
    GSYNC();
    { IDS(); ln2_phase(p, gw, NGW, lane); }
#undef IDS
}

extern "C" void kernel_launch(void* const* d_in, const int* in_sizes, int n_in, void* d_out, int out_size, void* d_ws, size_t ws_size, hipStream_t stream) {
    static int grid_blocks = 0;
    if (grid_blocks == 0) {
        if (n_in != 18 || ws_size < WS_END || out_size != TT * DM) { fprintf(stderr, "kernel_launch: unexpected shapes (n_in %d out %d ws %zu)\n", n_in, out_size, ws_size); grid_blocks = -1; return; }
        int dev = 0, cus = 0, per_cu = 0;
        hipGetDevice(&dev);
        hipDeviceGetAttribute(&cus, hipDeviceAttributeMultiprocessorCount, dev);
        if (hipFuncSetAttribute((const void*)fwd_megakernel, hipFuncAttributeMaxDynamicSharedMemorySize, LDS_BYTES) != hipSuccess) { fprintf(stderr, "kernel_launch: hipFuncSetAttribute failed\n"); }
        hipOccupancyMaxActiveBlocksPerMultiprocessor(&per_cu, (const void*)fwd_megakernel, NTHR, LDS_BYTES);
        if (per_cu < 1) per_cu = 1;
        (void)hipGetLastError();
        grid_blocks = cus * per_cu;
    }
    if (grid_blocks < 0) return;
    Params p{};
    for (int i = 0; i < 18; ++i) p.in[i] = (const float*)d_in[i];
    p.out = (float*)d_out; p.ws = (unsigned char*)d_ws;
    if (hipMemsetAsync((char*)d_ws + WS_CTL, 0, 16384, stream) != hipSuccess) { fprintf(stderr, "kernel_launch: hipMemsetAsync failed\n"); return; }
    void* args[] = {&p};
    hipError_t e = hipLaunchCooperativeKernel((void*)fwd_megakernel, dim3(grid_blocks), dim3(NTHR), args, LDS_BYTES, stream);
    if (e != hipSuccess) fprintf(stderr, "cooperative launch failed: %s (grid %d)\n", hipGetErrorString(e), grid_blocks);
}
```

```cpp
#include <hip/hip_runtime.h>
#include <hip/hip_cooperative_groups.h>
#include <cstdio>
#include <cstdint>
namespace cg = cooperative_groups;

#define DI __device__ __forceinline__
#define LAS __attribute__((address_space(3)))
typedef unsigned short bf16_t;
typedef short bf16x8 __attribute__((ext_vector_type(8)));
typedef short s16x4 __attribute__((ext_vector_type(4)));
typedef float f32x4 __attribute__((ext_vector_type(4)));
typedef unsigned u32x4 __attribute__((ext_vector_type(4)));
typedef unsigned u32x2 __attribute__((ext_vector_type(2)));
typedef int i32x4 __attribute__((ext_vector_type(4)));
typedef int i32x8 __attribute__((ext_vector_type(8)));

constexpr int TT = 49152;
constexpr int TP = 32768;
constexpr int DM = 1024;
constexpr int INW = 3088;
constexpr int FF = 2816;
constexpr int NE = 16;
constexpr int SLOTS_E = 6144;
constexpr float ALPHA = 1.189207115002721f;
constexpr float LN_EPS = 1e-5f, RMS_EPS = 1e-5f;

constexpr size_t MiB = 1u << 20;
constexpr size_t TILE_ELEMS = (size_t)TT * 256;
constexpr size_t TILE_BYTES = TILE_ELEMS * 2;
constexpr size_t WS_WI = 0;
constexpr size_t WS_WO = 6 * MiB;
constexpr size_t WS_DT = 8 * MiB;
constexpr size_t WS_ROPE = 11 * MiB;
constexpr size_t WS_AFF = 12 * MiB;
constexpr size_t WS_IDX = 15 * MiB;
constexpr size_t WS_GATE = 15 * MiB + 512 * 1024;
constexpr size_t WS_P = 20 * MiB;
constexpr size_t WS_XC = 308 * MiB;
constexpr size_t WS_XB = 404 * MiB;
constexpr size_t WS_MIX = WS_XB;
constexpr size_t WS_YF = WS_P + 8 * TILE_BYTES;
constexpr size_t WS_YB = WS_P + 10 * TILE_BYTES;
constexpr size_t WS_INV = 16 * MiB;
constexpr size_t WS_WD = 20 * MiB;
constexpr size_t WS_WGU = 108 * MiB;
constexpr size_t WS_EO = 212 * MiB;
constexpr size_t WS_X1B = 308 * MiB;
constexpr size_t WS_HID = 404 * MiB;
constexpr size_t WS_END = 668 * MiB;

constexpr int LDS_BYTES = 147456;
constexpr int NTHR = 512;

DI unsigned f2bf(float f) { unsigned u = __float_as_uint(f); return (u + 0x7fffu + ((u >> 16) & 1u)) >> 16; }
typedef float f32x2v __attribute__((ext_vector_type(2)));
typedef __bf16 bf16x2v __attribute__((ext_vector_type(2)));
DI unsigned pk2(float lo, float hi) { const f32x2v f = {lo, hi}; return __builtin_bit_cast(unsigned, __builtin_convertvector(f, bf16x2v)); }
DI unsigned pk4_f8(float a, float b, float c, float d) { int w = 0; w = __builtin_amdgcn_cvt_pk_fp8_f32(a, b, w, false); w = __builtin_amdgcn_cvt_pk_fp8_f32(c, d, w, true); return (unsigned)w; }
DI i32x8 cat8(bf16x8 lo, bf16x8 hi) { const i32x4 a = __builtin_bit_cast(i32x4, lo), b = __builtin_bit_cast(i32x4, hi); return __builtin_shufflevector(a, b, 0, 1, 2, 3, 4, 5, 6, 7); }
constexpr float WGU_SCALE = 32.0f, WD_SCALE = 64.0f;
DI float bflo(unsigned u) { return __uint_as_float(u << 16); }
DI float bfhi(unsigned u) { return __uint_as_float(u & 0xffff0000u); }
DI float wave_sum(float v) {
#pragma unroll
    for (int o = 1; o < 64; o <<= 1) v += __shfl_xor(v, o);
    return v;
}
DI void st_tr8_pair(LAS bf16_t* base, int stride, int colpair, int lane, const u32x4 v) {
    const unsigned px = __shfl_xor(v.x, 1), py = __shfl_xor(v.y, 1), pz = __shfl_xor(v.z, 1), pw = __shfl_xor(v.w, 1);
    const bool odd = (lane & 1) != 0;
    const unsigned d0 = odd ? ((px >> 16) | (v.x & 0xffff0000u)) : ((v.x & 0xffffu) | (px << 16));
    const unsigned d1 = odd ? ((py >> 16) | (v.y & 0xffff0000u)) : ((v.y & 0xffffu) | (py << 16));
    const unsigned d2 = odd ? ((pz >> 16) | (v.z & 0xffff0000u)) : ((v.z & 0xffffu) | (pz << 16));
    const unsigned d3 = odd ? ((pw >> 16) | (v.w & 0xffff0000u)) : ((v.w & 0xffffu) | (pw << 16));
    LAS unsigned* wp = (LAS unsigned*)(base + (odd ? stride : 0)) + colpair;
    wp[0] = d0; wp[stride] = d1; wp[2 * stride] = d2; wp[3 * stride] = d3;
}
DI float silu_f(float x) { return x / (1.0f + __expf(-x)); }
#define LDS_WAIT() asm volatile("s_waitcnt lgkmcnt(0)" ::: "memory")

struct Params { const float* in[18]; float* out; unsigned char* ws; };
DI int lane_id() { int l = (int)__builtin_amdgcn_mbcnt_hi(~0u, __builtin_amdgcn_mbcnt_lo(~0u, 0u)); asm volatile("" : "+v"(l)); return l; }
#define TIDX(wave_) ((wave_) * 64 + lane_id())

DI const float* xrow_ptr(const Params& p, int t) { return t < TP ? p.in[0] + (size_t)t * DM : p.in[1] + (size_t)(t - TP) * DM; }

namespace pg8 {
constexpr int BM = 256, BK = 64, HALF = 128, HTB = HALF * BK * 2, NXCD = 8, WGM = 8;
DI int lds_byte(int r, int c) { const int st = (r >> 4) * 2 + (c >> 5), rr = r & 15, cc = c & 31, ob = rr * 64 + cc * 2; return st * 1024 + (ob ^ (((ob >> 9) & 1) << 5)); }
DI void stage_rc(int b, int& R, int& C) { const int st = b / 1024, sb = b % 1024, swz = sb ^ (((sb >> 9) & 1) << 5); R = (st >> 1) * 16 + swz / 64; C = (st & 1) * 32 + (swz % 64) / 2; }
DI int perm32(int rho) { const int n = rho >> 4, i = rho & 15; return 8 * (i >> 2) + 4 * n + (i & 3); }

struct Unit { int pm, pn, bt; };

DI int xcd_remap(int L, int nwg) { const int q = nwg / NXCD, r = nwg % NXCD, xcd = L % NXCD, off = L / NXCD; return (xcd < r ? xcd * (q + 1) : r * (q + 1) + (xcd - r) * q) + off; }

struct SchedPlain {
    int nM, nN, nwg, G, c;
    DI void init(int M, int N, int G_, int c_) { nM = M / BM; nN = N / BM; nwg = nM * nN; G = G_; c = c_; }
    DI bool next(int i, Unit& u) const {
        const int L = i * G + c; if (L >= nwg) return false;
        const int wgid = xcd_remap(L, nwg);
        const int nig = WGM * nN, gid = wgid / nig, fm = gid * WGM, gsz = (nM - fm) < WGM ? (nM - fm) : WGM;
        u.pm = fm + ((wgid % nig) % gsz); u.pn = (wgid % nig) / gsz; u.bt = u.pn; return true;
    }
    DI int arow(const Unit& u, int r) const { return u.pm * BM + r; }
};
template <int NPN, bool GATHER> struct SchedGrouped {
    int G, c; const int* idx;
    DI bool next(int i, Unit& u) const {
        constexpr int PER_E = 24 * NPN, NWG = NE * PER_E;
        const int L = i * G + c; if (L >= NWG) return false;
        const int wgid = xcd_remap(L, NWG);
        const int e = wgid / PER_E, rem = wgid % PER_E;
        const int gid = rem / (8 * NPN), w2 = rem % (8 * NPN);
        u.pm = e * 24 + gid * 8 + (w2 % 8); u.pn = w2 / 8; u.bt = e * NPN + u.pn; return true;
    }
    DI int arow(const Unit& u, int r) const { if (GATHER) return idx[u.pm * BM + r]; else return u.pm * BM + r; }
};

template <class Epi, class Sched, bool F8 = false>
DI void gemm_phase(LAS unsigned char* lds, const bf16_t* Ag, const bf16_t* Btg, const int K, const Sched& S, const Epi& E, const int wave_in) {
    const int tid = TIDX(wave_in), wid = wave_in, lane = tid & 63, wr = wid >> 2, wc = wid & 3, fr = lane & 15, fq = lane >> 4;
    const int nt = K / BK;
    unsigned voffB[2];
#pragma unroll
    for (int i = 0; i < 2; ++i) { int R, C; stage_rc(tid * 16 + i * 8192, R, C); const int Rb = Epi::PERM ? ((R & ~31) + perm32(R & 31)) : R;
        voffB[i] = (unsigned)(Rb * K + C) * 2u; }
    const unsigned rowbytes = (unsigned)K * 2u;
    const size_t kstep = (size_t)(BK * 2);
    const size_t hstep = (size_t)HALF * K * 2;
    const size_t tstep = 2 * hstep;
    const unsigned ldsw = (unsigned)wid * 1024u;
    const int aoff = lds_byte(wr * 64 + fr, fq * 8), boff = lds_byte(wc * 32 + fr, fq * 8);
#define PG8_SA(b, h) (((b) * 2 + (h)) * HTB)
#define PG8_SB(b, h) ((4 + (b) * 2 + (h)) * HTB)
#define PG8_STAGE(bufoff, gbase, voff) do { _Pragma("unroll") for (int _i = 0; _i < 2; ++_i) \
        __builtin_amdgcn_global_load_lds((const unsigned*)((const char*)(gbase) + (voff)[_i]), (LAS unsigned*)(lds + (bufoff) + ldsw + _i * 8192), 16, 0, 0); } while (0)
#define PG8_STAGEA(bufoff, o0, o1, kb) do { \
        __builtin_amdgcn_global_load_lds((const unsigned*)((const char*)Ag + (size_t)(o0) + (size_t)(kb)), (LAS unsigned*)(lds + (bufoff) + ldsw), 16, 0, 0); \
        __builtin_amdgcn_global_load_lds((const unsigned*)((const char*)Ag + (size_t)(o1) + (size_t)(kb)), (LAS unsigned*)(lds + (bufoff) + ldsw + 8192), 16, 0, 0); } while (0)
#define PG8_LDA(dst, b, h) do { _Pragma("unroll") for (int m = 0; m < 4; ++m) _Pragma("unroll") for (int k = 0; k < 2; ++k) dst[m][k] = *(const LAS bf16x8*)(lds + PG8_SA(b, h) + aoff + m * 2048 + k * 1024); } while (0)
#define PG8_LDB(dst, b, h) do { _Pragma("unroll") for (int n = 0; n < 2; ++n) _Pragma("unroll") for (int k = 0; k < 2; ++k) dst[n][k] = *(const LAS bf16x8*)(lds + PG8_SB(b, h) + boff + n * 2048 + k * 1024); } while (0)
#define PG8_MMA(ai, bj, At, Bt) do { __builtin_amdgcn_s_setprio(1); _Pragma("unroll") for (int m = 0; m < 4; ++m) _Pragma("unroll") for (int n = 0; n < 2; ++n) { \
        if constexpr (F8) { acc[ai][bj][m][n] = __builtin_amdgcn_mfma_scale_f32_16x16x128_f8f6f4(cat8(Bt[n][0], Bt[n][1]), cat8(At[m][0], At[m][1]), acc[ai][bj][m][n], 0, 0, 0, 0, 0, 0); } \
        else { _Pragma("unroll") for (int k = 0; k < 2; ++k) acc[ai][bj][m][n] = __builtin_amdgcn_mfma_f32_16x16x32_bf16(Bt[n][k], At[m][k], acc[ai][bj][m][n], 0, 0, 0); } } \
        __builtin_amdgcn_s_setprio(0); } while (0)
#define PG8_WAIT_V(n) asm volatile("s_waitcnt vmcnt(" #n ")" ::: "memory")
#define PG8_WAIT_L(n) asm volatile("s_waitcnt lgkmcnt(" #n ")" ::: "memory")
#define PG8_BAR __builtin_amdgcn_s_barrier()
#define PG8_SCHED __builtin_amdgcn_sched_barrier(0)
#define PG8_OFFS(u, o00, o01, o10, o11) do { int R0_, C0_, R1_, C1_; const int t2_ = TIDX(wid); stage_rc(t2_ * 16, R0_, C0_); stage_rc(t2_ * 16 + 8192, R1_, C1_); \
        o00 = (unsigned)S.arow(u, R0_) * rowbytes + (unsigned)C0_ * 2u; o01 = (unsigned)S.arow(u, R1_) * rowbytes + (unsigned)C1_ * 2u; \
        o10 = (unsigned)S.arow(u, HALF + R0_) * rowbytes + (unsigned)C0_ * 2u; o11 = (unsigned)S.arow(u, HALF + R1_) * rowbytes + (unsigned)C1_ * 2u; } while (0)
    Unit cur, nxt; int ui = 0;
    if (!S.next(0, cur)) return;
    f32x4 acc[2][2][4][2];
#pragma unroll
    for (int a = 0; a < 2; ++a)
#pragma unroll
        for (int b = 0; b < 2; ++b)
#pragma unroll
            for (int m = 0; m < 4; ++m)
#pragma unroll
                for (int n = 0; n < 2; ++n) acc[a][b][m][n] = (f32x4){0.f, 0.f, 0.f, 0.f};
    bf16x8 At[4][2], B0[2][2], B1[2][2];
    unsigned c00, c01, c10, c11;
    PG8_OFFS(cur, c00, c01, c10, c11);
    const char* cB = (const char*)Btg + (size_t)cur.bt * tstep;
    PG8_STAGE(PG8_SB(0, 0), cB, voffB); PG8_STAGE(PG8_SB(0, 1), cB + hstep, voffB); PG8_STAGEA(PG8_SA(0, 0), c00, c01, 0); PG8_STAGEA(PG8_SA(0, 1), c10, c11, 0);
    if (wr == 1) PG8_BAR;
    PG8_WAIT_V(2); PG8_BAR;
    PG8_STAGE(PG8_SB(1, 0), cB + kstep, voffB); PG8_STAGEA(PG8_SA(1, 0), c00, c01, kstep); PG8_STAGE(PG8_SB(1, 1), cB + hstep + kstep, voffB);
    PG8_WAIT_V(6); PG8_BAR;
    for (;;) {
        const bool has_next = S.next(ui + 1, nxt);
        const char* nB = has_next ? (const char*)Btg + (size_t)nxt.bt * tstep : cB;
        for (int t = 0; t < nt; t += 2) {
            const bool last = (t == nt - 2);
            const size_t kb1 = (size_t)(t + 1) * kstep;
            const size_t kb2 = last ? 0 : (size_t)(t + 2) * kstep, kb3 = kb2 + kstep;
            const char* b2 = last ? nB : cB + (size_t)(t + 2) * kstep; const char* b3 = b2 + kstep;
            PG8_LDB(B0, 0, 0); PG8_LDB(B1, 0, 1); PG8_SCHED; PG8_LDA(At, 0, 0); PG8_STAGEA(PG8_SA(1, 1), c10, c11, kb1);
            PG8_WAIT_V(8); PG8_WAIT_L(0); PG8_BAR; PG8_MMA(0, 0, At, B0); PG8_MMA(0, 1, At, B1); PG8_BAR; PG8_SCHED;
            if (last && has_next) { PG8_OFFS(nxt, c00, c01, c10, c11); }
            PG8_LDA(At, 0, 1); PG8_STAGE(PG8_SB(0, 0), b2, voffB); PG8_STAGE(PG8_SB(0, 1), b2 + hstep, voffB); PG8_STAGEA(PG8_SA(0, 0), c00, c01, kb2);
            PG8_WAIT_V(8); PG8_WAIT_L(0); PG8_BAR; PG8_MMA(1, 0, At, B0); PG8_MMA(1, 1, At, B1); PG8_BAR; PG8_SCHED;
            PG8_LDB(B0, 1, 0); PG8_LDB(B1, 1, 1); PG8_SCHED; PG8_LDA(At, 1, 0); PG8_STAGEA(PG8_SA(0, 1), c10, c11, kb2);
            PG8_WAIT_V(8); PG8_WAIT_L(0); PG8_BAR; PG8_MMA(0, 0, At, B0); PG8_MMA(0, 1, At, B1); PG8_BAR; PG8_SCHED;
            PG8_LDA(At, 1, 1); PG8_STAGE(PG8_SB(1, 0), b3, voffB); PG8_STAGE(PG8_SB(1, 1), b3 + hstep, voffB); PG8_STAGEA(PG8_SA(1, 0), c00, c01, kb3);
            PG8_WAIT_V(8); PG8_WAIT_L(0); PG8_BAR; PG8_MMA(1, 0, At, B0); PG8_MMA(1, 1, At, B1); PG8_BAR; PG8_SCHED;
        }
        if (wr == 0) PG8_BAR;
        { const int l2 = lane_id(); E(acc, cur, wr, wc, l2 & 15, l2 >> 4); }
        if (!has_next) break;
#pragma unroll
        for (int a = 0; a < 2; ++a)
#pragma unroll
            for (int b = 0; b < 2; ++b)
#pragma unroll
                for (int m = 0; m < 4; ++m)
#pragma unroll
                    for (int n = 0; n < 2; ++n) acc[a][b][m][n] = (f32x4){0.f, 0.f, 0.f, 0.f};
        cur = nxt; cB = nB; ++ui;
        if (wr == 1) PG8_BAR;
    }
    PG8_WAIT_V(0);
    PG8_BAR;
#undef PG8_SA
#undef PG8_SB
#undef PG8_STAGE
#undef PG8_STAGEA
#undef PG8_LDA
#undef PG8_LDB
#undef PG8_MMA
#undef PG8_WAIT_V
#undef PG8_WAIT_L
#undef PG8_BAR
#undef PG8_SCHED
#undef PG8_OFFS
}

struct EpiProj {
    static constexpr bool PERM = true;
    bf16_t* P; const float* rope;
    DI void operator()(const f32x4 (&acc)[2][2][4][2], const Unit& u, int wr, int wc, int fr, int fq) const {
        bf16_t* base = P + (size_t)u.pn * TILE_ELEMS;
        const bool rot = (u.pn < 4) && ((wc & 1) == 0);
#pragma unroll
        for (int ai = 0; ai < 2; ++ai)
#pragma unroll
            for (int m = 0; m < 4; ++m) {
                const int row = u.pm * BM + ai * HALF + wr * 64 + m * 16 + fr;
                asm volatile("" ::: "memory");
                f32x4 cs0 = {1.f, 1.f, 1.f, 1.f}, cs1 = cs0, sn0 = {0.f, 0.f, 0.f, 0.f}, sn1 = sn0;
                if (rot && fq < 2) {
                    const int s = row < TP ? (row & 4095) : (row & 8191);
                    const f32x4* rp = (const f32x4*)(rope + (size_t)s * 16);
                    cs0 = rp[0]; cs1 = rp[1]; sn0 = rp[2]; sn1 = rp[3];
                    if (fq == 0) { sn0 = -sn0; sn1 = -sn1; }
                }
#pragma unroll
                for (int bj = 0; bj < 2; ++bj) {
                    f32x4 v0 = acc[ai][bj][m][0], v1 = acc[ai][bj][m][1];
                    if (rot) {
                        f32x4 o0, o1;
#pragma unroll
                        for (int j = 0; j < 4; ++j) { o0[j] = __shfl_xor(v0[j], 16); o1[j] = __shfl_xor(v1[j], 16); }
                        if (fq < 2) { v0 = v0 * cs0 + o0 * sn0; v1 = v1 * cs1 + o1 * sn1; }
                    }
                    u32x4 w; w.x = pk2(v0[0], v0[1]); w.y = pk2(v0[2], v0[3]); w.z = pk2(v1[0], v1[1]); w.w = pk2(v1[2], v1[3]);
                    *(u32x4*)(base + (size_t)row * 256 + bj * HALF + wc * 32 + 8 * fq) = w;
                }
            }
    }
};
struct EpiOut {
    static constexpr bool PERM = false;
    Params p;
    DI void operator()(const f32x4 (&acc)[2][2][4][2], const Unit& u, int wr, int wc, int fr, int fq) const {
#pragma unroll
        for (int ai = 0; ai < 2; ++ai)
#pragma unroll
            for (int m = 0; m < 4; ++m) {
                const int row = u.pm * BM + ai * HALF + wr * 64 + m * 16 + fr;
                const float* xr = xrow_ptr(p, row); float* orow = p.out + (size_t)row * DM;
#pragma unroll
                for (int bj = 0; bj < 2; ++bj)
#pragma unroll
                    for (int n = 0; n < 2; ++n) {
                        const int col = u.pn * BM + bj * HALF + wc * 32 + 16 * n + 4 * fq;
                        const f32x4 xv = *(const f32x4*)(xr + col);
                        *(f32x4*)(orow + col) = xv * ALPHA + acc[ai][bj][m][n];
                    }
            }
    }
};
struct EpiGU {
    static constexpr bool PERM = true;
    unsigned char* H;
    DI void operator()(const f32x4 (&acc)[2][2][4][2], const Unit& u, int wr, int wc, int fr, int fq) const {
#pragma unroll
        for (int ai = 0; ai < 2; ++ai)
#pragma unroll
            for (int m = 0; m < 4; ++m) {
                const int row = u.pm * BM + ai * HALF + wr * 64 + m * 16 + fr;
                const f32x4 g0 = acc[ai][0][m][0], g1 = acc[ai][0][m][1], u0 = acc[ai][1][m][0], u1 = acc[ai][1][m][1];
                f32x4 h0, h1;
#pragma unroll
                for (int j = 0; j < 4; ++j) { h0[j] = silu_f(g0[j] * (1.0f / WGU_SCALE)) * (u0[j] * (1.0f / WGU_SCALE)); h1[j] = silu_f(g1[j] * (1.0f / WGU_SCALE)) * (u1[j] * (1.0f / WGU_SCALE)); }
                u32x2 w; w.x = pk4_f8(h0[0], h0[1], h0[2], h0[3]); w.y = pk4_f8(h1[0], h1[1], h1[2], h1[3]);
                *(u32x2*)(H + (size_t)row * FF + u.pn * 128 + wc * 32 + 8 * fq) = w;
            }
    }
};
struct EpiDown {
    static constexpr bool PERM = true;
    bf16_t* eo; const float* gate;
    DI void operator()(const f32x4 (&acc)[2][2][4][2], const Unit& u, int wr, int wc, int fr, int fq) const {
#pragma unroll
        for (int ai = 0; ai < 2; ++ai)
#pragma unroll
            for (int m = 0; m < 4; ++m) {
                const int slot = u.pm * BM + ai * HALF + wr * 64 + m * 16 + fr;
                const float gv = gate[slot] * (1.0f / WD_SCALE);
                bf16_t* orow = eo + (size_t)slot * DM + u.pn * BM + wc * 32 + 8 * fq;
#pragma unroll
                for (int bj = 0; bj < 2; ++bj) {
                    const f32x4 v0 = acc[ai][bj][m][0] * gv, v1 = acc[ai][bj][m][1] * gv;
                    u32x4 w; w.x = pk2(v0[0], v0[1]); w.y = pk2(v0[2], v0[3]); w.z = pk2(v1[0], v1[1]); w.w = pk2(v1[2], v1[3]);
                    *(u32x4*)(orow + bj * HALF) = w;
                }
            }
    }
};
}

DI void transpose_item(const float* W, int ldw, int k0, int n0, bf16_t* WT, int ldt, int drow0, LAS float* scr, int lane) {
#pragma unroll 8
    for (int i = 0; i < 32; ++i) { const int kk = 2 * i + (lane >> 5); scr[kk * 33 + (lane & 31)] = W[(size_t)(k0 + kk) * ldw + n0 + (lane & 31)]; }
    LDS_WAIT();
    const int c = lane & 7;
#pragma unroll
    for (int j = 0; j < 4; ++j) { const int n = (lane >> 3) + 8 * j; const LAS float* s = scr + (8 * c) * 33 + n;
        u32x4 o; o.x = pk2(s[0 * 33], s[1 * 33]); o.y = pk2(s[2 * 33], s[3 * 33]); o.z = pk2(s[4 * 33], s[5 * 33]); o.w = pk2(s[6 * 33], s[7 * 33]);
        *(u32x4*)(WT + (size_t)(drow0 + n) * ldt + k0 + 8 * c) = o; }
    LDS_WAIT();
}

DI void transpose_item_f8(const float* W, int ldw, int k0, int n0, unsigned char* WT, int ldt, int drow0, float scale, LAS float* scr, int lane) {
#pragma unroll 8
    for (int i = 0; i < 32; ++i) { const int kk = 2 * i + (lane >> 5); scr[kk * 33 + (lane & 31)] = W[(size_t)(k0 + kk) * ldw + n0 + (lane & 31)] * scale; }
    LDS_WAIT();
    const int c = lane & 7;
#pragma unroll
    for (int j = 0; j < 4; ++j) { const int n = (lane >> 3) + 8 * j; const LAS float* sp = scr + (8 * c) * 33 + n;
        u32x2 o; o.x = pk4_f8(sp[0 * 33], sp[1 * 33], sp[2 * 33], sp[3 * 33]); o.y = pk4_f8(sp[4 * 33], sp[5 * 33], sp[6 * 33], sp[7 * 33]);
        *(u32x2*)(WT + (size_t)(drow0 + n) * ldt + k0 + 8 * c) = o; }
    LDS_WAIT();
}

DI void sincos_small(double r, double& s, double& c) {
    const double r2 = r * r; double ss = 1.0, cc = 1.0;
#pragma unroll
    for (int n = 12; n >= 1; --n) { ss = 1.0 - ss * r2 * (1.0 / (double)((2 * n) * (2 * n + 1))); cc = 1.0 - cc * r2 * (1.0 / (double)((2 * n - 1) * (2 * n))); }
    s = r * ss; c = cc;
}

DI void dot16(const f32x4 (&v)[4], const LAS float* wT, int lane, float (&r)[16]) {
#pragma unroll
    for (int e = 0; e < 16; ++e) {
        float a = 0.f;
        if ((e & 1) == 0) asm volatile("" ::: "memory");
#pragma unroll
        for (int j = 0; j < 4; ++j) { const f32x4 w = *(const LAS f32x4*)(wT + e * 1024 + 256 * j + 4 * lane); a += v[j][0] * w[0] + v[j][1] * w[1] + v[j][2] * w[2] + v[j][3] * w[3]; }
        r[e] = wave_sum(a);
    }
}

DI void phase0(const Params& p, LAS unsigned char* lds, int gw, int NGW, int wave, int lane) {
    const int tid = TIDX(wave);
    {
        LAS float* scr = (LAS float*)(lds + wave * 16384);
        for (int it = gw; it < 2048; it += NGW) {
            if (it < 1536) { const int kb = it / 96, nb = it % 96; transpose_item(p.in[2], INW, 64 * kb, 32 * nb, (bf16_t*)(p.ws + WS_WI), DM, 32 * nb, scr, lane); }
            else { const int r = it - 1536, kb = r / 32, nb = r % 32; transpose_item(p.in[9], DM, 64 * kb, 32 * nb, (bf16_t*)(p.ws + WS_WO), DM, 32 * nb, scr, lane); }
        }
    }
    {
        float* rope = (float*)(p.ws + WS_ROPE);
        const float invf[8] = {1.0f, 0.1939227432012558f, 0.03760603070259094f, 0.007292664609849453f, 0.0014142135623842478f, 0.00027424818836152554f, 5.318296098266728e-05f, 1.0313386155758053e-05f};
        for (int id = blockIdx.x * NTHR + tid; id < 8192 * 8; id += gridDim.x * NTHR) {
            const int pos = id >> 3, i = id & 7;
            float inv = invf[0];
#pragma unroll
            for (int k = 1; k < 8; ++k) inv = (i == k) ? invf[k] : inv;
            const float ang = (float)pos * inv;
            const double x = (double)ang; const double kq = rint(x * 0.15915494309189535); const double r = x - kq * 6.283185307179586476925;
            double s, c; sincos_small(r, s, c);
            rope[pos * 16 + i] = (float)c; rope[pos * 16 + 8 + i] = (float)s;
        }
    }
    __syncthreads();
    LAS float* wT = (LAS float*)lds;
    for (int id = tid; id < 16384; id += NTHR) { const int k = id >> 4, e = id & 15; wT[e * 1024 + k] = p.in[2][(size_t)k * INW + 3072 + e]; }
    __syncthreads();
    const float* dtb = p.in[5];
    float bias = 0.f;
    if (lane < 16) bias = dtb[lane];
    bf16_t* xb = (bf16_t*)(p.ws + WS_XB); float* dtout = (float*)(p.ws + WS_DT);
    for (int t = gw; t < TT; t += NGW) {
        const f32x4* xr = (const f32x4*)xrow_ptr(p, t) + lane;
        f32x4 v[4];
#pragma unroll
        for (int j = 0; j < 4; ++j) v[j] = xr[64 * j];
        u32x2* o8 = (u32x2*)(xb + (size_t)t * DM) + lane;
#pragma unroll
        for (int j = 0; j < 4; ++j) { u32x2 w; w.x = pk2(v[j][0], v[j][1]); w.y = pk2(v[j][2], v[j][3]); o8[64 * j] = w; }
        float r[16]; dot16(v, wT, lane, r);
        float mine = 0.f;
#pragma unroll
        for (int e = 0; e < 16; ++e) mine = (lane == e) ? r[e] : mine;
        if (lane < 16) { const float z = mine + bias; dtout[(size_t)t * 16 + lane] = fmaxf(z, 0.f) + log1pf(__expf(-fabsf(z))); }
    }
}

DI void conv_phase(const Params& p, int wave) {
    const int tid = blockIdx.x * NTHR + TIDX(wave), nthr = gridDim.x * NTHR;
    const int c = tid & 127, ch = 8 * c, tile = ch >> 8, cit = ch & 255;
    const float* cw = p.in[3]; const float* cb = p.in[4];
    float w[5][8], b[8];
#pragma unroll
    for (int j = 0; j < 5; ++j)
#pragma unroll
        for (int e = 0; e < 8; ++e) w[j][e] = cw[j * 1024 + ch + e];
#pragma unroll
    for (int e = 0; e < 8; ++e) b[e] = cb[ch + e];
    const bf16_t* src = (const bf16_t*)(p.ws + WS_P) + (size_t)(8 + tile) * TILE_ELEMS + cit;
    bf16_t* dst = (bf16_t*)(p.ws + WS_XC) + (size_t)tile * TILE_ELEMS + cit;
    for (int it = tid; it < TT * 128; it += nthr) {
        const int t = it >> 7;
        const int S = t < TP ? 4096 : 8192, s = t & (S - 1);
        float a[8];
#pragma unroll
        for (int e = 0; e < 8; ++e) a[e] = b[e];
#pragma unroll
        for (int j = 0; j < 5; ++j) {
            const int sj = s + j - 2;
            if (sj >= 0 && sj < S) {
                const u32x4 v = *(const u32x4*)(src + (size_t)(t + j - 2) * 256);
                a[0] += bflo(v.x) * w[j][0]; a[1] += bfhi(v.x) * w[j][1]; a[2] += bflo(v.y) * w[j][2]; a[3] += bfhi(v.y) * w[j][3];
                a[4] += bflo(v.z) * w[j][4]; a[5] += bfhi(v.z) * w[j][5]; a[6] += bflo(v.w) * w[j][6]; a[7] += bfhi(v.w) * w[j][7];
            }
        }
        u32x4 o; o.x = pk2(silu_f(a[0]), silu_f(a[1])); o.y = pk2(silu_f(a[2]), silu_f(a[3])); o.z = pk2(silu_f(a[4]), silu_f(a[5])); o.w = pk2(silu_f(a[6]), silu_f(a[7]));
        *(u32x4*)(dst + (size_t)t * 256) = o;
    }
}

DI bf16x8 tr_pair(const LAS bf16_t* lo, const LAS bf16_t* hi) {
    const s16x4 a = __builtin_amdgcn_ds_read_tr16_b64_v4i16((LAS s16x4*)lo), b = __builtin_amdgcn_ds_read_tr16_b64_v4i16((LAS s16x4*)hi);
    return __builtin_shufflevector(a, b, 0, 1, 2, 3, 4, 5, 6, 7);
}
DI void attn_step_params(int sidx, int p0, int& d, int& base, int& nk, int& kbase, bool& actA, bool& actB) {
    const int pi = sidx < 12 ? 0 : (sidx < 18 ? 1 : 2);
    const int st = sidx - (pi == 0 ? 0 : (pi == 1 ? 12 : (sidx < 23 ? 18 : 23)));
    d = 1 << (2 * pi); base = p0 - 64 * d + (sidx >= 23 ? 8 : 0); nk = pi == 0 ? 377 : (pi == 1 ? 191 : 144); kbase = 32 * st;
    actA = sidx < 23; actB = sidx < 18 || sidx >= 23;
}
DI void attn_phase(const Params& p, LAS unsigned char* lds, int gw, int NGW, int wave, int lane) {
    LAS bf16_t* Vn = (LAS bf16_t*)(lds + wave * 4608);
    const bf16_t* Pb = (const bf16_t*)(p.ws + WS_P);
    bf16_t* mix = (bf16_t*)(p.ws + WS_MIX);
    const int c = lane & 15, q = lane >> 4, qp = (lane & 15) >> 2, pp = lane & 3;
    for (int wi = gw; wi < 12288; wi += NGW) {
        const int head = wi & 7, qg = wi >> 3;
        const int t0 = (qg >> 3) * 256 + (qg & 7);
        const int S = t0 < TP ? 4096 : 8192, sbase = t0 & ~(S - 1), p0 = t0 - sbase;
        const int hoff = (head & 3) * 64;
        const bf16_t* Qt = Pb + (size_t)(0 + (head >> 2)) * TILE_ELEMS + hoff;
        const bf16_t* Kt = Pb + (size_t)(2 + (head >> 2)) * TILE_ELEMS + hoff;
        const bf16_t* Vg = Pb + (size_t)(4 + (head >> 2)) * TILE_ELEMS + hoff;
        bf16x8 qf[2][2];
#pragma unroll
        for (int X = 0; X < 2; ++X) { const bf16_t* qrow = Qt + (size_t)(t0 + 8 * X + 16 * c) * 256; qf[X][0] = *(const bf16x8*)(qrow + 8 * q); qf[X][1] = *(const bf16x8*)(qrow + 32 + 8 * q); }
        f32x4 O[2][4];
#pragma unroll
        for (int X = 0; X < 2; ++X)
#pragma unroll
            for (int d4 = 0; d4 < 4; ++d4) O[X][d4] = (f32x4){0.f, 0.f, 0.f, 0.f};
        float mrun[2] = {-1e30f, -1e30f}, lsum[2] = {0.f, 0.f};
        u32x4 vb[3][4]; bf16x8 kb[3][2][2];
#define ATT_LOADS(sidx_, V_, K_) do { int d_, base_, nk_, kbase_; bool a_, b_; attn_step_params(sidx_, p0, d_, base_, nk_, kbase_, a_, b_); \
            _Pragma("unroll") for (int i = 0; i < 4; ++i) { const int id = lane + 64 * i, key = id >> 3, dc = id & 7; \
                int pos = base_ + d_ * (kbase_ + key); pos = pos < 0 ? 0 : (pos > S - 1 ? S - 1 : pos); \
                V_[i] = *(const u32x4*)(Vg + (size_t)(sbase + pos) * 256 + 8 * dc); } \
            _Pragma("unroll") for (int kt = 0; kt < 2; ++kt) { int pos = base_ + d_ * (kbase_ + 16 * kt + c); pos = pos < 0 ? 0 : (pos > S - 1 ? S - 1 : pos); \
                const bf16_t* krow = Kt + (size_t)(sbase + pos) * 256; K_[kt][0] = *(const bf16x8*)(krow + 8 * q); K_[kt][1] = *(const bf16x8*)(krow + 32 + 8 * q); } } while (0)
        ATT_LOADS(0, vb[0], kb[0]);
        ATT_LOADS(1, vb[1], kb[1]);
        for (int s3 = 0; s3 < 30; s3 += 3) {
#pragma unroll
          for (int u = 0; u < 3; ++u) {
            const int sidx = s3 + u;
            if (sidx + 2 < 28) ATT_LOADS(sidx + 2, vb[(u + 2) % 3], kb[(u + 2) % 3]);
            if (sidx < 28) {
            int d, base, nk, kbase; bool act[2]; attn_step_params(sidx, p0, d, base, nk, kbase, act[0], act[1]);
            const int win = 64 * d;
#pragma unroll
            for (int i = 0; i < 4; ++i) { const int id = lane + 64 * i; *(LAS u32x4*)(Vn + (id >> 3) * 72 + 8 * (id & 7)) = vb[u][i]; }
            bf16x8 vf[4];
#pragma unroll
            for (int d4 = 0; d4 < 4; ++d4) { const LAS bf16_t* vr = Vn + (4 * q + qp) * 72 + 16 * d4 + 4 * pp; vf[d4] = tr_pair(vr, vr + 16 * 72); }
            f32x4 sc[2][2];
#pragma unroll
            for (int X = 0; X < 2; ++X)
#pragma unroll
                for (int kt = 0; kt < 2; ++kt) {
                    f32x4 a = {0.f, 0.f, 0.f, 0.f};
                    a = __builtin_amdgcn_mfma_f32_16x16x32_bf16(kb[u][kt][0], qf[X][0], a, 0, 0, 0);
                    a = __builtin_amdgcn_mfma_f32_16x16x32_bf16(kb[u][kt][1], qf[X][1], a, 0, 0, 0);
                    sc[X][kt] = a;
                }
            const int sh = d == 1 ? 0 : (d == 4 ? 2 : 4);
            int rr[2]; unsigned rng[2];
#pragma unroll
            for (int X = 0; X < 2; ++X) {
                const int pq = p0 + 8 * X + 16 * c;
                const int nb = base < 0 ? -base : 0;
                int klo = (pq - win - base) >> sh; const int k2 = (nb + d - 1) >> sh; klo = klo > k2 ? klo : k2;
                int khi = (pq + win - base) >> sh; const int k3 = (S - 1 - base) >> sh; khi = khi < k3 ? khi : k3; khi = khi < nk - 1 ? khi : nk - 1;
                if (!act[X]) { klo = 1 << 20; khi = klo; }
                rr[X] = kbase + 4 * q - klo; rng[X] = (unsigned)(khi - klo);
            }
            bool valid[2][2][4]; float mloc[2];
#pragma unroll
            for (int X = 0; X < 2; ++X) {
                float m = -1e30f;
#pragma unroll
                for (int kt = 0; kt < 2; ++kt)
#pragma unroll
                    for (int j = 0; j < 4; ++j) {
                        valid[X][kt][j] = (unsigned)(rr[X] + 16 * kt + j) <= rng[X];
                        const float sv = valid[X][kt][j] ? sc[X][kt][j] * 0.125f : -1e30f;
                        sc[X][kt][j] = sv; m = fmaxf(m, sv);
                    }
                mloc[X] = m;
            }
#pragma unroll
            for (int X = 0; X < 2; ++X) {
                const u32x2 r = __builtin_amdgcn_permlane32_swap(__float_as_uint(mloc[X]), __float_as_uint(mloc[X]), false, false);
                mloc[X] = fmaxf(fmaxf(mloc[X], __uint_as_float(r[0])), __uint_as_float(r[1]));
            }
#pragma unroll
            for (int X = 0; X < 2; ++X) {
                const u32x2 r = __builtin_amdgcn_permlane16_swap(__float_as_uint(mloc[X]), __float_as_uint(mloc[X]), false, false);
                mloc[X] = fmaxf(fmaxf(mloc[X], __uint_as_float(r[0])), __uint_as_float(r[1]));
            }
            float alpha[2]; bf16x8 pf[2];
#pragma unroll
            for (int X = 0; X < 2; ++X) {
                const float mnew = fmaxf(mrun[X], mloc[X]); alpha[X] = __expf(mrun[X] - mnew); mrun[X] = mnew;
                float ps = 0.f; float pv[2][4];
#pragma unroll
                for (int kt = 0; kt < 2; ++kt)
#pragma unroll
                    for (int j = 0; j < 4; ++j) { pv[kt][j] = valid[X][kt][j] ? __expf(sc[X][kt][j] - mnew) : 0.f; ps += pv[kt][j]; }
                lsum[X] = lsum[X] * alpha[X] + ps;
                u32x4 pw; pw.x = pk2(pv[0][0], pv[0][1]); pw.y = pk2(pv[0][2], pv[0][3]); pw.z = pk2(pv[1][0], pv[1][1]); pw.w = pk2(pv[1][2], pv[1][3]);
                pf[X] = __builtin_bit_cast(bf16x8, pw);
            }
#pragma unroll
            for (int d4 = 0; d4 < 4; ++d4)
#pragma unroll
                for (int X = 0; X < 2; ++X) O[X][d4] = __builtin_amdgcn_mfma_f32_16x16x32_bf16(vf[d4], pf[X], O[X][d4] * alpha[X], 0, 0, 0);
            }
          }
        }
#undef ATT_LOADS
#pragma unroll
        for (int X = 0; X < 2; ++X) {
            float l = lsum[X]; l += __shfl_xor(l, 16); l += __shfl_xor(l, 32);
            const float inv = 1.0f / l;
            bf16_t* orow = mix + (size_t)(t0 + 8 * X + 16 * c) * DM + head * 64 + 4 * q;
#pragma unroll
            for (int d4 = 0; d4 < 4; ++d4) { u32x2 w; w.x = pk2(O[X][d4][0] * inv, O[X][d4][1] * inv); w.y = pk2(O[X][d4][2] * inv, O[X][d4][3] * inv); *(u32x2*)(orow + 16 * d4) = w; }
        }
    }
}

constexpr size_t WS_SLOC = WS_P;
constexpr size_t WS_DEC = WS_P + 96 * MiB;
constexpr int N_SSD_ITEMS = 6144;
struct SsdItem { int h, dir, g, tb, ts; float A; };
DI SsdItem ssd_decode(const Params& p, int it) {
    int w, ci; if (it < 4096) { w = it >> 5; ci = it & 31; } else { w = 128 + ((it - 4096) >> 6); ci = (it - 4096) & 63; }
    SsdItem I; const int seq = w >> 4; I.h = (w >> 1) & 7; I.dir = w & 1; I.g = I.h >> 2;
    const int S = seq < 8 ? 4096 : 8192, sbase = seq < 8 ? seq * 4096 : TP + (seq - 8) * 8192;
    I.tb = I.dir ? sbase + S - 1 - 128 * ci : sbase + 128 * ci; I.ts = I.dir ? -1 : 1;
    I.A = -__expf(p.in[6][I.dir * 8 + I.h]);
    return I;
}
#define SSD_TOK(I, l) ((I).tb + (I).ts * (l))
DI void ssd_scan_chunk(float d0, float d1, float A, LAS float* acs, LAS float* dts, int lane) {
    const float v0 = d0 * A, v1 = d1 * A; float ps = v0 + v1;
#pragma unroll
    for (int o = 1; o < 64; o <<= 1) { const float t = __shfl_up(ps, o); if (lane >= o) ps += t; }
    acs[2 * lane] = ps - v1; acs[2 * lane + 1] = ps; dts[2 * lane] = d0; dts[2 * lane + 1] = d1;
}
DI void st_tr8(LAS bf16_t* wp, int stride, const u32x4 v) {
    wp[0 * stride] = (bf16_t)(v.x & 0xffffu); wp[1 * stride] = (bf16_t)(v.x >> 16); wp[2 * stride] = (bf16_t)(v.y & 0xffffu); wp[3 * stride] = (bf16_t)(v.y >> 16);
    wp[4 * stride] = (bf16_t)(v.z & 0xffffu); wp[5 * stride] = (bf16_t)(v.z >> 16); wp[6 * stride] = (bf16_t)(v.w & 0xffffu); wp[7 * stride] = (bf16_t)(v.w >> 16);
}
DI void ssd_state_phase(const Params& p, LAS unsigned char* lds, int wave, int lane) {
    const int tid = TIDX(wave), c = lane & 15, q = lane >> 4, w = wave, qp = (lane & 15) >> 2, pp = lane & 3;
    LAS float* acs = (LAS float*)(lds + 0); LAS float* dts = (LAS float*)(lds + 512);
    LAS bf16_t* Xt2 = (LAS bf16_t*)(lds + 1024); LAS bf16_t* Bt = (LAS bf16_t*)(lds + 1024 + 128 * 144);
    const float* dtb = (const float*)(p.ws + WS_DT);
    const bf16_t* XCb = (const bf16_t*)(p.ws + WS_XC);
    bf16_t* Sl = (bf16_t*)(p.ws + WS_SLOC); float* decv = (float*)(p.ws + WS_DEC);
    int it = (gridDim.x % 8 == 0) ? ((int)blockIdx.x % 8) * ((int)gridDim.x / 8) + (int)blockIdx.x / 8 : (int)blockIdx.x;
    if (it >= N_SSD_ITEMS) return;
    SsdItem I = ssd_decode(p, it);
    float pd0 = 0.f, pd1 = 0.f; u32x4 xv[2], bv[4];
#define SSD_LOADS_A(I) do { \
        if (w == 0) { pd0 = dtb[(size_t)SSD_TOK(I, 2 * lane) * 16 + (I).dir * 8 + (I).h]; pd1 = dtb[(size_t)SSD_TOK(I, 2 * lane + 1) * 16 + (I).dir * 8 + (I).h]; } \
        _Pragma("unroll") for (int i = 0; i < 2; ++i) { const int id = tid + NTHR * i, l = id >> 3, pc = id & 7; \
            xv[i] = *(const u32x4*)(XCb + (size_t)((I).h >> 2) * TILE_ELEMS + (size_t)SSD_TOK(I, l) * 256 + ((I).h & 3) * 64 + 8 * pc); } \
        _Pragma("unroll") for (int i = 0; i < 4; ++i) { const int id = tid + NTHR * i, l = id >> 4, ncn = id & 15; \
            bv[i] = *(const u32x4*)(XCb + 2 * TILE_ELEMS + (size_t)SSD_TOK(I, l) * 256 + (I).g * 128 + 8 * ncn); } } while (0)
    SSD_LOADS_A(I);
    for (; it < N_SSD_ITEMS; it += gridDim.x) {
        if (w == 0) ssd_scan_chunk(pd0, pd1, I.A, acs, dts, lane);
        __syncthreads();
        const float aend = acs[127];
#pragma unroll
        for (int i = 0; i < 2; ++i) {
            const int id = tid + NTHR * i, l = id >> 3, pc = id & 7;
            const float s2 = dts[l] * __expf(aend - acs[l]);
            const u32x4 v = xv[i];
            u32x4 o; o.x = pk2(bflo(v.x) * s2, bfhi(v.x) * s2); o.y = pk2(bflo(v.y) * s2, bfhi(v.y) * s2); o.z = pk2(bflo(v.z) * s2, bfhi(v.z) * s2); o.w = pk2(bflo(v.w) * s2, bfhi(v.w) * s2);
            *(LAS u32x4*)(Xt2 + l * 72 + 8 * pc) = o;
        }
#pragma unroll
        for (int i = 0; i < 4; ++i) { const int id = tid + NTHR * i; *(LAS u32x4*)(Bt + (id >> 4) * 136 + 8 * (id & 15)) = bv[i]; }
        const int itn = it + gridDim.x;
        if (itn < N_SSD_ITEMS) { I = ssd_decode(p, itn); SSD_LOADS_A(I); }
        __syncthreads();
        bf16_t* so = Sl + (size_t)it * 8192 + 16 * w + 4 * q;
#pragma unroll
        for (int pt = 0; pt < 4; ++pt) {
            f32x4 a = {0.f, 0.f, 0.f, 0.f};
#pragma unroll
            for (int ks = 0; ks < 4; ++ks) {
                const LAS bf16_t* br = Bt + (32 * ks + 8 * q + qp) * 136 + 16 * w + 4 * pp;
                const LAS bf16_t* xr = Xt2 + (32 * ks + 8 * q + qp) * 72 + 16 * pt + 4 * pp;
                const bf16x8 bfr = tr_pair(br, br + 4 * 136), xf = tr_pair(xr, xr + 4 * 72);
                a = __builtin_amdgcn_mfma_f32_16x16x32_bf16(bfr, xf, a, 0, 0, 0);
            }
            u32x2 o; o.x = pk2(a[0], a[1]); o.y = pk2(a[2], a[3]);
            *(u32x2*)(so + (16 * pt + c) * 128) = o;
        }
        if (tid == 0) decv[it] = __expf(aend);
    }
#undef SSD_LOADS_A
}
DI void ssd_scan_phase(const Params& p, int wave) {
    unsigned* Sl = (unsigned*)(p.ws + WS_SLOC); const float* decv = (const float*)(p.ws + WS_DEC);
    for (int chain = blockIdx.x * NTHR + TIDX(wave); chain < 160 * 4096; chain += gridDim.x * NTHR) {
        const int w = chain >> 12, j = chain & 4095;
        const int nc = w < 128 ? 32 : 64, cb = w < 128 ? 32 * w : 4096 + 64 * (w - 128);
        unsigned* ptr = Sl + (size_t)cb * 4096 + j; const float* dp = decv + cb;
        float s0 = 0.f, s1 = 0.f;
        for (int c0 = 0; c0 < nc; c0 += 8) {
            unsigned v[8]; float d[8];
#pragma unroll
            for (int k = 0; k < 8; ++k) { v[k] = ptr[(size_t)(c0 + k) * 4096]; d[k] = dp[c0 + k]; }
#pragma unroll
            for (int k = 0; k < 8; ++k) { ptr[(size_t)(c0 + k) * 4096] = pk2(s0, s1); s0 = s0 * d[k] + bflo(v[k]); s1 = s1 * d[k] + bfhi(v[k]); }
        }
    }
}
constexpr int SSDC_ACS = 0  , SSDC_XT1 = 2048, SSDC_BN = SSDC_XT1 + 128 * 144, SSDC_SBF = SSDC_BN + 128 * 272, SSDC_END = SSDC_SBF + 64 * 272;
static_assert(SSDC_END <= 131072, "ssd lds");
DI void ssd_out_phase(const Params& p, LAS unsigned char* lds, int wave, int lane) {
    const int tid = TIDX(wave), c = lane & 15, q = lane >> 4, w = wave, qp = (lane & 15) >> 2, pp = lane & 3;
    LAS bf16_t* Xt1 = (LAS bf16_t*)(lds + SSDC_XT1); LAS bf16_t* Bn = (LAS bf16_t*)(lds + SSDC_BN); LAS bf16_t* Sbf = (LAS bf16_t*)(lds + SSDC_SBF);
    const float* dtb = (const float*)(p.ws + WS_DT);
    const bf16_t* XCb = (const bf16_t*)(p.ws + WS_XC);
    const bf16_t* Sl = (const bf16_t*)(p.ws + WS_SLOC);
    int it = (gridDim.x % 8 == 0) ? ((int)blockIdx.x % 8) * ((int)gridDim.x / 8) + (int)blockIdx.x / 8 : (int)blockIdx.x;
    if (it >= N_SSD_ITEMS) return;
    SsdItem I = ssd_decode(p, it);
    float pd0 = 0.f, pd1 = 0.f; u32x4 xv[2], bv[4], sv[2]; bf16x8 Cn[4];
#define SSD_LOADS_C(I, itx) do { \
        if (w == 0) { pd0 = dtb[(size_t)SSD_TOK(I, 2 * lane) * 16 + (I).dir * 8 + (I).h]; pd1 = dtb[(size_t)SSD_TOK(I, 2 * lane + 1) * 16 + (I).dir * 8 + (I).h]; } \
        _Pragma("unroll") for (int i = 0; i < 2; ++i) { const int id = tid + NTHR * i, l = id >> 3, pc = id & 7; \
            xv[i] = *(const u32x4*)(XCb + (size_t)((I).h >> 2) * TILE_ELEMS + (size_t)SSD_TOK(I, l) * 256 + ((I).h & 3) * 64 + 8 * pc); \
            sv[i] = *(const u32x4*)(Sl + (size_t)(itx) * 8192 + (size_t)id * 8); } \
        _Pragma("unroll") for (int i = 0; i < 4; ++i) { const int id = tid + NTHR * i, l = id >> 4, ncn = id & 15; \
            bv[i] = *(const u32x4*)(XCb + 2 * TILE_ELEMS + (size_t)SSD_TOK(I, l) * 256 + (I).g * 128 + 8 * ncn); } \
        { const bf16_t* cr = XCb + 3 * TILE_ELEMS + (size_t)SSD_TOK(I, 16 * w + c) * 256 + (I).g * 128 + 8 * q; \
          _Pragma("unroll") for (int ks = 0; ks < 4; ++ks) Cn[ks] = *(const bf16x8*)(cr + 32 * ks); } } while (0)
    SSD_LOADS_C(I, it);
    int par = 0;
    for (; it < N_SSD_ITEMS; it += gridDim.x, par ^= 1) {
        LAS float* acs = (LAS float*)(lds + SSDC_ACS + par * 1024); LAS float* dts = acs + 128;
        if (w == 0) ssd_scan_chunk(pd0, pd1, I.A, acs, dts, lane);
        __syncthreads();
#pragma unroll
        for (int i = 0; i < 2; ++i) {
            const int id = tid + NTHR * i, l = id >> 3, pc = id & 7;
            const float s1 = dts[l];
            const u32x4 v = xv[i];
            u32x4 o; o.x = pk2(bflo(v.x) * s1, bfhi(v.x) * s1); o.y = pk2(bflo(v.y) * s1, bfhi(v.y) * s1); o.z = pk2(bflo(v.z) * s1, bfhi(v.z) * s1); o.w = pk2(bflo(v.w) * s1, bfhi(v.w) * s1);
            *(LAS u32x4*)(Xt1 + l * 72 + 8 * pc) = o;
            *(LAS u32x4*)(Sbf + (id >> 4) * 136 + 8 * (id & 15)) = sv[i];
        }
#pragma unroll
        for (int i = 0; i < 4; ++i) { const int id = tid + NTHR * i; *(LAS u32x4*)(Bn + (id >> 4) * 136 + 8 * (id & 15)) = bv[i]; }
        bf16x8 Cf[4];
#pragma unroll
        for (int ks = 0; ks < 4; ++ks) Cf[ks] = Cn[ks];
        const SsdItem Ic = I;
        const int itn = it + gridDim.x;
        if (itn < N_SSD_ITEMS) { I = ssd_decode(p, itn); SSD_LOADS_C(I, itn); }
        __syncthreads();
        {
            const int l = 16 * w + c;
            const float al = acs[l];
            f32x4 acc[4];
#pragma unroll
            for (int pt = 0; pt < 4; ++pt) {
                f32x4 a = {0.f, 0.f, 0.f, 0.f};
#pragma unroll
                for (int ks = 0; ks < 4; ++ks) { const bf16x8 sf = *(const LAS bf16x8*)(Sbf + (16 * pt + c) * 136 + 32 * ks + 8 * q); a = __builtin_amdgcn_mfma_f32_16x16x32_bf16(sf, Cf[ks], a, 0, 0, 0); }
                acc[pt] = a * __expf(al);
            }
            const int nsp = (w >> 1) + 1;
            for (int sp = 0; sp < nsp; ++sp) {
                f32x4 M[2];
#pragma unroll
                for (int hh = 0; hh < 2; ++hh) {
                    const int st = 2 * sp + hh;
                    f32x4 G = {0.f, 0.f, 0.f, 0.f};
                    if (st <= w) {
#pragma unroll
                        for (int ks = 0; ks < 4; ++ks) { const bf16x8 bfr = *(const LAS bf16x8*)(Bn + (16 * st + c) * 136 + 32 * ks + 8 * q); G = __builtin_amdgcn_mfma_f32_16x16x32_bf16(bfr, Cf[ks], G, 0, 0, 0); }
#pragma unroll
                        for (int j = 0; j < 4; ++j) { const int s = 16 * st + 4 * q + j; const float e = __expf(al - acs[s]); G[j] = (s <= l) ? G[j] * e : 0.f; }
                    }
                    M[hh] = G;
                }
                u32x4 pw; pw.x = pk2(M[0][0], M[0][1]); pw.y = pk2(M[0][2], M[0][3]); pw.z = pk2(M[1][0], M[1][1]); pw.w = pk2(M[1][2], M[1][3]);
                const bf16x8 pf = __builtin_bit_cast(bf16x8, pw);
#pragma unroll
                for (int pt = 0; pt < 4; ++pt) {
                    const LAS bf16_t* xr = Xt1 + (32 * sp + 4 * q + qp) * 72 + 16 * pt + 4 * pp;
                    const bf16x8 xf = tr_pair(xr, xr + 16 * 72);
                    acc[pt] = __builtin_amdgcn_mfma_f32_16x16x32_bf16(xf, pf, acc[pt], 0, 0, 0);
                }
            }
            bf16_t* yr = (bf16_t*)(p.ws + (Ic.dir ? WS_YB : WS_YF)) + Ic.h * 64 + (size_t)SSD_TOK(Ic, l) * 512 + 4 * q;
#pragma unroll
            for (int pt = 0; pt < 4; ++pt) { u32x2 o; o.x = pk2(acc[pt][0], acc[pt][1]); o.y = pk2(acc[pt][2], acc[pt][3]); *(u32x2*)(yr + 16 * pt) = o; }
        }
    }
#undef SSD_LOADS_C
}

DI void gate_phase(const Params& p, int gw, int NGW, int lane) {
    const bf16_t* yf = (const bf16_t*)(p.ws + WS_YF); const bf16_t* yb = (const bf16_t*)(p.ws + WS_YB);
    const bf16_t* xh = (const bf16_t*)(p.ws + WS_XC) + (size_t)(lane >> 5) * TILE_ELEMS + (8 * lane & 255);
    const bf16_t* zt = (const bf16_t*)(p.ws + WS_P) + (size_t)(6 + (lane >> 5)) * TILE_ELEMS + (8 * lane & 255);
    bf16_t* mix = (bf16_t*)(p.ws + WS_MIX) + 512 + 8 * lane;
    const float D = p.in[7][lane >> 3];
    float nw[8];
#pragma unroll
    for (int e = 0; e < 8; ++e) nw[e] = p.in[8][8 * lane + e];
    for (int t = gw; t < TT; t += NGW) {
        const u32x4 a = *(const u32x4*)(yf + (size_t)t * 512 + 8 * lane), b = *(const u32x4*)(yb + (size_t)t * 512 + 8 * lane);
        const u32x4 x = *(const u32x4*)(xh + (size_t)t * 256), z = *(const u32x4*)(zt + (size_t)t * 256);
        float y[8];
        y[0] = (bflo(a.x) + bflo(b.x) + D * bflo(x.x)) * silu_f(bflo(z.x)); y[1] = (bfhi(a.x) + bfhi(b.x) + D * bfhi(x.x)) * silu_f(bfhi(z.x));
        y[2] = (bflo(a.y) + bflo(b.y) + D * bflo(x.y)) * silu_f(bflo(z.y)); y[3] = (bfhi(a.y) + bfhi(b.y) + D * bfhi(x.y)) * silu_f(bfhi(z.y));
        y[4] = (bflo(a.z) + bflo(b.z) + D * bflo(x.z)) * silu_f(bflo(z.z)); y[5] = (bfhi(a.z) + bfhi(b.z) + D * bfhi(x.z)) * silu_f(bfhi(z.z));
        y[6] = (bflo(a.w) + bflo(b.w) + D * bflo(x.w)) * silu_f(bflo(z.w)); y[7] = (bfhi(a.w) + bfhi(b.w) + D * bfhi(x.w)) * silu_f(bfhi(z.w));
        float ss = 0.f;
#pragma unroll
        for (int e = 0; e < 8; ++e) ss += y[e] * y[e];
        ss = wave_sum(ss);
        const float r = 1.0f / sqrtf(ss * (1.0f / 512.0f) + RMS_EPS);
        u32x4 o; o.x = pk2(y[0] * r * nw[0], y[1] * r * nw[1]); o.y = pk2(y[2] * r * nw[2], y[3] * r * nw[3]); o.z = pk2(y[4] * r * nw[4], y[5] * r * nw[5]); o.w = pk2(y[6] * r * nw[6], y[7] * r * nw[7]);
        *(u32x4*)(mix + (size_t)t * DM) = o;
    }
}

DI void expert_gu_weights_phase(const Params& p, LAS unsigned char* lds, int gw, int NGW, int wave, int lane) {
    LAS float* scr = (LAS float*)(lds + wave * 16384);
    for (int it = gw; it < 16 * 2816; it += NGW) {
        const int e = it / 2816, r = it % 2816;
        const int isup = r >= 1408, rr = isup ? r - 1408 : r, kb = rr / 88, nb = rr % 88, n0 = 32 * nb;
        const float* W = (isup ? p.in[14] : p.in[13]) + (size_t)e * DM * FF;
        transpose_item_f8(W, FF, 64 * kb, n0, p.ws + WS_WGU, DM, e * 5632 + 256 * (n0 >> 7) + (n0 & 127) + (isup ? 128 : 0), WGU_SCALE, scr, lane);
    }
}
DI void expert_down_weights(const Params& p, LAS unsigned char* lds, int vw, int NVW, int wave, int lane) {
    LAS float* scr = (LAS float*)(lds + 4096 + wave * 16384);
    for (int it = vw; it < 16 * 1408; it += NVW) {
        const int e = it / 1408, rr = it % 1408, kb = rr / 32, nb = rr % 32;
        transpose_item_f8(p.in[15] + (size_t)e * FF * DM, DM, 64 * kb, 32 * nb, p.ws + WS_WD, FF, e * 1024 + 32 * nb, WD_SCALE, scr, lane);
    }
}

DI void ln1_router_phase(const Params& p, LAS unsigned char* lds, int gw, int NGW, int wave, int lane) {
    const int tid = TIDX(wave);
    LAS float* wT = (LAS float*)lds;
    for (int id = tid; id < 16384; id += NTHR) { const int k = id >> 4, e = id & 15; wT[e * 1024 + k] = p.in[12][id]; }
    __syncthreads();
    f32x4 gg[4], bb[4];
#pragma unroll
    for (int j = 0; j < 4; ++j) { gg[j] = ((const f32x4*)p.in[10])[64 * j + lane]; bb[j] = ((const f32x4*)p.in[11])[64 * j + lane]; }
    unsigned char* x1b = p.ws + WS_X1B; float* aff = (float*)(p.ws + WS_AFF);
    for (int t = gw; t < TT; t += NGW) {
        f32x4* orow = (f32x4*)(p.out + (size_t)t * DM) + lane;
        f32x4 v[4]; float s = 0.f;
#pragma unroll
        for (int j = 0; j < 4; ++j) { v[j] = orow[64 * j]; s += (v[j][0] + v[j][1]) + (v[j][2] + v[j][3]); }
        const float mean = wave_sum(s) * (1.0f / DM); float s2 = 0.f;
#pragma unroll
        for (int j = 0; j < 4; ++j) { v[j] = v[j] - mean; s2 += (v[j][0] * v[j][0] + v[j][1] * v[j][1]) + (v[j][2] * v[j][2] + v[j][3] * v[j][3]); }
        const float rstd = 1.0f / sqrtf(wave_sum(s2) * (1.0f / DM) + LN_EPS);
        unsigned* o4 = (unsigned*)(x1b + (size_t)t * DM) + lane;
#pragma unroll
        for (int j = 0; j < 4; ++j) {
            v[j] = v[j] * rstd * gg[j] + bb[j];
            orow[64 * j] = v[j] * ALPHA;
            o4[64 * j] = pk4_f8(v[j][0], v[j][1], v[j][2], v[j][3]);
        }
        float r[16]; dot16(v, wT, lane, r);
        float mx = r[0];
#pragma unroll
        for (int e = 1; e < 16; ++e) mx = fmaxf(mx, r[e]);
        float den = 0.f, mine = 0.f;
#pragma unroll
        for (int e = 0; e < 16; ++e) { const float ex = __expf(r[e] - mx); den += ex; mine = (lane == e) ? ex : mine; }
        if (lane < 16) aff[(size_t)lane * TT + t] = mine / den;
    }
}

DI void select_phase(const Params& p, LAS unsigned char* lds, int wave, int lane) {
    const int wk = blockIdx.x;
    if (wk >= 32) { expert_down_weights(p, lds, (wk - 32) * 8 + wave, ((int)gridDim.x - 32) * 8, wave, lane); return; }
    const int tid = TIDX(wave);
    const int trunk = wk >> 4, e = wk & 15;
    const int Tn = trunk ? 16384 : 32768, tbase = trunk ? TP : 0, cap = Tn / 8;
    const unsigned* col = (const unsigned*)(p.ws + WS_AFF) + (size_t)e * TT + tbase;
    LAS unsigned* hist = (LAS unsigned*)lds;
    LAS unsigned* ctl = (LAS unsigned*)(lds + 1024);
    LAS unsigned* wcnt = (LAS unsigned*)(lds + 2048);
    unsigned prefix = 0, remaining = (unsigned)cap;
    for (int pass = 0; pass < 4; ++pass) {
        const int shift = 24 - 8 * pass;
        for (int i = tid; i < 256; i += NTHR) hist[i] = 0u;
        __syncthreads();
        for (int i = tid; i < Tn; i += NTHR) {
            const unsigned bits = col[i];
            if (pass == 0 || (bits >> (shift + 8)) == prefix) atomicAdd((unsigned*)(hist + ((bits >> shift) & 255u)), 1u);
        }
        __syncthreads();
        if (wave == 0) {
            const unsigned h0 = hist[4 * lane], h1 = hist[4 * lane + 1], h2 = hist[4 * lane + 2], h3 = hist[4 * lane + 3], tot = h0 + h1 + h2 + h3;
            unsigned v = tot;
#pragma unroll
            for (int o = 1; o < 64; o <<= 1) { const unsigned t = __shfl_down(v, o); if (lane + o < 64) v += t; }
            const unsigned excl = v - tot;
            if (excl < remaining && remaining <= excl + tot) {
                unsigned cum = excl; int b;
                if (cum + h3 >= remaining) b = 3; else { cum += h3; if (cum + h2 >= remaining) b = 2; else { cum += h2; if (cum + h1 >= remaining) b = 1; else { cum += h1; b = 0; } } }
                ctl[0] = (prefix << 8) | (unsigned)(4 * lane + b); ctl[1] = remaining - cum;
            }
        }
        __syncthreads();
        prefix = ctl[0]; remaining = ctl[1];
        __syncthreads();
    }
    const unsigned thr = prefix, need_eq = remaining;
    int* idx = (int*)(p.ws + WS_IDX) + e * SLOTS_E + (trunk ? 4096 : 0);
    int* inv = (int*)(p.ws + WS_INV) + (size_t)e * TT + tbase;
    const int slot0 = e * SLOTS_E + (trunk ? 4096 : 0);
    float* gate = (float*)(p.ws + WS_GATE) + e * SLOTS_E + (trunk ? 4096 : 0);
    unsigned base_gt = 0, base_eq = 0;
    for (int b0 = 0; b0 < Tn; b0 += 4 * NTHR) {
        const u32x4 bits4 = *(const u32x4*)(col + b0 + 4 * tid);
        const unsigned bits[4] = {bits4.x, bits4.y, bits4.z, bits4.w};
        unsigned packed = 0;
#pragma unroll
        for (int j = 0; j < 4; ++j) packed += (bits[j] > thr ? 1u : 0u) + (bits[j] == thr ? 0x10000u : 0u);
        unsigned v = packed;
#pragma unroll
        for (int o = 1; o < 64; o <<= 1) { const unsigned t = __shfl_up(v, o); if (lane >= o) v += t; }
        if (lane == 63) wcnt[wave] = v;
        __syncthreads();
        unsigned off = 0, tot = 0;
#pragma unroll
        for (int w2 = 0; w2 < 8; ++w2) { const unsigned cnt = wcnt[w2]; off += (w2 < wave) ? cnt : 0u; tot += cnt; }
        const unsigned ex = off + (v - packed);
        unsigned gt_before = base_gt + (ex & 0xffffu), eq_before = base_eq + (ex >> 16);
        int invv[4];
#pragma unroll
        for (int j = 0; j < 4; ++j) {
            const bool gt = bits[j] > thr, eq = bits[j] == thr;
            const bool sel = gt || (eq && eq_before < need_eq);
            const unsigned pos = gt_before + (eq_before < need_eq ? eq_before : need_eq);
            const bool ok = sel && pos < (unsigned)cap;
            if (ok) { idx[pos] = tbase + b0 + 4 * tid + j; gate[pos] = __uint_as_float(bits[j]); }
            invv[j] = ok ? slot0 + (int)pos : -1;
            gt_before += gt ? 1u : 0u; eq_before += eq ? 1u : 0u;
        }
        *(i32x4*)(inv + b0 + 4 * tid) = (i32x4){invv[0], invv[1], invv[2], invv[3]};
        base_gt += tot & 0xffffu; base_eq += tot >> 16;
        __syncthreads();
    }
}

DI void ln2_phase(const Params& p, int gw, int NGW, int lane) {
    f32x4 gg[4], bb[4];
#pragma unroll
    for (int j = 0; j < 4; ++j) { gg[j] = ((const f32x4*)p.in[16])[64 * j + lane]; bb[j] = ((const f32x4*)p.in[17])[64 * j + lane]; }
    const int* inv = (const int*)(p.ws + WS_INV); const bf16_t* eo = (const bf16_t*)(p.ws + WS_EO);
    for (int t = gw; t < TT; t += NGW) {
        f32x4* orow = (f32x4*)(p.out + (size_t)t * DM) + lane;
        f32x4 v[4]; float s = 0.f;
#pragma unroll
        for (int j = 0; j < 4; ++j) v[j] = orow[64 * j];
        const int myslot = lane < 16 ? inv[(size_t)lane * TT + t] : -1;
        for (int e = 0; e < 16; ++e) {
            const int sl = __shfl(myslot, e);
            if (sl >= 0) {
                const u32x2* er = (const u32x2*)(eo + (size_t)sl * DM) + lane;
#pragma unroll
                for (int j = 0; j < 4; ++j) { const u32x2 w = er[64 * j]; v[j][0] += bflo(w.x); v[j][1] += bfhi(w.x); v[j][2] += bflo(w.y); v[j][3] += bfhi(w.y); }
            }
        }
#pragma unroll
        for (int j = 0; j < 4; ++j) s += (v[j][0] + v[j][1]) + (v[j][2] + v[j][3]);
        const float mean = wave_sum(s) * (1.0f / DM); float s2 = 0.f;
#pragma unroll
        for (int j = 0; j < 4; ++j) { v[j] = v[j] - mean; s2 += (v[j][0] * v[j][0] + v[j][1] * v[j][1]) + (v[j][2] * v[j][2] + v[j][3] * v[j][3]); }
        const float rstd = 1.0f / sqrtf(wave_sum(s2) * (1.0f / DM) + LN_EPS);
#pragma unroll
        for (int j = 0; j < 4; ++j) orow[64 * j] = v[j] * rstd * gg[j] + bb[j];
    }
}

constexpr size_t WS_CTL = 19 * MiB;
#define XB_TMO      128
#define XB_XCNT(j)  (256  + 64 * (j))
#define XB_XSUB(j)  (1280 + 64 * (j))
#define XB_XGEN(j)  (2304 + 64 * (j))
#define XB_TOP      3328
#define XB_TOPGEN   3392
#define XCD_BAR_WORDS 3456
#define XB_SPIN_CAP (1u << 18)
DI unsigned xb_ld(unsigned* p)              { return __hip_atomic_load(p, __ATOMIC_RELAXED, __HIP_MEMORY_SCOPE_AGENT); }
DI unsigned xb_add(unsigned* p, unsigned v) { return __hip_atomic_fetch_add(p, v, __ATOMIC_RELAXED, __HIP_MEMORY_SCOPE_AGENT); }
DI unsigned xb_xcc_id() { return (unsigned)__builtin_amdgcn_s_getreg((3 << 11) | 20) & 0xFu; }
#define XB_SPIN(cond, bar) do { unsigned _sp = 0; while (cond) { __builtin_amdgcn_s_sleep(1); \
    if ((++_sp & 255u) == 0u) { if (xb_ld(&(bar)[XB_TMO])) break; if (_sp > XB_SPIN_CAP) { atomicAdd(&(bar)[XB_TMO], 1u); break; } } } } while (0)
struct XcdBarrier { unsigned* bar; unsigned x; volatile LAS unsigned* st; };
DI void xcd_barrier_complete(unsigned* bar, unsigned x, unsigned& nloc, unsigned& nx) {
    const unsigned G = gridDim.x * gridDim.y * gridDim.z;
    unsigned sum, cnt, mine, sp = 0u;
    for (;;) {
        sum = 0u; cnt = 0u; mine = 0u;
#pragma unroll
        for (unsigned j = 0; j < 16; ++j) { const unsigned c = xb_ld(&bar[XB_XCNT(j)]); sum += c; cnt += (c > 0u) ? 1u : 0u; mine = (j == x) ? c : mine; }
        if (sum == G) break;
        __builtin_amdgcn_s_sleep(1);
        if ((++sp & 255u) == 0u) { if (xb_ld(&bar[XB_TMO])) break; if (sp > XB_SPIN_CAP) { atomicAdd(&bar[XB_TMO], 1u); break; } }
    }
    nloc = mine > 0u ? mine : 1u; nx = cnt > 0u ? cnt : 1u;
}
DI void xcd_barrier(const XcdBarrier& b, int wave) {
    asm volatile("s_waitcnt vmcnt(0)" ::: "memory");
    __syncthreads();
    if (wave == 0 && lane_id() == 0) {
        unsigned* bar = b.bar;
        __builtin_amdgcn_s_waitcnt(0);
        unsigned nloc = b.st[0], nx = b.st[1];
        if (nloc == 0u) { xcd_barrier_complete(bar, b.x, nloc, nx); b.st[0] = nloc; b.st[1] = nx; }
        const unsigned old = xb_add(&bar[XB_XSUB(b.x)], 1u);
        const unsigned gen = old / nloc;
        if (old + 1u == (gen + 1u) * nloc) {
            __builtin_amdgcn_fence(__ATOMIC_RELEASE, "agent");
            asm volatile("s_waitcnt vmcnt(0)" ::: "memory");
            const unsigned og = xb_add(&bar[XB_TOP], 1u);
            const unsigned tg = og / nx;
            if (og + 1u == (tg + 1u) * nx) xb_add(&bar[XB_TOPGEN], 1u);
            else XB_SPIN(xb_ld(&bar[XB_TOPGEN]) == tg, bar);
            __builtin_amdgcn_fence(__ATOMIC_ACQUIRE, "agent");
            xb_add(&bar[XB_XGEN(b.x)], 1u);
            asm volatile("s_waitcnt vmcnt(0)" ::: "memory");
        } else {
            XB_SPIN(xb_ld(&bar[XB_XGEN(b.x)]) == gen, bar);
            __builtin_amdgcn_fence(__ATOMIC_ACQUIRE, "agent");
            asm volatile("s_waitcnt vmcnt(0)" ::: "memory");
        }
    }
    __syncthreads();
}

__global__ void __launch_bounds__(NTHR, 2) fwd_megakernel(Params p) {
    extern __shared__ __attribute__((aligned(16))) unsigned char lds_raw[];
    LAS unsigned char* lds = (LAS unsigned char*)lds_raw;
    cg::grid_group grid = cg::this_grid();
    const int wave_k = __builtin_amdgcn_readfirstlane((int)threadIdx.x >> 6);
    XcdBarrier xb; xb.bar = (unsigned*)(p.ws + WS_CTL); xb.x = xb_xcc_id(); xb.st = (volatile LAS unsigned*)(lds + LDS_BYTES - 64);
    if (wave_k == 0 && lane_id() == 0) { xb.st[0] = 0u; xb.st[1] = 0u; (void)xb_add(&xb.bar[XB_XCNT(xb.x)], 1u); }
    __syncthreads();
#define GSYNC() xcd_barrier(xb, wave_k)
#define IDS() const int lane = lane_id(), wave = wave_k; \
    const int G = gridDim.x, gw = blockIdx.x * 8 + wave, NGW = G * 8; (void)lane; (void)gw; (void)NGW; (void)G;
    { IDS(); phase0(p, lds, gw, NGW, wave, lane); }
    grid.sync();
    {
        IDS();
        pg8::SchedPlain S; S.init(TT, 3072, G, (int)blockIdx.x);
        pg8::EpiProj E{(bf16_t*)(p.ws + WS_P), (const float*)(p.ws + WS_ROPE)};
        pg8::gemm_phase<pg8::EpiProj, pg8::SchedPlain>(lds, (const bf16_t*)(p.ws + WS_XB), (const bf16_t*)(p.ws + WS_WI), DM, S, E, wave);
    }
    GSYNC();
    conv_phase(p, wave_k);
    { IDS(); const int vcu = (G % 8 == 0) ? ((int)blockIdx.x % 8) * (G / 8) + (int)blockIdx.x / 8 : (int)blockIdx.x;
      attn_phase(p, lds, vcu * 8 + wave, NGW, wave, lane); }
    GSYNC();
    { IDS(); ssd_state_phase(p, lds, wave, lane); }
    GSYNC();
    ssd_scan_phase(p, wave_k);
    GSYNC();
    { IDS(); ssd_out_phase(p, lds, wave, lane); }
    GSYNC();
    { IDS(); gate_phase(p, gw, NGW, lane); }
    GSYNC();
    { IDS(); expert_gu_weights_phase(p, lds, gw, NGW, wave, lane); }
    __syncthreads();
    {
        IDS();
        pg8::SchedPlain S; S.init(TT, DM, G, (int)blockIdx.x);
        pg8::EpiOut E{p};
        pg8::gemm_phase<pg8::EpiOut, pg8::SchedPlain>(lds, (const bf16_t*)(p.ws + WS_MIX), (const bf16_t*)(p.ws + WS_WO), DM, S, E, wave);
    }
    GSYNC();
    { IDS(); ln1_router_phase(p, lds, gw, NGW, wave, lane); }
    GSYNC();
    { IDS(); select_phase(p, lds, wave, lane); }
    GSYNC();
    {
        IDS();
        const int* idx = (const int*)(p.ws + WS_IDX);
        pg8::SchedGrouped<22, true> S{G, (int)blockIdx.x, idx};
        pg8::EpiGU E{p.ws + WS_HID};
        pg8::gemm_phase<pg8::EpiGU, pg8::SchedGrouped<22, true>, true>(lds, (const bf16_t*)(p.ws + WS_X1B), (const bf16_t*)(p.ws + WS_WGU), DM / 2, S, E, wave);
    }
    GSYNC();
    {
        IDS();
        const int* idx = (const int*)(p.ws + WS_IDX);
        const float* gate = (const float*)(p.ws + WS_GATE);
        pg8::SchedGrouped<4, false> S{G, (int)blockIdx.x, idx};
        pg8::EpiDown E{(bf16_t*)(p.ws + WS_EO), gate};
        pg8::gemm_phase<pg8::EpiDown, pg8::SchedGrouped<4, false>, true>(lds, (const bf16_t*)(p.ws + WS_HID), (const bf16_t*)(p.ws + WS_WD), FF / 2, S, E, wave);
    }
    GSYNC();
    { IDS(); ln2_phase(p, gw, NGW, lane); }
#undef IDS
}

extern "C" void kernel_launch(void* const* d_in, const int* in_sizes, int n_in, void* d_out, int out_size, void* d_ws, size_t ws_size, hipStream_t stream) {
    static int grid_blocks = 0;
    if (grid_blocks == 0) {
        if (n_in != 18 || ws_size < WS_END || out_size != TT * DM) { fprintf(stderr, "kernel_launch: unexpected shapes (n_in %d out %d ws %zu)\n", n_in, out_size, ws_size); grid_blocks = -1; return; }
        int dev = 0, cus = 0, per_cu = 0;
        hipGetDevice(&dev);
        hipDeviceGetAttribute(&cus, hipDeviceAttributeMultiprocessorCount, dev);
        if (hipFuncSetAttribute((const void*)fwd_megakernel, hipFuncAttributeMaxDynamicSharedMemorySize, LDS_BYTES) != hipSuccess) { fprintf(stderr, "kernel_launch: hipFuncSetAttribute failed\n"); }
        hipOccupancyMaxActiveBlocksPerMultiprocessor(&per_cu, (const void*)fwd_megakernel, NTHR, LDS_BYTES);
        if (per_cu < 1) per_cu = 1;
        (void)hipGetLastError();
        grid_blocks = cus * per_cu;
    }
    if (grid_blocks < 0) return;
    Params p{};
    for (int i = 0; i < 18; ++i) p.in[i] = (const float*)d_in[i];
    p.out = (float*)d_out; p.ws = (unsigned char*)d_ws;
    if (hipMemsetAsync((char*)d_ws + WS_CTL, 0, 16384, stream) != hipSuccess) { fprintf(stderr, "kernel_launch: hipMemsetAsync failed\n"); return; }
    void* args[] = {&p};
    hipError_t e = hipLaunchCooperativeKernel((void*)fwd_megakernel, dim3(grid_blocks), dim3(NTHR), args, LDS_BYTES, stream);
    if (e != hipSuccess) fprintf(stderr, "cooperative launch failed: %s (grid %d)\n", hipGetErrorString(e), grid_blocks);
}
```

```cpp
#include <hip/hip_runtime.h>
#include <hip/hip_cooperative_groups.h>
#include <cstdio>
#include <cstdint>
namespace cg = cooperative_groups;

#define DI __device__ __forceinline__
#define LAS __attribute__((address_space(3)))
typedef unsigned short bf16_t;
typedef short bf16x8 __attribute__((ext_vector_type(8)));
typedef short s16x4 __attribute__((ext_vector_type(4)));
typedef float f32x4 __attribute__((ext_vector_type(4)));
typedef unsigned u32x4 __attribute__((ext_vector_type(4)));
typedef unsigned u32x2 __attribute__((ext_vector_type(2)));
typedef int i32x4 __attribute__((ext_vector_type(4)));
typedef int i32x8 __attribute__((ext_vector_type(8)));

constexpr int TT = 49152;
constexpr int TP = 32768;
constexpr int DM = 1024;
constexpr int INW = 3088;
constexpr int FF = 2816;
constexpr int NE = 16;
constexpr int SLOTS_E = 6144;
constexpr float ALPHA = 1.189207115002721f;
constexpr float LN_EPS = 1e-5f, RMS_EPS = 1e-5f;

constexpr size_t MiB = 1u << 20;
constexpr size_t TILE_ELEMS = (size_t)TT * 256;
constexpr size_t TILE_BYTES = TILE_ELEMS * 2;
constexpr size_t WS_WI = 0;
constexpr size_t WS_WO = 6 * MiB;
constexpr size_t WS_DT = 8 * MiB;
constexpr size_t WS_ROPE = 11 * MiB;
constexpr size_t WS_AFF = 12 * MiB;
constexpr size_t WS_IDX = 15 * MiB;
constexpr size_t WS_GATE = 15 * MiB + 512 * 1024;
constexpr size_t WS_P = 20 * MiB;
constexpr size_t WS_XC = 308 * MiB;
constexpr size_t WS_XB = 404 * MiB;
constexpr size_t WS_MIX = WS_XB;
constexpr size_t WS_YF = WS_P + 8 * TILE_BYTES;
constexpr size_t WS_YB = WS_P + 10 * TILE_BYTES;
constexpr size_t WS_INV = 16 * MiB;
constexpr size_t WS_WD = 20 * MiB;
constexpr size_t WS_WGU = 108 * MiB;
constexpr size_t WS_EO = 212 * MiB;
constexpr size_t WS_X1B = 308 * MiB;
constexpr size_t WS_HID = 404 * MiB;
constexpr size_t WS_END = 668 * MiB;

constexpr int LDS_BYTES = 147456;
constexpr int NTHR = 512;

DI unsigned f2bf(float f) { unsigned u = __float_as_uint(f); return (u + 0x7fffu + ((u >> 16) & 1u)) >> 16; }
typedef float f32x2v __attribute__((ext_vector_type(2)));
typedef __bf16 bf16x2v __attribute__((ext_vector_type(2)));
DI unsigned pk2(float lo, float hi) { const f32x2v f = {lo, hi}; return __builtin_bit_cast(unsigned, __builtin_convertvector(f, bf16x2v)); }
DI unsigned pk4_f8(float a, float b, float c, float d) { int w = 0; w = __builtin_amdgcn_cvt_pk_fp8_f32(a, b, w, false); w = __builtin_amdgcn_cvt_pk_fp8_f32(c, d, w, true); return (unsigned)w; }
DI i32x8 cat8(bf16x8 lo, bf16x8 hi) { const i32x4 a = __builtin_bit_cast(i32x4, lo), b = __builtin_bit_cast(i32x4, hi); return __builtin_shufflevector(a, b, 0, 1, 2, 3, 4, 5, 6, 7); }
constexpr float WGU_SCALE = 32.0f, WD_SCALE = 64.0f;
DI float bflo(unsigned u) { return __uint_as_float(u << 16); }
DI float bfhi(unsigned u) { return __uint_as_float(u & 0xffff0000u); }
DI float wave_sum(float v) {
#pragma unroll
    for (int o = 1; o < 64; o <<= 1) v += __shfl_xor(v, o);
    return v;
}
DI void st_tr8_pair(LAS bf16_t* base, int stride, int colpair, int lane, const u32x4 v) {
    const unsigned px = __shfl_xor(v.x, 1), py = __shfl_xor(v.y, 1), pz = __shfl_xor(v.z, 1), pw = __shfl_xor(v.w, 1);
    const bool odd = (lane & 1) != 0;
    const unsigned d0 = odd ? ((px >> 16) | (v.x & 0xffff0000u)) : ((v.x & 0xffffu) | (px << 16));
    const unsigned d1 = odd ? ((py >> 16) | (v.y & 0xffff0000u)) : ((v.y & 0xffffu) | (py << 16));
    const unsigned d2 = odd ? ((pz >> 16) | (v.z & 0xffff0000u)) : ((v.z & 0xffffu) | (pz << 16));
    const unsigned d3 = odd ? ((pw >> 16) | (v.w & 0xffff0000u)) : ((v.w & 0xffffu) | (pw << 16));
    LAS unsigned* wp = (LAS unsigned*)(base + (odd ? stride : 0)) + colpair;
    wp[0] = d0; wp[stride] = d1; wp[2 * stride] = d2; wp[3 * stride] = d3;
}
DI float silu_f(float x) { return x * __builtin_amdgcn_rcpf(1.0f + __expf(-x)); }
#define LDS_WAIT() asm volatile("s_waitcnt lgkmcnt(0)" ::: "memory")

struct Params { const float* in[18]; float* out; unsigned char* ws; };
DI int lane_id() { int l = (int)__builtin_amdgcn_mbcnt_hi(~0u, __builtin_amdgcn_mbcnt_lo(~0u, 0u)); asm volatile("" : "+v"(l)); return l; }
#define TIDX(wave_) ((wave_) * 64 + lane_id())

DI const float* xrow_ptr(const Params& p, int t) { return t < TP ? p.in[0] + (size_t)t * DM : p.in[1] + (size_t)(t - TP) * DM; }

namespace pg8 {
constexpr int BM = 256, BK = 64, HALF = 128, HTB = HALF * BK * 2, NXCD = 8, WGM = 8;
DI int lds_byte(int r, int c) { const int st = (r >> 4) * 2 + (c >> 5), rr = r & 15, cc = c & 31, ob = rr * 64 + cc * 2; return st * 1024 + (ob ^ (((ob >> 9) & 1) << 5)); }
DI void stage_rc(int b, int& R, int& C) { const int st = b / 1024, sb = b % 1024, swz = sb ^ (((sb >> 9) & 1) << 5); R = (st >> 1) * 16 + swz / 64; C = (st & 1) * 32 + (swz % 64) / 2; }
DI int perm32(int rho) { const int n = rho >> 4, i = rho & 15; return 8 * (i >> 2) + 4 * n + (i & 3); }

struct Unit { int pm, pn, bt; };

DI int xcd_remap(int L, int nwg) { const int q = nwg / NXCD, r = nwg % NXCD, xcd = L % NXCD, off = L / NXCD; return (xcd < r ? xcd * (q + 1) : r * (q + 1) + (xcd - r) * q) + off; }

struct SchedPlain {
    int nM, nN, nwg, G, c;
    DI void init(int M, int N, int G_, int c_) { nM = M / BM; nN = N / BM; nwg = nM * nN; G = G_; c = c_; }
    DI bool next(int i, Unit& u) const {
        const int L = i * G + c; if (L >= nwg) return false;
        const int wgid = xcd_remap(L, nwg);
        const int nig = WGM * nN, gid = wgid / nig, fm = gid * WGM, gsz = (nM - fm) < WGM ? (nM - fm) : WGM;
        u.pm = fm + ((wgid % nig) % gsz); u.pn = (wgid % nig) / gsz; u.bt = u.pn; return true;
    }
    DI int arow(const Unit& u, int r) const { return u.pm * BM + r; }
};
template <int NPN, bool GATHER> struct SchedGrouped {
    int G, c; const int* idx;
    DI bool next(int i, Unit& u) const {
        constexpr int PER_E = 24 * NPN, NWG = NE * PER_E;
        const int L = i * G + c; if (L >= NWG) return false;
        const int wgid = xcd_remap(L, NWG);
        const int e = wgid / PER_E, rem = wgid % PER_E;
        const int gid = rem / (8 * NPN), w2 = rem % (8 * NPN);
        u.pm = e * 24 + gid * 8 + (w2 % 8); u.pn = w2 / 8; u.bt = e * NPN + u.pn; return true;
    }
    DI int arow(const Unit& u, int r) const { if (GATHER) return idx[u.pm * BM + r]; else return u.pm * BM + r; }
};

template <class Epi, class Sched, bool F8 = false>
DI void gemm_phase(LAS unsigned char* lds, const bf16_t* Ag, const bf16_t* Btg, const int K, const Sched& S, const Epi& E, const int wave_in) {
    const int tid = TIDX(wave_in), wid = wave_in, lane = tid & 63, wr = wid >> 2, wc = wid & 3, fr = lane & 15, fq = lane >> 4;
    const int nt = K / BK;
    unsigned voffB[2];
#pragma unroll
    for (int i = 0; i < 2; ++i) { int R, C; stage_rc(tid * 16 + i * 8192, R, C); const int Rb = Epi::PERM ? ((R & ~31) + perm32(R & 31)) : R;
        voffB[i] = (unsigned)(Rb * K + C) * 2u; }
    const unsigned rowbytes = (unsigned)K * 2u;
    const size_t kstep = (size_t)(BK * 2);
    const size_t hstep = (size_t)HALF * K * 2;
    const size_t tstep = 2 * hstep;
    const unsigned ldsw = (unsigned)wid * 1024u;
    const int aoff = lds_byte(wr * 64 + fr, fq * 8), boff = lds_byte(wc * 32 + fr, fq * 8);
#define PG8_SA(b, h) (((b) * 2 + (h)) * HTB)
#define PG8_SB(b, h) ((4 + (b) * 2 + (h)) * HTB)
#define PG8_STAGE(bufoff, gbase, voff) do { _Pragma("unroll") for (int _i = 0; _i < 2; ++_i) \
        __builtin_amdgcn_global_load_lds((const unsigned*)((const char*)(gbase) + (voff)[_i]), (LAS unsigned*)(lds + (bufoff) + ldsw + _i * 8192), 16, 0, 0); } while (0)
#define PG8_STAGEA(bufoff, o0, o1, kb) do { \
        __builtin_amdgcn_global_load_lds((const unsigned*)((const char*)Ag + (size_t)(o0) + (size_t)(kb)), (LAS unsigned*)(lds + (bufoff) + ldsw), 16, 0, 0); \
        __builtin_amdgcn_global_load_lds((const unsigned*)((const char*)Ag + (size_t)(o1) + (size_t)(kb)), (LAS unsigned*)(lds + (bufoff) + ldsw + 8192), 16, 0, 0); } while (0)
#define PG8_LDA(dst, b, h) do { _Pragma("unroll") for (int m = 0; m < 4; ++m) _Pragma("unroll") for (int k = 0; k < 2; ++k) dst[m][k] = *(const LAS bf16x8*)(lds + PG8_SA(b, h) + aoff + m * 2048 + k * 1024); } while (0)
#define PG8_LDB(dst, b, h) do { _Pragma("unroll") for (int n = 0; n < 2; ++n) _Pragma("unroll") for (int k = 0; k < 2; ++k) dst[n][k] = *(const LAS bf16x8*)(lds + PG8_SB(b, h) + boff + n * 2048 + k * 1024); } while (0)
#define PG8_MMA(ai, bj, At, Bt) do { __builtin_amdgcn_s_setprio(1); _Pragma("unroll") for (int m = 0; m < 4; ++m) _Pragma("unroll") for (int n = 0; n < 2; ++n) { \
        if constexpr (F8) { acc[ai][bj][m][n] = __builtin_amdgcn_mfma_scale_f32_16x16x128_f8f6f4(cat8(Bt[n][0], Bt[n][1]), cat8(At[m][0], At[m][1]), acc[ai][bj][m][n], 0, 0, 0, 0, 0, 0); } \
        else { _Pragma("unroll") for (int k = 0; k < 2; ++k) acc[ai][bj][m][n] = __builtin_amdgcn_mfma_f32_16x16x32_bf16(Bt[n][k], At[m][k], acc[ai][bj][m][n], 0, 0, 0); } } \
        __builtin_amdgcn_s_setprio(0); } while (0)
#define PG8_WAIT_V(n) asm volatile("s_waitcnt vmcnt(" #n ")" ::: "memory")
#define PG8_WAIT_L(n) asm volatile("s_waitcnt lgkmcnt(" #n ")" ::: "memory")
#define PG8_BAR __builtin_amdgcn_s_barrier()
#define PG8_SCHED __builtin_amdgcn_sched_barrier(0)
#define PG8_OFFS(u, o00, o01, o10, o11) do { int R0_, C0_, R1_, C1_; const int t2_ = TIDX(wid); stage_rc(t2_ * 16, R0_, C0_); stage_rc(t2_ * 16 + 8192, R1_, C1_); \
        o00 = (unsigned)S.arow(u, R0_) * rowbytes + (unsigned)C0_ * 2u; o01 = (unsigned)S.arow(u, R1_) * rowbytes + (unsigned)C1_ * 2u; \
        o10 = (unsigned)S.arow(u, HALF + R0_) * rowbytes + (unsigned)C0_ * 2u; o11 = (unsigned)S.arow(u, HALF + R1_) * rowbytes + (unsigned)C1_ * 2u; } while (0)
    Unit cur, nxt; int ui = 0;
    if (!S.next(0, cur)) return;
    f32x4 acc[2][2][4][2];
#pragma unroll
    for (int a = 0; a < 2; ++a)
#pragma unroll
        for (int b = 0; b < 2; ++b)
#pragma unroll
            for (int m = 0; m < 4; ++m)
#pragma unroll
                for (int n = 0; n < 2; ++n) acc[a][b][m][n] = (f32x4){0.f, 0.f, 0.f, 0.f};
    bf16x8 At[4][2], B0[2][2], B1[2][2];
    unsigned c00, c01, c10, c11;
    PG8_OFFS(cur, c00, c01, c10, c11);
    const char* cB = (const char*)Btg + (size_t)cur.bt * tstep;
    PG8_STAGE(PG8_SB(0, 0), cB, voffB); PG8_STAGE(PG8_SB(0, 1), cB + hstep, voffB); PG8_STAGEA(PG8_SA(0, 0), c00, c01, 0); PG8_STAGEA(PG8_SA(0, 1), c10, c11, 0);
    if (wr == 1) PG8_BAR;
    PG8_WAIT_V(2); PG8_BAR;
    PG8_STAGE(PG8_SB(1, 0), cB + kstep, voffB); PG8_STAGEA(PG8_SA(1, 0), c00, c01, kstep); PG8_STAGE(PG8_SB(1, 1), cB + hstep + kstep, voffB);
    PG8_WAIT_V(6); PG8_BAR;
    for (;;) {
        const bool has_next = S.next(ui + 1, nxt);
        const char* nB = has_next ? (const char*)Btg + (size_t)nxt.bt * tstep : cB;
        for (int t = 0; t < nt; t += 2) {
            const bool last = (t == nt - 2);
            const size_t kb1 = (size_t)(t + 1) * kstep;
            const size_t kb2 = last ? 0 : (size_t)(t + 2) * kstep, kb3 = kb2 + kstep;
            const char* b2 = last ? nB : cB + (size_t)(t + 2) * kstep; const char* b3 = b2 + kstep;
            PG8_LDB(B0, 0, 0); PG8_LDB(B1, 0, 1); PG8_SCHED; PG8_LDA(At, 0, 0); PG8_STAGEA(PG8_SA(1, 1), c10, c11, kb1);
            PG8_WAIT_V(8); PG8_WAIT_L(0); PG8_BAR; PG8_MMA(0, 0, At, B0); PG8_MMA(0, 1, At, B1); PG8_BAR; PG8_SCHED;
            if (last && has_next) { PG8_OFFS(nxt, c00, c01, c10, c11); }
            PG8_LDA(At, 0, 1); PG8_STAGE(PG8_SB(0, 0), b2, voffB); PG8_STAGE(PG8_SB(0, 1), b2 + hstep, voffB); PG8_STAGEA(PG8_SA(0, 0), c00, c01, kb2);
            PG8_WAIT_V(8); PG8_WAIT_L(0); PG8_BAR; PG8_MMA(1, 0, At, B0); PG8_MMA(1, 1, At, B1); PG8_BAR; PG8_SCHED;
            PG8_LDB(B0, 1, 0); PG8_LDB(B1, 1, 1); PG8_SCHED; PG8_LDA(At, 1, 0); PG8_STAGEA(PG8_SA(0, 1), c10, c11, kb2);
            PG8_WAIT_V(8); PG8_WAIT_L(0); PG8_BAR; PG8_MMA(0, 0, At, B0); PG8_MMA(0, 1, At, B1); PG8_BAR; PG8_SCHED;
            PG8_LDA(At, 1, 1); PG8_STAGE(PG8_SB(1, 0), b3, voffB); PG8_STAGE(PG8_SB(1, 1), b3 + hstep, voffB); PG8_STAGEA(PG8_SA(1, 0), c00, c01, kb3);
            PG8_WAIT_V(8); PG8_WAIT_L(0); PG8_BAR; PG8_MMA(1, 0, At, B0); PG8_MMA(1, 1, At, B1); PG8_BAR; PG8_SCHED;
        }
        if (wr == 0) PG8_BAR;
        { const int l2 = lane_id(); E(acc, cur, wr, wc, l2 & 15, l2 >> 4); }
        if (!has_next) break;
#pragma unroll
        for (int a = 0; a < 2; ++a)
#pragma unroll
            for (int b = 0; b < 2; ++b)
#pragma unroll
                for (int m = 0; m < 4; ++m)
#pragma unroll
                    for (int n = 0; n < 2; ++n) acc[a][b][m][n] = (f32x4){0.f, 0.f, 0.f, 0.f};
        cur = nxt; cB = nB; ++ui;
        if (wr == 1) PG8_BAR;
    }
    PG8_WAIT_V(0);
    PG8_BAR;
#undef PG8_SA
#undef PG8_SB
#undef PG8_STAGE
#undef PG8_STAGEA
#undef PG8_LDA
#undef PG8_LDB
#undef PG8_MMA
#undef PG8_WAIT_V
#undef PG8_WAIT_L
#undef PG8_BAR
#undef PG8_SCHED
#undef PG8_OFFS
}

struct EpiProj {
    static constexpr bool PERM = true;
    bf16_t* P; const float* rope;
    DI void operator()(const f32x4 (&acc)[2][2][4][2], const Unit& u, int wr, int wc, int fr, int fq) const {
        bf16_t* base = P + (size_t)u.pn * TILE_ELEMS;
        const bool rot = (u.pn < 4) && ((wc & 1) == 0);
#pragma unroll
        for (int ai = 0; ai < 2; ++ai)
#pragma unroll
            for (int m = 0; m < 4; ++m) {
                const int row = u.pm * BM + ai * HALF + wr * 64 + m * 16 + fr;
                asm volatile("" ::: "memory");
                f32x4 cs0 = {1.f, 1.f, 1.f, 1.f}, cs1 = cs0, sn0 = {0.f, 0.f, 0.f, 0.f}, sn1 = sn0;
                if (rot && fq < 2) {
                    const int s = row < TP ? (row & 4095) : (row & 8191);
                    const f32x4* rp = (const f32x4*)(rope + (size_t)s * 16);
                    cs0 = rp[0]; cs1 = rp[1]; sn0 = rp[2]; sn1 = rp[3];
                    if (fq == 0) { sn0 = -sn0; sn1 = -sn1; }
                }
#pragma unroll
                for (int bj = 0; bj < 2; ++bj) {
                    f32x4 v0 = acc[ai][bj][m][0], v1 = acc[ai][bj][m][1];
                    if (rot) {
                        f32x4 o0, o1;
#pragma unroll
                        for (int j = 0; j < 4; ++j) { o0[j] = __shfl_xor(v0[j], 16); o1[j] = __shfl_xor(v1[j], 16); }
                        if (fq < 2) { v0 = v0 * cs0 + o0 * sn0; v1 = v1 * cs1 + o1 * sn1; }
                    }
                    u32x4 w; w.x = pk2(v0[0], v0[1]); w.y = pk2(v0[2], v0[3]); w.z = pk2(v1[0], v1[1]); w.w = pk2(v1[2], v1[3]);
                    *(u32x4*)(base + (size_t)row * 256 + bj * HALF + wc * 32 + 8 * fq) = w;
                }
            }
    }
};
struct EpiOut {
    static constexpr bool PERM = false;
    Params p;
    DI void operator()(const f32x4 (&acc)[2][2][4][2], const Unit& u, int wr, int wc, int fr, int fq) const {
#pragma unroll
        for (int ai = 0; ai < 2; ++ai)
#pragma unroll
            for (int m = 0; m < 4; ++m) {
                const int row = u.pm * BM + ai * HALF + wr * 64 + m * 16 + fr;
                const float* xr = xrow_ptr(p, row); float* orow = p.out + (size_t)row * DM;
#pragma unroll
                for (int bj = 0; bj < 2; ++bj)
#pragma unroll
                    for (int n = 0; n < 2; ++n) {
                        const int col = u.pn * BM + bj * HALF + wc * 32 + 16 * n + 4 * fq;
                        const f32x4 xv = *(const f32x4*)(xr + col);
                        *(f32x4*)(orow + col) = xv * ALPHA + acc[ai][bj][m][n];
                    }
            }
    }
};
struct EpiGU {
    static constexpr bool PERM = true;
    unsigned char* H;
    DI void operator()(const f32x4 (&acc)[2][2][4][2], const Unit& u, int wr, int wc, int fr, int fq) const {
#pragma unroll
        for (int ai = 0; ai < 2; ++ai)
#pragma unroll
            for (int m = 0; m < 4; ++m) {
                const int row = u.pm * BM + ai * HALF + wr * 64 + m * 16 + fr;
                const f32x4 g0 = acc[ai][0][m][0], g1 = acc[ai][0][m][1], u0 = acc[ai][1][m][0], u1 = acc[ai][1][m][1];
                f32x4 h0, h1;
#pragma unroll
                for (int j = 0; j < 4; ++j) { h0[j] = silu_f(g0[j] * (1.0f / WGU_SCALE)) * (u0[j] * (1.0f / WGU_SCALE)); h1[j] = silu_f(g1[j] * (1.0f / WGU_SCALE)) * (u1[j] * (1.0f / WGU_SCALE)); }
                u32x2 w; w.x = pk4_f8(h0[0], h0[1], h0[2], h0[3]); w.y = pk4_f8(h1[0], h1[1], h1[2], h1[3]);
                *(u32x2*)(H + (size_t)row * FF + u.pn * 128 + wc * 32 + 8 * fq) = w;
            }
    }
};
struct EpiDown {
    static constexpr bool PERM = true;
    bf16_t* eo; const float* gate;
    DI void operator()(const f32x4 (&acc)[2][2][4][2], const Unit& u, int wr, int wc, int fr, int fq) const {
#pragma unroll
        for (int ai = 0; ai < 2; ++ai)
#pragma unroll
            for (int m = 0; m < 4; ++m) {
                const int slot = u.pm * BM + ai * HALF + wr * 64 + m * 16 + fr;
                const float gv = gate[slot] * (1.0f / WD_SCALE);
                bf16_t* orow = eo + (size_t)slot * DM + u.pn * BM + wc * 32 + 8 * fq;
#pragma unroll
                for (int bj = 0; bj < 2; ++bj) {
                    const f32x4 v0 = acc[ai][bj][m][0] * gv, v1 = acc[ai][bj][m][1] * gv;
                    u32x4 w; w.x = pk2(v0[0], v0[1]); w.y = pk2(v0[2], v0[3]); w.z = pk2(v1[0], v1[1]); w.w = pk2(v1[2], v1[3]);
                    *(u32x4*)(orow + bj * HALF) = w;
                }
            }
    }
};
}

DI void transpose_item(const float* W, int ldw, int k0, int n0, bf16_t* WT, int ldt, int drow0, LAS float* scr, int lane) {
#pragma unroll 8
    for (int i = 0; i < 32; ++i) { const int kk = 2 * i + (lane >> 5); scr[kk * 33 + (lane & 31)] = W[(size_t)(k0 + kk) * ldw + n0 + (lane & 31)]; }
    LDS_WAIT();
    const int c = lane & 7;
#pragma unroll
    for (int j = 0; j < 4; ++j) { const int n = (lane >> 3) + 8 * j; const LAS float* s = scr + (8 * c) * 33 + n;
        u32x4 o; o.x = pk2(s[0 * 33], s[1 * 33]); o.y = pk2(s[2 * 33], s[3 * 33]); o.z = pk2(s[4 * 33], s[5 * 33]); o.w = pk2(s[6 * 33], s[7 * 33]);
        *(u32x4*)(WT + (size_t)(drow0 + n) * ldt + k0 + 8 * c) = o; }
    LDS_WAIT();
}

DI void transpose_item_f8(const float* W, int ldw, int k0, int n0, unsigned char* WT, int ldt, int drow0, float scale, LAS float* scr, int lane) {
#pragma unroll 8
    for (int i = 0; i < 32; ++i) { const int kk = 2 * i + (lane >> 5); scr[kk * 33 + (lane & 31)] = W[(size_t)(k0 + kk) * ldw + n0 + (lane & 31)] * scale; }
    LDS_WAIT();
    const int c = lane & 7;
#pragma unroll
    for (int j = 0; j < 4; ++j) { const int n = (lane >> 3) + 8 * j; const LAS float* sp = scr + (8 * c) * 33 + n;
        u32x2 o; o.x = pk4_f8(sp[0 * 33], sp[1 * 33], sp[2 * 33], sp[3 * 33]); o.y = pk4_f8(sp[4 * 33], sp[5 * 33], sp[6 * 33], sp[7 * 33]);
        *(u32x2*)(WT + (size_t)(drow0 + n) * ldt + k0 + 8 * c) = o; }
    LDS_WAIT();
}

DI void sincos_small(double r, double& s, double& c) {
    const double r2 = r * r; double ss = 1.0, cc = 1.0;
#pragma unroll
    for (int n = 12; n >= 1; --n) { ss = 1.0 - ss * r2 * (1.0 / (double)((2 * n) * (2 * n + 1))); cc = 1.0 - cc * r2 * (1.0 / (double)((2 * n - 1) * (2 * n))); }
    s = r * ss; c = cc;
}

DI void dot16(const f32x4 (&v)[4], const LAS float* wT, int lane, float (&r)[16]) {
#pragma unroll
    for (int e = 0; e < 16; ++e) {
        float a = 0.f;
        if ((e & 1) == 0) asm volatile("" ::: "memory");
#pragma unroll
        for (int j = 0; j < 4; ++j) { const f32x4 w = *(const LAS f32x4*)(wT + e * 1024 + 256 * j + 4 * lane); a += v[j][0] * w[0] + v[j][1] * w[1] + v[j][2] * w[2] + v[j][3] * w[3]; }
        r[e] = wave_sum(a);
    }
}

DI void phase0(const Params& p, LAS unsigned char* lds, int gw, int NGW, int wave, int lane) {
    const int tid = TIDX(wave);
    {
        LAS float* scr = (LAS float*)(lds + wave * 16384);
        for (int it = gw; it < 2048; it += NGW) {
            if (it < 1536) { const int kb = it / 96, nb = it % 96; transpose_item(p.in[2], INW, 64 * kb, 32 * nb, (bf16_t*)(p.ws + WS_WI), DM, 32 * nb, scr, lane); }
            else { const int r = it - 1536, kb = r / 32, nb = r % 32; transpose_item(p.in[9], DM, 64 * kb, 32 * nb, (bf16_t*)(p.ws + WS_WO), DM, 32 * nb, scr, lane); }
        }
    }
    {
        float* rope = (float*)(p.ws + WS_ROPE);
        const float invf[8] = {1.0f, 0.1939227432012558f, 0.03760603070259094f, 0.007292664609849453f, 0.0014142135623842478f, 0.00027424818836152554f, 5.318296098266728e-05f, 1.0313386155758053e-05f};
        for (int id = blockIdx.x * NTHR + tid; id < 8192 * 8; id += gridDim.x * NTHR) {
            const int pos = id >> 3, i = id & 7;
            float inv = invf[0];
#pragma unroll
            for (int k = 1; k < 8; ++k) inv = (i == k) ? invf[k] : inv;
            const float ang = (float)pos * inv;
            const double x = (double)ang; const double kq = rint(x * 0.15915494309189535); const double r = x - kq * 6.283185307179586476925;
            double s, c; sincos_small(r, s, c);
            rope[pos * 16 + i] = (float)c; rope[pos * 16 + 8 + i] = (float)s;
        }
    }
    __syncthreads();
    LAS float* wT = (LAS float*)lds;
    for (int id = tid; id < 16384; id += NTHR) { const int k = id >> 4, e = id & 15; wT[e * 1024 + k] = p.in[2][(size_t)k * INW + 3072 + e]; }
    __syncthreads();
    const float* dtb = p.in[5];
    float bias = 0.f;
    if (lane < 16) bias = dtb[lane];
    bf16_t* xb = (bf16_t*)(p.ws + WS_XB); float* dtout = (float*)(p.ws + WS_DT);
    for (int t = gw; t < TT; t += NGW) {
        const f32x4* xr = (const f32x4*)xrow_ptr(p, t) + lane;
        f32x4 v[4];
#pragma unroll
        for (int j = 0; j < 4; ++j) v[j] = xr[64 * j];
        u32x2* o8 = (u32x2*)(xb + (size_t)t * DM) + lane;
#pragma unroll
        for (int j = 0; j < 4; ++j) { u32x2 w; w.x = pk2(v[j][0], v[j][1]); w.y = pk2(v[j][2], v[j][3]); o8[64 * j] = w; }
        float r[16]; dot16(v, wT, lane, r);
        float mine = 0.f;
#pragma unroll
        for (int e = 0; e < 16; ++e) mine = (lane == e) ? r[e] : mine;
        if (lane < 16) { const float z = mine + bias; dtout[(size_t)t * 16 + lane] = fmaxf(z, 0.f) + log1pf(__expf(-fabsf(z))); }
    }
}

DI void conv_phase(const Params& p, int wave) {
    const int tid = blockIdx.x * NTHR + TIDX(wave), nthr = gridDim.x * NTHR;
    const int c = tid & 127, ch = 8 * c, tile = ch >> 8, cit = ch & 255;
    const float* cw = p.in[3]; const float* cb = p.in[4];
    float w[5][8], b[8];
#pragma unroll
    for (int j = 0; j < 5; ++j)
#pragma unroll
        for (int e = 0; e < 8; ++e) w[j][e] = cw[j * 1024 + ch + e];
#pragma unroll
    for (int e = 0; e < 8; ++e) b[e] = cb[ch + e];
    const bf16_t* src = (const bf16_t*)(p.ws + WS_P) + (size_t)(8 + tile) * TILE_ELEMS + cit;
    bf16_t* dst = (bf16_t*)(p.ws + WS_XC) + (size_t)tile * TILE_ELEMS + cit;
    for (int it = tid; it < TT * 128; it += nthr) {
        const int t = it >> 7;
        const int S = t < TP ? 4096 : 8192, s = t & (S - 1);
        float a[8];
#pragma unroll
        for (int e = 0; e < 8; ++e) a[e] = b[e];
#pragma unroll
        for (int j = 0; j < 5; ++j) {
            const int sj = s + j - 2;
            if (sj >= 0 && sj < S) {
                const u32x4 v = *(const u32x4*)(src + (size_t)(t + j - 2) * 256);
                a[0] += bflo(v.x) * w[j][0]; a[1] += bfhi(v.x) * w[j][1]; a[2] += bflo(v.y) * w[j][2]; a[3] += bfhi(v.y) * w[j][3];
                a[4] += bflo(v.z) * w[j][4]; a[5] += bfhi(v.z) * w[j][5]; a[6] += bflo(v.w) * w[j][6]; a[7] += bfhi(v.w) * w[j][7];
            }
        }
        u32x4 o; o.x = pk2(silu_f(a[0]), silu_f(a[1])); o.y = pk2(silu_f(a[2]), silu_f(a[3])); o.z = pk2(silu_f(a[4]), silu_f(a[5])); o.w = pk2(silu_f(a[6]), silu_f(a[7]));
        *(u32x4*)(dst + (size_t)t * 256) = o;
    }
}

DI bf16x8 tr_pair(const LAS bf16_t* lo, const LAS bf16_t* hi) {
    const s16x4 a = __builtin_amdgcn_ds_read_tr16_b64_v4i16((LAS s16x4*)lo), b = __builtin_amdgcn_ds_read_tr16_b64_v4i16((LAS s16x4*)hi);
    return __builtin_shufflevector(a, b, 0, 1, 2, 3, 4, 5, 6, 7);
}
DI void attn_step_params(int sidx, int p0, int& d, int& base, int& nk, int& kbase, bool& actA, bool& actB) {
    const int pi = sidx < 12 ? 0 : (sidx < 18 ? 1 : 2);
    const int st = sidx - (pi == 0 ? 0 : (pi == 1 ? 12 : (sidx < 23 ? 18 : 23)));
    d = 1 << (2 * pi); base = p0 - 64 * d + (sidx >= 23 ? 8 : 0); nk = pi == 0 ? 377 : (pi == 1 ? 191 : 144); kbase = 32 * st;
    actA = sidx < 23; actB = sidx < 18 || sidx >= 23;
}
DI void attn_phase(const Params& p, LAS unsigned char* lds, int gw, int NGW, int wave, int lane) {
    LAS bf16_t* Vn0 = (LAS bf16_t*)(lds + wave * 9216);
    const bf16_t* Pb = (const bf16_t*)(p.ws + WS_P);
    bf16_t* mix = (bf16_t*)(p.ws + WS_MIX);
    const int c = lane & 15, q = lane >> 4, qp = (lane & 15) >> 2, pp = lane & 3;
    for (int wi = gw; wi < 12288; wi += NGW) {
        const int head = wi & 7, qg = wi >> 3;
        const int t0 = (qg >> 3) * 256 + (qg & 7);
        const int S = t0 < TP ? 4096 : 8192, sbase = t0 & ~(S - 1), p0 = t0 - sbase;
        const int hoff = (head & 3) * 64;
        const bf16_t* Qt = Pb + (size_t)(0 + (head >> 2)) * TILE_ELEMS + hoff;
        const bf16_t* Kt = Pb + (size_t)(2 + (head >> 2)) * TILE_ELEMS + hoff;
        const bf16_t* Vg = Pb + (size_t)(4 + (head >> 2)) * TILE_ELEMS + hoff;
        bf16x8 qf[2][2];
#pragma unroll
        for (int X = 0; X < 2; ++X) { const bf16_t* qrow = Qt + (size_t)(t0 + 8 * X + 16 * c) * 256;
#pragma unroll
            for (int ks = 0; ks < 2; ++ks) {
                const u32x4 w = *(const u32x4*)(qrow + 32 * ks + 8 * q); constexpr float QS = 0.125f * 1.4426950408889634f;
                u32x4 o; o.x = pk2(bflo(w.x) * QS, bfhi(w.x) * QS); o.y = pk2(bflo(w.y) * QS, bfhi(w.y) * QS); o.z = pk2(bflo(w.z) * QS, bfhi(w.z) * QS); o.w = pk2(bflo(w.w) * QS, bfhi(w.w) * QS);
                qf[X][ks] = __builtin_bit_cast(bf16x8, o); } }
        f32x4 O[2][4];
#pragma unroll
        for (int X = 0; X < 2; ++X)
#pragma unroll
            for (int d4 = 0; d4 < 4; ++d4) O[X][d4] = (f32x4){0.f, 0.f, 0.f, 0.f};
        float mrun[2] = {-1e30f, -1e30f}, lsum[2] = {0.f, 0.f};
        u32x4 vb[3][4]; bf16x8 kb[3][2][2];
#define ATT_LOADS(sidx_, V_, K_) do { int d_, base_, nk_, kbase_; bool a_, b_; attn_step_params(sidx_, p0, d_, base_, nk_, kbase_, a_, b_); \
            _Pragma("unroll") for (int i = 0; i < 4; ++i) { const int id = lane + 64 * i, key = id >> 3, dc = id & 7; \
                int pos = base_ + d_ * (kbase_ + key); pos = pos < 0 ? 0 : (pos > S - 1 ? S - 1 : pos); \
                V_[i] = *(const u32x4*)(Vg + (size_t)(sbase + pos) * 256 + 8 * dc); } \
            _Pragma("unroll") for (int kt = 0; kt < 2; ++kt) { int pos = base_ + d_ * (kbase_ + 16 * kt + c); pos = pos < 0 ? 0 : (pos > S - 1 ? S - 1 : pos); \
                const bf16_t* krow = Kt + (size_t)(sbase + pos) * 256; K_[kt][0] = *(const bf16x8*)(krow + 8 * q); K_[kt][1] = *(const bf16x8*)(krow + 32 + 8 * q); } } while (0)
        ATT_LOADS(0, vb[0], kb[0]);
        ATT_LOADS(1, vb[1], kb[1]);
#pragma unroll
        for (int i = 0; i < 4; ++i) { const int id = lane + 64 * i; *(LAS u32x4*)(Vn0 + (id >> 3) * 72 + 8 * (id & 7)) = vb[0][i]; }
        for (int s3 = 0; s3 < 30; s3 += 3) {
#pragma unroll
          for (int u = 0; u < 3; ++u) {
            const int sidx = s3 + u;
            if (sidx + 2 < 28) ATT_LOADS(sidx + 2, vb[(u + 2) % 3], kb[(u + 2) % 3]);
            if (sidx < 28) {
            int d, base, nk, kbase; bool act[2]; attn_step_params(sidx, p0, d, base, nk, kbase, act[0], act[1]);
            const int win = 64 * d;
            bf16x8 vf[4];
            { const LAS bf16_t* Vn = Vn0 + (sidx & 1) * 2304;
#pragma unroll
              for (int d4 = 0; d4 < 4; ++d4) { const LAS bf16_t* vr = Vn + (4 * q + qp) * 72 + 16 * d4 + 4 * pp; vf[d4] = tr_pair(vr, vr + 16 * 72); } }
            if (sidx + 1 < 28) { LAS bf16_t* Vw = Vn0 + ((sidx + 1) & 1) * 2304;
#pragma unroll
              for (int i = 0; i < 4; ++i) { const int id = lane + 64 * i; *(LAS u32x4*)(Vw + (id >> 3) * 72 + 8 * (id & 7)) = vb[(u + 1) % 3][i]; } }
            f32x4 sc[2][2];
#pragma unroll
            for (int X = 0; X < 2; ++X)
#pragma unroll
                for (int kt = 0; kt < 2; ++kt) {
                    f32x4 a = {0.f, 0.f, 0.f, 0.f};
                    a = __builtin_amdgcn_mfma_f32_16x16x32_bf16(kb[u][kt][0], qf[X][0], a, 0, 0, 0);
                    a = __builtin_amdgcn_mfma_f32_16x16x32_bf16(kb[u][kt][1], qf[X][1], a, 0, 0, 0);
                    sc[X][kt] = a;
                }
            const int sh = d == 1 ? 0 : (d == 4 ? 2 : 4);
            int rr[2]; unsigned rng[2];
#pragma unroll
            for (int X = 0; X < 2; ++X) {
                const int pq = p0 + 8 * X + 16 * c;
                const int nb = base < 0 ? -base : 0;
                int klo = (pq - win - base) >> sh; const int k2 = (nb + d - 1) >> sh; klo = klo > k2 ? klo : k2;
                int khi = (pq + win - base) >> sh; const int k3 = (S - 1 - base) >> sh; khi = khi < k3 ? khi : k3; khi = khi < nk - 1 ? khi : nk - 1;
                if (!act[X]) { klo = 1 << 20; khi = klo; }
                rr[X] = kbase + 4 * q - klo; rng[X] = (unsigned)(khi - klo);
            }
            bool valid[2][2][4]; float mloc[2];
#pragma unroll
            for (int X = 0; X < 2; ++X) {
                float m = -1e30f;
#pragma unroll
                for (int kt = 0; kt < 2; ++kt)
#pragma unroll
                    for (int j = 0; j < 4; ++j) {
                        valid[X][kt][j] = (unsigned)(rr[X] + 16 * kt + j) <= rng[X];
                        const float sv = valid[X][kt][j] ? sc[X][kt][j] : -1e30f;
                        sc[X][kt][j] = sv; m = fmaxf(m, sv);
                    }
                mloc[X] = m;
            }
#pragma unroll
            for (int X = 0; X < 2; ++X) {
                const u32x2 r = __builtin_amdgcn_permlane32_swap(__float_as_uint(mloc[X]), __float_as_uint(mloc[X]), false, false);
                mloc[X] = fmaxf(fmaxf(mloc[X], __uint_as_float(r[0])), __uint_as_float(r[1]));
            }
#pragma unroll
            for (int X = 0; X < 2; ++X) {
                const u32x2 r = __builtin_amdgcn_permlane16_swap(__float_as_uint(mloc[X]), __float_as_uint(mloc[X]), false, false);
                mloc[X] = fmaxf(fmaxf(mloc[X], __uint_as_float(r[0])), __uint_as_float(r[1]));
            }
            float alpha[2]; bf16x8 pf[2];
#pragma unroll
            for (int X = 0; X < 2; ++X) {
                const float mnew = fmaxf(mrun[X], mloc[X]); alpha[X] = __builtin_amdgcn_exp2f(mrun[X] - mnew); mrun[X] = mnew;
                float ps = 0.f; float pv[2][4];
#pragma unroll
                for (int kt = 0; kt < 2; ++kt)
#pragma unroll
                    for (int j = 0; j < 4; ++j) { pv[kt][j] = valid[X][kt][j] ? __builtin_amdgcn_exp2f(sc[X][kt][j] - mnew) : 0.f; ps += pv[kt][j]; }
                lsum[X] = lsum[X] * alpha[X] + ps;
                u32x4 pw; pw.x = pk2(pv[0][0], pv[0][1]); pw.y = pk2(pv[0][2], pv[0][3]); pw.z = pk2(pv[1][0], pv[1][1]); pw.w = pk2(pv[1][2], pv[1][3]);
                pf[X] = __builtin_bit_cast(bf16x8, pw);
            }
#pragma unroll
            for (int d4 = 0; d4 < 4; ++d4)
#pragma unroll
                for (int X = 0; X < 2; ++X) O[X][d4] = __builtin_amdgcn_mfma_f32_16x16x32_bf16(vf[d4], pf[X], O[X][d4] * alpha[X], 0, 0, 0);
            }
          }
        }
#undef ATT_LOADS
#pragma unroll
        for (int X = 0; X < 2; ++X) {
            float l = lsum[X]; l += __shfl_xor(l, 16); l += __shfl_xor(l, 32);
            const float inv = 1.0f / l;
            bf16_t* orow = mix + (size_t)(t0 + 8 * X + 16 * c) * DM + head * 64 + 4 * q;
#pragma unroll
            for (int d4 = 0; d4 < 4; ++d4) { u32x2 w; w.x = pk2(O[X][d4][0] * inv, O[X][d4][1] * inv); w.y = pk2(O[X][d4][2] * inv, O[X][d4][3] * inv); *(u32x2*)(orow + 16 * d4) = w; }
        }
    }
}

constexpr size_t WS_SLOC = WS_P;
constexpr size_t WS_DEC = WS_P + 96 * MiB;
constexpr int N_SSD_ITEMS = 6144;
struct SsdItem { int h, dir, g, tb, ts; float A; };
DI SsdItem ssd_decode(const Params& p, int it) {
    int w, ci; if (it < 4096) { w = it >> 5; ci = it & 31; } else { w = 128 + ((it - 4096) >> 6); ci = (it - 4096) & 63; }
    SsdItem I; const int seq = w >> 4; I.h = (w >> 1) & 7; I.dir = w & 1; I.g = I.h >> 2;
    const int S = seq < 8 ? 4096 : 8192, sbase = seq < 8 ? seq * 4096 : TP + (seq - 8) * 8192;
    I.tb = I.dir ? sbase + S - 1 - 128 * ci : sbase + 128 * ci; I.ts = I.dir ? -1 : 1;
    I.A = -__expf(p.in[6][I.dir * 8 + I.h]);
    return I;
}
#define SSD_TOK(I, l) ((I).tb + (I).ts * (l))
DI void ssd_scan_chunk(float d0, float d1, float A, LAS float* acs, LAS float* dts, int lane) {
    const float v0 = d0 * A, v1 = d1 * A; float ps = v0 + v1;
#pragma unroll
    for (int o = 1; o < 64; o <<= 1) { const float t = __shfl_up(ps, o); if (lane >= o) ps += t; }
    acs[2 * lane] = ps - v1; acs[2 * lane + 1] = ps; dts[2 * lane] = d0; dts[2 * lane + 1] = d1;
}
DI void st_tr8(LAS bf16_t* wp, int stride, const u32x4 v) {
    wp[0 * stride] = (bf16_t)(v.x & 0xffffu); wp[1 * stride] = (bf16_t)(v.x >> 16); wp[2 * stride] = (bf16_t)(v.y & 0xffffu); wp[3 * stride] = (bf16_t)(v.y >> 16);
    wp[4 * stride] = (bf16_t)(v.z & 0xffffu); wp[5 * stride] = (bf16_t)(v.z >> 16); wp[6 * stride] = (bf16_t)(v.w & 0xffffu); wp[7 * stride] = (bf16_t)(v.w >> 16);
}
DI void ssd_state_phase(const Params& p, LAS unsigned char* lds, int wave, int lane) {
    const int tid = TIDX(wave), c = lane & 15, q = lane >> 4, w = wave, qp = (lane & 15) >> 2, pp = lane & 3;
    LAS float* acs = (LAS float*)(lds + 0); LAS float* dts = (LAS float*)(lds + 512);
    LAS bf16_t* Xt2 = (LAS bf16_t*)(lds + 1024); LAS bf16_t* Bt = (LAS bf16_t*)(lds + 1024 + 128 * 144);
    const float* dtb = (const float*)(p.ws + WS_DT);
    const bf16_t* XCb = (const bf16_t*)(p.ws + WS_XC);
    bf16_t* Sl = (bf16_t*)(p.ws + WS_SLOC); float* decv = (float*)(p.ws + WS_DEC);
    int it = (gridDim.x % 8 == 0) ? ((int)blockIdx.x % 8) * ((int)gridDim.x / 8) + (int)blockIdx.x / 8 : (int)blockIdx.x;
    if (it >= N_SSD_ITEMS) return;
    SsdItem I = ssd_decode(p, it);
    float pd0 = 0.f, pd1 = 0.f; u32x4 xv[2], bv[4];
#define SSD_LOADS_A(I) do { \
        if (w == 0) { pd0 = dtb[(size_t)SSD_TOK(I, 2 * lane) * 16 + (I).dir * 8 + (I).h]; pd1 = dtb[(size_t)SSD_TOK(I, 2 * lane + 1) * 16 + (I).dir * 8 + (I).h]; } \
        _Pragma("unroll") for (int i = 0; i < 2; ++i) { const int id = tid + NTHR * i, l = id >> 3, pc = id & 7; \
            xv[i] = *(const u32x4*)(XCb + (size_t)((I).h >> 2) * TILE_ELEMS + (size_t)SSD_TOK(I, l) * 256 + ((I).h & 3) * 64 + 8 * pc); } \
        _Pragma("unroll") for (int i = 0; i < 4; ++i) { const int id = tid + NTHR * i, l = id >> 4, ncn = id & 15; \
            bv[i] = *(const u32x4*)(XCb + 2 * TILE_ELEMS + (size_t)SSD_TOK(I, l) * 256 + (I).g * 128 + 8 * ncn); } } while (0)
    SSD_LOADS_A(I);
    for (; it < N_SSD_ITEMS; it += gridDim.x) {
        if (w == 0) ssd_scan_chunk(pd0, pd1, I.A, acs, dts, lane);
        __syncthreads();
        const float aend = acs[127];
#pragma unroll
        for (int i = 0; i < 2; ++i) {
            const int id = tid + NTHR * i, l = id >> 3, pc = id & 7;
            const float s2 = dts[l] * __expf(aend - acs[l]);
            const u32x4 v = xv[i];
            u32x4 o; o.x = pk2(bflo(v.x) * s2, bfhi(v.x) * s2); o.y = pk2(bflo(v.y) * s2, bfhi(v.y) * s2); o.z = pk2(bflo(v.z) * s2, bfhi(v.z) * s2); o.w = pk2(bflo(v.w) * s2, bfhi(v.w) * s2);
            *(LAS u32x4*)(Xt2 + l * 72 + 8 * pc) = o;
        }
#pragma unroll
        for (int i = 0; i < 4; ++i) { const int id = tid + NTHR * i; *(LAS u32x4*)(Bt + (id >> 4) * 136 + 8 * (id & 15)) = bv[i]; }
        const int itn = it + gridDim.x;
        if (itn < N_SSD_ITEMS) { I = ssd_decode(p, itn); SSD_LOADS_A(I); }
        __syncthreads();
        bf16_t* so = Sl + (size_t)it * 8192 + 16 * w + 4 * q;
#pragma unroll
        for (int pt = 0; pt < 4; ++pt) {
            f32x4 a = {0.f, 0.f, 0.f, 0.f};
#pragma unroll
            for (int ks = 0; ks < 4; ++ks) {
                const LAS bf16_t* br = Bt + (32 * ks + 8 * q + qp) * 136 + 16 * w + 4 * pp;
                const LAS bf16_t* xr = Xt2 + (32 * ks + 8 * q + qp) * 72 + 16 * pt + 4 * pp;
                const bf16x8 bfr = tr_pair(br, br + 4 * 136), xf = tr_pair(xr, xr + 4 * 72);
                a = __builtin_amdgcn_mfma_f32_16x16x32_bf16(bfr, xf, a, 0, 0, 0);
            }
            u32x2 o; o.x = pk2(a[0], a[1]); o.y = pk2(a[2], a[3]);
            *(u32x2*)(so + (16 * pt + c) * 128) = o;
        }
        if (tid == 0) decv[it] = __expf(aend);
    }
#undef SSD_LOADS_A
}
DI void ssd_scan_phase(const Params& p, int wave) {
    unsigned* Sl = (unsigned*)(p.ws + WS_SLOC); const float* decv = (const float*)(p.ws + WS_DEC);
    for (int chain = blockIdx.x * NTHR + TIDX(wave); chain < 160 * 4096; chain += gridDim.x * NTHR) {
        const int w = chain >> 12, j = chain & 4095;
        const int nc = w < 128 ? 32 : 64, cb = w < 128 ? 32 * w : 4096 + 64 * (w - 128);
        unsigned* ptr = Sl + (size_t)cb * 4096 + j; const float* dp = decv + cb;
        float s0 = 0.f, s1 = 0.f;
        for (int c0 = 0; c0 < nc; c0 += 8) {
            unsigned v[8]; float d[8];
#pragma unroll
            for (int k = 0; k < 8; ++k) { v[k] = ptr[(size_t)(c0 + k) * 4096]; d[k] = dp[c0 + k]; }
#pragma unroll
            for (int k = 0; k < 8; ++k) { ptr[(size_t)(c0 + k) * 4096] = pk2(s0, s1); s0 = s0 * d[k] + bflo(v[k]); s1 = s1 * d[k] + bfhi(v[k]); }
        }
    }
}
constexpr int SSDC_ACS = 0  , SSDC_XT1 = 2048, SSDC_BN = SSDC_XT1 + 128 * 144, SSDC_SBF = SSDC_BN + 128 * 272, SSDC_END = SSDC_SBF + 64 * 272;
static_assert(SSDC_END <= 131072, "ssd lds");
DI void ssd_out_phase(const Params& p, LAS unsigned char* lds, int wave, int lane) {
    const int tid = TIDX(wave), c = lane & 15, q = lane >> 4, w = wave, qp = (lane & 15) >> 2, pp = lane & 3;
    LAS bf16_t* Xt1 = (LAS bf16_t*)(lds + SSDC_XT1); LAS bf16_t* Bn = (LAS bf16_t*)(lds + SSDC_BN); LAS bf16_t* Sbf = (LAS bf16_t*)(lds + SSDC_SBF);
    const float* dtb = (const float*)(p.ws + WS_DT);
    const bf16_t* XCb = (const bf16_t*)(p.ws + WS_XC);
    const bf16_t* Sl = (const bf16_t*)(p.ws + WS_SLOC);
    int it = (gridDim.x % 8 == 0) ? ((int)blockIdx.x % 8) * ((int)gridDim.x / 8) + (int)blockIdx.x / 8 : (int)blockIdx.x;
    if (it >= N_SSD_ITEMS) return;
    SsdItem I = ssd_decode(p, it);
    float pd0 = 0.f, pd1 = 0.f; u32x4 xv[2], bv[4], sv[2]; bf16x8 Cn[4];
#define SSD_LOADS_C(I, itx) do { \
        if (w == 0) { pd0 = dtb[(size_t)SSD_TOK(I, 2 * lane) * 16 + (I).dir * 8 + (I).h]; pd1 = dtb[(size_t)SSD_TOK(I, 2 * lane + 1) * 16 + (I).dir * 8 + (I).h]; } \
        _Pragma("unroll") for (int i = 0; i < 2; ++i) { const int id = tid + NTHR * i, l = id >> 3, pc = id & 7; \
            xv[i] = *(const u32x4*)(XCb + (size_t)((I).h >> 2) * TILE_ELEMS + (size_t)SSD_TOK(I, l) * 256 + ((I).h & 3) * 64 + 8 * pc); \
            sv[i] = *(const u32x4*)(Sl + (size_t)(itx) * 8192 + (size_t)id * 8); } \
        _Pragma("unroll") for (int i = 0; i < 4; ++i) { const int id = tid + NTHR * i, l = id >> 4, ncn = id & 15; \
            bv[i] = *(const u32x4*)(XCb + 2 * TILE_ELEMS + (size_t)SSD_TOK(I, l) * 256 + (I).g * 128 + 8 * ncn); } \
        { const bf16_t* cr = XCb + 3 * TILE_ELEMS + (size_t)SSD_TOK(I, 16 * w + c) * 256 + (I).g * 128 + 8 * q; \
          _Pragma("unroll") for (int ks = 0; ks < 4; ++ks) Cn[ks] = *(const bf16x8*)(cr + 32 * ks); } } while (0)
    SSD_LOADS_C(I, it);
    int par = 0;
    for (; it < N_SSD_ITEMS; it += gridDim.x, par ^= 1) {
        LAS float* acs = (LAS float*)(lds + SSDC_ACS + par * 1024); LAS float* dts = acs + 128;
        if (w == 0) ssd_scan_chunk(pd0, pd1, I.A, acs, dts, lane);
        __syncthreads();
#pragma unroll
        for (int i = 0; i < 2; ++i) {
            const int id = tid + NTHR * i, l = id >> 3, pc = id & 7;
            const float s1 = dts[l];
            const u32x4 v = xv[i];
            u32x4 o; o.x = pk2(bflo(v.x) * s1, bfhi(v.x) * s1); o.y = pk2(bflo(v.y) * s1, bfhi(v.y) * s1); o.z = pk2(bflo(v.z) * s1, bfhi(v.z) * s1); o.w = pk2(bflo(v.w) * s1, bfhi(v.w) * s1);
            *(LAS u32x4*)(Xt1 + l * 72 + 8 * pc) = o;
            *(LAS u32x4*)(Sbf + (id >> 4) * 136 + 8 * (id & 15)) = sv[i];
        }
#pragma unroll
        for (int i = 0; i < 4; ++i) { const int id = tid + NTHR * i; *(LAS u32x4*)(Bn + (id >> 4) * 136 + 8 * (id & 15)) = bv[i]; }
        bf16x8 Cf[4];
#pragma unroll
        for (int ks = 0; ks < 4; ++ks) Cf[ks] = Cn[ks];
        const SsdItem Ic = I;
        const int itn = it + gridDim.x;
        if (itn < N_SSD_ITEMS) { I = ssd_decode(p, itn); SSD_LOADS_C(I, itn); }
        __syncthreads();
        {
            const int l = 16 * w + c;
            const float al = acs[l];
            f32x4 acc[4];
#pragma unroll
            for (int pt = 0; pt < 4; ++pt) {
                f32x4 a = {0.f, 0.f, 0.f, 0.f};
#pragma unroll
                for (int ks = 0; ks < 4; ++ks) { const bf16x8 sf = *(const LAS bf16x8*)(Sbf + (16 * pt + c) * 136 + 32 * ks + 8 * q); a = __builtin_amdgcn_mfma_f32_16x16x32_bf16(sf, Cf[ks], a, 0, 0, 0); }
                acc[pt] = a * __expf(al);
            }
            const int nsp = (w >> 1) + 1;
            for (int sp = 0; sp < nsp; ++sp) {
                f32x4 M[2];
#pragma unroll
                for (int hh = 0; hh < 2; ++hh) {
                    const int st = 2 * sp + hh;
                    f32x4 G = {0.f, 0.f, 0.f, 0.f};
                    if (st <= w) {
#pragma unroll
                        for (int ks = 0; ks < 4; ++ks) { const bf16x8 bfr = *(const LAS bf16x8*)(Bn + (16 * st + c) * 136 + 32 * ks + 8 * q); G = __builtin_amdgcn_mfma_f32_16x16x32_bf16(bfr, Cf[ks], G, 0, 0, 0); }
#pragma unroll
                        for (int j = 0; j < 4; ++j) { const int s = 16 * st + 4 * q + j; const float e = __expf(al - acs[s]); G[j] = (s <= l) ? G[j] * e : 0.f; }
                    }
                    M[hh] = G;
                }
                u32x4 pw; pw.x = pk2(M[0][0], M[0][1]); pw.y = pk2(M[0][2], M[0][3]); pw.z = pk2(M[1][0], M[1][1]); pw.w = pk2(M[1][2], M[1][3]);
                const bf16x8 pf = __builtin_bit_cast(bf16x8, pw);
#pragma unroll
                for (int pt = 0; pt < 4; ++pt) {
                    const LAS bf16_t* xr = Xt1 + (32 * sp + 4 * q + qp) * 72 + 16 * pt + 4 * pp;
                    const bf16x8 xf = tr_pair(xr, xr + 16 * 72);
                    acc[pt] = __builtin_amdgcn_mfma_f32_16x16x32_bf16(xf, pf, acc[pt], 0, 0, 0);
                }
            }
            bf16_t* yr = (bf16_t*)(p.ws + (Ic.dir ? WS_YB : WS_YF)) + Ic.h * 64 + (size_t)SSD_TOK(Ic, l) * 512 + 4 * q;
#pragma unroll
            for (int pt = 0; pt < 4; ++pt) { u32x2 o; o.x = pk2(acc[pt][0], acc[pt][1]); o.y = pk2(acc[pt][2], acc[pt][3]); *(u32x2*)(yr + 16 * pt) = o; }
        }
    }
#undef SSD_LOADS_C
}

DI void gate_phase(const Params& p, int gw, int NGW, int lane) {
    const bf16_t* yf = (const bf16_t*)(p.ws + WS_YF); const bf16_t* yb = (const bf16_t*)(p.ws + WS_YB);
    const bf16_t* xh = (const bf16_t*)(p.ws + WS_XC) + (size_t)(lane >> 5) * TILE_ELEMS + (8 * lane & 255);
    const bf16_t* zt = (const bf16_t*)(p.ws + WS_P) + (size_t)(6 + (lane >> 5)) * TILE_ELEMS + (8 * lane & 255);
    bf16_t* mix = (bf16_t*)(p.ws + WS_MIX) + 512 + 8 * lane;
    const float D = p.in[7][lane >> 3];
    float nw[8];
#pragma unroll
    for (int e = 0; e < 8; ++e) nw[e] = p.in[8][8 * lane + e];
    for (int t = gw; t < TT; t += NGW) {
        const u32x4 a = *(const u32x4*)(yf + (size_t)t * 512 + 8 * lane), b = *(const u32x4*)(yb + (size_t)t * 512 + 8 * lane);
        const u32x4 x = *(const u32x4*)(xh + (size_t)t * 256), z = *(const u32x4*)(zt + (size_t)t * 256);
        float y[8];
        y[0] = (bflo(a.x) + bflo(b.x) + D * bflo(x.x)) * silu_f(bflo(z.x)); y[1] = (bfhi(a.x) + bfhi(b.x) + D * bfhi(x.x)) * silu_f(bfhi(z.x));
        y[2] = (bflo(a.y) + bflo(b.y) + D * bflo(x.y)) * silu_f(bflo(z.y)); y[3] = (bfhi(a.y) + bfhi(b.y) + D * bfhi(x.y)) * silu_f(bfhi(z.y));
        y[4] = (bflo(a.z) + bflo(b.z) + D * bflo(x.z)) * silu_f(bflo(z.z)); y[5] = (bfhi(a.z) + bfhi(b.z) + D * bfhi(x.z)) * silu_f(bfhi(z.z));
        y[6] = (bflo(a.w) + bflo(b.w) + D * bflo(x.w)) * silu_f(bflo(z.w)); y[7] = (bfhi(a.w) + bfhi(b.w) + D * bfhi(x.w)) * silu_f(bfhi(z.w));
        float ss = 0.f;
#pragma unroll
        for (int e = 0; e < 8; ++e) ss += y[e] * y[e];
        ss = wave_sum(ss);
        const float r = 1.0f / sqrtf(ss * (1.0f / 512.0f) + RMS_EPS);
        u32x4 o; o.x = pk2(y[0] * r * nw[0], y[1] * r * nw[1]); o.y = pk2(y[2] * r * nw[2], y[3] * r * nw[3]); o.z = pk2(y[4] * r * nw[4], y[5] * r * nw[5]); o.w = pk2(y[6] * r * nw[6], y[7] * r * nw[7]);
        *(u32x4*)(mix + (size_t)t * DM) = o;
    }
}

DI void expert_gu_weights_phase(const Params& p, LAS unsigned char* lds, int gw, int NGW, int wave, int lane) {
    LAS float* scr = (LAS float*)(lds + wave * 16384);
    for (int it = gw; it < 16 * 2816; it += NGW) {
        const int e = it / 2816, r = it % 2816;
        const int isup = r >= 1408, rr = isup ? r - 1408 : r, kb = rr / 88, nb = rr % 88, n0 = 32 * nb;
        const float* W = (isup ? p.in[14] : p.in[13]) + (size_t)e * DM * FF;
        transpose_item_f8(W, FF, 64 * kb, n0, p.ws + WS_WGU, DM, e * 5632 + 256 * (n0 >> 7) + (n0 & 127) + (isup ? 128 : 0), WGU_SCALE, scr, lane);
    }
}
DI void expert_down_weights(const Params& p, LAS unsigned char* lds, int vw, int NVW, int wave, int lane) {
    LAS float* scr = (LAS float*)(lds + 4096 + wave * 16384);
    for (int it = vw; it < 16 * 1408; it += NVW) {
        const int e = it / 1408, rr = it % 1408, kb = rr / 32, nb = rr % 32;
        transpose_item_f8(p.in[15] + (size_t)e * FF * DM, DM, 64 * kb, 32 * nb, p.ws + WS_WD, FF, e * 1024 + 32 * nb, WD_SCALE, scr, lane);
    }
}

DI void ln1_router_phase(const Params& p, LAS unsigned char* lds, int gw, int NGW, int wave, int lane) {
    const int tid = TIDX(wave);
    LAS float* wT = (LAS float*)lds;
    for (int id = tid; id < 16384; id += NTHR) { const int k = id >> 4, e = id & 15; wT[e * 1024 + k] = p.in[12][id]; }
    __syncthreads();
    f32x4 gg[4], bb[4];
#pragma unroll
    for (int j = 0; j < 4; ++j) { gg[j] = ((const f32x4*)p.in[10])[64 * j + lane]; bb[j] = ((const f32x4*)p.in[11])[64 * j + lane]; }
    unsigned char* x1b = p.ws + WS_X1B; float* aff = (float*)(p.ws + WS_AFF);
    for (int t = gw; t < TT; t += NGW) {
        f32x4* orow = (f32x4*)(p.out + (size_t)t * DM) + lane;
        f32x4 v[4]; float s = 0.f;
#pragma unroll
        for (int j = 0; j < 4; ++j) { v[j] = orow[64 * j]; s += (v[j][0] + v[j][1]) + (v[j][2] + v[j][3]); }
        const float mean = wave_sum(s) * (1.0f / DM); float s2 = 0.f;
#pragma unroll
        for (int j = 0; j < 4; ++j) { v[j] = v[j] - mean; s2 += (v[j][0] * v[j][0] + v[j][1] * v[j][1]) + (v[j][2] * v[j][2] + v[j][3] * v[j][3]); }
        const float rstd = 1.0f / sqrtf(wave_sum(s2) * (1.0f / DM) + LN_EPS);
        unsigned* o4 = (unsigned*)(x1b + (size_t)t * DM) + lane;
#pragma unroll
        for (int j = 0; j < 4; ++j) {
            v[j] = v[j] * rstd * gg[j] + bb[j];
            orow[64 * j] = v[j] * ALPHA;
            o4[64 * j] = pk4_f8(v[j][0], v[j][1], v[j][2], v[j][3]);
        }
        float r[16]; dot16(v, wT, lane, r);
        float mx = r[0];
#pragma unroll
        for (int e = 1; e < 16; ++e) mx = fmaxf(mx, r[e]);
        float den = 0.f, mine = 0.f;
#pragma unroll
        for (int e = 0; e < 16; ++e) { const float ex = __expf(r[e] - mx); den += ex; mine = (lane == e) ? ex : mine; }
        if (lane < 16) aff[(size_t)lane * TT + t] = mine / den;
    }
}

DI void select_phase(const Params& p, LAS unsigned char* lds, int wave, int lane) {
    const int wk = blockIdx.x;
    if (wk >= 32) { expert_down_weights(p, lds, (wk - 32) * 8 + wave, ((int)gridDim.x - 32) * 8, wave, lane); return; }
    const int tid = TIDX(wave);
    const int trunk = wk >> 4, e = wk & 15;
    const int Tn = trunk ? 16384 : 32768, tbase = trunk ? TP : 0, cap = Tn / 8;
    const unsigned* col = (const unsigned*)(p.ws + WS_AFF) + (size_t)e * TT + tbase;
    LAS unsigned* hist = (LAS unsigned*)lds;
    LAS unsigned* ctl = (LAS unsigned*)(lds + 1024);
    LAS unsigned* wcnt = (LAS unsigned*)(lds + 2048);
    unsigned prefix = 0, remaining = (unsigned)cap;
    for (int pass = 0; pass < 4; ++pass) {
        const int shift = 24 - 8 * pass;
        for (int i = tid; i < 256; i += NTHR) hist[i] = 0u;
        __syncthreads();
        for (int i = tid; i < Tn; i += NTHR) {
            const unsigned bits = col[i];
            if (pass == 0 || (bits >> (shift + 8)) == prefix) atomicAdd((unsigned*)(hist + ((bits >> shift) & 255u)), 1u);
        }
        __syncthreads();
        if (wave == 0) {
            const unsigned h0 = hist[4 * lane], h1 = hist[4 * lane + 1], h2 = hist[4 * lane + 2], h3 = hist[4 * lane + 3], tot = h0 + h1 + h2 + h3;
            unsigned v = tot;
#pragma unroll
            for (int o = 1; o < 64; o <<= 1) { const unsigned t = __shfl_down(v, o); if (lane + o < 64) v += t; }
            const unsigned excl = v - tot;
            if (excl < remaining && remaining <= excl + tot) {
                unsigned cum = excl; int b;
                if (cum + h3 >= remaining) b = 3; else { cum += h3; if (cum + h2 >= remaining) b = 2; else { cum += h2; if (cum + h1 >= remaining) b = 1; else { cum += h1; b = 0; } } }
                ctl[0] = (prefix << 8) | (unsigned)(4 * lane + b); ctl[1] = remaining - cum;
            }
        }
        __syncthreads();
        prefix = ctl[0]; remaining = ctl[1];
        __syncthreads();
    }
    const unsigned thr = prefix, need_eq = remaining;
    int* idx = (int*)(p.ws + WS_IDX) + e * SLOTS_E + (trunk ? 4096 : 0);
    int* inv = (int*)(p.ws + WS_INV) + (size_t)e * TT + tbase;
    const int slot0 = e * SLOTS_E + (trunk ? 4096 : 0);
    float* gate = (float*)(p.ws + WS_GATE) + e * SLOTS_E + (trunk ? 4096 : 0);
    unsigned base_gt = 0, base_eq = 0;
    for (int b0 = 0; b0 < Tn; b0 += 4 * NTHR) {
        const u32x4 bits4 = *(const u32x4*)(col + b0 + 4 * tid);
        const unsigned bits[4] = {bits4.x, bits4.y, bits4.z, bits4.w};
        unsigned packed = 0;
#pragma unroll
        for (int j = 0; j < 4; ++j) packed += (bits[j] > thr ? 1u : 0u) + (bits[j] == thr ? 0x10000u : 0u);
        unsigned v = packed;
#pragma unroll
        for (int o = 1; o < 64; o <<= 1) { const unsigned t = __shfl_up(v, o); if (lane >= o) v += t; }
        if (lane == 63) wcnt[wave] = v;
        __syncthreads();
        unsigned off = 0, tot = 0;
#pragma unroll
        for (int w2 = 0; w2 < 8; ++w2) { const unsigned cnt = wcnt[w2]; off += (w2 < wave) ? cnt : 0u; tot += cnt; }
        const unsigned ex = off + (v - packed);
        unsigned gt_before = base_gt + (ex & 0xffffu), eq_before = base_eq + (ex >> 16);
        int invv[4];
#pragma unroll
        for (int j = 0; j < 4; ++j) {
            const bool gt = bits[j] > thr, eq = bits[j] == thr;
            const bool sel = gt || (eq && eq_before < need_eq);
            const unsigned pos = gt_before + (eq_before < need_eq ? eq_before : need_eq);
            const bool ok = sel && pos < (unsigned)cap;
            if (ok) { idx[pos] = tbase + b0 + 4 * tid + j; gate[pos] = __uint_as_float(bits[j]); }
            invv[j] = ok ? slot0 + (int)pos : -1;
            gt_before += gt ? 1u : 0u; eq_before += eq ? 1u : 0u;
        }
        *(i32x4*)(inv + b0 + 4 * tid) = (i32x4){invv[0], invv[1], invv[2], invv[3]};
        base_gt += tot & 0xffffu; base_eq += tot >> 16;
        __syncthreads();
    }
}

DI void ln2_phase(const Params& p, int gw, int NGW, int lane) {
    f32x4 gg[4], bb[4];
#pragma unroll
    for (int j = 0; j < 4; ++j) { gg[j] = ((const f32x4*)p.in[16])[64 * j + lane]; bb[j] = ((const f32x4*)p.in[17])[64 * j + lane]; }
    const int* inv = (const int*)(p.ws + WS_INV); const bf16_t* eo = (const bf16_t*)(p.ws + WS_EO);
    for (int t = gw; t < TT; t += NGW) {
        f32x4* orow = (f32x4*)(p.out + (size_t)t * DM) + lane;
        f32x4 v[4]; float s = 0.f;
#pragma unroll
        for (int j = 0; j < 4; ++j) v[j] = orow[64 * j];
        const int myslot = lane < 16 ? inv[(size_t)lane * TT + t] : -1;
        for (int e = 0; e < 16; ++e) {
            const int sl = __shfl(myslot, e);
            if (sl >= 0) {
                const u32x2* er = (const u32x2*)(eo + (size_t)sl * DM) + lane;
#pragma unroll
                for (int j = 0; j < 4; ++j) { const u32x2 w = er[64 * j]; v[j][0] += bflo(w.x); v[j][1] += bfhi(w.x); v[j][2] += bflo(w.y); v[j][3] += bfhi(w.y); }
            }
        }
#pragma unroll
        for (int j = 0; j < 4; ++j) s += (v[j][0] + v[j][1]) + (v[j][2] + v[j][3]);
        const float mean = wave_sum(s) * (1.0f / DM); float s2 = 0.f;
#pragma unroll
        for (int j = 0; j < 4; ++j) { v[j] = v[j] - mean; s2 += (v[j][0] * v[j][0] + v[j][1] * v[j][1]) + (v[j][2] * v[j][2] + v[j][3] * v[j][3]); }
        const float rstd = 1.0f / sqrtf(wave_sum(s2) * (1.0f / DM) + LN_EPS);
#pragma unroll
        for (int j = 0; j < 4; ++j) orow[64 * j] = v[j] * rstd * gg[j] + bb[j];
    }
}

constexpr size_t WS_CTL = 19 * MiB;
#define XB_TMO      128
#define XB_XCNT(j)  (256  + 64 * (j))
#define XB_XSUB(j)  (1280 + 64 * (j))
#define XB_XGEN(j)  (2304 + 64 * (j))
#define XB_TOP      3328
#define XB_TOPGEN   3392
#define XCD_BAR_WORDS 3456
#define XB_SPIN_CAP (1u << 18)
DI unsigned xb_ld(unsigned* p)              { return __hip_atomic_load(p, __ATOMIC_RELAXED, __HIP_MEMORY_SCOPE_AGENT); }
DI unsigned xb_add(unsigned* p, unsigned v) { return __hip_atomic_fetch_add(p, v, __ATOMIC_RELAXED, __HIP_MEMORY_SCOPE_AGENT); }
DI unsigned xb_xcc_id() { return (unsigned)__builtin_amdgcn_s_getreg((3 << 11) | 20) & 0xFu; }
#define XB_SPIN(cond, bar) do { unsigned _sp = 0; while (cond) { __builtin_amdgcn_s_sleep(1); \
    if ((++_sp & 255u) == 0u) { if (xb_ld(&(bar)[XB_TMO])) break; if (_sp > XB_SPIN_CAP) { atomicAdd(&(bar)[XB_TMO], 1u); break; } } } } while (0)
struct XcdBarrier { unsigned* bar; unsigned x; volatile LAS unsigned* st; };
DI void xcd_barrier_complete(unsigned* bar, unsigned x, unsigned& nloc, unsigned& nx) {
    const unsigned G = gridDim.x * gridDim.y * gridDim.z;
    unsigned sum, cnt, mine, sp = 0u;
    for (;;) {
        sum = 0u; cnt = 0u; mine = 0u;
#pragma unroll
        for (unsigned j = 0; j < 16; ++j) { const unsigned c = xb_ld(&bar[XB_XCNT(j)]); sum += c; cnt += (c > 0u) ? 1u : 0u; mine = (j == x) ? c : mine; }
        if (sum == G) break;
        __builtin_amdgcn_s_sleep(1);
        if ((++sp & 255u) == 0u) { if (xb_ld(&bar[XB_TMO])) break; if (sp > XB_SPIN_CAP) { atomicAdd(&bar[XB_TMO], 1u); break; } }
    }
    nloc = mine > 0u ? mine : 1u; nx = cnt > 0u ? cnt : 1u;
}
DI void xcd_barrier(const XcdBarrier& b, int wave) {
    asm volatile("s_waitcnt vmcnt(0)" ::: "memory");
    __syncthreads();
    if (wave == 0 && lane_id() == 0) {
        unsigned* bar = b.bar;
        __builtin_amdgcn_s_waitcnt(0);
        unsigned nloc = b.st[0], nx = b.st[1];
        if (nloc == 0u) { xcd_barrier_complete(bar, b.x, nloc, nx); b.st[0] = nloc; b.st[1] = nx; }
        const unsigned old = xb_add(&bar[XB_XSUB(b.x)], 1u);
        const unsigned gen = old / nloc;
        if (old + 1u == (gen + 1u) * nloc) {
            __builtin_amdgcn_fence(__ATOMIC_RELEASE, "agent");
            asm volatile("s_waitcnt vmcnt(0)" ::: "memory");
            const unsigned og = xb_add(&bar[XB_TOP], 1u);
            const unsigned tg = og / nx;
            if (og + 1u == (tg + 1u) * nx) xb_add(&bar[XB_TOPGEN], 1u);
            else XB_SPIN(xb_ld(&bar[XB_TOPGEN]) == tg, bar);
            __builtin_amdgcn_fence(__ATOMIC_ACQUIRE, "agent");
            xb_add(&bar[XB_XGEN(b.x)], 1u);
            asm volatile("s_waitcnt vmcnt(0)" ::: "memory");
        } else {
            XB_SPIN(xb_ld(&bar[XB_XGEN(b.x)]) == gen, bar);
            __builtin_amdgcn_fence(__ATOMIC_ACQUIRE, "agent");
            asm volatile("s_waitcnt vmcnt(0)" ::: "memory");
        }
    }
    __syncthreads();
}

__global__ void __launch_bounds__(NTHR, 2) fwd_megakernel(Params p) {
    extern __shared__ __attribute__((aligned(16))) unsigned char lds_raw[];
    LAS unsigned char* lds = (LAS unsigned char*)lds_raw;
    cg::grid_group grid = cg::this_grid();
    const int wave_k = __builtin_amdgcn_readfirstlane((int)threadIdx.x >> 6);
    XcdBarrier xb; xb.bar = (unsigned*)(p.ws + WS_CTL); xb.x = xb_xcc_id(); xb.st = (volatile LAS unsigned*)(lds + LDS_BYTES - 64);
    if (wave_k == 0 && lane_id() == 0) { xb.st[0] = 0u; xb.st[1] = 0u; (void)xb_add(&xb.bar[XB_XCNT(xb.x)], 1u); }
    __syncthreads();
#define GSYNC() xcd_barrier(xb, wave_k)
#define IDS() const int lane = lane_id(), wave = wave_k; \
    const int G = gridDim.x, gw = blockIdx.x * 8 + wave, NGW = G * 8; (void)lane; (void)gw; (void)NGW; (void)G;
    { IDS(); phase0(p, lds, gw, NGW, wave, lane); }
    grid.sync();
    {
        IDS();
        pg8::SchedPlain S; S.init(TT, 3072, G, (int)blockIdx.x);
        pg8::EpiProj E{(bf16_t*)(p.ws + WS_P), (const float*)(p.ws + WS_ROPE)};
        pg8::gemm_phase<pg8::EpiProj, pg8::SchedPlain>(lds, (const bf16_t*)(p.ws + WS_XB), (const bf16_t*)(p.ws + WS_WI), DM, S, E, wave);
    }
    GSYNC();
    conv_phase(p, wave_k);
    { IDS(); const int vcu = (G % 8 == 0) ? ((int)blockIdx.x % 8) * (G / 8) + (int)blockIdx.x / 8 : (int)blockIdx.x;
      attn_phase(p, lds, vcu * 8 + wave, NGW, wave, lane); }
    GSYNC();
    { IDS(); ssd_state_phase(p, lds, wave, lane); }
    GSYNC();
    ssd_scan_phase(p, wave_k);
    GSYNC();
    { IDS(); ssd_out_phase(p, lds, wave, lane); }
    GSYNC();
    { IDS(); gate_phase(p, gw, NGW, lane); }
    GSYNC();
    { IDS(); expert_gu_weights_phase(p, lds, gw, NGW, wave, lane); }
    __syncthreads();
    {
        IDS();
        pg8::SchedPlain S; S.init(TT, DM, G, (int)blockIdx.x);
        pg8::EpiOut E{p};
        pg8::gemm_phase<pg8::EpiOut, pg8::SchedPlain>(lds, (const bf16_t*)(p.ws + WS_MIX), (const bf16_t*)(p.ws + WS_WO), DM, S, E, wave);
    }
    GSYNC();
    { IDS(); ln1_router_phase(p, lds, gw, NGW, wave, lane); }
    GSYNC();
    { IDS(); select_phase(p, lds, wave, lane); }
    GSYNC();
    {
        IDS();
        const int* idx = (const int*)(p.ws + WS_IDX);
        pg8::SchedGrouped<22, true> S{G, (int)blockIdx.x, idx};
        pg8::EpiGU E{p.ws + WS_HID};
        pg8::gemm_phase<pg8::EpiGU, pg8::SchedGrouped<22, true>, true>(lds, (const bf16_t*)(p.ws + WS_X1B), (const bf16_t*)(p.ws + WS_WGU), DM / 2, S, E, wave);
    }
    GSYNC();
    {
        IDS();
        const int* idx = (const int*)(p.ws + WS_IDX);
        const float* gate = (const float*)(p.ws + WS_GATE);
        pg8::SchedGrouped<4, false> S{G, (int)blockIdx.x, idx};
        pg8::EpiDown E{(bf16_t*)(p.ws + WS_EO), gate};
        pg8::gemm_phase<pg8::EpiDown, pg8::SchedGrouped<4, false>, true>(lds, (const bf16_t*)(p.ws + WS_HID), (const bf16_t*)(p.ws + WS_WD), FF / 2, S, E, wave);
    }
    GSYNC();
    { IDS(); ln2_phase(p, gw, NGW, lane); }
#undef IDS
}

extern "C" void kernel_launch(void* const* d_in, const int* in_sizes, int n_in, void* d_out, int out_size, void* d_ws, size_t ws_size, hipStream_t stream) {
    static int grid_blocks = 0;
    if (grid_blocks == 0) {
        if (n_in != 18 || ws_size < WS_END || out_size != TT * DM) { fprintf(stderr, "kernel_launch: unexpected shapes (n_in %d out %d ws %zu)\n", n_in, out_size, ws_size); grid_blocks = -1; return; }
        int dev = 0, cus = 0, per_cu = 0;
        hipGetDevice(&dev);
        hipDeviceGetAttribute(&cus, hipDeviceAttributeMultiprocessorCount, dev);
        if (hipFuncSetAttribute((const void*)fwd_megakernel, hipFuncAttributeMaxDynamicSharedMemorySize, LDS_BYTES) != hipSuccess) { fprintf(stderr, "kernel_launch: hipFuncSetAttribute failed\n"); }
        hipOccupancyMaxActiveBlocksPerMultiprocessor(&per_cu, (const void*)fwd_megakernel, NTHR, LDS_BYTES);
        if (per_cu < 1) per_cu = 1;
        (void)hipGetLastError();
        grid_blocks = cus * per_cu;
    }
    if (grid_blocks < 0) return;
    Params p{};
    for (int i = 0; i < 18; ++i) p.in[i] = (const float*)d_in[i];
    p.out = (float*)d_out; p.ws = (unsigned char*)d_ws;
    if (hipMemsetAsync((char*)d_ws + WS_CTL, 0, 16384, stream) != hipSuccess) { fprintf(stderr, "kernel_launch: hipMemsetAsync failed\n"); return; }
    void* args[] = {&p};
    hipError_t e = hipLaunchCooperativeKernel((void*)fwd_megakernel, dim3(grid_blocks), dim3(NTHR), args, LDS_BYTES, stream);
    if (e != hipSuccess) fprintf(stderr, "cooperative launch failed: %s (grid %d)\n", hipGetErrorString(e), grid_blocks);
}
```

```cpp
#include <hip/hip_runtime.h>
#include <hip/hip_cooperative_groups.h>
#include <cstdio>
#include <cstdint>
namespace cg = cooperative_groups;

#define DI __device__ __forceinline__
#define LAS __attribute__((address_space(3)))
typedef unsigned short bf16_t;
typedef short bf16x8 __attribute__((ext_vector_type(8)));
typedef short s16x4 __attribute__((ext_vector_type(4)));
typedef float f32x4 __attribute__((ext_vector_type(4)));
typedef unsigned u32x4 __attribute__((ext_vector_type(4)));
typedef unsigned u32x2 __attribute__((ext_vector_type(2)));
typedef int i32x4 __attribute__((ext_vector_type(4)));
typedef int i32x8 __attribute__((ext_vector_type(8)));

constexpr int TT = 49152;
constexpr int TP = 32768;
constexpr int DM = 1024;
constexpr int INW = 3088;
constexpr int FF = 2816;
constexpr int NE = 16;
constexpr int SLOTS_E = 6144;
constexpr float ALPHA = 1.189207115002721f;
constexpr float LN_EPS = 1e-5f, RMS_EPS = 1e-5f;

constexpr size_t MiB = 1u << 20;
constexpr size_t TILE_ELEMS = (size_t)TT * 256;
constexpr size_t TILE_BYTES = TILE_ELEMS * 2;
constexpr size_t WS_WI = 0;
constexpr size_t WS_WO = 6 * MiB;
constexpr size_t WS_DT = 8 * MiB;
constexpr size_t WS_ROPE = 11 * MiB;
constexpr size_t WS_AFF = 12 * MiB;
constexpr size_t WS_IDX = 15 * MiB;
constexpr size_t WS_GATE = 15 * MiB + 512 * 1024;
constexpr size_t WS_P = 20 * MiB;
constexpr size_t WS_XC = 308 * MiB;
constexpr size_t WS_XB = 404 * MiB;
constexpr size_t WS_MIX = WS_XB;
constexpr size_t WS_YF = WS_P + 8 * TILE_BYTES;
constexpr size_t WS_YB = WS_P + 10 * TILE_BYTES;
constexpr size_t WS_INV = 16 * MiB;
constexpr size_t WS_WD = 20 * MiB;
constexpr size_t WS_WGU = 108 * MiB;
constexpr size_t WS_EO = 212 * MiB;
constexpr size_t WS_X1B = 308 * MiB;
constexpr size_t WS_HID = 404 * MiB;
constexpr size_t WS_END = 668 * MiB;

constexpr int LDS_BYTES = 147456;
constexpr int NTHR = 512;

DI unsigned f2bf(float f) { unsigned u = __float_as_uint(f); return (u + 0x7fffu + ((u >> 16) & 1u)) >> 16; }
typedef float f32x2v __attribute__((ext_vector_type(2)));
typedef __bf16 bf16x2v __attribute__((ext_vector_type(2)));
DI unsigned pk2(float lo, float hi) { const f32x2v f = {lo, hi}; return __builtin_bit_cast(unsigned, __builtin_convertvector(f, bf16x2v)); }
DI unsigned pk4_f8(float a, float b, float c, float d) { int w = 0; w = __builtin_amdgcn_cvt_pk_fp8_f32(a, b, w, false); w = __builtin_amdgcn_cvt_pk_fp8_f32(c, d, w, true); return (unsigned)w; }
DI i32x8 cat8(bf16x8 lo, bf16x8 hi) { const i32x4 a = __builtin_bit_cast(i32x4, lo), b = __builtin_bit_cast(i32x4, hi); return __builtin_shufflevector(a, b, 0, 1, 2, 3, 4, 5, 6, 7); }
constexpr float WGU_SCALE = 32.0f, WD_SCALE = 64.0f;
DI float bflo(unsigned u) { return __uint_as_float(u << 16); }
DI float bfhi(unsigned u) { return __uint_as_float(u & 0xffff0000u); }
DI float wave_sum(float v) {
#pragma unroll
    for (int o = 1; o < 64; o <<= 1) v += __shfl_xor(v, o);
    return v;
}
DI void st_tr8_pair(LAS bf16_t* base, int stride, int colpair, int lane, const u32x4 v) {
    const unsigned px = __shfl_xor(v.x, 1), py = __shfl_xor(v.y, 1), pz = __shfl_xor(v.z, 1), pw = __shfl_xor(v.w, 1);
    const bool odd = (lane & 1) != 0;
    const unsigned d0 = odd ? ((px >> 16) | (v.x & 0xffff0000u)) : ((v.x & 0xffffu) | (px << 16));
    const unsigned d1 = odd ? ((py >> 16) | (v.y & 0xffff0000u)) : ((v.y & 0xffffu) | (py << 16));
    const unsigned d2 = odd ? ((pz >> 16) | (v.z & 0xffff0000u)) : ((v.z & 0xffffu) | (pz << 16));
    const unsigned d3 = odd ? ((pw >> 16) | (v.w & 0xffff0000u)) : ((v.w & 0xffffu) | (pw << 16));
    LAS unsigned* wp = (LAS unsigned*)(base + (odd ? stride : 0)) + colpair;
    wp[0] = d0; wp[stride] = d1; wp[2 * stride] = d2; wp[3 * stride] = d3;
}
DI float silu_f(float x) { return x * __builtin_amdgcn_rcpf(1.0f + __expf(-x)); }
#define LDS_WAIT() asm volatile("s_waitcnt lgkmcnt(0)" ::: "memory")

struct Params { const float* in[18]; float* out; unsigned char* ws; };
DI int lane_id() { int l = (int)__builtin_amdgcn_mbcnt_hi(~0u, __builtin_amdgcn_mbcnt_lo(~0u, 0u)); asm volatile("" : "+v"(l)); return l; }
#define TIDX(wave_) ((wave_) * 64 + lane_id())

DI const float* xrow_ptr(const Params& p, int t) { return t < TP ? p.in[0] + (size_t)t * DM : p.in[1] + (size_t)(t - TP) * DM; }

namespace pg8 {
constexpr int BM = 256, BK = 64, HALF = 128, HTB = HALF * BK * 2, NXCD = 8, WGM = 8;
DI int lds_byte(int r, int c) { const int st = (r >> 4) * 2 + (c >> 5), rr = r & 15, cc = c & 31, ob = rr * 64 + cc * 2; return st * 1024 + (ob ^ (((ob >> 9) & 1) << 5)); }
DI void stage_rc(int b, int& R, int& C) { const int st = b / 1024, sb = b % 1024, swz = sb ^ (((sb >> 9) & 1) << 5); R = (st >> 1) * 16 + swz / 64; C = (st & 1) * 32 + (swz % 64) / 2; }
DI int perm32(int rho) { const int n = rho >> 4, i = rho & 15; return 8 * (i >> 2) + 4 * n + (i & 3); }

struct Unit { int pm, pn, bt; };

DI int xcd_remap(int L, int nwg) { const int q = nwg / NXCD, r = nwg % NXCD, xcd = L % NXCD, off = L / NXCD; return (xcd < r ? xcd * (q + 1) : r * (q + 1) + (xcd - r) * q) + off; }

struct SchedPlain {
    int nM, nN, nwg, G, c;
    DI void init(int M, int N, int G_, int c_) { nM = M / BM; nN = N / BM; nwg = nM * nN; G = G_; c = c_; }
    DI bool next(int i, Unit& u) const {
        const int L = i * G + c; if (L >= nwg) return false;
        const int wgid = xcd_remap(L, nwg);
        const int nig = WGM * nN, gid = wgid / nig, fm = gid * WGM, gsz = (nM - fm) < WGM ? (nM - fm) : WGM;
        u.pm = fm + ((wgid % nig) % gsz); u.pn = (wgid % nig) / gsz; u.bt = u.pn; return true;
    }
    DI int arow(const Unit& u, int r) const { return u.pm * BM + r; }
};
template <int NPN, bool GATHER> struct SchedGrouped {
    int G, c; const int* idx;
    DI bool next(int i, Unit& u) const {
        constexpr int PER_E = 24 * NPN, NWG = NE * PER_E;
        const int L = i * G + c; if (L >= NWG) return false;
        const int wgid = xcd_remap(L, NWG);
        const int e = wgid / PER_E, rem = wgid % PER_E;
        const int gid = rem / (8 * NPN), w2 = rem % (8 * NPN);
        u.pm = e * 24 + gid * 8 + (w2 % 8); u.pn = w2 / 8; u.bt = e * NPN + u.pn; return true;
    }
    DI int arow(const Unit& u, int r) const { if (GATHER) return idx[u.pm * BM + r]; else return u.pm * BM + r; }
};

template <class Epi, class Sched, bool F8 = false>
DI void gemm_phase(LAS unsigned char* lds, const bf16_t* Ag, const bf16_t* Btg, const int K, const Sched& S, const Epi& E, const int wave_in) {
    const int tid = TIDX(wave_in), wid = wave_in, lane = tid & 63, wr = wid >> 2, wc = wid & 3, fr = lane & 15, fq = lane >> 4;
    const int nt = K / BK;
    unsigned voffB[2];
#pragma unroll
    for (int i = 0; i < 2; ++i) { int R, C; stage_rc(tid * 16 + i * 8192, R, C); const int Rb = Epi::PERM ? ((R & ~31) + perm32(R & 31)) : R;
        voffB[i] = (unsigned)(Rb * K + C) * 2u; }
    const unsigned rowbytes = (unsigned)K * 2u;
    const size_t kstep = (size_t)(BK * 2);
    const size_t hstep = (size_t)HALF * K * 2;
    const size_t tstep = 2 * hstep;
    const unsigned ldsw = (unsigned)wid * 1024u;
    const int aoff = lds_byte(wr * 64 + fr, fq * 8), boff = lds_byte(wc * 32 + fr, fq * 8);
#define PG8_SA(b, h) (((b) * 2 + (h)) * HTB)
#define PG8_SB(b, h) ((4 + (b) * 2 + (h)) * HTB)
#define PG8_STAGE(bufoff, gbase, voff) do { _Pragma("unroll") for (int _i = 0; _i < 2; ++_i) \
        __builtin_amdgcn_global_load_lds((const unsigned*)((const char*)(gbase) + (voff)[_i]), (LAS unsigned*)(lds + (bufoff) + ldsw + _i * 8192), 16, 0, 0); } while (0)
#define PG8_STAGEA(bufoff, o0, o1, kb) do { \
        __builtin_amdgcn_global_load_lds((const unsigned*)((const char*)Ag + (size_t)(o0) + (size_t)(kb)), (LAS unsigned*)(lds + (bufoff) + ldsw), 16, 0, 0); \
        __builtin_amdgcn_global_load_lds((const unsigned*)((const char*)Ag + (size_t)(o1) + (size_t)(kb)), (LAS unsigned*)(lds + (bufoff) + ldsw + 8192), 16, 0, 0); } while (0)
#define PG8_LDA(dst, b, h) do { _Pragma("unroll") for (int m = 0; m < 4; ++m) _Pragma("unroll") for (int k = 0; k < 2; ++k) dst[m][k] = *(const LAS bf16x8*)(lds + PG8_SA(b, h) + aoff + m * 2048 + k * 1024); } while (0)
#define PG8_LDB(dst, b, h) do { _Pragma("unroll") for (int n = 0; n < 2; ++n) _Pragma("unroll") for (int k = 0; k < 2; ++k) dst[n][k] = *(const LAS bf16x8*)(lds + PG8_SB(b, h) + boff + n * 2048 + k * 1024); } while (0)
#define PG8_MMA(ai, bj, At, Bt) do { __builtin_amdgcn_s_setprio(1); _Pragma("unroll") for (int m = 0; m < 4; ++m) _Pragma("unroll") for (int n = 0; n < 2; ++n) { \
        if constexpr (F8) { acc[ai][bj][m][n] = __builtin_amdgcn_mfma_scale_f32_16x16x128_f8f6f4(cat8(Bt[n][0], Bt[n][1]), cat8(At[m][0], At[m][1]), acc[ai][bj][m][n], 0, 0, 0, 0, 0, 0); } \
        else { _Pragma("unroll") for (int k = 0; k < 2; ++k) acc[ai][bj][m][n] = __builtin_amdgcn_mfma_f32_16x16x32_bf16(Bt[n][k], At[m][k], acc[ai][bj][m][n], 0, 0, 0); } } \
        __builtin_amdgcn_s_setprio(0); } while (0)
#define PG8_WAIT_V(n) asm volatile("s_waitcnt vmcnt(" #n ")" ::: "memory")
#define PG8_WAIT_L(n) asm volatile("s_waitcnt lgkmcnt(" #n ")" ::: "memory")
#define PG8_BAR __builtin_amdgcn_s_barrier()
#define PG8_SCHED __builtin_amdgcn_sched_barrier(0)
#define PG8_OFFS(u, o00, o01, o10, o11) do { int R0_, C0_, R1_, C1_; const int t2_ = TIDX(wid); stage_rc(t2_ * 16, R0_, C0_); stage_rc(t2_ * 16 + 8192, R1_, C1_); \
        o00 = (unsigned)S.arow(u, R0_) * rowbytes + (unsigned)C0_ * 2u; o01 = (unsigned)S.arow(u, R1_) * rowbytes + (unsigned)C1_ * 2u; \
        o10 = (unsigned)S.arow(u, HALF + R0_) * rowbytes + (unsigned)C0_ * 2u; o11 = (unsigned)S.arow(u, HALF + R1_) * rowbytes + (unsigned)C1_ * 2u; } while (0)
    Unit cur, nxt; int ui = 0;
    if (!S.next(0, cur)) return;
    f32x4 acc[2][2][4][2];
#pragma unroll
    for (int a = 0; a < 2; ++a)
#pragma unroll
        for (int b = 0; b < 2; ++b)
#pragma unroll
            for (int m = 0; m < 4; ++m)
#pragma unroll
                for (int n = 0; n < 2; ++n) acc[a][b][m][n] = (f32x4){0.f, 0.f, 0.f, 0.f};
    bf16x8 At[4][2], B0[2][2], B1[2][2];
    unsigned c00, c01, c10, c11;
    PG8_OFFS(cur, c00, c01, c10, c11);
    const char* cB = (const char*)Btg + (size_t)cur.bt * tstep;
    PG8_STAGE(PG8_SB(0, 0), cB, voffB); PG8_STAGE(PG8_SB(0, 1), cB + hstep, voffB); PG8_STAGEA(PG8_SA(0, 0), c00, c01, 0); PG8_STAGEA(PG8_SA(0, 1), c10, c11, 0);
    if (wr == 1) PG8_BAR;
    PG8_WAIT_V(2); PG8_BAR;
    PG8_STAGE(PG8_SB(1, 0), cB + kstep, voffB); PG8_STAGEA(PG8_SA(1, 0), c00, c01, kstep); PG8_STAGE(PG8_SB(1, 1), cB + hstep + kstep, voffB);
    PG8_WAIT_V(6); PG8_BAR;
    for (;;) {
        const bool has_next = S.next(ui + 1, nxt);
        const char* nB = has_next ? (const char*)Btg + (size_t)nxt.bt * tstep : cB;
        for (int t = 0; t < nt; t += 2) {
            const bool last = (t == nt - 2);
            const size_t kb1 = (size_t)(t + 1) * kstep;
            const size_t kb2 = last ? 0 : (size_t)(t + 2) * kstep, kb3 = kb2 + kstep;
            const char* b2 = last ? nB : cB + (size_t)(t + 2) * kstep; const char* b3 = b2 + kstep;
            PG8_LDB(B0, 0, 0); PG8_LDB(B1, 0, 1); PG8_SCHED; PG8_LDA(At, 0, 0); PG8_STAGEA(PG8_SA(1, 1), c10, c11, kb1);
            PG8_WAIT_V(8); PG8_WAIT_L(0); PG8_BAR; PG8_MMA(0, 0, At, B0); PG8_MMA(0, 1, At, B1); PG8_BAR; PG8_SCHED;
            if (last && has_next) { PG8_OFFS(nxt, c00, c01, c10, c11); }
            PG8_LDA(At, 0, 1); PG8_STAGE(PG8_SB(0, 0), b2, voffB); PG8_STAGE(PG8_SB(0, 1), b2 + hstep, voffB); PG8_STAGEA(PG8_SA(0, 0), c00, c01, kb2);
            PG8_WAIT_V(8); PG8_WAIT_L(0); PG8_BAR; PG8_MMA(1, 0, At, B0); PG8_MMA(1, 1, At, B1); PG8_BAR; PG8_SCHED;
            PG8_LDB(B0, 1, 0); PG8_LDB(B1, 1, 1); PG8_SCHED; PG8_LDA(At, 1, 0); PG8_STAGEA(PG8_SA(0, 1), c10, c11, kb2);
            PG8_WAIT_V(8); PG8_WAIT_L(0); PG8_BAR; PG8_MMA(0, 0, At, B0); PG8_MMA(0, 1, At, B1); PG8_BAR; PG8_SCHED;
            PG8_LDA(At, 1, 1); PG8_STAGE(PG8_SB(1, 0), b3, voffB); PG8_STAGE(PG8_SB(1, 1), b3 + hstep, voffB); PG8_STAGEA(PG8_SA(1, 0), c00, c01, kb3);
            PG8_WAIT_V(8); PG8_WAIT_L(0); PG8_BAR; PG8_MMA(1, 0, At, B0); PG8_MMA(1, 1, At, B1); PG8_BAR; PG8_SCHED;
        }
        if (wr == 0) PG8_BAR;
        { const int l2 = lane_id(); E(acc, cur, wr, wc, l2 & 15, l2 >> 4); }
        if (!has_next) break;
#pragma unroll
        for (int a = 0; a < 2; ++a)
#pragma unroll
            for (int b = 0; b < 2; ++b)
#pragma unroll
                for (int m = 0; m < 4; ++m)
#pragma unroll
                    for (int n = 0; n < 2; ++n) acc[a][b][m][n] = (f32x4){0.f, 0.f, 0.f, 0.f};
        cur = nxt; cB = nB; ++ui;
        if (wr == 1) PG8_BAR;
    }
    PG8_WAIT_V(0);
    PG8_BAR;
#undef PG8_SA
#undef PG8_SB
#undef PG8_STAGE
#undef PG8_STAGEA
#undef PG8_LDA
#undef PG8_LDB
#undef PG8_MMA
#undef PG8_WAIT_V
#undef PG8_WAIT_L
#undef PG8_BAR
#undef PG8_SCHED
#undef PG8_OFFS
}

struct EpiProj {
    static constexpr bool PERM = true;
    bf16_t* P; const float* rope;
    DI void operator()(const f32x4 (&acc)[2][2][4][2], const Unit& u, int wr, int wc, int fr, int fq) const {
        bf16_t* base = P + (size_t)u.pn * TILE_ELEMS;
        const bool rot = (u.pn < 4) && ((wc & 1) == 0);
#pragma unroll
        for (int ai = 0; ai < 2; ++ai)
#pragma unroll
            for (int m = 0; m < 4; ++m) {
                const int row = u.pm * BM + ai * HALF + wr * 64 + m * 16 + fr;
                asm volatile("" ::: "memory");
                f32x4 cs0 = {1.f, 1.f, 1.f, 1.f}, cs1 = cs0, sn0 = {0.f, 0.f, 0.f, 0.f}, sn1 = sn0;
                if (rot && fq < 2) {
                    const int s = row < TP ? (row & 4095) : (row & 8191);
                    const f32x4* rp = (const f32x4*)(rope + (size_t)s * 16);
                    cs0 = rp[0]; cs1 = rp[1]; sn0 = rp[2]; sn1 = rp[3];
                    if (fq == 0) { sn0 = -sn0; sn1 = -sn1; }
                }
#pragma unroll
                for (int bj = 0; bj < 2; ++bj) {
                    f32x4 v0 = acc[ai][bj][m][0], v1 = acc[ai][bj][m][1];
                    if (rot) {
                        f32x4 o0, o1;
#pragma unroll
                        for (int j = 0; j < 4; ++j) { o0[j] = __shfl_xor(v0[j], 16); o1[j] = __shfl_xor(v1[j], 16); }
                        if (fq < 2) { v0 = v0 * cs0 + o0 * sn0; v1 = v1 * cs1 + o1 * sn1; }
                    }
                    u32x4 w; w.x = pk2(v0[0], v0[1]); w.y = pk2(v0[2], v0[3]); w.z = pk2(v1[0], v1[1]); w.w = pk2(v1[2], v1[3]);
                    *(u32x4*)(base + (size_t)row * 256 + bj * HALF + wc * 32 + 8 * fq) = w;
                }
            }
    }
};
struct EpiOut {
    static constexpr bool PERM = false;
    Params p;
    DI void operator()(const f32x4 (&acc)[2][2][4][2], const Unit& u, int wr, int wc, int fr, int fq) const {
#pragma unroll
        for (int ai = 0; ai < 2; ++ai)
#pragma unroll
            for (int m = 0; m < 4; ++m) {
                const int row = u.pm * BM + ai * HALF + wr * 64 + m * 16 + fr;
                const float* xr = xrow_ptr(p, row); float* orow = p.out + (size_t)row * DM;
#pragma unroll
                for (int bj = 0; bj < 2; ++bj)
#pragma unroll
                    for (int n = 0; n < 2; ++n) {
                        const int col = u.pn * BM + bj * HALF + wc * 32 + 16 * n + 4 * fq;
                        const f32x4 xv = *(const f32x4*)(xr + col);
                        *(f32x4*)(orow + col) = xv * ALPHA + acc[ai][bj][m][n];
                    }
            }
    }
};
struct EpiGU {
    static constexpr bool PERM = true;
    unsigned char* H;
    DI void operator()(const f32x4 (&acc)[2][2][4][2], const Unit& u, int wr, int wc, int fr, int fq) const {
#pragma unroll
        for (int ai = 0; ai < 2; ++ai)
#pragma unroll
            for (int m = 0; m < 4; ++m) {
                const int row = u.pm * BM + ai * HALF + wr * 64 + m * 16 + fr;
                const f32x4 g0 = acc[ai][0][m][0], g1 = acc[ai][0][m][1], u0 = acc[ai][1][m][0], u1 = acc[ai][1][m][1];
                f32x4 h0, h1;
#pragma unroll
                for (int j = 0; j < 4; ++j) { h0[j] = silu_f(g0[j] * (1.0f / WGU_SCALE)) * (u0[j] * (1.0f / WGU_SCALE)); h1[j] = silu_f(g1[j] * (1.0f / WGU_SCALE)) * (u1[j] * (1.0f / WGU_SCALE)); }
                u32x2 w; w.x = pk4_f8(h0[0], h0[1], h0[2], h0[3]); w.y = pk4_f8(h1[0], h1[1], h1[2], h1[3]);
                *(u32x2*)(H + (size_t)row * FF + u.pn * 128 + wc * 32 + 8 * fq) = w;
            }
    }
};
struct EpiDown {
    static constexpr bool PERM = true;
    bf16_t* eo; const float* gate;
    DI void operator()(const f32x4 (&acc)[2][2][4][2], const Unit& u, int wr, int wc, int fr, int fq) const {
#pragma unroll
        for (int ai = 0; ai < 2; ++ai)
#pragma unroll
            for (int m = 0; m < 4; ++m) {
                const int slot = u.pm * BM + ai * HALF + wr * 64 + m * 16 + fr;
                const float gv = gate[slot] * (1.0f / WD_SCALE);
                bf16_t* orow = eo + (size_t)slot * DM + u.pn * BM + wc * 32 + 8 * fq;
#pragma unroll
                for (int bj = 0; bj < 2; ++bj) {
                    const f32x4 v0 = acc[ai][bj][m][0] * gv, v1 = acc[ai][bj][m][1] * gv;
                    u32x4 w; w.x = pk2(v0[0], v0[1]); w.y = pk2(v0[2], v0[3]); w.z = pk2(v1[0], v1[1]); w.w = pk2(v1[2], v1[3]);
                    *(u32x4*)(orow + bj * HALF) = w;
                }
            }
    }
};
}

DI void transpose_item(const float* W, int ldw, int k0, int n0, bf16_t* WT, int ldt, int drow0, LAS float* scr, int lane) {
#pragma unroll 8
    for (int i = 0; i < 32; ++i) { const int kk = 2 * i + (lane >> 5); scr[kk * 33 + (lane & 31)] = W[(size_t)(k0 + kk) * ldw + n0 + (lane & 31)]; }
    LDS_WAIT();
    const int c = lane & 7;
#pragma unroll
    for (int j = 0; j < 4; ++j) { const int n = (lane >> 3) + 8 * j; const LAS float* s = scr + (8 * c) * 33 + n;
        u32x4 o; o.x = pk2(s[0 * 33], s[1 * 33]); o.y = pk2(s[2 * 33], s[3 * 33]); o.z = pk2(s[4 * 33], s[5 * 33]); o.w = pk2(s[6 * 33], s[7 * 33]);
        *(u32x4*)(WT + (size_t)(drow0 + n) * ldt + k0 + 8 * c) = o; }
    LDS_WAIT();
}

DI void transpose_item_f8(const float* W, int ldw, int k0, int n0, unsigned char* WT, int ldt, int drow0, float scale, LAS float* scr, int lane) {
#pragma unroll 8
    for (int i = 0; i < 32; ++i) { const int kk = 2 * i + (lane >> 5); scr[kk * 33 + (lane & 31)] = W[(size_t)(k0 + kk) * ldw + n0 + (lane & 31)] * scale; }
    LDS_WAIT();
    const int c = lane & 7;
#pragma unroll
    for (int j = 0; j < 4; ++j) { const int n = (lane >> 3) + 8 * j; const LAS float* sp = scr + (8 * c) * 33 + n;
        u32x2 o; o.x = pk4_f8(sp[0 * 33], sp[1 * 33], sp[2 * 33], sp[3 * 33]); o.y = pk4_f8(sp[4 * 33], sp[5 * 33], sp[6 * 33], sp[7 * 33]);
        *(u32x2*)(WT + (size_t)(drow0 + n) * ldt + k0 + 8 * c) = o; }
    LDS_WAIT();
}

DI void sincos_small(double r, double& s, double& c) {
    const double r2 = r * r; double ss = 1.0, cc = 1.0;
#pragma unroll
    for (int n = 12; n >= 1; --n) { ss = 1.0 - ss * r2 * (1.0 / (double)((2 * n) * (2 * n + 1))); cc = 1.0 - cc * r2 * (1.0 / (double)((2 * n - 1) * (2 * n))); }
    s = r * ss; c = cc;
}

DI void dot16(const f32x4 (&v)[4], const LAS float* wT, int lane, float (&r)[16]) {
#pragma unroll
    for (int e = 0; e < 16; ++e) {
        float a = 0.f;
        if ((e & 1) == 0) asm volatile("" ::: "memory");
#pragma unroll
        for (int j = 0; j < 4; ++j) { const f32x4 w = *(const LAS f32x4*)(wT + e * 1024 + 256 * j + 4 * lane); a += v[j][0] * w[0] + v[j][1] * w[1] + v[j][2] * w[2] + v[j][3] * w[3]; }
        r[e] = wave_sum(a);
    }
}

DI void phase0(const Params& p, LAS unsigned char* lds, int gw, int NGW, int wave, int lane) {
    const int tid = TIDX(wave);
    {
        LAS float* scr = (LAS float*)(lds + wave * 16384);
        for (int it = gw; it < 2048; it += NGW) {
            if (it < 1536) { const int kb = it / 96, nb = it % 96; transpose_item(p.in[2], INW, 64 * kb, 32 * nb, (bf16_t*)(p.ws + WS_WI), DM, 32 * nb, scr, lane); }
            else { const int r = it - 1536, kb = r / 32, nb = r % 32; transpose_item(p.in[9], DM, 64 * kb, 32 * nb, (bf16_t*)(p.ws + WS_WO), DM, 32 * nb, scr, lane); }
        }
    }
    {
        float* rope = (float*)(p.ws + WS_ROPE);
        const float invf[8] = {1.0f, 0.1939227432012558f, 0.03760603070259094f, 0.007292664609849453f, 0.0014142135623842478f, 0.00027424818836152554f, 5.318296098266728e-05f, 1.0313386155758053e-05f};
        for (int id = blockIdx.x * NTHR + tid; id < 8192 * 8; id += gridDim.x * NTHR) {
            const int pos = id >> 3, i = id & 7;
            float inv = invf[0];
#pragma unroll
            for (int k = 1; k < 8; ++k) inv = (i == k) ? invf[k] : inv;
            const float ang = (float)pos * inv;
            const double x = (double)ang; const double kq = rint(x * 0.15915494309189535); const double r = x - kq * 6.283185307179586476925;
            double s, c; sincos_small(r, s, c);
            rope[pos * 16 + i] = (float)c; rope[pos * 16 + 8 + i] = (float)s;
        }
    }
    __syncthreads();
    LAS float* wT = (LAS float*)lds;
    for (int id = tid; id < 16384; id += NTHR) { const int k = id >> 4, e = id & 15; wT[e * 1024 + k] = p.in[2][(size_t)k * INW + 3072 + e]; }
    __syncthreads();
    const float* dtb = p.in[5];
    float bias = 0.f;
    if (lane < 16) bias = dtb[lane];
    bf16_t* xb = (bf16_t*)(p.ws + WS_XB); float* dtout = (float*)(p.ws + WS_DT);
    for (int t = gw; t < TT; t += NGW) {
        const f32x4* xr = (const f32x4*)xrow_ptr(p, t) + lane;
        f32x4 v[4];
#pragma unroll
        for (int j = 0; j < 4; ++j) v[j] = xr[64 * j];
        u32x2* o8 = (u32x2*)(xb + (size_t)t * DM) + lane;
#pragma unroll
        for (int j = 0; j < 4; ++j) { u32x2 w; w.x = pk2(v[j][0], v[j][1]); w.y = pk2(v[j][2], v[j][3]); o8[64 * j] = w; }
        float r[16]; dot16(v, wT, lane, r);
        float mine = 0.f;
#pragma unroll
        for (int e = 0; e < 16; ++e) mine = (lane == e) ? r[e] : mine;
        if (lane < 16) { const float z = mine + bias; dtout[(size_t)t * 16 + lane] = fmaxf(z, 0.f) + log1pf(__expf(-fabsf(z))); }
    }
}

DI void conv_phase(const Params& p, int wave) {
    const int tid = blockIdx.x * NTHR + TIDX(wave), nthr = gridDim.x * NTHR;
    const int c = tid & 127, ch = 8 * c, tile = ch >> 8, cit = ch & 255;
    const float* cw = p.in[3]; const float* cb = p.in[4];
    float w[5][8], b[8];
#pragma unroll
    for (int j = 0; j < 5; ++j)
#pragma unroll
        for (int e = 0; e < 8; ++e) w[j][e] = cw[j * 1024 + ch + e];
#pragma unroll
    for (int e = 0; e < 8; ++e) b[e] = cb[ch + e];
    const bf16_t* src = (const bf16_t*)(p.ws + WS_P) + (size_t)(8 + tile) * TILE_ELEMS + cit;
    bf16_t* dst = (bf16_t*)(p.ws + WS_XC) + (size_t)tile * TILE_ELEMS + cit;
    for (int it = tid; it < TT * 128; it += nthr) {
        const int t = it >> 7;
        const int S = t < TP ? 4096 : 8192, s = t & (S - 1);
        float a[8];
#pragma unroll
        for (int e = 0; e < 8; ++e) a[e] = b[e];
#pragma unroll
        for (int j = 0; j < 5; ++j) {
            const int sj = s + j - 2;
            if (sj >= 0 && sj < S) {
                const u32x4 v = *(const u32x4*)(src + (size_t)(t + j - 2) * 256);
                a[0] += bflo(v.x) * w[j][0]; a[1] += bfhi(v.x) * w[j][1]; a[2] += bflo(v.y) * w[j][2]; a[3] += bfhi(v.y) * w[j][3];
                a[4] += bflo(v.z) * w[j][4]; a[5] += bfhi(v.z) * w[j][5]; a[6] += bflo(v.w) * w[j][6]; a[7] += bfhi(v.w) * w[j][7];
            }
        }
        u32x4 o; o.x = pk2(silu_f(a[0]), silu_f(a[1])); o.y = pk2(silu_f(a[2]), silu_f(a[3])); o.z = pk2(silu_f(a[4]), silu_f(a[5])); o.w = pk2(silu_f(a[6]), silu_f(a[7]));
        *(u32x4*)(dst + (size_t)t * 256) = o;
    }
}

DI bf16x8 tr_pair(const LAS bf16_t* lo, const LAS bf16_t* hi) {
    const s16x4 a = __builtin_amdgcn_ds_read_tr16_b64_v4i16((LAS s16x4*)lo), b = __builtin_amdgcn_ds_read_tr16_b64_v4i16((LAS s16x4*)hi);
    return __builtin_shufflevector(a, b, 0, 1, 2, 3, 4, 5, 6, 7);
}
DI void attn_step_params(int sidx, int p0, int& d, int& base, int& nk, int& kbase, bool& actA, bool& actB) {
    const int pi = sidx < 12 ? 0 : (sidx < 18 ? 1 : 2);
    const int st = sidx - (pi == 0 ? 0 : (pi == 1 ? 12 : (sidx < 23 ? 18 : 23)));
    d = 1 << (2 * pi); base = p0 - 64 * d + (sidx >= 23 ? 8 : 0); nk = pi == 0 ? 377 : (pi == 1 ? 191 : 144); kbase = 32 * st;
    actA = sidx < 23; actB = sidx < 18 || sidx >= 23;
}
DI void attn_phase(const Params& p, LAS unsigned char* lds, int gw, int NGW, int wave, int lane) {
    LAS bf16_t* Vn0 = (LAS bf16_t*)(lds + wave * 9216);
    const bf16_t* Pb = (const bf16_t*)(p.ws + WS_P);
    bf16_t* mix = (bf16_t*)(p.ws + WS_MIX);
    const int c = lane & 15, q = lane >> 4, qp = (lane & 15) >> 2, pp = lane & 3;
    for (int wi = gw; wi < 12288; wi += NGW) {
        const int head = wi & 7, qg = wi >> 3;
        const int t0 = (qg >> 3) * 256 + (qg & 7);
        const int S = t0 < TP ? 4096 : 8192, sbase = t0 & ~(S - 1), p0 = t0 - sbase;
        const int hoff = (head & 3) * 64;
        const bf16_t* Qt = Pb + (size_t)(0 + (head >> 2)) * TILE_ELEMS + hoff;
        const bf16_t* Kt = Pb + (size_t)(2 + (head >> 2)) * TILE_ELEMS + hoff;
        const bf16_t* Vg = Pb + (size_t)(4 + (head >> 2)) * TILE_ELEMS + hoff;
        bf16x8 qf[2][2];
#pragma unroll
        for (int X = 0; X < 2; ++X) { const bf16_t* qrow = Qt + (size_t)(t0 + 8 * X + 16 * c) * 256;
#pragma unroll
            for (int ks = 0; ks < 2; ++ks) {
                const u32x4 w = *(const u32x4*)(qrow + 32 * ks + 8 * q); constexpr float QS = 0.125f * 1.4426950408889634f;
                u32x4 o; o.x = pk2(bflo(w.x) * QS, bfhi(w.x) * QS); o.y = pk2(bflo(w.y) * QS, bfhi(w.y) * QS); o.z = pk2(bflo(w.z) * QS, bfhi(w.z) * QS); o.w = pk2(bflo(w.w) * QS, bfhi(w.w) * QS);
                qf[X][ks] = __builtin_bit_cast(bf16x8, o); } }
        f32x4 O[2][4];
#pragma unroll
        for (int X = 0; X < 2; ++X)
#pragma unroll
            for (int d4 = 0; d4 < 4; ++d4) O[X][d4] = (f32x4){0.f, 0.f, 0.f, 0.f};
        float mrun[2] = {-1e30f, -1e30f}, lsum[2] = {0.f, 0.f};
        u32x4 vb[3][4]; bf16x8 kb[3][2][2];
#define ATT_LOADS(sidx_, V_, K_) do { int d_, base_, nk_, kbase_; bool a_, b_; attn_step_params(sidx_, p0, d_, base_, nk_, kbase_, a_, b_); \
            _Pragma("unroll") for (int i = 0; i < 4; ++i) { const int id = lane + 64 * i, key = id >> 3, dc = id & 7; \
                int pos = base_ + d_ * (kbase_ + key); pos = pos < 0 ? 0 : (pos > S - 1 ? S - 1 : pos); \
                V_[i] = *(const u32x4*)(Vg + (size_t)(sbase + pos) * 256 + 8 * dc); } \
            _Pragma("unroll") for (int kt = 0; kt < 2; ++kt) { int pos = base_ + d_ * (kbase_ + 16 * kt + c); pos = pos < 0 ? 0 : (pos > S - 1 ? S - 1 : pos); \
                const bf16_t* krow = Kt + (size_t)(sbase + pos) * 256; K_[kt][0] = *(const bf16x8*)(krow + 8 * q); K_[kt][1] = *(const bf16x8*)(krow + 32 + 8 * q); } } while (0)
        ATT_LOADS(0, vb[0], kb[0]);
        ATT_LOADS(1, vb[1], kb[1]);
#pragma unroll
        for (int i = 0; i < 4; ++i) { const int id = lane + 64 * i; *(LAS u32x4*)(Vn0 + (id >> 3) * 72 + 8 * (id & 7)) = vb[0][i]; }
        for (int s3 = 0; s3 < 30; s3 += 3) {
#pragma unroll
          for (int u = 0; u < 3; ++u) {
            const int sidx = s3 + u;
            if (sidx + 2 < 28) ATT_LOADS(sidx + 2, vb[(u + 2) % 3], kb[(u + 2) % 3]);
            if (sidx < 28) {
            int d, base, nk, kbase; bool act[2]; attn_step_params(sidx, p0, d, base, nk, kbase, act[0], act[1]);
            const int win = 64 * d;
            bf16x8 vf[4];
            { const LAS bf16_t* Vn = Vn0 + (sidx & 1) * 2304;
#pragma unroll
              for (int d4 = 0; d4 < 4; ++d4) { const LAS bf16_t* vr = Vn + (4 * q + qp) * 72 + 16 * d4 + 4 * pp; vf[d4] = tr_pair(vr, vr + 16 * 72); } }
            if (sidx + 1 < 28) { LAS bf16_t* Vw = Vn0 + ((sidx + 1) & 1) * 2304;
#pragma unroll
              for (int i = 0; i < 4; ++i) { const int id = lane + 64 * i; *(LAS u32x4*)(Vw + (id >> 3) * 72 + 8 * (id & 7)) = vb[(u + 1) % 3][i]; } }
            f32x4 sc[2][2];
#pragma unroll
            for (int X = 0; X < 2; ++X)
#pragma unroll
                for (int kt = 0; kt < 2; ++kt) {
                    f32x4 a = {0.f, 0.f, 0.f, 0.f};
                    a = __builtin_amdgcn_mfma_f32_16x16x32_bf16(kb[u][kt][0], qf[X][0], a, 0, 0, 0);
                    a = __builtin_amdgcn_mfma_f32_16x16x32_bf16(kb[u][kt][1], qf[X][1], a, 0, 0, 0);
                    sc[X][kt] = a;
                }
            const int sh = d == 1 ? 0 : (d == 4 ? 2 : 4);
            int rr[2]; unsigned rng[2];
#pragma unroll
            for (int X = 0; X < 2; ++X) {
                const int pq = p0 + 8 * X + 16 * c;
                const int nb = base < 0 ? -base : 0;
                int klo = (pq - win - base) >> sh; const int k2 = (nb + d - 1) >> sh; klo = klo > k2 ? klo : k2;
                int khi = (pq + win - base) >> sh; const int k3 = (S - 1 - base) >> sh; khi = khi < k3 ? khi : k3; khi = khi < nk - 1 ? khi : nk - 1;
                if (!act[X]) { klo = 1 << 20; khi = klo; }
                rr[X] = kbase + 4 * q - klo; rng[X] = (unsigned)(khi - klo);
            }
            bool valid[2][2][4]; float mloc[2];
#pragma unroll
            for (int X = 0; X < 2; ++X) {
                float m = -1e30f;
#pragma unroll
                for (int kt = 0; kt < 2; ++kt)
#pragma unroll
                    for (int j = 0; j < 4; ++j) {
                        valid[X][kt][j] = (unsigned)(rr[X] + 16 * kt + j) <= rng[X];
                        const float sv = valid[X][kt][j] ? sc[X][kt][j] : -1e30f;
                        sc[X][kt][j] = sv; m = fmaxf(m, sv);
                    }
                mloc[X] = m;
            }
#pragma unroll
            for (int X = 0; X < 2; ++X) {
                const u32x2 r = __builtin_amdgcn_permlane32_swap(__float_as_uint(mloc[X]), __float_as_uint(mloc[X]), false, false);
                mloc[X] = fmaxf(fmaxf(mloc[X], __uint_as_float(r[0])), __uint_as_float(r[1]));
            }
#pragma unroll
            for (int X = 0; X < 2; ++X) {
                const u32x2 r = __builtin_amdgcn_permlane16_swap(__float_as_uint(mloc[X]), __float_as_uint(mloc[X]), false, false);
                mloc[X] = fmaxf(fmaxf(mloc[X], __uint_as_float(r[0])), __uint_as_float(r[1]));
            }
            float alpha[2]; bf16x8 pf[2];
#pragma unroll
            for (int X = 0; X < 2; ++X) {
                const float mnew = fmaxf(mrun[X], mloc[X]); alpha[X] = __builtin_amdgcn_exp2f(mrun[X] - mnew); mrun[X] = mnew;
                float ps = 0.f; float pv[2][4];
#pragma unroll
                for (int kt = 0; kt < 2; ++kt)
#pragma unroll
                    for (int j = 0; j < 4; ++j) { pv[kt][j] = valid[X][kt][j] ? __builtin_amdgcn_exp2f(sc[X][kt][j] - mnew) : 0.f; ps += pv[kt][j]; }
                lsum[X] = lsum[X] * alpha[X] + ps;
                u32x4 pw; pw.x = pk2(pv[0][0], pv[0][1]); pw.y = pk2(pv[0][2], pv[0][3]); pw.z = pk2(pv[1][0], pv[1][1]); pw.w = pk2(pv[1][2], pv[1][3]);
                pf[X] = __builtin_bit_cast(bf16x8, pw);
            }
#pragma unroll
            for (int d4 = 0; d4 < 4; ++d4)
#pragma unroll
                for (int X = 0; X < 2; ++X) O[X][d4] = __builtin_amdgcn_mfma_f32_16x16x32_bf16(vf[d4], pf[X], O[X][d4] * alpha[X], 0, 0, 0);
            }
          }
        }
#undef ATT_LOADS
#pragma unroll
        for (int X = 0; X < 2; ++X) {
            float l = lsum[X]; l += __shfl_xor(l, 16); l += __shfl_xor(l, 32);
            const float inv = 1.0f / l;
            bf16_t* orow = mix + (size_t)(t0 + 8 * X + 16 * c) * DM + head * 64 + 4 * q;
#pragma unroll
            for (int d4 = 0; d4 < 4; ++d4) { u32x2 w; w.x = pk2(O[X][d4][0] * inv, O[X][d4][1] * inv); w.y = pk2(O[X][d4][2] * inv, O[X][d4][3] * inv); *(u32x2*)(orow + 16 * d4) = w; }
        }
    }
}

constexpr size_t WS_SLOC = WS_P;
constexpr size_t WS_DEC = WS_P + 96 * MiB;
constexpr int N_SSD_ITEMS = 6144;
constexpr int N_SSD_UNITS = 3072;
struct SsdUnit { int h, g, tok0, itf, itb; float Af, Ab; };
DI SsdUnit ssd_decode(const Params& p, int u) {
    SsdUnit I; const int cg = u >> 3; I.h = u & 7; I.g = I.h >> 2; I.tok0 = cg * 128;
    int seq, cn, nc; if (cg < 256) { seq = cg >> 5; cn = cg & 31; nc = 32; } else { seq = 8 + ((cg - 256) >> 6); cn = (cg - 256) & 63; nc = 64; }
    const int wf = seq * 16 + I.h * 2, wb = wf + 1;
    I.itf = (wf < 128 ? 32 * wf : 4096 + 64 * (wf - 128)) + cn;
    I.itb = (wb < 128 ? 32 * wb : 4096 + 64 * (wb - 128)) + (nc - 1 - cn);
    I.Af = -__expf(p.in[6][I.h]); I.Ab = -__expf(p.in[6][8 + I.h]);
    return I;
}
DI void ssd_scan_chunk2(float f0, float f1, float b0, float b1, float Af, float Ab, LAS float* acsf, LAS float* acsb, LAS float* dtsf, LAS float* dtsb, int lane) {
    const float v0 = f0 * Af, v1 = f1 * Af; float ps = v0 + v1;
    const float w0 = b0 * Ab, w1 = b1 * Ab; float qs = w0 + w1;
#pragma unroll
    for (int o = 1; o < 64; o <<= 1) { const float t = __shfl_up(ps, o); const float t2 = __shfl_down(qs, o); if (lane >= o) ps += t; if (lane + o < 64) qs += t2; }
    acsf[2 * lane] = ps - v1; acsf[2 * lane + 1] = ps; acsb[2 * lane] = qs; acsb[2 * lane + 1] = qs - w0;
    dtsf[2 * lane] = f0; dtsf[2 * lane + 1] = f1; dtsb[2 * lane] = b0; dtsb[2 * lane + 1] = b1;
}
DI u32x4 scale8(const u32x4 v, float sc) { u32x4 o; o.x = pk2(bflo(v.x) * sc, bfhi(v.x) * sc); o.y = pk2(bflo(v.y) * sc, bfhi(v.y) * sc); o.z = pk2(bflo(v.z) * sc, bfhi(v.z) * sc); o.w = pk2(bflo(v.w) * sc, bfhi(v.w) * sc); return o; }
DI void ssd_state_phase(const Params& p, LAS unsigned char* lds, int wave, int lane) {
    const int tid = TIDX(wave), c = lane & 15, q = lane >> 4, w = wave, qp = (lane & 15) >> 2, pp = lane & 3;
    LAS float* acsf = (LAS float*)(lds + 0); LAS float* acsb = (LAS float*)(lds + 512); LAS float* dtsf = (LAS float*)(lds + 1024); LAS float* dtsb = (LAS float*)(lds + 1536);
    LAS bf16_t* Xf = (LAS bf16_t*)(lds + 2048); LAS bf16_t* Xb = (LAS bf16_t*)(lds + 2048 + 18432); LAS bf16_t* Bn = (LAS bf16_t*)(lds + 2048 + 2 * 18432);
    const float* dtb = (const float*)(p.ws + WS_DT);
    const bf16_t* XCb = (const bf16_t*)(p.ws + WS_XC);
    bf16_t* Sl = (bf16_t*)(p.ws + WS_SLOC); float* decv = (float*)(p.ws + WS_DEC);
    int it = (gridDim.x % 8 == 0) ? ((int)blockIdx.x % 8) * ((int)gridDim.x / 8) + (int)blockIdx.x / 8 : (int)blockIdx.x;
    if (it >= N_SSD_UNITS) return;
    SsdUnit I = ssd_decode(p, it);
    float pf0 = 0.f, pf1 = 0.f, pb0 = 0.f, pb1 = 0.f; u32x4 xv[2], bv[4];
#define SSD_LOADS_A(I) do { \
        if (w == 0) { const float* d_ = dtb + (size_t)((I).tok0 + 2 * lane) * 16 + (I).h; pf0 = d_[0]; pb0 = d_[8]; pf1 = d_[16]; pb1 = d_[24]; } \
        _Pragma("unroll") for (int i = 0; i < 2; ++i) { const int id = tid + NTHR * i, l = id >> 3, pc = id & 7; \
            xv[i] = *(const u32x4*)(XCb + (size_t)((I).h >> 2) * TILE_ELEMS + (size_t)((I).tok0 + l) * 256 + ((I).h & 3) * 64 + 8 * pc); } \
        _Pragma("unroll") for (int i = 0; i < 4; ++i) { const int id = tid + NTHR * i, l = id >> 4, ncn = id & 15; \
            bv[i] = *(const u32x4*)(XCb + 2 * TILE_ELEMS + (size_t)((I).tok0 + l) * 256 + (I).g * 128 + 8 * ncn); } } while (0)
    SSD_LOADS_A(I);
    for (; it < N_SSD_UNITS; it += gridDim.x) {
        if (w == 0) ssd_scan_chunk2(pf0, pf1, pb0, pb1, I.Af, I.Ab, acsf, acsb, dtsf, dtsb, lane);
        __syncthreads();
        const float aendf = acsf[127], aendb = acsb[0];
#pragma unroll
        for (int i = 0; i < 2; ++i) {
            const int id = tid + NTHR * i, l = id >> 3, pc = id & 7;
            *(LAS u32x4*)(Xf + l * 72 + 8 * pc) = scale8(xv[i], dtsf[l] * __expf(aendf - acsf[l]));
            *(LAS u32x4*)(Xb + l * 72 + 8 * pc) = scale8(xv[i], dtsb[l] * __expf(aendb - acsb[l]));
        }
#pragma unroll
        for (int i = 0; i < 4; ++i) { const int id = tid + NTHR * i; *(LAS u32x4*)(Bn + (id >> 4) * 136 + 8 * (id & 15)) = bv[i]; }
        const int itf = I.itf, itb = I.itb;
        const int itn = it + gridDim.x;
        if (itn < N_SSD_UNITS) { I = ssd_decode(p, itn); SSD_LOADS_A(I); }
        __syncthreads();
        bf16_t* sof = Sl + (size_t)itf * 8192 + 16 * w + 4 * q; bf16_t* sob = Sl + (size_t)itb * 8192 + 16 * w + 4 * q;
#pragma unroll
        for (int pt = 0; pt < 4; ++pt) {
            f32x4 af = {0.f, 0.f, 0.f, 0.f}, ab = {0.f, 0.f, 0.f, 0.f};
#pragma unroll
            for (int ks = 0; ks < 4; ++ks) {
                const LAS bf16_t* br = Bn + (32 * ks + 8 * q + qp) * 136 + 16 * w + 4 * pp;
                const LAS bf16_t* xrf = Xf + (32 * ks + 8 * q + qp) * 72 + 16 * pt + 4 * pp;
                const LAS bf16_t* xrb = Xb + (32 * ks + 8 * q + qp) * 72 + 16 * pt + 4 * pp;
                const bf16x8 bfr = tr_pair(br, br + 4 * 136);
                af = __builtin_amdgcn_mfma_f32_16x16x32_bf16(bfr, tr_pair(xrf, xrf + 4 * 72), af, 0, 0, 0);
                ab = __builtin_amdgcn_mfma_f32_16x16x32_bf16(bfr, tr_pair(xrb, xrb + 4 * 72), ab, 0, 0, 0);
            }
            u32x2 o; o.x = pk2(af[0], af[1]); o.y = pk2(af[2], af[3]); *(u32x2*)(sof + (16 * pt + c) * 128) = o;
            o.x = pk2(ab[0], ab[1]); o.y = pk2(ab[2], ab[3]); *(u32x2*)(sob + (16 * pt + c) * 128) = o;
        }
        if (tid == 0) { decv[itf] = __expf(aendf); decv[itb] = __expf(aendb); }
    }
#undef SSD_LOADS_A
}
DI void ssd_scan_phase(const Params& p, int wave) {
    unsigned* Sl = (unsigned*)(p.ws + WS_SLOC); const float* decv = (const float*)(p.ws + WS_DEC);
    for (int chain = blockIdx.x * NTHR + TIDX(wave); chain < 160 * 4096; chain += gridDim.x * NTHR) {
        const int w = chain >> 12, j = chain & 4095;
        const int nc = w < 128 ? 32 : 64, cb = w < 128 ? 32 * w : 4096 + 64 * (w - 128);
        unsigned* ptr = Sl + (size_t)cb * 4096 + j; const float* dp = decv + cb;
        float s0 = 0.f, s1 = 0.f;
        for (int c0 = 0; c0 < nc; c0 += 8) {
            unsigned v[8]; float d[8];
#pragma unroll
            for (int k = 0; k < 8; ++k) { v[k] = ptr[(size_t)(c0 + k) * 4096]; d[k] = dp[c0 + k]; }
#pragma unroll
            for (int k = 0; k < 8; ++k) { ptr[(size_t)(c0 + k) * 4096] = pk2(s0, s1); s0 = s0 * d[k] + bflo(v[k]); s1 = s1 * d[k] + bfhi(v[k]); }
        }
    }
}
constexpr int SSDC_XF = 4096, SSDC_XB = SSDC_XF + 18432, SSDC_BN = SSDC_XB + 18432, SSDC_SF = SSDC_BN + 128 * 272, SSDC_SB = SSDC_SF + 64 * 272, SSDC_END = SSDC_SB + 64 * 272;
static_assert(SSDC_END <= 131072, "ssd lds");
DI void ssd_out_phase(const Params& p, LAS unsigned char* lds, int wave, int lane) {
    const int tid = TIDX(wave), c = lane & 15, q = lane >> 4, w = wave, qp = (lane & 15) >> 2, pp = lane & 3;
    LAS bf16_t* Xf = (LAS bf16_t*)(lds + SSDC_XF); LAS bf16_t* Xb = (LAS bf16_t*)(lds + SSDC_XB); LAS bf16_t* Bn = (LAS bf16_t*)(lds + SSDC_BN);
    LAS bf16_t* Sf = (LAS bf16_t*)(lds + SSDC_SF); LAS bf16_t* Sb = (LAS bf16_t*)(lds + SSDC_SB);
    const float* dtb = (const float*)(p.ws + WS_DT);
    const bf16_t* XCb = (const bf16_t*)(p.ws + WS_XC);
    const bf16_t* Sl = (const bf16_t*)(p.ws + WS_SLOC);
    int it = (gridDim.x % 8 == 0) ? ((int)blockIdx.x % 8) * ((int)gridDim.x / 8) + (int)blockIdx.x / 8 : (int)blockIdx.x;
    if (it >= N_SSD_UNITS) return;
    SsdUnit I = ssd_decode(p, it);
    float pf0 = 0.f, pf1 = 0.f, pb0 = 0.f, pb1 = 0.f; u32x4 xv[2], bv[4], svf[2], svb[2]; bf16x8 Cn[4];
#define SSD_LOADS_C(I) do { \
        if (w == 0) { const float* d_ = dtb + (size_t)((I).tok0 + 2 * lane) * 16 + (I).h; pf0 = d_[0]; pb0 = d_[8]; pf1 = d_[16]; pb1 = d_[24]; } \
        _Pragma("unroll") for (int i = 0; i < 2; ++i) { const int id = tid + NTHR * i, l = id >> 3, pc = id & 7; \
            xv[i] = *(const u32x4*)(XCb + (size_t)((I).h >> 2) * TILE_ELEMS + (size_t)((I).tok0 + l) * 256 + ((I).h & 3) * 64 + 8 * pc); \
            svf[i] = *(const u32x4*)(Sl + (size_t)(I).itf * 8192 + (size_t)id * 8); svb[i] = *(const u32x4*)(Sl + (size_t)(I).itb * 8192 + (size_t)id * 8); } \
        _Pragma("unroll") for (int i = 0; i < 4; ++i) { const int id = tid + NTHR * i, l = id >> 4, ncn = id & 15; \
            bv[i] = *(const u32x4*)(XCb + 2 * TILE_ELEMS + (size_t)((I).tok0 + l) * 256 + (I).g * 128 + 8 * ncn); } \
        { const bf16_t* cr = XCb + 3 * TILE_ELEMS + (size_t)((I).tok0 + 16 * w + c) * 256 + (I).g * 128 + 8 * q; \
          _Pragma("unroll") for (int ks = 0; ks < 4; ++ks) Cn[ks] = *(const bf16x8*)(cr + 32 * ks); } } while (0)
    SSD_LOADS_C(I);
    int par = 0;
    for (; it < N_SSD_UNITS; it += gridDim.x, par ^= 1) {
        LAS float* acsf = (LAS float*)(lds + par * 2048); LAS float* acsb = acsf + 128; LAS float* dtsf = acsf + 256; LAS float* dtsb = acsf + 384;
        if (w == 0) ssd_scan_chunk2(pf0, pf1, pb0, pb1, I.Af, I.Ab, acsf, acsb, dtsf, dtsb, lane);
        __syncthreads();
#pragma unroll
        for (int i = 0; i < 2; ++i) {
            const int id = tid + NTHR * i, l = id >> 3, pc = id & 7;
            *(LAS u32x4*)(Xf + l * 72 + 8 * pc) = scale8(xv[i], dtsf[l]);
            *(LAS u32x4*)(Xb + l * 72 + 8 * pc) = scale8(xv[i], dtsb[l]);
            *(LAS u32x4*)(Sf + (id >> 4) * 136 + 8 * (id & 15)) = svf[i];
            *(LAS u32x4*)(Sb + (id >> 4) * 136 + 8 * (id & 15)) = svb[i];
        }
#pragma unroll
        for (int i = 0; i < 4; ++i) { const int id = tid + NTHR * i; *(LAS u32x4*)(Bn + (id >> 4) * 136 + 8 * (id & 15)) = bv[i]; }
        bf16x8 Cf[4];
#pragma unroll
        for (int ks = 0; ks < 4; ++ks) Cf[ks] = Cn[ks];
        const int tok0 = I.tok0, hh = I.h;
        const int itn = it + gridDim.x;
        if (itn < N_SSD_UNITS) { I = ssd_decode(p, itn); SSD_LOADS_C(I); }
        __syncthreads();
        {
            const int l = 16 * w + c;
            const float alf = acsf[l], alb = acsb[l];
            f32x4 accf[4], accb[4];
#pragma unroll
            for (int pt = 0; pt < 4; ++pt) {
                f32x4 a = {0.f, 0.f, 0.f, 0.f}, b = {0.f, 0.f, 0.f, 0.f};
#pragma unroll
                for (int ks = 0; ks < 4; ++ks) {
                    a = __builtin_amdgcn_mfma_f32_16x16x32_bf16(*(const LAS bf16x8*)(Sf + (16 * pt + c) * 136 + 32 * ks + 8 * q), Cf[ks], a, 0, 0, 0);
                    b = __builtin_amdgcn_mfma_f32_16x16x32_bf16(*(const LAS bf16x8*)(Sb + (16 * pt + c) * 136 + 32 * ks + 8 * q), Cf[ks], b, 0, 0, 0);
                }
                accf[pt] = a * __expf(alf); accb[pt] = b * __expf(alb);
            }
            const int spd = w >> 1;
            for (int sp = 0; sp < 4; ++sp) {
                f32x4 Mf[2], Mb[2];
#pragma unroll
                for (int hx = 0; hx < 2; ++hx) {
                    const int st = 2 * sp + hx;
                    f32x4 G = {0.f, 0.f, 0.f, 0.f};
#pragma unroll
                    for (int ks = 0; ks < 4; ++ks) G = __builtin_amdgcn_mfma_f32_16x16x32_bf16(*(const LAS bf16x8*)(Bn + (16 * st + c) * 136 + 32 * ks + 8 * q), Cf[ks], G, 0, 0, 0);
#pragma unroll
                    for (int j = 0; j < 4; ++j) {
                        const int sx = 16 * st + 4 * q + j;
                        Mf[hx][j] = (sx <= l) ? G[j] * __expf(alf - acsf[sx]) : 0.f;
                        Mb[hx][j] = (sx >= l) ? G[j] * __expf(alb - acsb[sx]) : 0.f;
                    }
                }
                if (sp <= spd) {
                    u32x4 pw; pw.x = pk2(Mf[0][0], Mf[0][1]); pw.y = pk2(Mf[0][2], Mf[0][3]); pw.z = pk2(Mf[1][0], Mf[1][1]); pw.w = pk2(Mf[1][2], Mf[1][3]);
                    const bf16x8 pf = __builtin_bit_cast(bf16x8, pw);
#pragma unroll
                    for (int pt = 0; pt < 4; ++pt) { const LAS bf16_t* xr = Xf + (32 * sp + 4 * q + qp) * 72 + 16 * pt + 4 * pp;
                        accf[pt] = __builtin_amdgcn_mfma_f32_16x16x32_bf16(tr_pair(xr, xr + 16 * 72), pf, accf[pt], 0, 0, 0); }
                }
                if (sp >= spd) {
                    u32x4 pw; pw.x = pk2(Mb[0][0], Mb[0][1]); pw.y = pk2(Mb[0][2], Mb[0][3]); pw.z = pk2(Mb[1][0], Mb[1][1]); pw.w = pk2(Mb[1][2], Mb[1][3]);
                    const bf16x8 pf = __builtin_bit_cast(bf16x8, pw);
#pragma unroll
                    for (int pt = 0; pt < 4; ++pt) { const LAS bf16_t* xr = Xb + (32 * sp + 4 * q + qp) * 72 + 16 * pt + 4 * pp;
                        accb[pt] = __builtin_amdgcn_mfma_f32_16x16x32_bf16(tr_pair(xr, xr + 16 * 72), pf, accb[pt], 0, 0, 0); }
                }
            }
            bf16_t* yrf = (bf16_t*)(p.ws + WS_YF) + hh * 64 + (size_t)(tok0 + l) * 512 + 4 * q;
            bf16_t* yrb = (bf16_t*)(p.ws + WS_YB) + hh * 64 + (size_t)(tok0 + l) * 512 + 4 * q;
#pragma unroll
            for (int pt = 0; pt < 4; ++pt) {
                u32x2 o; o.x = pk2(accf[pt][0], accf[pt][1]); o.y = pk2(accf[pt][2], accf[pt][3]); *(u32x2*)(yrf + 16 * pt) = o;
                o.x = pk2(accb[pt][0], accb[pt][1]); o.y = pk2(accb[pt][2], accb[pt][3]); *(u32x2*)(yrb + 16 * pt) = o;
            }
        }
    }
#undef SSD_LOADS_C
}

DI void gate_phase(const Params& p, int gw, int NGW, int lane) {
    const bf16_t* yf = (const bf16_t*)(p.ws + WS_YF); const bf16_t* yb = (const bf16_t*)(p.ws + WS_YB);
    const bf16_t* xh = (const bf16_t*)(p.ws + WS_XC) + (size_t)(lane >> 5) * TILE_ELEMS + (8 * lane & 255);
    const bf16_t* zt = (const bf16_t*)(p.ws + WS_P) + (size_t)(6 + (lane >> 5)) * TILE_ELEMS + (8 * lane & 255);
    bf16_t* mix = (bf16_t*)(p.ws + WS_MIX) + 512 + 8 * lane;
    const float D = p.in[7][lane >> 3];
    float nw[8];
#pragma unroll
    for (int e = 0; e < 8; ++e) nw[e] = p.in[8][8 * lane + e];
    for (int t = gw; t < TT; t += NGW) {
        const u32x4 a = *(const u32x4*)(yf + (size_t)t * 512 + 8 * lane), b = *(const u32x4*)(yb + (size_t)t * 512 + 8 * lane);
        const u32x4 x = *(const u32x4*)(xh + (size_t)t * 256), z = *(const u32x4*)(zt + (size_t)t * 256);
        float y[8];
        y[0] = (bflo(a.x) + bflo(b.x) + D * bflo(x.x)) * silu_f(bflo(z.x)); y[1] = (bfhi(a.x) + bfhi(b.x) + D * bfhi(x.x)) * silu_f(bfhi(z.x));
        y[2] = (bflo(a.y) + bflo(b.y) + D * bflo(x.y)) * silu_f(bflo(z.y)); y[3] = (bfhi(a.y) + bfhi(b.y) + D * bfhi(x.y)) * silu_f(bfhi(z.y));
        y[4] = (bflo(a.z) + bflo(b.z) + D * bflo(x.z)) * silu_f(bflo(z.z)); y[5] = (bfhi(a.z) + bfhi(b.z) + D * bfhi(x.z)) * silu_f(bfhi(z.z));
        y[6] = (bflo(a.w) + bflo(b.w) + D * bflo(x.w)) * silu_f(bflo(z.w)); y[7] = (bfhi(a.w) + bfhi(b.w) + D * bfhi(x.w)) * silu_f(bfhi(z.w));
        float ss = 0.f;
#pragma unroll
        for (int e = 0; e < 8; ++e) ss += y[e] * y[e];
        ss = wave_sum(ss);
        const float r = 1.0f / sqrtf(ss * (1.0f / 512.0f) + RMS_EPS);
        u32x4 o; o.x = pk2(y[0] * r * nw[0], y[1] * r * nw[1]); o.y = pk2(y[2] * r * nw[2], y[3] * r * nw[3]); o.z = pk2(y[4] * r * nw[4], y[5] * r * nw[5]); o.w = pk2(y[6] * r * nw[6], y[7] * r * nw[7]);
        *(u32x4*)(mix + (size_t)t * DM) = o;
    }
}

DI void expert_gu_weights_phase(const Params& p, LAS unsigned char* lds, int gw, int NGW, int wave, int lane) {
    LAS float* scr = (LAS float*)(lds + wave * 16384);
    for (int it = gw; it < 16 * 2816; it += NGW) {
        const int e = it / 2816, r = it % 2816;
        const int isup = r >= 1408, rr = isup ? r - 1408 : r, kb = rr / 88, nb = rr % 88, n0 = 32 * nb;
        const float* W = (isup ? p.in[14] : p.in[13]) + (size_t)e * DM * FF;
        transpose_item_f8(W, FF, 64 * kb, n0, p.ws + WS_WGU, DM, e * 5632 + 256 * (n0 >> 7) + (n0 & 127) + (isup ? 128 : 0), WGU_SCALE, scr, lane);
    }
}
DI void expert_down_weights(const Params& p, LAS unsigned char* lds, int vw, int NVW, int wave, int lane) {
    LAS float* scr = (LAS float*)(lds + 4096 + wave * 16384);
    for (int it = vw; it < 16 * 1408; it += NVW) {
        const int e = it / 1408, rr = it % 1408, kb = rr / 32, nb = rr % 32;
        transpose_item_f8(p.in[15] + (size_t)e * FF * DM, DM, 64 * kb, 32 * nb, p.ws + WS_WD, FF, e * 1024 + 32 * nb, WD_SCALE, scr, lane);
    }
}

DI void ln1_router_phase(const Params& p, LAS unsigned char* lds, int gw, int NGW, int wave, int lane) {
    const int tid = TIDX(wave);
    LAS float* wT = (LAS float*)lds;
    for (int id = tid; id < 16384; id += NTHR) { const int k = id >> 4, e = id & 15; wT[e * 1024 + k] = p.in[12][id]; }
    __syncthreads();
    f32x4 gg[4], bb[4];
#pragma unroll
    for (int j = 0; j < 4; ++j) { gg[j] = ((const f32x4*)p.in[10])[64 * j + lane]; bb[j] = ((const f32x4*)p.in[11])[64 * j + lane]; }
    unsigned char* x1b = p.ws + WS_X1B; float* aff = (float*)(p.ws + WS_AFF);
    for (int t = gw; t < TT; t += NGW) {
        f32x4* orow = (f32x4*)(p.out + (size_t)t * DM) + lane;
        f32x4 v[4]; float s = 0.f;
#pragma unroll
        for (int j = 0; j < 4; ++j) { v[j] = orow[64 * j]; s += (v[j][0] + v[j][1]) + (v[j][2] + v[j][3]); }
        const float mean = wave_sum(s) * (1.0f / DM); float s2 = 0.f;
#pragma unroll
        for (int j = 0; j < 4; ++j) { v[j] = v[j] - mean; s2 += (v[j][0] * v[j][0] + v[j][1] * v[j][1]) + (v[j][2] * v[j][2] + v[j][3] * v[j][3]); }
        const float rstd = 1.0f / sqrtf(wave_sum(s2) * (1.0f / DM) + LN_EPS);
        unsigned* o4 = (unsigned*)(x1b + (size_t)t * DM) + lane;
#pragma unroll
        for (int j = 0; j < 4; ++j) {
            v[j] = v[j] * rstd * gg[j] + bb[j];
            orow[64 * j] = v[j] * ALPHA;
            o4[64 * j] = pk4_f8(v[j][0], v[j][1], v[j][2], v[j][3]);
        }
        float r[16]; dot16(v, wT, lane, r);
        float mx = r[0];
#pragma unroll
        for (int e = 1; e < 16; ++e) mx = fmaxf(mx, r[e]);
        float den = 0.f, mine = 0.f;
#pragma unroll
        for (int e = 0; e < 16; ++e) { const float ex = __expf(r[e] - mx); den += ex; mine = (lane == e) ? ex : mine; }
        if (lane < 16) aff[(size_t)lane * TT + t] = mine / den;
    }
}

DI void select_phase(const Params& p, LAS unsigned char* lds, int wave, int lane) {
    const int wk = blockIdx.x;
    if (wk >= 32) { expert_down_weights(p, lds, (wk - 32) * 8 + wave, ((int)gridDim.x - 32) * 8, wave, lane); return; }
    const int tid = TIDX(wave);
    const int trunk = wk >> 4, e = wk & 15;
    const int Tn = trunk ? 16384 : 32768, tbase = trunk ? TP : 0, cap = Tn / 8;
    const unsigned* col = (const unsigned*)(p.ws + WS_AFF) + (size_t)e * TT + tbase;
    LAS unsigned* hist = (LAS unsigned*)lds;
    LAS unsigned* ctl = (LAS unsigned*)(lds + 1024);
    LAS unsigned* wcnt = (LAS unsigned*)(lds + 2048);
    unsigned prefix = 0, remaining = (unsigned)cap;
    for (int pass = 0; pass < 4; ++pass) {
        const int shift = 24 - 8 * pass;
        for (int i = tid; i < 256; i += NTHR) hist[i] = 0u;
        __syncthreads();
        for (int i = tid; i < Tn; i += NTHR) {
            const unsigned bits = col[i];
            if (pass == 0 || (bits >> (shift + 8)) == prefix) atomicAdd((unsigned*)(hist + ((bits >> shift) & 255u)), 1u);
        }
        __syncthreads();
        if (wave == 0) {
            const unsigned h0 = hist[4 * lane], h1 = hist[4 * lane + 1], h2 = hist[4 * lane + 2], h3 = hist[4 * lane + 3], tot = h0 + h1 + h2 + h3;
            unsigned v = tot;
#pragma unroll
            for (int o = 1; o < 64; o <<= 1) { const unsigned t = __shfl_down(v, o); if (lane + o < 64) v += t; }
            const unsigned excl = v - tot;
            if (excl < remaining && remaining <= excl + tot) {
                unsigned cum = excl; int b;
                if (cum + h3 >= remaining) b = 3; else { cum += h3; if (cum + h2 >= remaining) b = 2; else { cum += h2; if (cum + h1 >= remaining) b = 1; else { cum += h1; b = 0; } } }
                ctl[0] = (prefix << 8) | (unsigned)(4 * lane + b); ctl[1] = remaining - cum;
            }
        }
        __syncthreads();
        prefix = ctl[0]; remaining = ctl[1];
        __syncthreads();
    }
    const unsigned thr = prefix, need_eq = remaining;
    int* idx = (int*)(p.ws + WS_IDX) + e * SLOTS_E + (trunk ? 4096 : 0);
    int* inv = (int*)(p.ws + WS_INV) + (size_t)e * TT + tbase;
    const int slot0 = e * SLOTS_E + (trunk ? 4096 : 0);
    float* gate = (float*)(p.ws + WS_GATE) + e * SLOTS_E + (trunk ? 4096 : 0);
    unsigned base_gt = 0, base_eq = 0;
    for (int b0 = 0; b0 < Tn; b0 += 4 * NTHR) {
        const u32x4 bits4 = *(const u32x4*)(col + b0 + 4 * tid);
        const unsigned bits[4] = {bits4.x, bits4.y, bits4.z, bits4.w};
        unsigned packed = 0;
#pragma unroll
        for (int j = 0; j < 4; ++j) packed += (bits[j] > thr ? 1u : 0u) + (bits[j] == thr ? 0x10000u : 0u);
        unsigned v = packed;
#pragma unroll
        for (int o = 1; o < 64; o <<= 1) { const unsigned t = __shfl_up(v, o); if (lane >= o) v += t; }
        if (lane == 63) wcnt[wave] = v;
        __syncthreads();
        unsigned off = 0, tot = 0;
#pragma unroll
        for (int w2 = 0; w2 < 8; ++w2) { const unsigned cnt = wcnt[w2]; off += (w2 < wave) ? cnt : 0u; tot += cnt; }
        const unsigned ex = off + (v - packed);
        unsigned gt_before = base_gt + (ex & 0xffffu), eq_before = base_eq + (ex >> 16);
        int invv[4];
#pragma unroll
        for (int j = 0; j < 4; ++j) {
            const bool gt = bits[j] > thr, eq = bits[j] == thr;
            const bool sel = gt || (eq && eq_before < need_eq);
            const unsigned pos = gt_before + (eq_before < need_eq ? eq_before : need_eq);
            const bool ok = sel && pos < (unsigned)cap;
            if (ok) { idx[pos] = tbase + b0 + 4 * tid + j; gate[pos] = __uint_as_float(bits[j]); }
            invv[j] = ok ? slot0 + (int)pos : -1;
            gt_before += gt ? 1u : 0u; eq_before += eq ? 1u : 0u;
        }
        *(i32x4*)(inv + b0 + 4 * tid) = (i32x4){invv[0], invv[1], invv[2], invv[3]};
        base_gt += tot & 0xffffu; base_eq += tot >> 16;
        __syncthreads();
    }
}

DI void ln2_phase(const Params& p, int gw, int NGW, int lane) {
    f32x4 gg[4], bb[4];
#pragma unroll
    for (int j = 0; j < 4; ++j) { gg[j] = ((const f32x4*)p.in[16])[64 * j + lane]; bb[j] = ((const f32x4*)p.in[17])[64 * j + lane]; }
    const int* inv = (const int*)(p.ws + WS_INV); const bf16_t* eo = (const bf16_t*)(p.ws + WS_EO);
    for (int t = gw; t < TT; t += NGW) {
        f32x4* orow = (f32x4*)(p.out + (size_t)t * DM) + lane;
        f32x4 v[4]; float s = 0.f;
#pragma unroll
        for (int j = 0; j < 4; ++j) v[j] = orow[64 * j];
        const int myslot = lane < 16 ? inv[(size_t)lane * TT + t] : -1;
        for (int e = 0; e < 16; ++e) {
            const int sl = __shfl(myslot, e);
            if (sl >= 0) {
                const u32x2* er = (const u32x2*)(eo + (size_t)sl * DM) + lane;
#pragma unroll
                for (int j = 0; j < 4; ++j) { const u32x2 w = er[64 * j]; v[j][0] += bflo(w.x); v[j][1] += bfhi(w.x); v[j][2] += bflo(w.y); v[j][3] += bfhi(w.y); }
            }
        }
#pragma unroll
        for (int j = 0; j < 4; ++j) s += (v[j][0] + v[j][1]) + (v[j][2] + v[j][3]);
        const float mean = wave_sum(s) * (1.0f / DM); float s2 = 0.f;
#pragma unroll
        for (int j = 0; j < 4; ++j) { v[j] = v[j] - mean; s2 += (v[j][0] * v[j][0] + v[j][1] * v[j][1]) + (v[j][2] * v[j][2] + v[j][3] * v[j][3]); }
        const float rstd = 1.0f / sqrtf(wave_sum(s2) * (1.0f / DM) + LN_EPS);
#pragma unroll
        for (int j = 0; j < 4; ++j) orow[64 * j] = v[j] * rstd * gg[j] + bb[j];
    }
}

constexpr size_t WS_CTL = 19 * MiB;
#define XB_TMO      128
#define XB_XCNT(j)  (256  + 64 * (j))
#define XB_XSUB(j)  (1280 + 64 * (j))
#define XB_XGEN(j)  (2304 + 64 * (j))
#define XB_TOP      3328
#define XB_TOPGEN   3392
#define XCD_BAR_WORDS 3456
#define XB_SPIN_CAP (1u << 18)
DI unsigned xb_ld(unsigned* p)              { return __hip_atomic_load(p, __ATOMIC_RELAXED, __HIP_MEMORY_SCOPE_AGENT); }
DI unsigned xb_add(unsigned* p, unsigned v) { return __hip_atomic_fetch_add(p, v, __ATOMIC_RELAXED, __HIP_MEMORY_SCOPE_AGENT); }
DI unsigned xb_xcc_id() { return (unsigned)__builtin_amdgcn_s_getreg((3 << 11) | 20) & 0xFu; }
#define XB_SPIN(cond, bar) do { unsigned _sp = 0; while (cond) { __builtin_amdgcn_s_sleep(1); \
    if ((++_sp & 255u) == 0u) { if (xb_ld(&(bar)[XB_TMO])) break; if (_sp > XB_SPIN_CAP) { atomicAdd(&(bar)[XB_TMO], 1u); break; } } } } while (0)
struct XcdBarrier { unsigned* bar; unsigned x; volatile LAS unsigned* st; };
DI void xcd_barrier_complete(unsigned* bar, unsigned x, unsigned& nloc, unsigned& nx) {
    const unsigned G = gridDim.x * gridDim.y * gridDim.z;
    unsigned sum, cnt, mine, sp = 0u;
    for (;;) {
        sum = 0u; cnt = 0u; mine = 0u;
#pragma unroll
        for (unsigned j = 0; j < 16; ++j) { const unsigned c = xb_ld(&bar[XB_XCNT(j)]); sum += c; cnt += (c > 0u) ? 1u : 0u; mine = (j == x) ? c : mine; }
        if (sum == G) break;
        __builtin_amdgcn_s_sleep(1);
        if ((++sp & 255u) == 0u) { if (xb_ld(&bar[XB_TMO])) break; if (sp > XB_SPIN_CAP) { atomicAdd(&bar[XB_TMO], 1u); break; } }
    }
    nloc = mine > 0u ? mine : 1u; nx = cnt > 0u ? cnt : 1u;
}
DI void xcd_barrier(const XcdBarrier& b, int wave) {
    asm volatile("s_waitcnt vmcnt(0)" ::: "memory");
    __syncthreads();
    if (wave == 0 && lane_id() == 0) {
        unsigned* bar = b.bar;
        __builtin_amdgcn_s_waitcnt(0);
        unsigned nloc = b.st[0], nx = b.st[1];
        if (nloc == 0u) { xcd_barrier_complete(bar, b.x, nloc, nx); b.st[0] = nloc; b.st[1] = nx; }
        const unsigned old = xb_add(&bar[XB_XSUB(b.x)], 1u);
        const unsigned gen = old / nloc;
        if (old + 1u == (gen + 1u) * nloc) {
            __builtin_amdgcn_fence(__ATOMIC_RELEASE, "agent");
            asm volatile("s_waitcnt vmcnt(0)" ::: "memory");
            const unsigned og = xb_add(&bar[XB_TOP], 1u);
            const unsigned tg = og / nx;
            if (og + 1u == (tg + 1u) * nx) xb_add(&bar[XB_TOPGEN], 1u);
            else XB_SPIN(xb_ld(&bar[XB_TOPGEN]) == tg, bar);
            __builtin_amdgcn_fence(__ATOMIC_ACQUIRE, "agent");
            xb_add(&bar[XB_XGEN(b.x)], 1u);
            asm volatile("s_waitcnt vmcnt(0)" ::: "memory");
        } else {
            XB_SPIN(xb_ld(&bar[XB_XGEN(b.x)]) == gen, bar);
            __builtin_amdgcn_fence(__ATOMIC_ACQUIRE, "agent");
            asm volatile("s_waitcnt vmcnt(0)" ::: "memory");
        }
    }
    __syncthreads();
}

__global__ void __launch_bounds__(NTHR, 2) fwd_megakernel(Params p) {
    extern __shared__ __attribute__((aligned(16))) unsigned char lds_raw[];
    LAS unsigned char* lds = (LAS unsigned char*)lds_raw;
    cg::grid_group grid = cg::this_grid();
    const int wave_k = __builtin_amdgcn_readfirstlane((int)threadIdx.x >> 6);
    XcdBarrier xb; xb.bar = (unsigned*)(p.ws + WS_CTL); xb.x = xb_xcc_id(); xb.st = (volatile LAS unsigned*)(lds + LDS_BYTES - 64);
    if (wave_k == 0 && lane_id() == 0) { xb.st[0] = 0u; xb.st[1] = 0u; (void)xb_add(&xb.bar[XB_XCNT(xb.x)], 1u); }
    __syncthreads();
#define GSYNC() xcd_barrier(xb, wave_k)
#define IDS() const int lane = lane_id(), wave = wave_k; \
    const int G = gridDim.x, gw = blockIdx.x * 8 + wave, NGW = G * 8; (void)lane; (void)gw; (void)NGW; (void)G;
    { IDS(); phase0(p, lds, gw, NGW, wave, lane); }
    grid.sync();
    {
        IDS();
        pg8::SchedPlain S; S.init(TT, 3072, G, (int)blockIdx.x);
        pg8::EpiProj E{(bf16_t*)(p.ws + WS_P), (const float*)(p.ws + WS_ROPE)};
        pg8::gemm_phase<pg8::EpiProj, pg8::SchedPlain>(lds, (const bf16_t*)(p.ws + WS_XB), (const bf16_t*)(p.ws + WS_WI), DM, S, E, wave);
    }
    GSYNC();
    conv_phase(p, wave_k);
    { IDS(); const int vcu = (G % 8 == 0) ? ((int)blockIdx.x % 8) * (G / 8) + (int)blockIdx.x / 8 : (int)blockIdx.x;
      attn_phase(p, lds, vcu * 8 + wave, NGW, wave, lane); }
    GSYNC();
    { IDS(); ssd_state_phase(p, lds, wave, lane); }
    GSYNC();
    ssd_scan_phase(p, wave_k);
    GSYNC();
    { IDS(); ssd_out_phase(p, lds, wave, lane); }
    GSYNC();
    { IDS(); gate_phase(p, gw, NGW, lane); }
    GSYNC();
    { IDS(); expert_gu_weights_phase(p, lds, gw, NGW, wave, lane); }
    __syncthreads();
    {
        IDS();
        pg8::SchedPlain S; S.init(TT, DM, G, (int)blockIdx.x);
        pg8::EpiOut E{p};
        pg8::gemm_phase<pg8::EpiOut, pg8::SchedPlain>(lds, (const bf16_t*)(p.ws + WS_MIX), (const bf16_t*)(p.ws + WS_WO), DM, S, E, wave);
    }
    GSYNC();
    { IDS(); ln1_router_phase(p, lds, gw, NGW, wave, lane); }
    GSYNC();
    { IDS(); select_phase(p, lds, wave, lane); }
    GSYNC();
    {
        IDS();
        const int* idx = (const int*)(p.ws + WS_IDX);
        pg8::SchedGrouped<22, true> S{G, (int)blockIdx.x, idx};
        pg8::EpiGU E{p.ws + WS_HID};
        pg8::gemm_phase<pg8::EpiGU, pg8::SchedGrouped<22, true>, true>(lds, (const bf16_t*)(p.ws + WS_X1B), (const bf16_t*)(p.ws + WS_WGU), DM / 2, S, E, wave);
    }
    GSYNC();
    {
        IDS();
        const int* idx = (const int*)(p.ws + WS_IDX);
        const float* gate = (const float*)(p.ws + WS_GATE);
        pg8::SchedGrouped<4, false> S{G, (int)blockIdx.x, idx};
        pg8::EpiDown E{(bf16_t*)(p.ws + WS_EO), gate};
        pg8::gemm_phase<pg8::EpiDown, pg8::SchedGrouped<4, false>, true>(lds, (const bf16_t*)(p.ws + WS_HID), (const bf16_t*)(p.ws + WS_WD), FF / 2, S, E, wave);
    }
    GSYNC();
    { IDS(); ln2_phase(p, gw, NGW, lane); }
#undef IDS
}

extern "C" void kernel_launch(void* const* d_in, const int* in_sizes, int n_in, void* d_out, int out_size, void* d_ws, size_t ws_size, hipStream_t stream) {
    static int grid_blocks = 0;
    if (grid_blocks == 0) {
        if (n_in != 18 || ws_size < WS_END || out_size != TT * DM) { fprintf(stderr, "kernel_launch: unexpected shapes (n_in %d out %d ws %zu)\n", n_in, out_size, ws_size); grid_blocks = -1; return; }
        int dev = 0, cus = 0, per_cu = 0;
        hipGetDevice(&dev);
        hipDeviceGetAttribute(&cus, hipDeviceAttributeMultiprocessorCount, dev);
        if (hipFuncSetAttribute((const void*)fwd_megakernel, hipFuncAttributeMaxDynamicSharedMemorySize, LDS_BYTES) != hipSuccess) { fprintf(stderr, "kernel_launch: hipFuncSetAttribute failed\n"); }
        hipOccupancyMaxActiveBlocksPerMultiprocessor(&per_cu, (const void*)fwd_megakernel, NTHR, LDS_BYTES);
        if (per_cu < 1) per_cu = 1;
        (void)hipGetLastError();
        grid_blocks = cus * per_cu;
    }
    if (grid_blocks < 0) return;
    Params p{};
    for (int i = 0; i < 18; ++i) p.in[i] = (const float*)d_in[i];
    p.out = (float*)d_out; p.ws = (unsigned char*)d_ws;
    if (hipMemsetAsync((char*)d_ws + WS_CTL, 0, 16384, stream) != hipSuccess) { fprintf(stderr, "kernel_launch: hipMemsetAsync failed\n"); return; }
    void* args[] = {&p};
    hipError_t e = hipLaunchCooperativeKernel((void*)fwd_megakernel, dim3(grid_blocks), dim3(NTHR), args, LDS_BYTES, stream);
    if (e != hipSuccess) fprintf(stderr, "cooperative launch failed: %s (grid %d)\n", hipGetErrorString(e), grid_blocks);
}
```

```cpp
#include <hip/hip_runtime.h>
#include <hip/hip_cooperative_groups.h>
#include <cstdio>
#include <cstdint>
namespace cg = cooperative_groups;

#define DI __device__ __forceinline__
#define LAS __attribute__((address_space(3)))
typedef unsigned short bf16_t;
typedef short bf16x8 __attribute__((ext_vector_type(8)));
typedef short s16x4 __attribute__((ext_vector_type(4)));
typedef float f32x4 __attribute__((ext_vector_type(4)));
typedef unsigned u32x4 __attribute__((ext_vector_type(4)));
typedef unsigned u32x2 __attribute__((ext_vector_type(2)));
typedef int i32x4 __attribute__((ext_vector_type(4)));
typedef int i32x8 __attribute__((ext_vector_type(8)));

constexpr int TT = 49152;
constexpr int TP = 32768;
constexpr int DM = 1024;
constexpr int INW = 3088;
constexpr int FF = 2816;
constexpr int NE = 16;
constexpr int SLOTS_E = 6144;
constexpr float ALPHA = 1.189207115002721f;
constexpr float LN_EPS = 1e-5f, RMS_EPS = 1e-5f;

constexpr size_t MiB = 1u << 20;
constexpr size_t TILE_ELEMS = (size_t)TT * 256;
constexpr size_t TILE_BYTES = TILE_ELEMS * 2;
constexpr size_t WS_WI = 0;
constexpr size_t WS_WO = 6 * MiB;
constexpr size_t WS_DT = 8 * MiB;
constexpr size_t WS_ROPE = 11 * MiB;
constexpr size_t WS_AFF = 12 * MiB;
constexpr size_t WS_IDX = 15 * MiB;
constexpr size_t WS_GATE = 15 * MiB + 512 * 1024;
constexpr size_t WS_P = 20 * MiB;
constexpr size_t WS_XC = 308 * MiB;
constexpr size_t WS_XB = 404 * MiB;
constexpr size_t WS_MIX = WS_XB;
constexpr size_t WS_YF = WS_P + 8 * TILE_BYTES;
constexpr size_t WS_YB = WS_P + 10 * TILE_BYTES;
constexpr size_t WS_INV = 16 * MiB;
constexpr size_t WS_WD = 20 * MiB;
constexpr size_t WS_H = 248 * MiB;
constexpr size_t WS_X1H = 64 * MiB;
constexpr size_t WS_WGU = 160 * MiB;
constexpr size_t WS_EO = 160 * MiB;
constexpr size_t WS_X1B = 352 * MiB;
constexpr size_t WS_HID = 404 * MiB;
constexpr size_t WS_END = 668 * MiB;

constexpr int LDS_BYTES = 147456;
constexpr int NTHR = 512;

DI unsigned f2bf(float f) { unsigned u = __float_as_uint(f); return (u + 0x7fffu + ((u >> 16) & 1u)) >> 16; }
typedef float f32x2v __attribute__((ext_vector_type(2)));
typedef __bf16 bf16x2v __attribute__((ext_vector_type(2)));
DI unsigned pk2(float lo, float hi) { const f32x2v f = {lo, hi}; return __builtin_bit_cast(unsigned, __builtin_convertvector(f, bf16x2v)); }
DI unsigned pk4_f8(float a, float b, float c, float d) { int w = 0; w = __builtin_amdgcn_cvt_pk_fp8_f32(a, b, w, false); w = __builtin_amdgcn_cvt_pk_fp8_f32(c, d, w, true); return (unsigned)w; }
DI i32x8 cat8(bf16x8 lo, bf16x8 hi) { const i32x4 a = __builtin_bit_cast(i32x4, lo), b = __builtin_bit_cast(i32x4, hi); return __builtin_shufflevector(a, b, 0, 1, 2, 3, 4, 5, 6, 7); }
constexpr float WGU_SCALE = 32.0f, WD_SCALE = 64.0f, EO_SCALE = 16.0f;
DI float bflo(unsigned u) { return __uint_as_float(u << 16); }
DI float bfhi(unsigned u) { return __uint_as_float(u & 0xffff0000u); }
DI float wave_sum(float v) {
#pragma unroll
    for (int o = 1; o < 64; o <<= 1) v += __shfl_xor(v, o);
    return v;
}
DI void st_tr8_pair(LAS bf16_t* base, int stride, int colpair, int lane, const u32x4 v) {
    const unsigned px = __shfl_xor(v.x, 1), py = __shfl_xor(v.y, 1), pz = __shfl_xor(v.z, 1), pw = __shfl_xor(v.w, 1);
    const bool odd = (lane & 1) != 0;
    const unsigned d0 = odd ? ((px >> 16) | (v.x & 0xffff0000u)) : ((v.x & 0xffffu) | (px << 16));
    const unsigned d1 = odd ? ((py >> 16) | (v.y & 0xffff0000u)) : ((v.y & 0xffffu) | (py << 16));
    const unsigned d2 = odd ? ((pz >> 16) | (v.z & 0xffff0000u)) : ((v.z & 0xffffu) | (pz << 16));
    const unsigned d3 = odd ? ((pw >> 16) | (v.w & 0xffff0000u)) : ((v.w & 0xffffu) | (pw << 16));
    LAS unsigned* wp = (LAS unsigned*)(base + (odd ? stride : 0)) + colpair;
    wp[0] = d0; wp[stride] = d1; wp[2 * stride] = d2; wp[3 * stride] = d3;
}
DI float silu_f(float x) { return x * __builtin_amdgcn_rcpf(1.0f + __expf(-x)); }
#define LDS_WAIT() asm volatile("s_waitcnt lgkmcnt(0)" ::: "memory")
#define LDS_BARRIER() do { asm volatile("s_waitcnt lgkmcnt(0)" ::: "memory"); __builtin_amdgcn_s_barrier(); asm volatile("" ::: "memory"); } while (0)

struct Params { const float* in[18]; float* out; unsigned char* ws; };
DI int lane_id() { int l = (int)__builtin_amdgcn_mbcnt_hi(~0u, __builtin_amdgcn_mbcnt_lo(~0u, 0u)); asm volatile("" : "+v"(l)); return l; }
#define TIDX(wave_) ((wave_) * 64 + lane_id())

DI const float* xrow_ptr(const Params& p, int t) { return t < TP ? p.in[0] + (size_t)t * DM : p.in[1] + (size_t)(t - TP) * DM; }

namespace pg8 {
constexpr int BM = 256, BK = 64, HALF = 128, HTB = HALF * BK * 2, NXCD = 8, WGM = 8;
DI int lds_byte(int r, int c) { const int st = (r >> 4) * 2 + (c >> 5), rr = r & 15, cc = c & 31, ob = rr * 64 + cc * 2; return st * 1024 + (ob ^ (((ob >> 9) & 1) << 5)); }
DI void stage_rc(int b, int& R, int& C) { const int st = b / 1024, sb = b % 1024, swz = sb ^ (((sb >> 9) & 1) << 5); R = (st >> 1) * 16 + swz / 64; C = (st & 1) * 32 + (swz % 64) / 2; }
DI int perm32(int rho) { const int n = rho >> 4, i = rho & 15; return 8 * (i >> 2) + 4 * n + (i & 3); }

struct Unit { int pm, pn, bt; };

DI int xcd_remap(int L, int nwg) { const int q = nwg / NXCD, r = nwg % NXCD, xcd = L % NXCD, off = L / NXCD; return (xcd < r ? xcd * (q + 1) : r * (q + 1) + (xcd - r) * q) + off; }

struct SchedPlain {
    int nM, nN, nwg, G, c;
    DI void init(int M, int N, int G_, int c_) { nM = M / BM; nN = N / BM; nwg = nM * nN; G = G_; c = c_; }
    DI bool next(int i, Unit& u) const {
        const int L = i * G + c; if (L >= nwg) return false;
        const int wgid = xcd_remap(L, nwg);
        const int nig = WGM * nN, gid = wgid / nig, fm = gid * WGM, gsz = (nM - fm) < WGM ? (nM - fm) : WGM;
        u.pm = fm + ((wgid % nig) % gsz); u.pn = (wgid % nig) / gsz; u.bt = u.pn; return true;
    }
    DI int arow(const Unit& u, int r) const { return u.pm * BM + r; }
};
template <int NPN, bool GATHER> struct SchedGrouped {
    int G, c; const int* idx;
    DI bool next(int i, Unit& u) const {
        constexpr int PER_E = 24 * NPN, NWG = NE * PER_E;
        const int L = i * G + c; if (L >= NWG) return false;
        const int wgid = xcd_remap(L, NWG);
        const int e = wgid / PER_E, rem = wgid % PER_E;
        const int gid = rem / (8 * NPN), w2 = rem % (8 * NPN);
        u.pm = e * 24 + gid * 8 + (w2 % 8); u.pn = w2 / 8; u.bt = e * NPN + u.pn; return true;
    }
    DI int arow(const Unit& u, int r) const { if (GATHER) return idx[u.pm * BM + r]; else return u.pm * BM + r; }
};

template <class Epi, class Sched, bool F8 = false>
DI void gemm_phase(LAS unsigned char* lds, const bf16_t* Ag, const bf16_t* Btg, const int K, const Sched& S, const Epi& E, const int wave_in) {
    const int tid = TIDX(wave_in), wid = wave_in, lane = tid & 63, wr = wid >> 2, wc = wid & 3, fr = lane & 15, fq = lane >> 4;
    const int nt = K / BK;
    unsigned voffB[2];
#pragma unroll
    for (int i = 0; i < 2; ++i) { int R, C; stage_rc(tid * 16 + i * 8192, R, C); const int Rb = Epi::PERM ? ((R & ~31) + perm32(R & 31)) : R;
        voffB[i] = (unsigned)(Rb * K + C) * 2u; }
    const unsigned rowbytes = (unsigned)K * 2u;
    const size_t kstep = (size_t)(BK * 2);
    const size_t hstep = (size_t)HALF * K * 2;
    const size_t tstep = 2 * hstep;
    const unsigned ldsw = (unsigned)wid * 1024u;
    const int aoff = lds_byte(wr * 64 + fr, fq * 8), boff = lds_byte(wc * 32 + fr, fq * 8);
#define PG8_SA(b, h) (((b) * 2 + (h)) * HTB)
#define PG8_SB(b, h) ((4 + (b) * 2 + (h)) * HTB)
#define PG8_STAGE(bufoff, gbase, voff) do { _Pragma("unroll") for (int _i = 0; _i < 2; ++_i) \
        __builtin_amdgcn_global_load_lds((const unsigned*)((const char*)(gbase) + (voff)[_i]), (LAS unsigned*)(lds + (bufoff) + ldsw + _i * 8192), 16, 0, 0); } while (0)
#define PG8_STAGEA(bufoff, o0, o1, kb) do { \
        __builtin_amdgcn_global_load_lds((const unsigned*)((const char*)Ag + (size_t)(o0) + (size_t)(kb)), (LAS unsigned*)(lds + (bufoff) + ldsw), 16, 0, 0); \
        __builtin_amdgcn_global_load_lds((const unsigned*)((const char*)Ag + (size_t)(o1) + (size_t)(kb)), (LAS unsigned*)(lds + (bufoff) + ldsw + 8192), 16, 0, 0); } while (0)
#define PG8_LDA(dst, b, h) do { _Pragma("unroll") for (int m = 0; m < 4; ++m) _Pragma("unroll") for (int k = 0; k < 2; ++k) dst[m][k] = *(const LAS bf16x8*)(lds + PG8_SA(b, h) + aoff + m * 2048 + k * 1024); } while (0)
#define PG8_LDB(dst, b, h) do { _Pragma("unroll") for (int n = 0; n < 2; ++n) _Pragma("unroll") for (int k = 0; k < 2; ++k) dst[n][k] = *(const LAS bf16x8*)(lds + PG8_SB(b, h) + boff + n * 2048 + k * 1024); } while (0)
#define PG8_MMA(ai, bj, At, Bt) do { __builtin_amdgcn_s_setprio(1); _Pragma("unroll") for (int m = 0; m < 4; ++m) _Pragma("unroll") for (int n = 0; n < 2; ++n) { \
        if constexpr (F8) { acc[ai][bj][m][n] = __builtin_amdgcn_mfma_scale_f32_16x16x128_f8f6f4(cat8(Bt[n][0], Bt[n][1]), cat8(At[m][0], At[m][1]), acc[ai][bj][m][n], 0, 0, 0, 0, 0, 0); } \
        else { _Pragma("unroll") for (int k = 0; k < 2; ++k) acc[ai][bj][m][n] = __builtin_amdgcn_mfma_f32_16x16x32_bf16(Bt[n][k], At[m][k], acc[ai][bj][m][n], 0, 0, 0); } } \
        __builtin_amdgcn_s_setprio(0); } while (0)
#define PG8_WAIT_V(n) asm volatile("s_waitcnt vmcnt(" #n ")" ::: "memory")
#define PG8_WAIT_L(n) asm volatile("s_waitcnt lgkmcnt(" #n ")" ::: "memory")
#define PG8_BAR __builtin_amdgcn_s_barrier()
#define PG8_SCHED __builtin_amdgcn_sched_barrier(0)
#define PG8_OFFS(u, o00, o01, o10, o11) do { int R0_, C0_, R1_, C1_; const int t2_ = TIDX(wid); stage_rc(t2_ * 16, R0_, C0_); stage_rc(t2_ * 16 + 8192, R1_, C1_); \
        o00 = (unsigned)S.arow(u, R0_) * rowbytes + (unsigned)C0_ * 2u; o01 = (unsigned)S.arow(u, R1_) * rowbytes + (unsigned)C1_ * 2u; \
        o10 = (unsigned)S.arow(u, HALF + R0_) * rowbytes + (unsigned)C0_ * 2u; o11 = (unsigned)S.arow(u, HALF + R1_) * rowbytes + (unsigned)C1_ * 2u; } while (0)
    Unit cur, nxt; int ui = 0;
    if (!S.next(0, cur)) return;
    f32x4 acc[2][2][4][2];
#pragma unroll
    for (int a = 0; a < 2; ++a)
#pragma unroll
        for (int b = 0; b < 2; ++b)
#pragma unroll
            for (int m = 0; m < 4; ++m)
#pragma unroll
                for (int n = 0; n < 2; ++n) acc[a][b][m][n] = (f32x4){0.f, 0.f, 0.f, 0.f};
    bf16x8 At[4][2], B0[2][2], B1[2][2];
    unsigned c00, c01, c10, c11;
    PG8_OFFS(cur, c00, c01, c10, c11);
    const char* cB = (const char*)Btg + (size_t)cur.bt * tstep;
    PG8_STAGE(PG8_SB(0, 0), cB, voffB); PG8_STAGE(PG8_SB(0, 1), cB + hstep, voffB); PG8_STAGEA(PG8_SA(0, 0), c00, c01, 0); PG8_STAGEA(PG8_SA(0, 1), c10, c11, 0);
    if (wr == 1) PG8_BAR;
    PG8_WAIT_V(2); PG8_BAR;
    PG8_STAGE(PG8_SB(1, 0), cB + kstep, voffB); PG8_STAGEA(PG8_SA(1, 0), c00, c01, kstep); PG8_STAGE(PG8_SB(1, 1), cB + hstep + kstep, voffB);
    PG8_WAIT_V(6); PG8_BAR;
    for (;;) {
        const bool has_next = S.next(ui + 1, nxt);
        const char* nB = has_next ? (const char*)Btg + (size_t)nxt.bt * tstep : cB;
        for (int t = 0; t < nt; t += 2) {
            const bool last = (t == nt - 2);
            const size_t kb1 = (size_t)(t + 1) * kstep;
            const size_t kb2 = last ? 0 : (size_t)(t + 2) * kstep, kb3 = kb2 + kstep;
            const char* b2 = last ? nB : cB + (size_t)(t + 2) * kstep; const char* b3 = b2 + kstep;
            PG8_LDB(B0, 0, 0); PG8_LDB(B1, 0, 1); PG8_SCHED; PG8_LDA(At, 0, 0); PG8_STAGEA(PG8_SA(1, 1), c10, c11, kb1);
            PG8_WAIT_V(8); PG8_WAIT_L(0); PG8_BAR; PG8_MMA(0, 0, At, B0); PG8_MMA(0, 1, At, B1); PG8_BAR; PG8_SCHED;
            if (last && has_next) { PG8_OFFS(nxt, c00, c01, c10, c11); }
            PG8_LDA(At, 0, 1); PG8_STAGE(PG8_SB(0, 0), b2, voffB); PG8_STAGE(PG8_SB(0, 1), b2 + hstep, voffB); PG8_STAGEA(PG8_SA(0, 0), c00, c01, kb2);
            PG8_WAIT_V(8); PG8_WAIT_L(0); PG8_BAR; PG8_MMA(1, 0, At, B0); PG8_MMA(1, 1, At, B1); PG8_BAR; PG8_SCHED;
            PG8_LDB(B0, 1, 0); PG8_LDB(B1, 1, 1); PG8_SCHED; PG8_LDA(At, 1, 0); PG8_STAGEA(PG8_SA(0, 1), c10, c11, kb2);
            PG8_WAIT_V(8); PG8_WAIT_L(0); PG8_BAR; PG8_MMA(0, 0, At, B0); PG8_MMA(0, 1, At, B1); PG8_BAR; PG8_SCHED;
            PG8_LDA(At, 1, 1); PG8_STAGE(PG8_SB(1, 0), b3, voffB); PG8_STAGE(PG8_SB(1, 1), b3 + hstep, voffB); PG8_STAGEA(PG8_SA(1, 0), c00, c01, kb3);
            PG8_WAIT_V(8); PG8_WAIT_L(0); PG8_BAR; PG8_MMA(1, 0, At, B0); PG8_MMA(1, 1, At, B1); PG8_BAR; PG8_SCHED;
        }
        if (wr == 0) PG8_BAR;
        { const int l2 = lane_id(); E(acc, cur, wr, wc, l2 & 15, l2 >> 4); }
        if (!has_next) break;
#pragma unroll
        for (int a = 0; a < 2; ++a)
#pragma unroll
            for (int b = 0; b < 2; ++b)
#pragma unroll
                for (int m = 0; m < 4; ++m)
#pragma unroll
                    for (int n = 0; n < 2; ++n) acc[a][b][m][n] = (f32x4){0.f, 0.f, 0.f, 0.f};
        cur = nxt; cB = nB; ++ui;
        if (wr == 1) PG8_BAR;
    }
    PG8_WAIT_V(0);
    PG8_BAR;
#undef PG8_SA
#undef PG8_SB
#undef PG8_STAGE
#undef PG8_STAGEA
#undef PG8_LDA
#undef PG8_LDB
#undef PG8_MMA
#undef PG8_WAIT_V
#undef PG8_WAIT_L
#undef PG8_BAR
#undef PG8_SCHED
#undef PG8_OFFS
}

struct EpiProj {
    static constexpr bool PERM = true;
    bf16_t* P; const float* rope;
    DI void operator()(const f32x4 (&acc)[2][2][4][2], const Unit& u, int wr, int wc, int fr, int fq) const {
        bf16_t* base = P + (size_t)u.pn * TILE_ELEMS;
        const bool rot = (u.pn < 4) && ((wc & 1) == 0);
#pragma unroll
        for (int ai = 0; ai < 2; ++ai)
#pragma unroll
            for (int m = 0; m < 4; ++m) {
                const int row = u.pm * BM + ai * HALF + wr * 64 + m * 16 + fr;
                asm volatile("" ::: "memory");
                f32x4 cs0 = {1.f, 1.f, 1.f, 1.f}, cs1 = cs0, sn0 = {0.f, 0.f, 0.f, 0.f}, sn1 = sn0;
                if (rot && fq < 2) {
                    const int s = row < TP ? (row & 4095) : (row & 8191);
                    const f32x4* rp = (const f32x4*)(rope + (size_t)s * 16);
                    cs0 = rp[0]; cs1 = rp[1]; sn0 = rp[2]; sn1 = rp[3];
                    if (fq == 0) { sn0 = -sn0; sn1 = -sn1; }
                }
#pragma unroll
                for (int bj = 0; bj < 2; ++bj) {
                    f32x4 v0 = acc[ai][bj][m][0], v1 = acc[ai][bj][m][1];
                    if (rot) {
                        f32x4 o0, o1;
#pragma unroll
                        for (int j = 0; j < 4; ++j) { o0[j] = __shfl_xor(v0[j], 16); o1[j] = __shfl_xor(v1[j], 16); }
                        if (fq < 2) { v0 = v0 * cs0 + o0 * sn0; v1 = v1 * cs1 + o1 * sn1; }
                    }
                    u32x4 w; w.x = pk2(v0[0], v0[1]); w.y = pk2(v0[2], v0[3]); w.z = pk2(v1[0], v1[1]); w.w = pk2(v1[2], v1[3]);
                    *(u32x4*)(base + (size_t)row * 256 + bj * HALF + wc * 32 + 8 * fq) = w;
                }
            }
    }
};
struct EpiOut {
    static constexpr bool PERM = false;
    Params p;
    DI void operator()(const f32x4 (&acc)[2][2][4][2], const Unit& u, int wr, int wc, int fr, int fq) const {
#pragma unroll
        for (int ai = 0; ai < 2; ++ai)
#pragma unroll
            for (int m = 0; m < 4; ++m) {
                const int row = u.pm * BM + ai * HALF + wr * 64 + m * 16 + fr;
                const float* xr = xrow_ptr(p, row); bf16_t* orow = (bf16_t*)(p.ws + WS_H) + (size_t)row * DM;
#pragma unroll
                for (int bj = 0; bj < 2; ++bj)
#pragma unroll
                    for (int n = 0; n < 2; ++n) {
                        const int col = u.pn * BM + bj * HALF + wc * 32 + 16 * n + 4 * fq;
                        const f32x4 xv = *(const f32x4*)(xr + col);
                        const f32x4 hv = xv * ALPHA + acc[ai][bj][m][n];
                        u32x2 w; w.x = pk2(hv[0], hv[1]); w.y = pk2(hv[2], hv[3]); *(u32x2*)(orow + col) = w;
                    }
            }
    }
};
struct EpiGU {
    static constexpr bool PERM = true;
    unsigned char* H;
    DI void operator()(const f32x4 (&acc)[2][2][4][2], const Unit& u, int wr, int wc, int fr, int fq) const {
#pragma unroll
        for (int ai = 0; ai < 2; ++ai)
#pragma unroll
            for (int m = 0; m < 4; ++m) {
                const int row = u.pm * BM + ai * HALF + wr * 64 + m * 16 + fr;
                const f32x4 g0 = acc[ai][0][m][0], g1 = acc[ai][0][m][1], u0 = acc[ai][1][m][0], u1 = acc[ai][1][m][1];
                f32x4 h0, h1;
#pragma unroll
                for (int j = 0; j < 4; ++j) { h0[j] = silu_f(g0[j] * (1.0f / WGU_SCALE)) * (u0[j] * (1.0f / WGU_SCALE)); h1[j] = silu_f(g1[j] * (1.0f / WGU_SCALE)) * (u1[j] * (1.0f / WGU_SCALE)); }
                u32x2 w; w.x = pk4_f8(h0[0], h0[1], h0[2], h0[3]); w.y = pk4_f8(h1[0], h1[1], h1[2], h1[3]);
                *(u32x2*)(H + (size_t)row * FF + u.pn * 128 + wc * 32 + 8 * fq) = w;
            }
    }
};
struct EpiDown {
    static constexpr bool PERM = true;
    unsigned char* eo; const float* gate;
    DI void operator()(const f32x4 (&acc)[2][2][4][2], const Unit& u, int wr, int wc, int fr, int fq) const {
#pragma unroll
        for (int ai = 0; ai < 2; ++ai)
#pragma unroll
            for (int m = 0; m < 4; ++m) {
                const int slot = u.pm * BM + ai * HALF + wr * 64 + m * 16 + fr;
                const float gv = gate[slot] * (EO_SCALE / WD_SCALE);
                unsigned char* orow = eo + (size_t)slot * DM + u.pn * BM + wc * 32 + 8 * fq;
#pragma unroll
                for (int bj = 0; bj < 2; ++bj) {
                    const f32x4 v0 = acc[ai][bj][m][0] * gv, v1 = acc[ai][bj][m][1] * gv;
                    u32x2 w; w.x = pk4_f8(v0[0], v0[1], v0[2], v0[3]); w.y = pk4_f8(v1[0], v1[1], v1[2], v1[3]);
                    *(u32x2*)(orow + bj * HALF) = w;
                }
            }
    }
};
}

DI void transpose_item(const float* W, int ldw, int k0, int n0, bf16_t* WT, int ldt, int drow0, LAS float* scr, int lane) {
#pragma unroll 8
    for (int i = 0; i < 32; ++i) { const int kk = 2 * i + (lane >> 5); scr[kk * 33 + (lane & 31)] = W[(size_t)(k0 + kk) * ldw + n0 + (lane & 31)]; }
    LDS_WAIT();
    const int c = lane & 7;
#pragma unroll
    for (int j = 0; j < 4; ++j) { const int n = (lane >> 3) + 8 * j; const LAS float* s = scr + (8 * c) * 33 + n;
        u32x4 o; o.x = pk2(s[0 * 33], s[1 * 33]); o.y = pk2(s[2 * 33], s[3 * 33]); o.z = pk2(s[4 * 33], s[5 * 33]); o.w = pk2(s[6 * 33], s[7 * 33]);
        *(u32x4*)(WT + (size_t)(drow0 + n) * ldt + k0 + 8 * c) = o; }
    LDS_WAIT();
}

DI void transpose_item_f8(const float* W, int ldw, int k0, int n0, unsigned char* WT, int ldt, int drow0, float scale, LAS float* scr, int lane) {
#pragma unroll 8
    for (int i = 0; i < 32; ++i) { const int kk = 2 * i + (lane >> 5); scr[kk * 33 + (lane & 31)] = W[(size_t)(k0 + kk) * ldw + n0 + (lane & 31)] * scale; }
    LDS_WAIT();
    const int c = lane & 7;
#pragma unroll
    for (int j = 0; j < 4; ++j) { const int n = (lane >> 3) + 8 * j; const LAS float* sp = scr + (8 * c) * 33 + n;
        u32x2 o; o.x = pk4_f8(sp[0 * 33], sp[1 * 33], sp[2 * 33], sp[3 * 33]); o.y = pk4_f8(sp[4 * 33], sp[5 * 33], sp[6 * 33], sp[7 * 33]);
        *(u32x2*)(WT + (size_t)(drow0 + n) * ldt + k0 + 8 * c) = o; }
    LDS_WAIT();
}

DI void sincos_small(double r, double& s, double& c) {
    const double r2 = r * r; double ss = 1.0, cc = 1.0;
#pragma unroll
    for (int n = 12; n >= 1; --n) { ss = 1.0 - ss * r2 * (1.0 / (double)((2 * n) * (2 * n + 1))); cc = 1.0 - cc * r2 * (1.0 / (double)((2 * n - 1) * (2 * n))); }
    s = r * ss; c = cc;
}

DI void dot16(const f32x4 (&v)[4], const LAS float* wT, int lane, float (&r)[16]) {
#pragma unroll
    for (int e = 0; e < 16; ++e) {
        float a = 0.f;
        if ((e & 1) == 0) asm volatile("" ::: "memory");
#pragma unroll
        for (int j = 0; j < 4; ++j) { const f32x4 w = *(const LAS f32x4*)(wT + e * 1024 + 256 * j + 4 * lane); a += v[j][0] * w[0] + v[j][1] * w[1] + v[j][2] * w[2] + v[j][3] * w[3]; }
        r[e] = wave_sum(a);
    }
}

DI int ecol(int lane) { return ((lane & 1) << 3) | ((lane & 2) << 1) | ((lane & 4) >> 1) | ((lane & 8) >> 3); }
DI float treduce16(float (&a)[16], int lane) {
#pragma unroll
    for (int k = 0; k < 4; ++k) {
        const int n2 = 8 >> k; const bool bit = (lane >> k) & 1;
#pragma unroll
        for (int i = 0; i < 8; ++i) if (i < n2) { const float lo = a[i], hi = a[i + n2]; const float send = bit ? lo : hi, keep = bit ? hi : lo; a[i] = keep + __shfl_xor(send, 1 << k); }
    }
    float r = a[0]; r += __shfl_xor(r, 16); r += __shfl_xor(r, 32);
    return r;
}
DI void dot16x2(const f32x4 (&va)[4], const f32x4 (&vb)[4], const LAS float* wT, int lane, float& ra, float& rb) {
    float a[16], b[16];
#pragma unroll
    for (int e = 0; e < 16; ++e) {
        float x = 0.f, y = 0.f;
        asm volatile("" ::: "memory");
#pragma unroll
        for (int j = 0; j < 4; ++j) { const f32x4 w = *(const LAS f32x4*)(wT + e * 1024 + 256 * j + 4 * lane);
            x += va[j][0] * w[0] + va[j][1] * w[1] + va[j][2] * w[2] + va[j][3] * w[3]; y += vb[j][0] * w[0] + vb[j][1] * w[1] + vb[j][2] * w[2] + vb[j][3] * w[3]; }
        a[e] = x; b[e] = y;
    }
    ra = treduce16(a, lane); rb = treduce16(b, lane);
}

DI void phase0(const Params& p, LAS unsigned char* lds, int gw, int NGW, int wave, int lane) {
    const int tid = TIDX(wave);
    {
        LAS float* scr = (LAS float*)(lds + wave * 16384);
        for (int it = gw; it < 2048; it += NGW) {
            if (it < 1536) { const int kb = it / 96, nb = it % 96; transpose_item(p.in[2], INW, 64 * kb, 32 * nb, (bf16_t*)(p.ws + WS_WI), DM, 32 * nb, scr, lane); }
            else { const int r = it - 1536, kb = r / 32, nb = r % 32; transpose_item(p.in[9], DM, 64 * kb, 32 * nb, (bf16_t*)(p.ws + WS_WO), DM, 32 * nb, scr, lane); }
        }
    }
    {
        float* rope = (float*)(p.ws + WS_ROPE);
        const float invf[8] = {1.0f, 0.1939227432012558f, 0.03760603070259094f, 0.007292664609849453f, 0.0014142135623842478f, 0.00027424818836152554f, 5.318296098266728e-05f, 1.0313386155758053e-05f};
        for (int id = blockIdx.x * NTHR + tid; id < 8192 * 8; id += gridDim.x * NTHR) {
            const int pos = id >> 3, i = id & 7;
            float inv = invf[0];
#pragma unroll
            for (int k = 1; k < 8; ++k) inv = (i == k) ? invf[k] : inv;
            const float ang = (float)pos * inv;
            const double x = (double)ang; const double kq = rint(x * 0.15915494309189535); const double r = x - kq * 6.283185307179586476925;
            double s, c; sincos_small(r, s, c);
            rope[pos * 16 + i] = (float)c; rope[pos * 16 + 8 + i] = (float)s;
        }
    }
    __syncthreads();
    LAS float* wT = (LAS float*)lds;
    for (int id = tid; id < 16384; id += NTHR) { const int k = id >> 4, e = id & 15; wT[e * 1024 + k] = p.in[2][(size_t)k * INW + 3072 + e]; }
    __syncthreads();
    const float* dtb = p.in[5];
    const int ec = ecol(lane);
    const float bias = dtb[ec];
    bf16_t* xb = (bf16_t*)(p.ws + WS_XB); float* dtout = (float*)(p.ws + WS_DT);
#pragma unroll 2
    for (int t = gw; t < TT; t += 2 * NGW) {
        const int t2 = (t + NGW < TT) ? t + NGW : t;
        const f32x4* xra = (const f32x4*)xrow_ptr(p, t) + lane; const f32x4* xrb = (const f32x4*)xrow_ptr(p, t2) + lane;
        f32x4 va[4], vb[4];
#pragma unroll
        for (int j = 0; j < 4; ++j) { va[j] = xra[64 * j]; vb[j] = xrb[64 * j]; }
        u32x2* oa = (u32x2*)(xb + (size_t)t * DM) + lane; u32x2* ob = (u32x2*)(xb + (size_t)t2 * DM) + lane;
#pragma unroll
        for (int j = 0; j < 4; ++j) { u32x2 w; w.x = pk2(va[j][0], va[j][1]); w.y = pk2(va[j][2], va[j][3]); oa[64 * j] = w; w.x = pk2(vb[j][0], vb[j][1]); w.y = pk2(vb[j][2], vb[j][3]); ob[64 * j] = w; }
        float ra, rb; dot16x2(va, vb, wT, lane, ra, rb);
        if (lane < 16) { const float za = ra + bias, zb = rb + bias;
            dtout[(size_t)t * 16 + ec] = fmaxf(za, 0.f) + log1pf(__expf(-fabsf(za))); dtout[(size_t)t2 * 16 + ec] = fmaxf(zb, 0.f) + log1pf(__expf(-fabsf(zb))); }
    }
}

DI void conv_phase(const Params& p, int wave) {
    const int tid = blockIdx.x * NTHR + TIDX(wave), nthr = gridDim.x * NTHR;
    const int c = tid & 127, ch = 8 * c, tile = ch >> 8, cit = ch & 255;
    const float* cw = p.in[3]; const float* cb = p.in[4];
    float w[5][8], b[8];
#pragma unroll
    for (int j = 0; j < 5; ++j)
#pragma unroll
        for (int e = 0; e < 8; ++e) w[j][e] = cw[j * 1024 + ch + e];
#pragma unroll
    for (int e = 0; e < 8; ++e) b[e] = cb[ch + e];
    const bf16_t* src = (const bf16_t*)(p.ws + WS_P) + (size_t)(8 + tile) * TILE_ELEMS + cit;
    bf16_t* dst = (bf16_t*)(p.ws + WS_XC) + (size_t)tile * TILE_ELEMS + cit;
    const int seg = tid >> 7, nseg = nthr >> 7, L = (TT + nseg - 1) / nseg;
    const int t0 = seg * L, t1 = (t0 + L < TT) ? t0 + L : TT;
    if (t0 >= t1) return;
#define CONV_ROW(tt) (((tt) >= 0 && (tt) < TT) ? *(const u32x4*)(src + (size_t)(tt) * 256) : (u32x4){0u, 0u, 0u, 0u})
    u32x4 r0 = CONV_ROW(t0 - 2), r1 = CONV_ROW(t0 - 1), r2 = CONV_ROW(t0), r3 = CONV_ROW(t0 + 1), r4 = CONV_ROW(t0 + 2);
#pragma unroll 8
    for (int t = t0; t < t1; ++t) {
        const u32x4 rn = CONV_ROW(t + 3);
        const int S = t < TP ? 4096 : 8192, s = t & (S - 1);
        float a[8];
#pragma unroll
        for (int e = 0; e < 8; ++e) a[e] = b[e];
        const u32x4 rows[5] = {r0, r1, r2, r3, r4};
#pragma unroll
        for (int j = 0; j < 5; ++j) {
            const int sj = s + j - 2;
            if (sj >= 0 && sj < S) {
                const u32x4 v = rows[j];
                a[0] += bflo(v.x) * w[j][0]; a[1] += bfhi(v.x) * w[j][1]; a[2] += bflo(v.y) * w[j][2]; a[3] += bfhi(v.y) * w[j][3];
                a[4] += bflo(v.z) * w[j][4]; a[5] += bfhi(v.z) * w[j][5]; a[6] += bflo(v.w) * w[j][6]; a[7] += bfhi(v.w) * w[j][7];
            }
        }
        u32x4 o; o.x = pk2(silu_f(a[0]), silu_f(a[1])); o.y = pk2(silu_f(a[2]), silu_f(a[3])); o.z = pk2(silu_f(a[4]), silu_f(a[5])); o.w = pk2(silu_f(a[6]), silu_f(a[7]));
        *(u32x4*)(dst + (size_t)t * 256) = o;
        r0 = r1; r1 = r2; r2 = r3; r3 = r4; r4 = rn;
    }
#undef CONV_ROW
}

DI bf16x8 tr_pair(const LAS bf16_t* lo, const LAS bf16_t* hi) {
    const s16x4 a = __builtin_amdgcn_ds_read_tr16_b64_v4i16((LAS s16x4*)lo), b = __builtin_amdgcn_ds_read_tr16_b64_v4i16((LAS s16x4*)hi);
    return __builtin_shufflevector(a, b, 0, 1, 2, 3, 4, 5, 6, 7);
}
DI void attn_step_params(int sidx, int p0, int& d, int& base, int& nk, int& kbase, bool& actA, bool& actB) {
    const int pi = sidx < 12 ? 0 : (sidx < 18 ? 1 : 2);
    const int st = sidx - (pi == 0 ? 0 : (pi == 1 ? 12 : (sidx < 23 ? 18 : 23)));
    d = 1 << (2 * pi); base = p0 - 64 * d + (sidx >= 23 ? 8 : 0); nk = pi == 0 ? 377 : (pi == 1 ? 191 : 144); kbase = 32 * st;
    actA = sidx < 23; actB = sidx < 18 || sidx >= 23;
}
DI void attn_phase(const Params& p, LAS unsigned char* lds, int gw, int NGW, int wave, int lane) {
    LAS bf16_t* Vn0 = (LAS bf16_t*)(lds + wave * 9216);
    const bf16_t* Pb = (const bf16_t*)(p.ws + WS_P);
    bf16_t* mix = (bf16_t*)(p.ws + WS_MIX);
    const int c = lane & 15, q = lane >> 4, qp = (lane & 15) >> 2, pp = lane & 3;
    for (int wi = gw; wi < 12288; wi += NGW) {
        const int head = wi & 7, qg = wi >> 3;
        const int t0 = (qg >> 3) * 256 + (qg & 7);
        const int S = t0 < TP ? 4096 : 8192, sbase = t0 & ~(S - 1), p0 = t0 - sbase;
        const int hoff = (head & 3) * 64;
        const bf16_t* Qt = Pb + (size_t)(0 + (head >> 2)) * TILE_ELEMS + hoff;
        const bf16_t* Kt = Pb + (size_t)(2 + (head >> 2)) * TILE_ELEMS + hoff;
        const bf16_t* Vg = Pb + (size_t)(4 + (head >> 2)) * TILE_ELEMS + hoff;
        bf16x8 qf[2][2];
#pragma unroll
        for (int X = 0; X < 2; ++X) { const bf16_t* qrow = Qt + (size_t)(t0 + 8 * X + 16 * c) * 256;
#pragma unroll
            for (int ks = 0; ks < 2; ++ks) {
                const u32x4 w = *(const u32x4*)(qrow + 32 * ks + 8 * q); constexpr float QS = 0.125f * 1.4426950408889634f;
                u32x4 o; o.x = pk2(bflo(w.x) * QS, bfhi(w.x) * QS); o.y = pk2(bflo(w.y) * QS, bfhi(w.y) * QS); o.z = pk2(bflo(w.z) * QS, bfhi(w.z) * QS); o.w = pk2(bflo(w.w) * QS, bfhi(w.w) * QS);
                qf[X][ks] = __builtin_bit_cast(bf16x8, o); } }
        f32x4 O[2][4];
#pragma unroll
        for (int X = 0; X < 2; ++X)
#pragma unroll
            for (int d4 = 0; d4 < 4; ++d4) O[X][d4] = (f32x4){0.f, 0.f, 0.f, 0.f};
        float mrun[2] = {-1e30f, -1e30f}, lsum[2] = {0.f, 0.f};
        u32x4 vb[3][4]; bf16x8 kb[3][2][2];
#define ATT_LOADS(sidx_, V_, K_) do { int d_, base_, nk_, kbase_; bool a_, b_; attn_step_params(sidx_, p0, d_, base_, nk_, kbase_, a_, b_); \
            _Pragma("unroll") for (int i = 0; i < 4; ++i) { const int id = lane + 64 * i, key = id >> 3, dc = id & 7; \
                int pos = base_ + d_ * (kbase_ + key); pos = pos < 0 ? 0 : (pos > S - 1 ? S - 1 : pos); \
                V_[i] = *(const u32x4*)(Vg + (size_t)(sbase + pos) * 256 + 8 * dc); } \
            _Pragma("unroll") for (int kt = 0; kt < 2; ++kt) { int pos = base_ + d_ * (kbase_ + 16 * kt + c); pos = pos < 0 ? 0 : (pos > S - 1 ? S - 1 : pos); \
                const bf16_t* krow = Kt + (size_t)(sbase + pos) * 256; K_[kt][0] = *(const bf16x8*)(krow + 8 * q); K_[kt][1] = *(const bf16x8*)(krow + 32 + 8 * q); } } while (0)
        ATT_LOADS(0, vb[0], kb[0]);
        ATT_LOADS(1, vb[1], kb[1]);
#pragma unroll
        for (int i = 0; i < 4; ++i) { const int id = lane + 64 * i; *(LAS u32x4*)(Vn0 + (id >> 3) * 72 + 8 * (id & 7)) = vb[0][i]; }
#pragma unroll
        for (int s3 = 0; s3 < 30; s3 += 3) {
#pragma unroll
          for (int u = 0; u < 3; ++u) {
            const int sidx = s3 + u;
            if (sidx + 2 < 28) ATT_LOADS(sidx + 2, vb[(u + 2) % 3], kb[(u + 2) % 3]);
            if (sidx < 28) {
            int d, base, nk, kbase; bool act[2]; attn_step_params(sidx, p0, d, base, nk, kbase, act[0], act[1]);
            const int win = 64 * d;
            bf16x8 vf[4];
            { const LAS bf16_t* Vn = Vn0 + (sidx & 1) * 2304;
#pragma unroll
              for (int d4 = 0; d4 < 4; ++d4) { const LAS bf16_t* vr = Vn + (4 * q + qp) * 72 + 16 * d4 + 4 * pp; vf[d4] = tr_pair(vr, vr + 16 * 72); } }
            if (sidx + 1 < 28) { LAS bf16_t* Vw = Vn0 + ((sidx + 1) & 1) * 2304;
#pragma unroll
              for (int i = 0; i < 4; ++i) { const int id = lane + 64 * i; *(LAS u32x4*)(Vw + (id >> 3) * 72 + 8 * (id & 7)) = vb[(u + 1) % 3][i]; } }
            f32x4 sc[2][2];
#pragma unroll
            for (int X = 0; X < 2; ++X)
#pragma unroll
                for (int kt = 0; kt < 2; ++kt) {
                    f32x4 a = {0.f, 0.f, 0.f, 0.f};
                    a = __builtin_amdgcn_mfma_f32_16x16x32_bf16(kb[u][kt][0], qf[X][0], a, 0, 0, 0);
                    a = __builtin_amdgcn_mfma_f32_16x16x32_bf16(kb[u][kt][1], qf[X][1], a, 0, 0, 0);
                    sc[X][kt] = a;
                }
            const int sh = d == 1 ? 0 : (d == 4 ? 2 : 4);
            int rr[2]; unsigned rng[2];
#pragma unroll
            for (int X = 0; X < 2; ++X) {
                const int pq = p0 + 8 * X + 16 * c;
                const int nb = base < 0 ? -base : 0;
                int klo = (pq - win - base) >> sh; const int k2 = (nb + d - 1) >> sh; klo = klo > k2 ? klo : k2;
                int khi = (pq + win - base) >> sh; const int k3 = (S - 1 - base) >> sh; khi = khi < k3 ? khi : k3; khi = khi < nk - 1 ? khi : nk - 1;
                if (!act[X]) { klo = 1 << 20; khi = klo; }
                rr[X] = kbase + 4 * q - klo; rng[X] = (unsigned)(khi - klo);
            }
            bool valid[2][2][4]; float mloc[2];
#pragma unroll
            for (int X = 0; X < 2; ++X) {
                float m = -1e30f;
#pragma unroll
                for (int kt = 0; kt < 2; ++kt)
#pragma unroll
                    for (int j = 0; j < 4; ++j) {
                        valid[X][kt][j] = (unsigned)(rr[X] + 16 * kt + j) <= rng[X];
                        const float sv = valid[X][kt][j] ? sc[X][kt][j] : -1e30f;
                        sc[X][kt][j] = sv; m = fmaxf(m, sv);
                    }
                mloc[X] = m;
            }
#pragma unroll
            for (int X = 0; X < 2; ++X) {
                const u32x2 r = __builtin_amdgcn_permlane32_swap(__float_as_uint(mloc[X]), __float_as_uint(mloc[X]), false, false);
                mloc[X] = fmaxf(fmaxf(mloc[X], __uint_as_float(r[0])), __uint_as_float(r[1]));
            }
#pragma unroll
            for (int X = 0; X < 2; ++X) {
                const u32x2 r = __builtin_amdgcn_permlane16_swap(__float_as_uint(mloc[X]), __float_as_uint(mloc[X]), false, false);
                mloc[X] = fmaxf(fmaxf(mloc[X], __uint_as_float(r[0])), __uint_as_float(r[1]));
            }
            float alpha[2]; bf16x8 pf[2];
#pragma unroll
            for (int X = 0; X < 2; ++X) {
                const float mnew = fmaxf(mrun[X], mloc[X]); alpha[X] = __builtin_amdgcn_exp2f(mrun[X] - mnew); mrun[X] = mnew;
                float ps = 0.f; float pv[2][4];
#pragma unroll
                for (int kt = 0; kt < 2; ++kt)
#pragma unroll
                    for (int j = 0; j < 4; ++j) { pv[kt][j] = valid[X][kt][j] ? __builtin_amdgcn_exp2f(sc[X][kt][j] - mnew) : 0.f; ps += pv[kt][j]; }
                lsum[X] = lsum[X] * alpha[X] + ps;
                u32x4 pw; pw.x = pk2(pv[0][0], pv[0][1]); pw.y = pk2(pv[0][2], pv[0][3]); pw.z = pk2(pv[1][0], pv[1][1]); pw.w = pk2(pv[1][2], pv[1][3]);
                pf[X] = __builtin_bit_cast(bf16x8, pw);
            }
#pragma unroll
            for (int d4 = 0; d4 < 4; ++d4)
#pragma unroll
                for (int X = 0; X < 2; ++X) O[X][d4] = __builtin_amdgcn_mfma_f32_16x16x32_bf16(vf[d4], pf[X], O[X][d4] * alpha[X], 0, 0, 0);
            }
          }
        }
#undef ATT_LOADS
#pragma unroll
        for (int X = 0; X < 2; ++X) {
            float l = lsum[X]; l += __shfl_xor(l, 16); l += __shfl_xor(l, 32);
            const float inv = 1.0f / l;
            bf16_t* orow = mix + (size_t)(t0 + 8 * X + 16 * c) * DM + head * 64 + 4 * q;
#pragma unroll
            for (int d4 = 0; d4 < 4; ++d4) { u32x2 w; w.x = pk2(O[X][d4][0] * inv, O[X][d4][1] * inv); w.y = pk2(O[X][d4][2] * inv, O[X][d4][3] * inv); *(u32x2*)(orow + 16 * d4) = w; }
        }
    }
}

constexpr size_t WS_SLOC = WS_P;
constexpr size_t WS_DEC = WS_P + 96 * MiB;
constexpr int N_SSD_ITEMS = 6144;
constexpr int N_SSD_UNITS = 3072;
struct SsdUnit { int h, g, tok0, itf, itb; float Af, Ab; };
DI SsdUnit ssd_decode(const Params& p, int u) {
    SsdUnit I; const int cg = u >> 3; I.h = u & 7; I.g = I.h >> 2; I.tok0 = cg * 128;
    int seq, cn, nc; if (cg < 256) { seq = cg >> 5; cn = cg & 31; nc = 32; } else { seq = 8 + ((cg - 256) >> 6); cn = (cg - 256) & 63; nc = 64; }
    const int wf = seq * 16 + I.h * 2, wb = wf + 1;
    I.itf = (wf < 128 ? 32 * wf : 4096 + 64 * (wf - 128)) + cn;
    I.itb = (wb < 128 ? 32 * wb : 4096 + 64 * (wb - 128)) + (nc - 1 - cn);
    I.Af = -__expf(p.in[6][I.h]); I.Ab = -__expf(p.in[6][8 + I.h]);
    return I;
}
DI void ssd_scan_chunk2(float f0, float f1, float b0, float b1, float Af, float Ab, LAS float* acsf, LAS float* acsb, LAS float* dtsf, LAS float* dtsb, int lane) {
    const float v0 = f0 * Af, v1 = f1 * Af; float ps = v0 + v1;
    const float w0 = b0 * Ab, w1 = b1 * Ab; float qs = w0 + w1;
#pragma unroll
    for (int o = 1; o < 64; o <<= 1) { const float t = __shfl_up(ps, o); const float t2 = __shfl_down(qs, o); if (lane >= o) ps += t; if (lane + o < 64) qs += t2; }
    acsf[2 * lane] = ps - v1; acsf[2 * lane + 1] = ps; acsb[2 * lane] = qs; acsb[2 * lane + 1] = qs - w0;
    dtsf[2 * lane] = f0; dtsf[2 * lane + 1] = f1; dtsb[2 * lane] = b0; dtsb[2 * lane + 1] = b1;
}
DI u32x4 scale8(const u32x4 v, float sc) { u32x4 o; o.x = pk2(bflo(v.x) * sc, bfhi(v.x) * sc); o.y = pk2(bflo(v.y) * sc, bfhi(v.y) * sc); o.z = pk2(bflo(v.z) * sc, bfhi(v.z) * sc); o.w = pk2(bflo(v.w) * sc, bfhi(v.w) * sc); return o; }
DI void ssd_state_phase(const Params& p, LAS unsigned char* lds, int wave, int lane) {
    const int tid = TIDX(wave), c = lane & 15, q = lane >> 4, w = wave, qp = (lane & 15) >> 2, pp = lane & 3;
    LAS float* acsf = (LAS float*)(lds + 0); LAS float* acsb = (LAS float*)(lds + 512); LAS float* dtsf = (LAS float*)(lds + 1024); LAS float* dtsb = (LAS float*)(lds + 1536);
    LAS bf16_t* Xf = (LAS bf16_t*)(lds + 2048); LAS bf16_t* Xb = (LAS bf16_t*)(lds + 2048 + 18432); LAS bf16_t* Bn = (LAS bf16_t*)(lds + 2048 + 2 * 18432);
    const float* dtb = (const float*)(p.ws + WS_DT);
    const bf16_t* XCb = (const bf16_t*)(p.ws + WS_XC);
    bf16_t* Sl = (bf16_t*)(p.ws + WS_SLOC); float* decv = (float*)(p.ws + WS_DEC);
    const int vcu0 = (gridDim.x % 8 == 0) ? ((int)blockIdx.x % 8) * ((int)gridDim.x / 8) + (int)blockIdx.x / 8 : (int)blockIdx.x;
#define SSD_UNIT_OFA(s_) ([&]{ const int cgi_ = vcu0 + (int)gridDim.x * ((s_) >> 2); return cgi_ < 768 ? ((cgi_ >> 1) * 8 + (cgi_ & 1) * 4 + ((s_) & 3)) : -1; }())
    int st_ = 0;
    int it = SSD_UNIT_OFA(0);
    if (it < 0) return;
    SsdUnit I = ssd_decode(p, it);
    float pf0 = 0.f, pf1 = 0.f, pb0 = 0.f, pb1 = 0.f; u32x4 xv[2], bv[4];
    bf16x8 bfr[4];
#define SSD_LOADS_A(I, fresh_) do { \
        if (w == 0) { const float* d_ = dtb + (size_t)((I).tok0 + 2 * lane) * 16 + (I).h; pf0 = d_[0]; pb0 = d_[8]; pf1 = d_[16]; pb1 = d_[24]; } \
        _Pragma("unroll") for (int i = 0; i < 2; ++i) { const int id = tid + NTHR * i, l = id >> 3, pc = id & 7; \
            xv[i] = *(const u32x4*)(XCb + (size_t)((I).h >> 2) * TILE_ELEMS + (size_t)((I).tok0 + l) * 256 + ((I).h & 3) * 64 + 8 * pc); } \
        if (fresh_) { _Pragma("unroll") for (int i = 0; i < 4; ++i) { const int id = tid + NTHR * i, l = id >> 4, ncn = id & 15; \
            bv[i] = *(const u32x4*)(XCb + 2 * TILE_ELEMS + (size_t)((I).tok0 + l) * 256 + (I).g * 128 + 8 * ncn); } } } while (0)
    SSD_LOADS_A(I, true);
    for (; it >= 0; ) {
        const bool fresh = (st_ & 3) == 0;
        if (w == 0) ssd_scan_chunk2(pf0, pf1, pb0, pb1, I.Af, I.Ab, acsf, acsb, dtsf, dtsb, lane);
        LDS_BARRIER();
        const float aendf = acsf[127], aendb = acsb[0];
#pragma unroll
        for (int i = 0; i < 2; ++i) {
            const int id = tid + NTHR * i, l = id >> 3, pc = id & 7;
            *(LAS u32x4*)(Xf + l * 72 + 8 * pc) = scale8(xv[i], dtsf[l] * __expf(aendf - acsf[l]));
            *(LAS u32x4*)(Xb + l * 72 + 8 * pc) = scale8(xv[i], dtsb[l] * __expf(aendb - acsb[l]));
        }
        if (fresh) {
#pragma unroll
            for (int i = 0; i < 4; ++i) { const int id = tid + NTHR * i; *(LAS u32x4*)(Bn + (id >> 4) * 136 + 8 * (id & 15)) = bv[i]; }
        }
        const int itf = I.itf, itb = I.itb;
        ++st_;
        it = SSD_UNIT_OFA(st_);
        if (it >= 0) { I = ssd_decode(p, it); SSD_LOADS_A(I, (st_ & 3) == 0); }
        LDS_BARRIER();
        if (fresh) {
#pragma unroll
            for (int ks = 0; ks < 4; ++ks) { const LAS bf16_t* br = Bn + (32 * ks + 8 * q + qp) * 136 + 16 * w + 4 * pp; bfr[ks] = tr_pair(br, br + 4 * 136); }
        }
        bf16_t* sof = Sl + (size_t)itf * 8192 + 16 * w + 4 * q; bf16_t* sob = Sl + (size_t)itb * 8192 + 16 * w + 4 * q;
#pragma unroll
        for (int pt = 0; pt < 4; ++pt) {
            f32x4 af = {0.f, 0.f, 0.f, 0.f}, ab = {0.f, 0.f, 0.f, 0.f};
#pragma unroll
            for (int ks = 0; ks < 4; ++ks) {
                const LAS bf16_t* xrf = Xf + (32 * ks + 8 * q + qp) * 72 + 16 * pt + 4 * pp;
                const LAS bf16_t* xrb = Xb + (32 * ks + 8 * q + qp) * 72 + 16 * pt + 4 * pp;
                af = __builtin_amdgcn_mfma_f32_16x16x32_bf16(bfr[ks], tr_pair(xrf, xrf + 4 * 72), af, 0, 0, 0);
                ab = __builtin_amdgcn_mfma_f32_16x16x32_bf16(bfr[ks], tr_pair(xrb, xrb + 4 * 72), ab, 0, 0, 0);
            }
            u32x2 o; o.x = pk2(af[0], af[1]); o.y = pk2(af[2], af[3]); *(u32x2*)(sof + (16 * pt + c) * 128) = o;
            o.x = pk2(ab[0], ab[1]); o.y = pk2(ab[2], ab[3]); *(u32x2*)(sob + (16 * pt + c) * 128) = o;
        }
        if (tid == 0) { decv[itf] = __expf(aendf); decv[itb] = __expf(aendb); }
    }
#undef SSD_LOADS_A
#undef SSD_UNIT_OFA
}
DI void ssd_scan_phase(const Params& p, int wave) {
    unsigned* Sl = (unsigned*)(p.ws + WS_SLOC); const float* decv = (const float*)(p.ws + WS_DEC);
    for (int chain = blockIdx.x * NTHR + TIDX(wave); chain < 160 * 4096; chain += gridDim.x * NTHR) {
        const int w = chain >> 12, j = chain & 4095;
        const int nc = w < 128 ? 32 : 64, cb = w < 128 ? 32 * w : 4096 + 64 * (w - 128);
        unsigned* ptr = Sl + (size_t)cb * 4096 + j; const float* dp = decv + cb;
        float s0 = 0.f, s1 = 0.f;
        for (int c0 = 0; c0 < nc; c0 += 8) {
            unsigned v[8]; float d[8];
#pragma unroll
            for (int k = 0; k < 8; ++k) { v[k] = ptr[(size_t)(c0 + k) * 4096]; d[k] = dp[c0 + k]; }
#pragma unroll
            for (int k = 0; k < 8; ++k) { ptr[(size_t)(c0 + k) * 4096] = pk2(s0, s1); s0 = s0 * d[k] + bflo(v[k]); s1 = s1 * d[k] + bfhi(v[k]); }
        }
    }
}
constexpr int SSDC_XF = 4096, SSDC_XB = SSDC_XF + 18432, SSDC_BN = SSDC_XB + 18432, SSDC_SF = SSDC_BN + 128 * 272, SSDC_SB = SSDC_SF + 64 * 272, SSDC_END = SSDC_SB + 64 * 272;
static_assert(SSDC_END <= 131072, "ssd lds");
DI void ssd_out_phase(const Params& p, LAS unsigned char* lds, int wave, int lane) {
    const int tid = TIDX(wave), c = lane & 15, q = lane >> 4, w = wave, qp = (lane & 15) >> 2, pp = lane & 3;
    LAS bf16_t* Xf = (LAS bf16_t*)(lds + SSDC_XF); LAS bf16_t* Xb = (LAS bf16_t*)(lds + SSDC_XB); LAS bf16_t* Bn = (LAS bf16_t*)(lds + SSDC_BN);
    LAS bf16_t* Sf = (LAS bf16_t*)(lds + SSDC_SF); LAS bf16_t* Sb = (LAS bf16_t*)(lds + SSDC_SB);
    const float* dtb = (const float*)(p.ws + WS_DT);
    const bf16_t* XCb = (const bf16_t*)(p.ws + WS_XC);
    const bf16_t* Sl = (const bf16_t*)(p.ws + WS_SLOC);
    const int vcu0 = (gridDim.x % 8 == 0) ? ((int)blockIdx.x % 8) * ((int)gridDim.x / 8) + (int)blockIdx.x / 8 : (int)blockIdx.x;
#define SSD_UNIT_OF(s_) ([&]{ const int cgi_ = vcu0 + (int)gridDim.x * ((s_) >> 2); return cgi_ < 768 ? ((cgi_ >> 1) * 8 + (cgi_ & 1) * 4 + ((s_) & 3)) : -1; }())
    int st_ = 0;
    int it = SSD_UNIT_OF(0);
    if (it < 0) return;
    SsdUnit I = ssd_decode(p, it);
    float pf0 = 0.f, pf1 = 0.f, pb0 = 0.f, pb1 = 0.f; u32x4 xv[2], bv[4], svf[2], svb[2]; bf16x8 Cn[4];
    bf16x8 Cf[4]; f32x4 Gt[8];
#define SSD_LOADS_C(I, fresh_) do { \
        if (w == 0) { const float* d_ = dtb + (size_t)((I).tok0 + 2 * lane) * 16 + (I).h; pf0 = d_[0]; pb0 = d_[8]; pf1 = d_[16]; pb1 = d_[24]; } \
        _Pragma("unroll") for (int i = 0; i < 2; ++i) { const int id = tid + NTHR * i, l = id >> 3, pc = id & 7; \
            xv[i] = *(const u32x4*)(XCb + (size_t)((I).h >> 2) * TILE_ELEMS + (size_t)((I).tok0 + l) * 256 + ((I).h & 3) * 64 + 8 * pc); \
            svf[i] = *(const u32x4*)(Sl + (size_t)(I).itf * 8192 + (size_t)id * 8); svb[i] = *(const u32x4*)(Sl + (size_t)(I).itb * 8192 + (size_t)id * 8); } \
        if (fresh_) { \
        _Pragma("unroll") for (int i = 0; i < 4; ++i) { const int id = tid + NTHR * i, l = id >> 4, ncn = id & 15; \
            bv[i] = *(const u32x4*)(XCb + 2 * TILE_ELEMS + (size_t)((I).tok0 + l) * 256 + (I).g * 128 + 8 * ncn); } \
        { const bf16_t* cr = XCb + 3 * TILE_ELEMS + (size_t)((I).tok0 + 16 * w + c) * 256 + (I).g * 128 + 8 * q; \
          _Pragma("unroll") for (int ks = 0; ks < 4; ++ks) Cn[ks] = *(const bf16x8*)(cr + 32 * ks); } } } while (0)
    SSD_LOADS_C(I, true);
    int par = 0;
    for (; it >= 0; par ^= 1) {
        const bool fresh = (st_ & 3) == 0;
        LAS float* acsf = (LAS float*)(lds + par * 2048); LAS float* acsb = acsf + 128; LAS float* dtsf = acsf + 256; LAS float* dtsb = acsf + 384;
        if (w == 0) ssd_scan_chunk2(pf0, pf1, pb0, pb1, I.Af, I.Ab, acsf, acsb, dtsf, dtsb, lane);
        LDS_BARRIER();
#pragma unroll
        for (int i = 0; i < 2; ++i) {
            const int id = tid + NTHR * i, l = id >> 3, pc = id & 7;
            *(LAS u32x4*)(Xf + l * 72 + 8 * pc) = scale8(xv[i], dtsf[l]);
            *(LAS u32x4*)(Xb + l * 72 + 8 * pc) = scale8(xv[i], dtsb[l]);
            *(LAS u32x4*)(Sf + (id >> 4) * 136 + 8 * (id & 15)) = svf[i];
            *(LAS u32x4*)(Sb + (id >> 4) * 136 + 8 * (id & 15)) = svb[i];
        }
        if (fresh) {
#pragma unroll
            for (int i = 0; i < 4; ++i) { const int id = tid + NTHR * i; *(LAS u32x4*)(Bn + (id >> 4) * 136 + 8 * (id & 15)) = bv[i]; }
#pragma unroll
            for (int ks = 0; ks < 4; ++ks) Cf[ks] = Cn[ks];
        }
        const int tok0 = I.tok0, hh = I.h;
        ++st_;
        it = SSD_UNIT_OF(st_);
        if (it >= 0) { I = ssd_decode(p, it); SSD_LOADS_C(I, (st_ & 3) == 0); }
        LDS_BARRIER();
        if (fresh) {
#pragma unroll
            for (int stt = 0; stt < 8; ++stt) { f32x4 G = {0.f, 0.f, 0.f, 0.f};
#pragma unroll
                for (int ks = 0; ks < 4; ++ks) G = __builtin_amdgcn_mfma_f32_16x16x32_bf16(*(const LAS bf16x8*)(Bn + (16 * stt + c) * 136 + 32 * ks + 8 * q), Cf[ks], G, 0, 0, 0);
                Gt[stt] = G; }
        }
        {
            const int l = 16 * w + c;
            const float alf = acsf[l], alb = acsb[l];
            f32x4 accf[4], accb[4];
#pragma unroll
            for (int pt = 0; pt < 4; ++pt) {
                f32x4 a = {0.f, 0.f, 0.f, 0.f}, b = {0.f, 0.f, 0.f, 0.f};
#pragma unroll
                for (int ks = 0; ks < 4; ++ks) {
                    a = __builtin_amdgcn_mfma_f32_16x16x32_bf16(*(const LAS bf16x8*)(Sf + (16 * pt + c) * 136 + 32 * ks + 8 * q), Cf[ks], a, 0, 0, 0);
                    b = __builtin_amdgcn_mfma_f32_16x16x32_bf16(*(const LAS bf16x8*)(Sb + (16 * pt + c) * 136 + 32 * ks + 8 * q), Cf[ks], b, 0, 0, 0);
                }
                accf[pt] = a * __expf(alf); accb[pt] = b * __expf(alb);
            }
            const int spd = w >> 1;
#pragma unroll
            for (int sp = 0; sp < 4; ++sp) {
                f32x4 Mf[2], Mb[2];
#pragma unroll
                for (int hx = 0; hx < 2; ++hx) {
                    const int st = 2 * sp + hx;
                    const f32x4 G = Gt[st];
#pragma unroll
                    for (int j = 0; j < 4; ++j) {
                        const int sx = 16 * st + 4 * q + j;
                        Mf[hx][j] = (sx <= l) ? G[j] * __expf(alf - acsf[sx]) : 0.f;
                        Mb[hx][j] = (sx >= l) ? G[j] * __expf(alb - acsb[sx]) : 0.f;
                    }
                }
                if (sp <= spd) {
                    u32x4 pw; pw.x = pk2(Mf[0][0], Mf[0][1]); pw.y = pk2(Mf[0][2], Mf[0][3]); pw.z = pk2(Mf[1][0], Mf[1][1]); pw.w = pk2(Mf[1][2], Mf[1][3]);
                    const bf16x8 pf = __builtin_bit_cast(bf16x8, pw);
#pragma unroll
                    for (int pt = 0; pt < 4; ++pt) { const LAS bf16_t* xr = Xf + (32 * sp + 4 * q + qp) * 72 + 16 * pt + 4 * pp;
                        accf[pt] = __builtin_amdgcn_mfma_f32_16x16x32_bf16(tr_pair(xr, xr + 16 * 72), pf, accf[pt], 0, 0, 0); }
                }
                if (sp >= spd) {
                    u32x4 pw; pw.x = pk2(Mb[0][0], Mb[0][1]); pw.y = pk2(Mb[0][2], Mb[0][3]); pw.z = pk2(Mb[1][0], Mb[1][1]); pw.w = pk2(Mb[1][2], Mb[1][3]);
                    const bf16x8 pf = __builtin_bit_cast(bf16x8, pw);
#pragma unroll
                    for (int pt = 0; pt < 4; ++pt) { const LAS bf16_t* xr = Xb + (32 * sp + 4 * q + qp) * 72 + 16 * pt + 4 * pp;
                        accb[pt] = __builtin_amdgcn_mfma_f32_16x16x32_bf16(tr_pair(xr, xr + 16 * 72), pf, accb[pt], 0, 0, 0); }
                }
            }
            bf16_t* yrf = (bf16_t*)(p.ws + WS_YF) + hh * 64 + (size_t)(tok0 + l) * 512 + 4 * q;
#pragma unroll
            for (int pt = 0; pt < 4; ++pt) {
                const f32x4 ys = accf[pt] + accb[pt];
                u32x2 o; o.x = pk2(ys[0], ys[1]); o.y = pk2(ys[2], ys[3]); *(u32x2*)(yrf + 16 * pt) = o;
            }
        }
    }
#undef SSD_LOADS_C
#undef SSD_UNIT_OF
}

DI void gate_phase(const Params& p, int gw, int NGW, int lane) {
    const bf16_t* yf = (const bf16_t*)(p.ws + WS_YF); const bf16_t* yb = (const bf16_t*)(p.ws + WS_YB);
    const bf16_t* xh = (const bf16_t*)(p.ws + WS_XC) + (size_t)(lane >> 5) * TILE_ELEMS + (8 * lane & 255);
    const bf16_t* zt = (const bf16_t*)(p.ws + WS_P) + (size_t)(6 + (lane >> 5)) * TILE_ELEMS + (8 * lane & 255);
    bf16_t* mix = (bf16_t*)(p.ws + WS_MIX) + 512 + 8 * lane;
    const float D = p.in[7][lane >> 3];
    float nw[8];
#pragma unroll
    for (int e = 0; e < 8; ++e) nw[e] = p.in[8][8 * lane + e];
#pragma unroll 8
    for (int t = gw; t < TT; t += NGW) {
        const u32x4 a = *(const u32x4*)(yf + (size_t)t * 512 + 8 * lane); const u32x4 b = {0u, 0u, 0u, 0u};
        const u32x4 x = *(const u32x4*)(xh + (size_t)t * 256), z = *(const u32x4*)(zt + (size_t)t * 256);
        float y[8];
        y[0] = (bflo(a.x) + bflo(b.x) + D * bflo(x.x)) * silu_f(bflo(z.x)); y[1] = (bfhi(a.x) + bfhi(b.x) + D * bfhi(x.x)) * silu_f(bfhi(z.x));
        y[2] = (bflo(a.y) + bflo(b.y) + D * bflo(x.y)) * silu_f(bflo(z.y)); y[3] = (bfhi(a.y) + bfhi(b.y) + D * bfhi(x.y)) * silu_f(bfhi(z.y));
        y[4] = (bflo(a.z) + bflo(b.z) + D * bflo(x.z)) * silu_f(bflo(z.z)); y[5] = (bfhi(a.z) + bfhi(b.z) + D * bfhi(x.z)) * silu_f(bfhi(z.z));
        y[6] = (bflo(a.w) + bflo(b.w) + D * bflo(x.w)) * silu_f(bflo(z.w)); y[7] = (bfhi(a.w) + bfhi(b.w) + D * bfhi(x.w)) * silu_f(bfhi(z.w));
        float ss = 0.f;
#pragma unroll
        for (int e = 0; e < 8; ++e) ss += y[e] * y[e];
        ss = wave_sum(ss);
        const float r = 1.0f / sqrtf(ss * (1.0f / 512.0f) + RMS_EPS);
        u32x4 o; o.x = pk2(y[0] * r * nw[0], y[1] * r * nw[1]); o.y = pk2(y[2] * r * nw[2], y[3] * r * nw[3]); o.z = pk2(y[4] * r * nw[4], y[5] * r * nw[5]); o.w = pk2(y[6] * r * nw[6], y[7] * r * nw[7]);
        *(u32x4*)(mix + (size_t)t * DM) = o;
    }
}

struct TrItem { const float* src; unsigned char* dst; };
template <class F> DI void transpose_items_f8(F item_of, int first, int count, int step, int ldw, int ldt, float scale, LAS float* scr, int lane) {
    if (first >= count) return;
    float cur[32], nxt[32];
    TrItem I = item_of(first);
#pragma unroll
    for (int i = 0; i < 32; ++i) cur[i] = I.src[(size_t)(2 * i + (lane >> 5)) * ldw + (lane & 31)];
    for (int it = first; it < count; it += step) {
        const int itn = it + step; TrItem In = I;
        if (itn < count) { In = item_of(itn);
#pragma unroll
            for (int i = 0; i < 32; ++i) nxt[i] = In.src[(size_t)(2 * i + (lane >> 5)) * ldw + (lane & 31)]; }
#pragma unroll
        for (int i = 0; i < 32; ++i) scr[(2 * i + (lane >> 5)) * 33 + (lane & 31)] = cur[i] * scale;
        LDS_WAIT();
        const int c = lane & 7;
#pragma unroll
        for (int j = 0; j < 4; ++j) { const int n = (lane >> 3) + 8 * j; const LAS float* sp = scr + (8 * c) * 33 + n;
            u32x2 o; o.x = pk4_f8(sp[0 * 33], sp[1 * 33], sp[2 * 33], sp[3 * 33]); o.y = pk4_f8(sp[4 * 33], sp[5 * 33], sp[6 * 33], sp[7 * 33]);
            *(u32x2*)(I.dst + (size_t)n * ldt + 8 * c) = o; }
        LDS_WAIT();
#pragma unroll
        for (int i = 0; i < 32; ++i) cur[i] = nxt[i];
        I = In;
    }
}
DI void expert_gu_weights_phase(const Params& p, LAS unsigned char* lds, int gw, int NGW, int wave, int lane) {
    LAS float* scr = (LAS float*)(lds + wave * 16384);
    const float* Wg = p.in[13]; const float* Wu = p.in[14]; unsigned char* WT = p.ws + WS_WGU;
    auto item_of = [=](int it) {
        const int e = it / 2816, r = it % 2816;
        const int isup = r >= 1408, rr = isup ? r - 1408 : r, kb = rr / 88, nb = rr % 88, n0 = 32 * nb, k0 = 64 * kb;
        TrItem I; I.src = (isup ? Wu : Wg) + (size_t)e * DM * FF + (size_t)k0 * FF + n0;
        I.dst = WT + (size_t)(e * 5632 + 256 * (n0 >> 7) + (n0 & 127) + (isup ? 128 : 0)) * DM + k0;
        return I; };
    transpose_items_f8(item_of, gw, 16 * 2816, NGW, FF, DM, WGU_SCALE, scr, lane);
}
DI void expert_down_weights(const Params& p, LAS unsigned char* lds, int vw, int NVW, int wave, int lane) {
    LAS float* scr = (LAS float*)(lds + 4096 + wave * 16384);
    const float* Wdn = p.in[15]; unsigned char* WT = p.ws + WS_WD;
    auto item_of = [=](int it) {
        const int e = it / 1408, rr = it % 1408, kb = rr / 32, nb = rr % 32;
        TrItem I; I.src = Wdn + (size_t)e * FF * DM + (size_t)(64 * kb) * DM + 32 * nb;
        I.dst = WT + (size_t)(e * 1024 + 32 * nb) * FF + 64 * kb;
        return I; };
    transpose_items_f8(item_of, vw, 16 * 1408, NVW, DM, FF, WD_SCALE, scr, lane);
}

DI void ln1_router_phase(const Params& p, LAS unsigned char* lds, int gw, int NGW, int wave, int lane) {
    const int tid = TIDX(wave);
    LAS float* wT = (LAS float*)lds;
    for (int id = tid; id < 16384; id += NTHR) { const int k = id >> 4, e = id & 15; wT[e * 1024 + k] = p.in[12][id]; }
    __syncthreads();
    f32x4 gg[4], bb[4];
#pragma unroll
    for (int j = 0; j < 4; ++j) { gg[j] = ((const f32x4*)p.in[10])[64 * j + lane]; bb[j] = ((const f32x4*)p.in[11])[64 * j + lane]; }
    unsigned char* x1b = p.ws + WS_X1B; float* aff = (float*)(p.ws + WS_AFF);
    const int ec = ecol(lane);
#pragma unroll 2
    for (int t = gw; t < TT; t += 2 * NGW) {
        const int t2 = (t + NGW < TT) ? t + NGW : t;
        const u32x2* hra = (const u32x2*)((const bf16_t*)(p.ws + WS_H) + (size_t)t * DM) + lane; const u32x2* hrb = (const u32x2*)((const bf16_t*)(p.ws + WS_H) + (size_t)t2 * DM) + lane;
        f32x4 va[4], vb[4]; float sa = 0.f, sb = 0.f;
#pragma unroll
        for (int j = 0; j < 4; ++j) { const u32x2 wa = hra[64 * j], wb = hrb[64 * j]; va[j] = (f32x4){bflo(wa.x), bfhi(wa.x), bflo(wa.y), bfhi(wa.y)}; vb[j] = (f32x4){bflo(wb.x), bfhi(wb.x), bflo(wb.y), bfhi(wb.y)}; sa += (va[j][0] + va[j][1]) + (va[j][2] + va[j][3]); sb += (vb[j][0] + vb[j][1]) + (vb[j][2] + vb[j][3]); }
        const float meana = wave_sum(sa) * (1.0f / DM), meanb = wave_sum(sb) * (1.0f / DM); float qa = 0.f, qb = 0.f;
#pragma unroll
        for (int j = 0; j < 4; ++j) { va[j] = va[j] - meana; vb[j] = vb[j] - meanb;
            qa += (va[j][0] * va[j][0] + va[j][1] * va[j][1]) + (va[j][2] * va[j][2] + va[j][3] * va[j][3]); qb += (vb[j][0] * vb[j][0] + vb[j][1] * vb[j][1]) + (vb[j][2] * vb[j][2] + vb[j][3] * vb[j][3]); }
        const float rstda = 1.0f / sqrtf(wave_sum(qa) * (1.0f / DM) + LN_EPS), rstdb = 1.0f / sqrtf(wave_sum(qb) * (1.0f / DM) + LN_EPS);
        unsigned* o4a = (unsigned*)(x1b + (size_t)t * DM) + lane; unsigned* o4b = (unsigned*)(x1b + (size_t)t2 * DM) + lane;
        u32x2* oha = (u32x2*)((bf16_t*)(p.ws + WS_X1H) + (size_t)t * DM) + lane; u32x2* ohb = (u32x2*)((bf16_t*)(p.ws + WS_X1H) + (size_t)t2 * DM) + lane;
#pragma unroll
        for (int j = 0; j < 4; ++j) {
            va[j] = va[j] * rstda * gg[j] + bb[j]; vb[j] = vb[j] * rstdb * gg[j] + bb[j];
            { u32x2 wv; wv.x = pk2(va[j][0], va[j][1]); wv.y = pk2(va[j][2], va[j][3]); oha[64 * j] = wv; wv.x = pk2(vb[j][0], vb[j][1]); wv.y = pk2(vb[j][2], vb[j][3]); ohb[64 * j] = wv; }
            o4a[64 * j] = pk4_f8(va[j][0], va[j][1], va[j][2], va[j][3]); o4b[64 * j] = pk4_f8(vb[j][0], vb[j][1], vb[j][2], vb[j][3]);
        }
        float ra, rb; dot16x2(va, vb, wT, lane, ra, rb);
        float ma = ra, mb = rb;
#pragma unroll
        for (int o = 1; o < 16; o <<= 1) { ma = fmaxf(ma, __shfl_xor(ma, o)); mb = fmaxf(mb, __shfl_xor(mb, o)); }
        const float ea = __expf(ra - ma), eb = __expf(rb - mb); float da = ea, db = eb;
#pragma unroll
        for (int o = 1; o < 16; o <<= 1) { da += __shfl_xor(da, o); db += __shfl_xor(db, o); }
        if (lane < 16) { aff[(size_t)ec * TT + t] = ea / da; aff[(size_t)ec * TT + t2] = eb / db; }
    }
}

DI void select_phase(const Params& p, LAS unsigned char* lds, int wave, int lane) {
    const int wk = blockIdx.x;
    if (wk >= 32) { expert_down_weights(p, lds, (wk - 32) * 8 + wave, ((int)gridDim.x - 32) * 8, wave, lane); return; }
    const int tid = TIDX(wave);
    const int trunk = wk >> 4, e = wk & 15;
    const int Tn = trunk ? 16384 : 32768, tbase = trunk ? TP : 0, cap = Tn / 8;
    const unsigned* col = (const unsigned*)(p.ws + WS_AFF) + (size_t)e * TT + tbase;
    LAS unsigned* hist = (LAS unsigned*)lds;
    LAS unsigned* ctl = (LAS unsigned*)(lds + 1024);
    LAS unsigned* wcnt = (LAS unsigned*)(lds + 2048);
    const int nblk = Tn / (4 * NTHR);
    u32x4 cv[16];
#pragma unroll
    for (int k = 0; k < 16; ++k) cv[k] = (k < nblk) ? *(const u32x4*)(col + 4 * NTHR * k + 4 * tid) : (u32x4){0u, 0u, 0u, 0u};
    unsigned prefix = 0, remaining = (unsigned)cap;
    for (int pass = 0; pass < 4; ++pass) {
        const int shift = 24 - 8 * pass;
        for (int i = tid; i < 256; i += NTHR) hist[i] = 0u;
        __syncthreads();
#pragma unroll
        for (int k = 0; k < 16; ++k) if (k < nblk) {
            const unsigned bb4[4] = {cv[k].x, cv[k].y, cv[k].z, cv[k].w};
#pragma unroll
            for (int j = 0; j < 4; ++j) if (pass == 0 || (bb4[j] >> (shift + 8)) == prefix) atomicAdd((unsigned*)(hist + ((bb4[j] >> shift) & 255u)), 1u);
        }
        __syncthreads();
        if (wave == 0) {
            const unsigned h0 = hist[4 * lane], h1 = hist[4 * lane + 1], h2 = hist[4 * lane + 2], h3 = hist[4 * lane + 3], tot = h0 + h1 + h2 + h3;
            unsigned v = tot;
#pragma unroll
            for (int o = 1; o < 64; o <<= 1) { const unsigned t = __shfl_down(v, o); if (lane + o < 64) v += t; }
            const unsigned excl = v - tot;
            if (excl < remaining && remaining <= excl + tot) {
                unsigned cum = excl; int b;
                if (cum + h3 >= remaining) b = 3; else { cum += h3; if (cum + h2 >= remaining) b = 2; else { cum += h2; if (cum + h1 >= remaining) b = 1; else { cum += h1; b = 0; } } }
                ctl[0] = (prefix << 8) | (unsigned)(4 * lane + b); ctl[1] = remaining - cum;
            }
        }
        __syncthreads();
        prefix = ctl[0]; remaining = ctl[1];
        __syncthreads();
    }
    const unsigned thr = prefix, need_eq = remaining;
    int* idx = (int*)(p.ws + WS_IDX) + e * SLOTS_E + (trunk ? 4096 : 0);
    int* inv = (int*)(p.ws + WS_INV) + (size_t)e * TT + tbase;
    const int slot0 = e * SLOTS_E + (trunk ? 4096 : 0);
    float* gate = (float*)(p.ws + WS_GATE) + e * SLOTS_E + (trunk ? 4096 : 0);
    unsigned base_gt = 0, base_eq = 0;
#pragma unroll
    for (int k = 0; k < 16; ++k) if (k < nblk) {
        const int b0 = 4 * NTHR * k;
        const unsigned bits[4] = {cv[k].x, cv[k].y, cv[k].z, cv[k].w};
        unsigned packed = 0;
#pragma unroll
        for (int j = 0; j < 4; ++j) packed += (bits[j] > thr ? 1u : 0u) + (bits[j] == thr ? 0x10000u : 0u);
        unsigned v = packed;
#pragma unroll
        for (int o = 1; o < 64; o <<= 1) { const unsigned t = __shfl_up(v, o); if (lane >= o) v += t; }
        if (lane == 63) wcnt[(k & 1) * 8 + wave] = v;
        __syncthreads();
        unsigned off = 0, tot = 0;
#pragma unroll
        for (int w2 = 0; w2 < 8; ++w2) { const unsigned cnt = wcnt[(k & 1) * 8 + w2]; off += (w2 < wave) ? cnt : 0u; tot += cnt; }
        const unsigned ex = off + (v - packed);
        unsigned gt_before = base_gt + (ex & 0xffffu), eq_before = base_eq + (ex >> 16);
        int invv[4];
#pragma unroll
        for (int j = 0; j < 4; ++j) {
            const bool gt = bits[j] > thr, eq = bits[j] == thr;
            const bool sel = gt || (eq && eq_before < need_eq);
            const unsigned pos = gt_before + (eq_before < need_eq ? eq_before : need_eq);
            const bool ok = sel && pos < (unsigned)cap;
            if (ok) { idx[pos] = tbase + b0 + 4 * tid + j; gate[pos] = __uint_as_float(bits[j]); }
            invv[j] = ok ? slot0 + (int)pos : -1;
            gt_before += gt ? 1u : 0u; eq_before += eq ? 1u : 0u;
        }
        *(i32x4*)(inv + b0 + 4 * tid) = (i32x4){invv[0], invv[1], invv[2], invv[3]};
        base_gt += tot & 0xffffu; base_eq += tot >> 16;
    }
}

DI void ln2_phase(const Params& p, int gw, int NGW, int lane) {
    f32x4 gg[4], bb[4];
#pragma unroll
    for (int j = 0; j < 4; ++j) { gg[j] = ((const f32x4*)p.in[16])[64 * j + lane]; bb[j] = ((const f32x4*)p.in[17])[64 * j + lane]; }
    const int* inv = (const int*)(p.ws + WS_INV); const unsigned char* eo = p.ws + WS_EO;
    const bf16_t* x1h = (const bf16_t*)(p.ws + WS_X1H);
    u32x2 nv[4]; int nslot;
    { const int t0 = gw < TT ? gw : 0; const u32x2* r0 = (const u32x2*)(x1h + (size_t)t0 * DM) + lane;
#pragma unroll
      for (int j = 0; j < 4; ++j) nv[j] = r0[64 * j];
      nslot = lane < 16 ? inv[(size_t)lane * TT + t0] : -1; }
    for (int t = gw; t < TT; t += NGW) {
        f32x4* orow = (f32x4*)(p.out + (size_t)t * DM) + lane;
        f32x4 v[4]; float s = 0.f;
#pragma unroll
        for (int j = 0; j < 4; ++j) v[j] = (f32x4){bflo(nv[j].x), bfhi(nv[j].x), bflo(nv[j].y), bfhi(nv[j].y)} * ALPHA;
        const int myslot = nslot;
        { const int tn = t + NGW; if (tn < TT) { const u32x2* rn = (const u32x2*)(x1h + (size_t)tn * DM) + lane;
#pragma unroll
            for (int j = 0; j < 4; ++j) nv[j] = rn[64 * j];
            nslot = lane < 16 ? inv[(size_t)lane * TT + tn] : -1; } }
        for (int e = 0; e < 16; ++e) {
            const int sl = __shfl(myslot, e);
            if (sl >= 0) {
                const unsigned* er = (const unsigned*)(eo + (size_t)sl * DM) + lane;
#pragma unroll
                for (int j = 0; j < 4; ++j) { const int w = (int)er[64 * j];
                    v[j][0] += __builtin_amdgcn_cvt_f32_fp8(w, 0) * (1.0f / EO_SCALE); v[j][1] += __builtin_amdgcn_cvt_f32_fp8(w, 1) * (1.0f / EO_SCALE);
                    v[j][2] += __builtin_amdgcn_cvt_f32_fp8(w, 2) * (1.0f / EO_SCALE); v[j][3] += __builtin_amdgcn_cvt_f32_fp8(w, 3) * (1.0f / EO_SCALE); }
            }
        }
#pragma unroll
        for (int j = 0; j < 4; ++j) s += (v[j][0] + v[j][1]) + (v[j][2] + v[j][3]);
        const float mean = wave_sum(s) * (1.0f / DM); float s2 = 0.f;
#pragma unroll
        for (int j = 0; j < 4; ++j) { v[j] = v[j] - mean; s2 += (v[j][0] * v[j][0] + v[j][1] * v[j][1]) + (v[j][2] * v[j][2] + v[j][3] * v[j][3]); }
        const float rstd = 1.0f / sqrtf(wave_sum(s2) * (1.0f / DM) + LN_EPS);
#pragma unroll
        for (int j = 0; j < 4; ++j) orow[64 * j] = v[j] * rstd * gg[j] + bb[j];
    }
}

constexpr size_t WS_CTL = 19 * MiB;
#define XB_TMO      128
#define XB_XCNT(j)  (256  + 64 * (j))
#define XB_XSUB(j)  (1280 + 64 * (j))
#define XB_XGEN(j)  (2304 + 64 * (j))
#define XB_TOP      3328
#define XB_TOPGEN   3392
#define XCD_BAR_WORDS 3456
#define XB_SPIN_CAP (1u << 18)
DI unsigned xb_ld(unsigned* p)              { return __hip_atomic_load(p, __ATOMIC_RELAXED, __HIP_MEMORY_SCOPE_AGENT); }
DI unsigned xb_add(unsigned* p, unsigned v) { return __hip_atomic_fetch_add(p, v, __ATOMIC_RELAXED, __HIP_MEMORY_SCOPE_AGENT); }
DI unsigned xb_xcc_id() { return (unsigned)__builtin_amdgcn_s_getreg((3 << 11) | 20) & 0xFu; }
#define XB_SPIN(cond, bar) do { unsigned _sp = 0; while (cond) { __builtin_amdgcn_s_sleep(1); \
    if ((++_sp & 255u) == 0u) { if (xb_ld(&(bar)[XB_TMO])) break; if (_sp > XB_SPIN_CAP) { atomicAdd(&(bar)[XB_TMO], 1u); break; } } } } while (0)
struct XcdBarrier { unsigned* bar; unsigned x; volatile LAS unsigned* st; };
DI void xcd_barrier_complete(unsigned* bar, unsigned x, unsigned& nloc, unsigned& nx) {
    const unsigned G = gridDim.x * gridDim.y * gridDim.z;
    unsigned sum, cnt, mine, sp = 0u;
    for (;;) {
        sum = 0u; cnt = 0u; mine = 0u;
#pragma unroll
        for (unsigned j = 0; j < 16; ++j) { const unsigned c = xb_ld(&bar[XB_XCNT(j)]); sum += c; cnt += (c > 0u) ? 1u : 0u; mine = (j == x) ? c : mine; }
        if (sum == G) break;
        __builtin_amdgcn_s_sleep(1);
        if ((++sp & 255u) == 0u) { if (xb_ld(&bar[XB_TMO])) break; if (sp > XB_SPIN_CAP) { atomicAdd(&bar[XB_TMO], 1u); break; } }
    }
    nloc = mine > 0u ? mine : 1u; nx = cnt > 0u ? cnt : 1u;
}
DI void xcd_barrier(const XcdBarrier& b, int wave) {
    asm volatile("s_waitcnt vmcnt(0)" ::: "memory");
    __syncthreads();
    if (wave == 0 && lane_id() == 0) {
        unsigned* bar = b.bar;
        __builtin_amdgcn_s_waitcnt(0);
        unsigned nloc = b.st[0], nx = b.st[1];
        if (nloc == 0u) { xcd_barrier_complete(bar, b.x, nloc, nx); b.st[0] = nloc; b.st[1] = nx; }
        const unsigned old = xb_add(&bar[XB_XSUB(b.x)], 1u);
        const unsigned gen = old / nloc;
        if (old + 1u == (gen + 1u) * nloc) {
            __builtin_amdgcn_fence(__ATOMIC_RELEASE, "agent");
            asm volatile("s_waitcnt vmcnt(0)" ::: "memory");
            const unsigned og = xb_add(&bar[XB_TOP], 1u);
            const unsigned tg = og / nx;
            if (og + 1u == (tg + 1u) * nx) xb_add(&bar[XB_TOPGEN], 1u);
            else XB_SPIN(xb_ld(&bar[XB_TOPGEN]) == tg, bar);
            __builtin_amdgcn_fence(__ATOMIC_ACQUIRE, "agent");
            xb_add(&bar[XB_XGEN(b.x)], 1u);
            asm volatile("s_waitcnt vmcnt(0)" ::: "memory");
        } else {
            XB_SPIN(xb_ld(&bar[XB_XGEN(b.x)]) == gen, bar);
            __builtin_amdgcn_fence(__ATOMIC_ACQUIRE, "agent");
            asm volatile("s_waitcnt vmcnt(0)" ::: "memory");
        }
    }
    __syncthreads();
}

__global__ void __launch_bounds__(NTHR, 2) fwd_megakernel(Params p) {
    extern __shared__ __attribute__((aligned(16))) unsigned char lds_raw[];
    LAS unsigned char* lds = (LAS unsigned char*)lds_raw;
    cg::grid_group grid = cg::this_grid();
    const int wave_k = __builtin_amdgcn_readfirstlane((int)threadIdx.x >> 6);
    XcdBarrier xb; xb.bar = (unsigned*)(p.ws + WS_CTL); xb.x = xb_xcc_id(); xb.st = (volatile LAS unsigned*)(lds + LDS_BYTES - 64);
    if (wave_k == 0 && lane_id() == 0) { xb.st[0] = 0u; xb.st[1] = 0u; (void)xb_add(&xb.bar[XB_XCNT(xb.x)], 1u); }
    __syncthreads();
#define GSYNC() xcd_barrier(xb, wave_k)
#define IDS() const int lane = lane_id(), wave = wave_k; \
    const int G = gridDim.x, gw = blockIdx.x * 8 + wave, NGW = G * 8; (void)lane; (void)gw; (void)NGW; (void)G;
    { IDS(); phase0(p, lds, gw, NGW, wave, lane); }
    grid.sync();
    {
        IDS();
        pg8::SchedPlain S; S.init(TT, 3072, G, (int)blockIdx.x);
        pg8::EpiProj E{(bf16_t*)(p.ws + WS_P), (const float*)(p.ws + WS_ROPE)};
        pg8::gemm_phase<pg8::EpiProj, pg8::SchedPlain>(lds, (const bf16_t*)(p.ws + WS_XB), (const bf16_t*)(p.ws + WS_WI), DM, S, E, wave);
    }
    GSYNC();
    conv_phase(p, wave_k);
    { IDS(); const int vcu = (G % 8 == 0) ? ((int)blockIdx.x % 8) * (G / 8) + (int)blockIdx.x / 8 : (int)blockIdx.x;
      attn_phase(p, lds, vcu * 8 + wave, NGW, wave, lane); }
    GSYNC();
    { IDS(); ssd_state_phase(p, lds, wave, lane); }
    GSYNC();
    ssd_scan_phase(p, wave_k);
    GSYNC();
    { IDS(); ssd_out_phase(p, lds, wave, lane); }
    GSYNC();
    { IDS(); gate_phase(p, gw, NGW, lane); }
    GSYNC();
    { IDS(); expert_gu_weights_phase(p, lds, gw, NGW, wave, lane); }
    __syncthreads();
    {
        IDS();
        pg8::SchedPlain S; S.init(TT, DM, G, (int)blockIdx.x);
        pg8::EpiOut E{p};
        pg8::gemm_phase<pg8::EpiOut, pg8::SchedPlain>(lds, (const bf16_t*)(p.ws + WS_MIX), (const bf16_t*)(p.ws + WS_WO), DM, S, E, wave);
    }
    GSYNC();
    { IDS(); ln1_router_phase(p, lds, gw, NGW, wave, lane); }
    GSYNC();
    { IDS(); select_phase(p, lds, wave, lane); }
    GSYNC();
    {
        IDS();
        const int* idx = (const int*)(p.ws + WS_IDX);
        pg8::SchedGrouped<22, true> S{G, (int)blockIdx.x, idx};
        pg8::EpiGU E{p.ws + WS_HID};
        pg8::gemm_phase<pg8::EpiGU, pg8::SchedGrouped<22, true>, true>(lds, (const bf16_t*)(p.ws + WS_X1B), (const bf16_t*)(p.ws + WS_WGU), DM / 2, S, E, wave);
    }
    GSYNC();
    {
        IDS();
        const int* idx = (const int*)(p.ws + WS_IDX);
        const float* gate = (const float*)(p.ws + WS_GATE);
        pg8::SchedGrouped<4, false> S{G, (int)blockIdx.x, idx};
        pg8::EpiDown E{p.ws + WS_EO, gate};
        pg8::gemm_phase<pg8::EpiDown, pg8::SchedGrouped<4, false>, true>(lds, (const bf16_t*)(p.ws + WS_HID), (const bf16_t*)(p.ws + WS_WD), FF / 2, S, E, wave);
    }
    GSYNC();
    { IDS(); ln2_phase(p, gw, NGW, lane); }
#undef IDS
}

extern "C" void kernel_launch(void* const* d_in, const int* in_sizes, int n_in, void* d_out, int out_size, void* d_ws, size_t ws_size, hipStream_t stream) {
    static int grid_blocks = 0;
    if (grid_blocks == 0) {
        if (n_in != 18 || ws_size < WS_END || out_size != TT * DM) { fprintf(stderr, "kernel_launch: unexpected shapes (n_in %d out %d ws %zu)\n", n_in, out_size, ws_size); grid_blocks = -1; return; }
        int dev = 0, cus = 0, per_cu = 0;
        hipGetDevice(&dev);
        hipDeviceGetAttribute(&cus, hipDeviceAttributeMultiprocessorCount, dev);
        if (hipFuncSetAttribute((const void*)fwd_megakernel, hipFuncAttributeMaxDynamicSharedMemorySize, LDS_BYTES) != hipSuccess) { fprintf(stderr, "kernel_launch: hipFuncSetAttribute failed\n"); }
        hipOccupancyMaxActiveBlocksPerMultiprocessor(&per_cu, (const void*)fwd_megakernel, NTHR, LDS_BYTES);
        if (per_cu < 1) per_cu = 1;
        (void)hipGetLastError();
        grid_blocks = cus * per_cu;
    }
    if (grid_blocks < 0) return;
    Params p{};
    for (int i = 0; i < 18; ++i) p.in[i] = (const float*)d_in[i];
    p.out = (float*)d_out; p.ws = (unsigned char*)d_ws;
    if (hipMemsetAsync((char*)d_ws + WS_CTL, 0, 16384, stream) != hipSuccess) { fprintf(stderr, "kernel_launch: hipMemsetAsync failed\n"); return; }
    void* args[] = {&p};
    hipError_t e = hipLaunchCooperativeKernel((void*)fwd_megakernel, dim3(grid_blocks), dim3(NTHR), args, LDS_BYTES, stream);
    if (e != hipSuccess) fprintf(stderr, "cooperative launch failed: %s (grid %d)\n", hipGetErrorString(e), grid_blocks);
}
```

```cpp
#include <hip/hip_runtime.h>
#include <hip/hip_cooperative_groups.h>
#include <cstdio>
#include <cstdint>
namespace cg = cooperative_groups;

#define DI __device__ __forceinline__
#define LAS __attribute__((address_space(3)))
typedef unsigned short bf16_t;
typedef short bf16x8 __attribute__((ext_vector_type(8)));
typedef short s16x4 __attribute__((ext_vector_type(4)));
typedef float f32x4 __attribute__((ext_vector_type(4)));
typedef unsigned u32x4 __attribute__((ext_vector_type(4)));
typedef unsigned u32x2 __attribute__((ext_vector_type(2)));
typedef int i32x4 __attribute__((ext_vector_type(4)));
typedef int i32x8 __attribute__((ext_vector_type(8)));

constexpr int TT = 49152;
constexpr int TP = 32768;
constexpr int DM = 1024;
constexpr int INW = 3088;
constexpr int FF = 2816;
constexpr int NE = 16;
constexpr int SLOTS_E = 6144;
constexpr float ALPHA = 1.189207115002721f;
constexpr float LN_EPS = 1e-5f, RMS_EPS = 1e-5f;

constexpr size_t MiB = 1u << 20;
constexpr size_t TILE_ELEMS = (size_t)TT * 256;
constexpr size_t TILE_BYTES = TILE_ELEMS * 2;
constexpr size_t WS_WI = 0;
constexpr size_t WS_WO = 6 * MiB;
constexpr size_t WS_DT = 8 * MiB;
constexpr size_t WS_ROPE = 11 * MiB;
constexpr size_t WS_AFF = 12 * MiB;
constexpr size_t WS_IDX = 15 * MiB;
constexpr size_t WS_GATE = 15 * MiB + 512 * 1024;
constexpr size_t WS_P = 20 * MiB;
constexpr size_t WS_XC = 308 * MiB;
constexpr size_t WS_XB = 404 * MiB;
constexpr size_t WS_MIX = WS_XB;
constexpr size_t WS_YF = WS_P + 8 * TILE_BYTES;
constexpr size_t WS_YB = WS_P + 10 * TILE_BYTES;
constexpr size_t WS_INV = 16 * MiB;
constexpr size_t WS_WD = 20 * MiB;
constexpr size_t WS_H = 248 * MiB;
constexpr size_t WS_X1H = 64 * MiB;
constexpr size_t WS_WGU = 160 * MiB;
constexpr size_t WS_EO = 160 * MiB;
constexpr size_t WS_X1B = 352 * MiB;
constexpr size_t WS_HID = 404 * MiB;
constexpr size_t WS_END = 668 * MiB;

constexpr int LDS_BYTES = 147456;
constexpr int NTHR = 512;

DI unsigned f2bf(float f) { unsigned u = __float_as_uint(f); return (u + 0x7fffu + ((u >> 16) & 1u)) >> 16; }
typedef float f32x2v __attribute__((ext_vector_type(2)));
typedef __bf16 bf16x2v __attribute__((ext_vector_type(2)));
DI unsigned pk2(float lo, float hi) { const f32x2v f = {lo, hi}; return __builtin_bit_cast(unsigned, __builtin_convertvector(f, bf16x2v)); }
DI unsigned pk4_f8(float a, float b, float c, float d) { int w = 0; w = __builtin_amdgcn_cvt_pk_fp8_f32(a, b, w, false); w = __builtin_amdgcn_cvt_pk_fp8_f32(c, d, w, true); return (unsigned)w; }
DI i32x8 cat8(bf16x8 lo, bf16x8 hi) { const i32x4 a = __builtin_bit_cast(i32x4, lo), b = __builtin_bit_cast(i32x4, hi); return __builtin_shufflevector(a, b, 0, 1, 2, 3, 4, 5, 6, 7); }
constexpr float WGU_SCALE = 32.0f, WD_SCALE = 64.0f, EO_SCALE = 16.0f;
DI float bflo(unsigned u) { return __uint_as_float(u << 16); }
DI float bfhi(unsigned u) { return __uint_as_float(u & 0xffff0000u); }
DI float wave_sum(float v) {
#pragma unroll
    for (int o = 1; o < 64; o <<= 1) v += __shfl_xor(v, o);
    return v;
}
DI void st_tr8_pair(LAS bf16_t* base, int stride, int colpair, int lane, const u32x4 v) {
    const unsigned px = __shfl_xor(v.x, 1), py = __shfl_xor(v.y, 1), pz = __shfl_xor(v.z, 1), pw = __shfl_xor(v.w, 1);
    const bool odd = (lane & 1) != 0;
    const unsigned d0 = odd ? ((px >> 16) | (v.x & 0xffff0000u)) : ((v.x & 0xffffu) | (px << 16));
    const unsigned d1 = odd ? ((py >> 16) | (v.y & 0xffff0000u)) : ((v.y & 0xffffu) | (py << 16));
    const unsigned d2 = odd ? ((pz >> 16) | (v.z & 0xffff0000u)) : ((v.z & 0xffffu) | (pz << 16));
    const unsigned d3 = odd ? ((pw >> 16) | (v.w & 0xffff0000u)) : ((v.w & 0xffffu) | (pw << 16));
    LAS unsigned* wp = (LAS unsigned*)(base + (odd ? stride : 0)) + colpair;
    wp[0] = d0; wp[stride] = d1; wp[2 * stride] = d2; wp[3 * stride] = d3;
}
DI float silu_f(float x) { return x * __builtin_amdgcn_rcpf(1.0f + __expf(-x)); }
#define LDS_WAIT() asm volatile("s_waitcnt lgkmcnt(0)" ::: "memory")
#define LDS_BARRIER() do { asm volatile("s_waitcnt lgkmcnt(0)" ::: "memory"); __builtin_amdgcn_s_barrier(); asm volatile("" ::: "memory"); } while (0)

struct Params { const float* in[18]; float* out; unsigned char* ws; };
DI int lane_id() { int l = (int)__builtin_amdgcn_mbcnt_hi(~0u, __builtin_amdgcn_mbcnt_lo(~0u, 0u)); asm volatile("" : "+v"(l)); return l; }
#define TIDX(wave_) ((wave_) * 64 + lane_id())

DI const float* xrow_ptr(const Params& p, int t) { return t < TP ? p.in[0] + (size_t)t * DM : p.in[1] + (size_t)(t - TP) * DM; }

namespace pg8 {
constexpr int BM = 256, BK = 64, HALF = 128, HTB = HALF * BK * 2, NXCD = 8, WGM = 8;
DI int lds_byte(int r, int c) { const int st = (r >> 4) * 2 + (c >> 5), rr = r & 15, cc = c & 31, ob = rr * 64 + cc * 2; return st * 1024 + (ob ^ (((ob >> 9) & 1) << 5)); }
DI void stage_rc(int b, int& R, int& C) { const int st = b / 1024, sb = b % 1024, swz = sb ^ (((sb >> 9) & 1) << 5); R = (st >> 1) * 16 + swz / 64; C = (st & 1) * 32 + (swz % 64) / 2; }
DI int perm32(int rho) { const int n = rho >> 4, i = rho & 15; return 8 * (i >> 2) + 4 * n + (i & 3); }

struct Unit { int pm, pn, bt; };

DI int xcd_remap(int L, int nwg) { const int q = nwg / NXCD, r = nwg % NXCD, xcd = L % NXCD, off = L / NXCD; return (xcd < r ? xcd * (q + 1) : r * (q + 1) + (xcd - r) * q) + off; }

struct SchedPlain {
    int nM, nN, nwg, G, c;
    DI void init(int M, int N, int G_, int c_) { nM = M / BM; nN = N / BM; nwg = nM * nN; G = G_; c = c_; }
    DI bool next(int i, Unit& u) const {
        const int L = i * G + c; if (L >= nwg) return false;
        const int wgid = xcd_remap(L, nwg);
        const int nig = WGM * nN, gid = wgid / nig, fm = gid * WGM, gsz = (nM - fm) < WGM ? (nM - fm) : WGM;
        u.pm = fm + ((wgid % nig) % gsz); u.pn = (wgid % nig) / gsz; u.bt = u.pn; return true;
    }
    DI int arow(const Unit& u, int r) const { return u.pm * BM + r; }
};
template <int NPN, bool GATHER> struct SchedGrouped {
    int G, c; const int* idx;
    DI bool next(int i, Unit& u) const {
        constexpr int PER_E = 24 * NPN, NWG = NE * PER_E;
        const int L = i * G + c; if (L >= NWG) return false;
        const int wgid = xcd_remap(L, NWG);
        const int e = wgid / PER_E, rem = wgid % PER_E;
        const int gid = rem / (8 * NPN), w2 = rem % (8 * NPN);
        u.pm = e * 24 + gid * 8 + (w2 % 8); u.pn = w2 / 8; u.bt = e * NPN + u.pn; return true;
    }
    DI int arow(const Unit& u, int r) const { if (GATHER) return idx[u.pm * BM + r]; else return u.pm * BM + r; }
};

template <class Epi, class Sched, bool F8 = false>
DI void gemm_phase(LAS unsigned char* lds, const bf16_t* Ag, const bf16_t* Btg, const int K, const Sched& S, const Epi& E, const int wave_in) {
    const int tid = TIDX(wave_in), wid = wave_in, lane = tid & 63, wr = wid >> 2, wc = wid & 3, fr = lane & 15, fq = lane >> 4;
    const int nt = K / BK;
    unsigned voffB[2];
#pragma unroll
    for (int i = 0; i < 2; ++i) { int R, C; stage_rc(tid * 16 + i * 8192, R, C); const int Rb = Epi::PERM ? ((R & ~31) + perm32(R & 31)) : R;
        voffB[i] = (unsigned)(Rb * K + C) * 2u; }
    const unsigned rowbytes = (unsigned)K * 2u;
    const size_t kstep = (size_t)(BK * 2);
    const size_t hstep = (size_t)HALF * K * 2;
    const size_t tstep = 2 * hstep;
    const unsigned ldsw = (unsigned)wid * 1024u;
    const int aoff = lds_byte(wr * 64 + fr, fq * 8), boff = lds_byte(wc * 32 + fr, fq * 8);
#define PG8_SA(b, h) (((b) * 2 + (h)) * HTB)
#define PG8_SB(b, h) ((4 + (b) * 2 + (h)) * HTB)
#define PG8_STAGE(bufoff, gbase, voff) do { _Pragma("unroll") for (int _i = 0; _i < 2; ++_i) \
        __builtin_amdgcn_global_load_lds((const unsigned*)((const char*)(gbase) + (voff)[_i]), (LAS unsigned*)(lds + (bufoff) + ldsw + _i * 8192), 16, 0, 0); } while (0)
#define PG8_STAGEA(bufoff, o0, o1, kb) do { \
        __builtin_amdgcn_global_load_lds((const unsigned*)((const char*)Ag + (size_t)(o0) + (size_t)(kb)), (LAS unsigned*)(lds + (bufoff) + ldsw), 16, 0, 0); \
        __builtin_amdgcn_global_load_lds((const unsigned*)((const char*)Ag + (size_t)(o1) + (size_t)(kb)), (LAS unsigned*)(lds + (bufoff) + ldsw + 8192), 16, 0, 0); } while (0)
#define PG8_LDA(dst, b, h) do { _Pragma("unroll") for (int m = 0; m < 4; ++m) _Pragma("unroll") for (int k = 0; k < 2; ++k) dst[m][k] = *(const LAS bf16x8*)(lds + PG8_SA(b, h) + aoff + m * 2048 + k * 1024); } while (0)
#define PG8_LDB(dst, b, h) do { _Pragma("unroll") for (int n = 0; n < 2; ++n) _Pragma("unroll") for (int k = 0; k < 2; ++k) dst[n][k] = *(const LAS bf16x8*)(lds + PG8_SB(b, h) + boff + n * 2048 + k * 1024); } while (0)
#define PG8_MMA(ai, bj, At, Bt) do { __builtin_amdgcn_s_setprio(1); _Pragma("unroll") for (int m = 0; m < 4; ++m) _Pragma("unroll") for (int n = 0; n < 2; ++n) { \
        if constexpr (F8) { acc[ai][bj][m][n] = __builtin_amdgcn_mfma_scale_f32_16x16x128_f8f6f4(cat8(Bt[n][0], Bt[n][1]), cat8(At[m][0], At[m][1]), acc[ai][bj][m][n], 0, 0, 0, 0, 0, 0); } \
        else { _Pragma("unroll") for (int k = 0; k < 2; ++k) acc[ai][bj][m][n] = __builtin_amdgcn_mfma_f32_16x16x32_bf16(Bt[n][k], At[m][k], acc[ai][bj][m][n], 0, 0, 0); } } \
        __builtin_amdgcn_s_setprio(0); } while (0)
#define PG8_WAIT_V(n) asm volatile("s_waitcnt vmcnt(" #n ")" ::: "memory")
#define PG8_WAIT_L(n) asm volatile("s_waitcnt lgkmcnt(" #n ")" ::: "memory")
#define PG8_BAR __builtin_amdgcn_s_barrier()
#define PG8_SCHED __builtin_amdgcn_sched_barrier(0)
#define PG8_OFFS(u, o00, o01, o10, o11) do { int R0_, C0_, R1_, C1_; const int t2_ = TIDX(wid); stage_rc(t2_ * 16, R0_, C0_); stage_rc(t2_ * 16 + 8192, R1_, C1_); \
        o00 = (unsigned)S.arow(u, R0_) * rowbytes + (unsigned)C0_ * 2u; o01 = (unsigned)S.arow(u, R1_) * rowbytes + (unsigned)C1_ * 2u; \
        o10 = (unsigned)S.arow(u, HALF + R0_) * rowbytes + (unsigned)C0_ * 2u; o11 = (unsigned)S.arow(u, HALF + R1_) * rowbytes + (unsigned)C1_ * 2u; } while (0)
    Unit cur, nxt; int ui = 0;
    if (!S.next(0, cur)) return;
    f32x4 acc[2][2][4][2];
#pragma unroll
    for (int a = 0; a < 2; ++a)
#pragma unroll
        for (int b = 0; b < 2; ++b)
#pragma unroll
            for (int m = 0; m < 4; ++m)
#pragma unroll
                for (int n = 0; n < 2; ++n) acc[a][b][m][n] = (f32x4){0.f, 0.f, 0.f, 0.f};
    bf16x8 At[4][2], B0[2][2], B1[2][2];
    unsigned c00, c01, c10, c11;
    PG8_OFFS(cur, c00, c01, c10, c11);
    const char* cB = (const char*)Btg + (size_t)cur.bt * tstep;
    PG8_STAGE(PG8_SB(0, 0), cB, voffB); PG8_STAGE(PG8_SB(0, 1), cB + hstep, voffB); PG8_STAGEA(PG8_SA(0, 0), c00, c01, 0); PG8_STAGEA(PG8_SA(0, 1), c10, c11, 0);
    if (wr == 1) PG8_BAR;
    PG8_WAIT_V(2); PG8_BAR;
    PG8_STAGE(PG8_SB(1, 0), cB + kstep, voffB); PG8_STAGEA(PG8_SA(1, 0), c00, c01, kstep); PG8_STAGE(PG8_SB(1, 1), cB + hstep + kstep, voffB);
    PG8_WAIT_V(6); PG8_BAR;
    for (;;) {
        const bool has_next = S.next(ui + 1, nxt);
        const char* nB = has_next ? (const char*)Btg + (size_t)nxt.bt * tstep : cB;
        for (int t = 0; t < nt; t += 2) {
            const bool last = (t == nt - 2);
            const size_t kb1 = (size_t)(t + 1) * kstep;
            const size_t kb2 = last ? 0 : (size_t)(t + 2) * kstep, kb3 = kb2 + kstep;
            const char* b2 = last ? nB : cB + (size_t)(t + 2) * kstep; const char* b3 = b2 + kstep;
            PG8_LDB(B0, 0, 0); PG8_LDB(B1, 0, 1); PG8_SCHED; PG8_LDA(At, 0, 0); PG8_STAGEA(PG8_SA(1, 1), c10, c11, kb1);
            PG8_WAIT_V(8); PG8_WAIT_L(0); PG8_BAR; PG8_MMA(0, 0, At, B0); PG8_MMA(0, 1, At, B1); PG8_BAR; PG8_SCHED;
            if (last && has_next) { PG8_OFFS(nxt, c00, c01, c10, c11); }
            PG8_LDA(At, 0, 1); PG8_STAGE(PG8_SB(0, 0), b2, voffB); PG8_STAGE(PG8_SB(0, 1), b2 + hstep, voffB); PG8_STAGEA(PG8_SA(0, 0), c00, c01, kb2);
            PG8_WAIT_V(8); PG8_WAIT_L(0); PG8_BAR; PG8_MMA(1, 0, At, B0); PG8_MMA(1, 1, At, B1); PG8_BAR; PG8_SCHED;
            PG8_LDB(B0, 1, 0); PG8_LDB(B1, 1, 1); PG8_SCHED; PG8_LDA(At, 1, 0); PG8_STAGEA(PG8_SA(0, 1), c10, c11, kb2);
            PG8_WAIT_V(8); PG8_WAIT_L(0); PG8_BAR; PG8_MMA(0, 0, At, B0); PG8_MMA(0, 1, At, B1); PG8_BAR; PG8_SCHED;
            PG8_LDA(At, 1, 1); PG8_STAGE(PG8_SB(1, 0), b3, voffB); PG8_STAGE(PG8_SB(1, 1), b3 + hstep, voffB); PG8_STAGEA(PG8_SA(1, 0), c00, c01, kb3);
            PG8_WAIT_V(8); PG8_WAIT_L(0); PG8_BAR; PG8_MMA(1, 0, At, B0); PG8_MMA(1, 1, At, B1); PG8_BAR; PG8_SCHED;
        }
        if (wr == 0) PG8_BAR;
        { const int l2 = lane_id(); E(acc, cur, wr, wc, l2 & 15, l2 >> 4); }
        if (!has_next) break;
#pragma unroll
        for (int a = 0; a < 2; ++a)
#pragma unroll
            for (int b = 0; b < 2; ++b)
#pragma unroll
                for (int m = 0; m < 4; ++m)
#pragma unroll
                    for (int n = 0; n < 2; ++n) acc[a][b][m][n] = (f32x4){0.f, 0.f, 0.f, 0.f};
        cur = nxt; cB = nB; ++ui;
        if (wr == 1) PG8_BAR;
    }
    PG8_WAIT_V(0);
    PG8_BAR;
#undef PG8_SA
#undef PG8_SB
#undef PG8_STAGE
#undef PG8_STAGEA
#undef PG8_LDA
#undef PG8_LDB
#undef PG8_MMA
#undef PG8_WAIT_V
#undef PG8_WAIT_L
#undef PG8_BAR
#undef PG8_SCHED
#undef PG8_OFFS
}

struct EpiProj {
    static constexpr bool PERM = true;
    bf16_t* P; const float* rope;
    DI void operator()(const f32x4 (&acc)[2][2][4][2], const Unit& u, int wr, int wc, int fr, int fq) const {
        bf16_t* base = P + (size_t)u.pn * TILE_ELEMS;
        const bool rot = (u.pn < 4) && ((wc & 1) == 0);
#pragma unroll
        for (int ai = 0; ai < 2; ++ai)
#pragma unroll
            for (int m = 0; m < 4; ++m) {
                const int row = u.pm * BM + ai * HALF + wr * 64 + m * 16 + fr;
                asm volatile("" ::: "memory");
                f32x4 cs0 = {1.f, 1.f, 1.f, 1.f}, cs1 = cs0, sn0 = {0.f, 0.f, 0.f, 0.f}, sn1 = sn0;
                if (rot && fq < 2) {
                    const int s = row < TP ? (row & 4095) : (row & 8191);
                    const f32x4* rp = (const f32x4*)(rope + (size_t)s * 16);
                    cs0 = rp[0]; cs1 = rp[1]; sn0 = rp[2]; sn1 = rp[3];
                    if (fq == 0) { sn0 = -sn0; sn1 = -sn1; }
                }
#pragma unroll
                for (int bj = 0; bj < 2; ++bj) {
                    f32x4 v0 = acc[ai][bj][m][0], v1 = acc[ai][bj][m][1];
                    if (rot) {
                        f32x4 o0, o1;
#pragma unroll
                        for (int j = 0; j < 4; ++j) { o0[j] = __shfl_xor(v0[j], 16); o1[j] = __shfl_xor(v1[j], 16); }
                        if (fq < 2) { v0 = v0 * cs0 + o0 * sn0; v1 = v1 * cs1 + o1 * sn1; }
                    }
                    u32x4 w; w.x = pk2(v0[0], v0[1]); w.y = pk2(v0[2], v0[3]); w.z = pk2(v1[0], v1[1]); w.w = pk2(v1[2], v1[3]);
                    *(u32x4*)(base + (size_t)row * 256 + bj * HALF + wc * 32 + 8 * fq) = w;
                }
            }
    }
};
struct EpiOut {
    static constexpr bool PERM = false;
    Params p;
    DI void operator()(const f32x4 (&acc)[2][2][4][2], const Unit& u, int wr, int wc, int fr, int fq) const {
#pragma unroll
        for (int ai = 0; ai < 2; ++ai)
#pragma unroll
            for (int m = 0; m < 4; ++m) {
                const int row = u.pm * BM + ai * HALF + wr * 64 + m * 16 + fr;
                const float* xr = xrow_ptr(p, row); bf16_t* orow = (bf16_t*)(p.ws + WS_H) + (size_t)row * DM;
#pragma unroll
                for (int bj = 0; bj < 2; ++bj)
#pragma unroll
                    for (int n = 0; n < 2; ++n) {
                        const int col = u.pn * BM + bj * HALF + wc * 32 + 16 * n + 4 * fq;
                        const f32x4 xv = *(const f32x4*)(xr + col);
                        const f32x4 hv = xv * ALPHA + acc[ai][bj][m][n];
                        u32x2 w; w.x = pk2(hv[0], hv[1]); w.y = pk2(hv[2], hv[3]); *(u32x2*)(orow + col) = w;
                    }
            }
    }
};
struct EpiGU {
    static constexpr bool PERM = true;
    unsigned char* H;
    DI void operator()(const f32x4 (&acc)[2][2][4][2], const Unit& u, int wr, int wc, int fr, int fq) const {
#pragma unroll
        for (int ai = 0; ai < 2; ++ai)
#pragma unroll
            for (int m = 0; m < 4; ++m) {
                const int row = u.pm * BM + ai * HALF + wr * 64 + m * 16 + fr;
                const f32x4 g0 = acc[ai][0][m][0], g1 = acc[ai][0][m][1], u0 = acc[ai][1][m][0], u1 = acc[ai][1][m][1];
                f32x4 h0, h1;
#pragma unroll
                for (int j = 0; j < 4; ++j) { h0[j] = silu_f(g0[j] * (1.0f / WGU_SCALE)) * (u0[j] * (1.0f / WGU_SCALE)); h1[j] = silu_f(g1[j] * (1.0f / WGU_SCALE)) * (u1[j] * (1.0f / WGU_SCALE)); }
                u32x2 w; w.x = pk4_f8(h0[0], h0[1], h0[2], h0[3]); w.y = pk4_f8(h1[0], h1[1], h1[2], h1[3]);
                *(u32x2*)(H + (size_t)row * FF + u.pn * 128 + wc * 32 + 8 * fq) = w;
            }
    }
};
struct EpiDown {
    static constexpr bool PERM = true;
    unsigned char* eo; const float* gate;
    DI void operator()(const f32x4 (&acc)[2][2][4][2], const Unit& u, int wr, int wc, int fr, int fq) const {
#pragma unroll
        for (int ai = 0; ai < 2; ++ai)
#pragma unroll
            for (int m = 0; m < 4; ++m) {
                const int slot = u.pm * BM + ai * HALF + wr * 64 + m * 16 + fr;
                const float gv = gate[slot] * (EO_SCALE / WD_SCALE);
                unsigned char* orow = eo + (size_t)slot * DM + u.pn * BM + wc * 32 + 8 * fq;
#pragma unroll
                for (int bj = 0; bj < 2; ++bj) {
                    const f32x4 v0 = acc[ai][bj][m][0] * gv, v1 = acc[ai][bj][m][1] * gv;
                    u32x2 w; w.x = pk4_f8(v0[0], v0[1], v0[2], v0[3]); w.y = pk4_f8(v1[0], v1[1], v1[2], v1[3]);
                    *(u32x2*)(orow + bj * HALF) = w;
                }
            }
    }
};
}

DI void transpose_item(const float* W, int ldw, int k0, int n0, bf16_t* WT, int ldt, int drow0, LAS float* scr, int lane) {
#pragma unroll 8
    for (int i = 0; i < 32; ++i) { const int kk = 2 * i + (lane >> 5); scr[kk * 33 + (lane & 31)] = W[(size_t)(k0 + kk) * ldw + n0 + (lane & 31)]; }
    LDS_WAIT();
    const int c = lane & 7;
#pragma unroll
    for (int j = 0; j < 4; ++j) { const int n = (lane >> 3) + 8 * j; const LAS float* s = scr + (8 * c) * 33 + n;
        u32x4 o; o.x = pk2(s[0 * 33], s[1 * 33]); o.y = pk2(s[2 * 33], s[3 * 33]); o.z = pk2(s[4 * 33], s[5 * 33]); o.w = pk2(s[6 * 33], s[7 * 33]);
        *(u32x4*)(WT + (size_t)(drow0 + n) * ldt + k0 + 8 * c) = o; }
    LDS_WAIT();
}

DI void transpose_item_f8(const float* W, int ldw, int k0, int n0, unsigned char* WT, int ldt, int drow0, float scale, LAS float* scr, int lane) {
#pragma unroll 8
    for (int i = 0; i < 32; ++i) { const int kk = 2 * i + (lane >> 5); scr[kk * 33 + (lane & 31)] = W[(size_t)(k0 + kk) * ldw + n0 + (lane & 31)] * scale; }
    LDS_WAIT();
    const int c = lane & 7;
#pragma unroll
    for (int j = 0; j < 4; ++j) { const int n = (lane >> 3) + 8 * j; const LAS float* sp = scr + (8 * c) * 33 + n;
        u32x2 o; o.x = pk4_f8(sp[0 * 33], sp[1 * 33], sp[2 * 33], sp[3 * 33]); o.y = pk4_f8(sp[4 * 33], sp[5 * 33], sp[6 * 33], sp[7 * 33]);
        *(u32x2*)(WT + (size_t)(drow0 + n) * ldt + k0 + 8 * c) = o; }
    LDS_WAIT();
}

DI void sincos_small(double r, double& s, double& c) {
    const double r2 = r * r; double ss = 1.0, cc = 1.0;
#pragma unroll
    for (int n = 12; n >= 1; --n) { ss = 1.0 - ss * r2 * (1.0 / (double)((2 * n) * (2 * n + 1))); cc = 1.0 - cc * r2 * (1.0 / (double)((2 * n - 1) * (2 * n))); }
    s = r * ss; c = cc;
}

DI void dot16(const f32x4 (&v)[4], const LAS float* wT, int lane, float (&r)[16]) {
#pragma unroll
    for (int e = 0; e < 16; ++e) {
        float a = 0.f;
        if ((e & 1) == 0) asm volatile("" ::: "memory");
#pragma unroll
        for (int j = 0; j < 4; ++j) { const f32x4 w = *(const LAS f32x4*)(wT + e * 1024 + 256 * j + 4 * lane); a += v[j][0] * w[0] + v[j][1] * w[1] + v[j][2] * w[2] + v[j][3] * w[3]; }
        r[e] = wave_sum(a);
    }
}

DI int ecol(int lane) { return ((lane & 1) << 3) | ((lane & 2) << 1) | ((lane & 4) >> 1) | ((lane & 8) >> 3); }
DI float treduce16(float (&a)[16], int lane) {
#pragma unroll
    for (int k = 0; k < 4; ++k) {
        const int n2 = 8 >> k; const bool bit = (lane >> k) & 1;
#pragma unroll
        for (int i = 0; i < 8; ++i) if (i < n2) { const float lo = a[i], hi = a[i + n2]; const float send = bit ? lo : hi, keep = bit ? hi : lo; a[i] = keep + __shfl_xor(send, 1 << k); }
    }
    float r = a[0]; r += __shfl_xor(r, 16); r += __shfl_xor(r, 32);
    return r;
}
DI void dot16x2(const f32x4 (&va)[4], const f32x4 (&vb)[4], const LAS float* wT, int lane, float& ra, float& rb) {
    float a[16], b[16];
#pragma unroll
    for (int e = 0; e < 16; ++e) {
        float x = 0.f, y = 0.f;
        asm volatile("" ::: "memory");
#pragma unroll
        for (int j = 0; j < 4; ++j) { const f32x4 w = *(const LAS f32x4*)(wT + e * 1024 + 256 * j + 4 * lane);
            x += va[j][0] * w[0] + va[j][1] * w[1] + va[j][2] * w[2] + va[j][3] * w[3]; y += vb[j][0] * w[0] + vb[j][1] * w[1] + vb[j][2] * w[2] + vb[j][3] * w[3]; }
        a[e] = x; b[e] = y;
    }
    ra = treduce16(a, lane); rb = treduce16(b, lane);
}

DI void phase0(const Params& p, LAS unsigned char* lds, int gw, int NGW, int wave, int lane) {
    const int tid = TIDX(wave);
    {
        LAS float* scr = (LAS float*)(lds + wave * 16384);
        for (int it = gw; it < 2048; it += NGW) {
            if (it < 1536) { const int kb = it / 96, nb = it % 96; transpose_item(p.in[2], INW, 64 * kb, 32 * nb, (bf16_t*)(p.ws + WS_WI), DM, 32 * nb, scr, lane); }
            else { const int r = it - 1536, kb = r / 32, nb = r % 32; transpose_item(p.in[9], DM, 64 * kb, 32 * nb, (bf16_t*)(p.ws + WS_WO), DM, 32 * nb, scr, lane); }
        }
    }
    {
        float* rope = (float*)(p.ws + WS_ROPE);
        const float invf[8] = {1.0f, 0.1939227432012558f, 0.03760603070259094f, 0.007292664609849453f, 0.0014142135623842478f, 0.00027424818836152554f, 5.318296098266728e-05f, 1.0313386155758053e-05f};
        for (int id = blockIdx.x * NTHR + tid; id < 8192 * 8; id += gridDim.x * NTHR) {
            const int pos = id >> 3, i = id & 7;
            float inv = invf[0];
#pragma unroll
            for (int k = 1; k < 8; ++k) inv = (i == k) ? invf[k] : inv;
            const float ang = (float)pos * inv;
            const double x = (double)ang; const double kq = rint(x * 0.15915494309189535); const double r = x - kq * 6.283185307179586476925;
            double s, c; sincos_small(r, s, c);
            rope[pos * 16 + i] = (float)c; rope[pos * 16 + 8 + i] = (float)s;
        }
    }
    __syncthreads();
    LAS float* wT = (LAS float*)lds;
    for (int id = tid; id < 16384; id += NTHR) { const int k = id >> 4, e = id & 15; wT[e * 1024 + k] = p.in[2][(size_t)k * INW + 3072 + e]; }
    __syncthreads();
    const float* dtb = p.in[5];
    const int ec = ecol(lane);
    const float bias = dtb[ec];
    bf16_t* xb = (bf16_t*)(p.ws + WS_XB); float* dtout = (float*)(p.ws + WS_DT);
#pragma unroll 2
    for (int t = gw; t < TT; t += 2 * NGW) {
        const int t2 = (t + NGW < TT) ? t + NGW : t;
        const f32x4* xra = (const f32x4*)xrow_ptr(p, t) + lane; const f32x4* xrb = (const f32x4*)xrow_ptr(p, t2) + lane;
        f32x4 va[4], vb[4];
#pragma unroll
        for (int j = 0; j < 4; ++j) { va[j] = xra[64 * j]; vb[j] = xrb[64 * j]; }
        u32x2* oa = (u32x2*)(xb + (size_t)t * DM) + lane; u32x2* ob = (u32x2*)(xb + (size_t)t2 * DM) + lane;
#pragma unroll
        for (int j = 0; j < 4; ++j) { u32x2 w; w.x = pk2(va[j][0], va[j][1]); w.y = pk2(va[j][2], va[j][3]); oa[64 * j] = w; w.x = pk2(vb[j][0], vb[j][1]); w.y = pk2(vb[j][2], vb[j][3]); ob[64 * j] = w; }
        float ra, rb; dot16x2(va, vb, wT, lane, ra, rb);
        if (lane < 16) { const float za = ra + bias, zb = rb + bias;
            dtout[(size_t)t * 16 + ec] = fmaxf(za, 0.f) + log1pf(__expf(-fabsf(za))); dtout[(size_t)t2 * 16 + ec] = fmaxf(zb, 0.f) + log1pf(__expf(-fabsf(zb))); }
    }
}

DI void conv_phase(const Params& p, int wave) {
    const int tid = blockIdx.x * NTHR + TIDX(wave), nthr = gridDim.x * NTHR;
    const int c = tid & 127, ch = 8 * c, tile = ch >> 8, cit = ch & 255;
    const float* cw = p.in[3]; const float* cb = p.in[4];
    float w[5][8], b[8];
#pragma unroll
    for (int j = 0; j < 5; ++j)
#pragma unroll
        for (int e = 0; e < 8; ++e) w[j][e] = cw[j * 1024 + ch + e];
#pragma unroll
    for (int e = 0; e < 8; ++e) b[e] = cb[ch + e];
    const bf16_t* src = (const bf16_t*)(p.ws + WS_P) + (size_t)(8 + tile) * TILE_ELEMS + cit;
    bf16_t* dst = (bf16_t*)(p.ws + WS_XC) + (size_t)tile * TILE_ELEMS + cit;
    const int seg = tid >> 7, nseg = nthr >> 7, L = (TT + nseg - 1) / nseg;
    const int t0 = seg * L, t1 = (t0 + L < TT) ? t0 + L : TT;
    if (t0 >= t1) return;
#define CONV_ROW(tt) (((tt) >= 0 && (tt) < TT) ? *(const u32x4*)(src + (size_t)(tt) * 256) : (u32x4){0u, 0u, 0u, 0u})
    u32x4 r0 = CONV_ROW(t0 - 2), r1 = CONV_ROW(t0 - 1), r2 = CONV_ROW(t0), r3 = CONV_ROW(t0 + 1), r4 = CONV_ROW(t0 + 2);
#pragma unroll 4
    for (int t = t0; t < t1; ++t) {
        const u32x4 rn = CONV_ROW(t + 3);
        const int S = t < TP ? 4096 : 8192, s = t & (S - 1);
        float a[8];
#pragma unroll
        for (int e = 0; e < 8; ++e) a[e] = b[e];
        const u32x4 rows[5] = {r0, r1, r2, r3, r4};
#pragma unroll
        for (int j = 0; j < 5; ++j) {
            const int sj = s + j - 2;
            if (sj >= 0 && sj < S) {
                const u32x4 v = rows[j];
                a[0] += bflo(v.x) * w[j][0]; a[1] += bfhi(v.x) * w[j][1]; a[2] += bflo(v.y) * w[j][2]; a[3] += bfhi(v.y) * w[j][3];
                a[4] += bflo(v.z) * w[j][4]; a[5] += bfhi(v.z) * w[j][5]; a[6] += bflo(v.w) * w[j][6]; a[7] += bfhi(v.w) * w[j][7];
            }
        }
        u32x4 o; o.x = pk2(silu_f(a[0]), silu_f(a[1])); o.y = pk2(silu_f(a[2]), silu_f(a[3])); o.z = pk2(silu_f(a[4]), silu_f(a[5])); o.w = pk2(silu_f(a[6]), silu_f(a[7]));
        *(u32x4*)(dst + (size_t)t * 256) = o;
        r0 = r1; r1 = r2; r2 = r3; r3 = r4; r4 = rn;
    }
#undef CONV_ROW
}

DI bf16x8 tr_pair(const LAS bf16_t* lo, const LAS bf16_t* hi) {
    const s16x4 a = __builtin_amdgcn_ds_read_tr16_b64_v4i16((LAS s16x4*)lo), b = __builtin_amdgcn_ds_read_tr16_b64_v4i16((LAS s16x4*)hi);
    return __builtin_shufflevector(a, b, 0, 1, 2, 3, 4, 5, 6, 7);
}
DI void attn_step_params(int sidx, int p0, int& d, int& base, int& nk, int& kbase, bool& actA, bool& actB) {
    const int pi = sidx < 12 ? 0 : (sidx < 18 ? 1 : 2);
    const int st = sidx - (pi == 0 ? 0 : (pi == 1 ? 12 : (sidx < 23 ? 18 : 23)));
    d = 1 << (2 * pi); base = p0 - 64 * d + (sidx >= 23 ? 8 : 0); nk = pi == 0 ? 377 : (pi == 1 ? 191 : 144); kbase = 32 * st;
    actA = sidx < 23; actB = sidx < 18 || sidx >= 23;
}
DI void attn_phase(const Params& p, LAS unsigned char* lds, int gw, int NGW, int wave, int lane) {
    LAS bf16_t* Vn0 = (LAS bf16_t*)(lds + wave * 9216);
    const bf16_t* Pb = (const bf16_t*)(p.ws + WS_P);
    bf16_t* mix = (bf16_t*)(p.ws + WS_MIX);
    const int c = lane & 15, q = lane >> 4, qp = (lane & 15) >> 2, pp = lane & 3;
    for (int wi = gw; wi < 12288; wi += NGW) {
        const int head = wi & 7, qg = wi >> 3;
        const int t0 = (qg >> 3) * 256 + (qg & 7);
        const int S = t0 < TP ? 4096 : 8192, sbase = t0 & ~(S - 1), p0 = t0 - sbase;
        const int hoff = (head & 3) * 64;
        const bf16_t* Qt = Pb + (size_t)(0 + (head >> 2)) * TILE_ELEMS + hoff;
        const bf16_t* Kt = Pb + (size_t)(2 + (head >> 2)) * TILE_ELEMS + hoff;
        const bf16_t* Vg = Pb + (size_t)(4 + (head >> 2)) * TILE_ELEMS + hoff;
        bf16x8 qf[2][2];
#pragma unroll
        for (int X = 0; X < 2; ++X) { const bf16_t* qrow = Qt + (size_t)(t0 + 8 * X + 16 * c) * 256;
#pragma unroll
            for (int ks = 0; ks < 2; ++ks) {
                const u32x4 w = *(const u32x4*)(qrow + 32 * ks + 8 * q); constexpr float QS = 0.125f * 1.4426950408889634f;
                u32x4 o; o.x = pk2(bflo(w.x) * QS, bfhi(w.x) * QS); o.y = pk2(bflo(w.y) * QS, bfhi(w.y) * QS); o.z = pk2(bflo(w.z) * QS, bfhi(w.z) * QS); o.w = pk2(bflo(w.w) * QS, bfhi(w.w) * QS);
                qf[X][ks] = __builtin_bit_cast(bf16x8, o); } }
        f32x4 O[2][4];
#pragma unroll
        for (int X = 0; X < 2; ++X)
#pragma unroll
            for (int d4 = 0; d4 < 4; ++d4) O[X][d4] = (f32x4){0.f, 0.f, 0.f, 0.f};
        float mrun[2] = {-1e30f, -1e30f}, lsum[2] = {0.f, 0.f};
        u32x4 vb[3][4]; bf16x8 kb[3][2][2];
#define ATT_LOADS(sidx_, V_, K_) do { int d_, base_, nk_, kbase_; bool a_, b_; attn_step_params(sidx_, p0, d_, base_, nk_, kbase_, a_, b_); \
            _Pragma("unroll") for (int i = 0; i < 4; ++i) { const int id = lane + 64 * i, key = id >> 3, dc = id & 7; \
                int pos = base_ + d_ * (kbase_ + key); pos = pos < 0 ? 0 : (pos > S - 1 ? S - 1 : pos); \
                V_[i] = *(const u32x4*)(Vg + (size_t)(sbase + pos) * 256 + 8 * dc); } \
            _Pragma("unroll") for (int kt = 0; kt < 2; ++kt) { int pos = base_ + d_ * (kbase_ + 16 * kt + c); pos = pos < 0 ? 0 : (pos > S - 1 ? S - 1 : pos); \
                const bf16_t* krow = Kt + (size_t)(sbase + pos) * 256; K_[kt][0] = *(const bf16x8*)(krow + 8 * q); K_[kt][1] = *(const bf16x8*)(krow + 32 + 8 * q); } } while (0)
        ATT_LOADS(0, vb[0], kb[0]);
        ATT_LOADS(1, vb[1], kb[1]);
#pragma unroll
        for (int i = 0; i < 4; ++i) { const int id = lane + 64 * i; *(LAS u32x4*)(Vn0 + (id >> 3) * 72 + 8 * (id & 7)) = vb[0][i]; }
#pragma unroll
        for (int s3 = 0; s3 < 30; s3 += 3) {
#pragma unroll
          for (int u = 0; u < 3; ++u) {
            const int sidx = s3 + u;
            if (sidx + 2 < 28) ATT_LOADS(sidx + 2, vb[(u + 2) % 3], kb[(u + 2) % 3]);
            if (sidx < 28) {
            int d, base, nk, kbase; bool act[2]; attn_step_params(sidx, p0, d, base, nk, kbase, act[0], act[1]);
            const int win = 64 * d;
            bf16x8 vf[4];
            { const LAS bf16_t* Vn = Vn0 + (sidx & 1) * 2304;
#pragma unroll
              for (int d4 = 0; d4 < 4; ++d4) { const LAS bf16_t* vr = Vn + (4 * q + qp) * 72 + 16 * d4 + 4 * pp; vf[d4] = tr_pair(vr, vr + 16 * 72); } }
            if (sidx + 1 < 28) { LAS bf16_t* Vw = Vn0 + ((sidx + 1) & 1) * 2304;
#pragma unroll
              for (int i = 0; i < 4; ++i) { const int id = lane + 64 * i; *(LAS u32x4*)(Vw + (id >> 3) * 72 + 8 * (id & 7)) = vb[(u + 1) % 3][i]; } }
            f32x4 sc[2][2];
#pragma unroll
            for (int X = 0; X < 2; ++X)
#pragma unroll
                for (int kt = 0; kt < 2; ++kt) {
                    f32x4 a = {0.f, 0.f, 0.f, 0.f};
                    a = __builtin_amdgcn_mfma_f32_16x16x32_bf16(kb[u][kt][0], qf[X][0], a, 0, 0, 0);
                    a = __builtin_amdgcn_mfma_f32_16x16x32_bf16(kb[u][kt][1], qf[X][1], a, 0, 0, 0);
                    sc[X][kt] = a;
                }
            const int sh = d == 1 ? 0 : (d == 4 ? 2 : 4);
            int rr[2]; unsigned rng[2];
#pragma unroll
            for (int X = 0; X < 2; ++X) {
                const int pq = p0 + 8 * X + 16 * c;
                const int nb = base < 0 ? -base : 0;
                int klo = (pq - win - base) >> sh; const int k2 = (nb + d - 1) >> sh; klo = klo > k2 ? klo : k2;
                int khi = (pq + win - base) >> sh; const int k3 = (S - 1 - base) >> sh; khi = khi < k3 ? khi : k3; khi = khi < nk - 1 ? khi : nk - 1;
                if (!act[X]) { klo = 1 << 20; khi = klo; }
                rr[X] = kbase + 4 * q - klo; rng[X] = (unsigned)(khi - klo);
            }
            bool valid[2][2][4]; float mloc[2];
#pragma unroll
            for (int X = 0; X < 2; ++X) {
                float m = -1e30f;
#pragma unroll
                for (int kt = 0; kt < 2; ++kt)
#pragma unroll
                    for (int j = 0; j < 4; ++j) {
                        valid[X][kt][j] = (unsigned)(rr[X] + 16 * kt + j) <= rng[X];
                        const float sv = valid[X][kt][j] ? sc[X][kt][j] : -1e30f;
                        sc[X][kt][j] = sv; m = fmaxf(m, sv);
                    }
                mloc[X] = m;
            }
#pragma unroll
            for (int X = 0; X < 2; ++X) {
                const u32x2 r = __builtin_amdgcn_permlane32_swap(__float_as_uint(mloc[X]), __float_as_uint(mloc[X]), false, false);
                mloc[X] = fmaxf(fmaxf(mloc[X], __uint_as_float(r[0])), __uint_as_float(r[1]));
            }
#pragma unroll
            for (int X = 0; X < 2; ++X) {
                const u32x2 r = __builtin_amdgcn_permlane16_swap(__float_as_uint(mloc[X]), __float_as_uint(mloc[X]), false, false);
                mloc[X] = fmaxf(fmaxf(mloc[X], __uint_as_float(r[0])), __uint_as_float(r[1]));
            }
            float alpha[2]; bf16x8 pf[2];
#pragma unroll
            for (int X = 0; X < 2; ++X) {
                const float mnew = fmaxf(mrun[X], mloc[X]); alpha[X] = __builtin_amdgcn_exp2f(mrun[X] - mnew); mrun[X] = mnew;
                float ps = 0.f; float pv[2][4];
#pragma unroll
                for (int kt = 0; kt < 2; ++kt)
#pragma unroll
                    for (int j = 0; j < 4; ++j) { pv[kt][j] = valid[X][kt][j] ? __builtin_amdgcn_exp2f(sc[X][kt][j] - mnew) : 0.f; ps += pv[kt][j]; }
                lsum[X] = lsum[X] * alpha[X] + ps;
                u32x4 pw; pw.x = pk2(pv[0][0], pv[0][1]); pw.y = pk2(pv[0][2], pv[0][3]); pw.z = pk2(pv[1][0], pv[1][1]); pw.w = pk2(pv[1][2], pv[1][3]);
                pf[X] = __builtin_bit_cast(bf16x8, pw);
            }
#pragma unroll
            for (int d4 = 0; d4 < 4; ++d4)
#pragma unroll
                for (int X = 0; X < 2; ++X) O[X][d4] = __builtin_amdgcn_mfma_f32_16x16x32_bf16(vf[d4], pf[X], O[X][d4] * alpha[X], 0, 0, 0);
            }
          }
        }
#undef ATT_LOADS
#pragma unroll
        for (int X = 0; X < 2; ++X) {
            float l = lsum[X]; l += __shfl_xor(l, 16); l += __shfl_xor(l, 32);
            const float inv = 1.0f / l;
            bf16_t* orow = mix + (size_t)(t0 + 8 * X + 16 * c) * DM + head * 64 + 4 * q;
#pragma unroll
            for (int d4 = 0; d4 < 4; ++d4) { u32x2 w; w.x = pk2(O[X][d4][0] * inv, O[X][d4][1] * inv); w.y = pk2(O[X][d4][2] * inv, O[X][d4][3] * inv); *(u32x2*)(orow + 16 * d4) = w; }
        }
    }
}

constexpr size_t WS_SLOC = WS_P;
constexpr size_t WS_DEC = WS_P + 96 * MiB;
constexpr int N_SSD_ITEMS = 6144;
constexpr int N_SSD_UNITS = 3072;
struct SsdUnit { int h, g, tok0, itf, itb; float Af, Ab; };
DI SsdUnit ssd_decode(const Params& p, int u) {
    SsdUnit I; const int cg = u >> 3; I.h = u & 7; I.g = I.h >> 2; I.tok0 = cg * 128;
    int seq, cn, nc; if (cg < 256) { seq = cg >> 5; cn = cg & 31; nc = 32; } else { seq = 8 + ((cg - 256) >> 6); cn = (cg - 256) & 63; nc = 64; }
    const int wf = seq * 16 + I.h * 2, wb = wf + 1;
    I.itf = (wf < 128 ? 32 * wf : 4096 + 64 * (wf - 128)) + cn;
    I.itb = (wb < 128 ? 32 * wb : 4096 + 64 * (wb - 128)) + (nc - 1 - cn);
    I.Af = -__expf(p.in[6][I.h]); I.Ab = -__expf(p.in[6][8 + I.h]);
    return I;
}
DI void ssd_scan_chunk2(float f0, float f1, float b0, float b1, float Af, float Ab, LAS float* acsf, LAS float* acsb, LAS float* dtsf, LAS float* dtsb, int lane) {
    const float v0 = f0 * Af, v1 = f1 * Af; float ps = v0 + v1;
    const float w0 = b0 * Ab, w1 = b1 * Ab; float qs = w0 + w1;
#pragma unroll
    for (int o = 1; o < 64; o <<= 1) { const float t = __shfl_up(ps, o); const float t2 = __shfl_down(qs, o); if (lane >= o) ps += t; if (lane + o < 64) qs += t2; }
    acsf[2 * lane] = ps - v1; acsf[2 * lane + 1] = ps; acsb[2 * lane] = qs; acsb[2 * lane + 1] = qs - w0;
    dtsf[2 * lane] = f0; dtsf[2 * lane + 1] = f1; dtsb[2 * lane] = b0; dtsb[2 * lane + 1] = b1;
}
DI u32x4 scale8(const u32x4 v, float sc) { u32x4 o; o.x = pk2(bflo(v.x) * sc, bfhi(v.x) * sc); o.y = pk2(bflo(v.y) * sc, bfhi(v.y) * sc); o.z = pk2(bflo(v.z) * sc, bfhi(v.z) * sc); o.w = pk2(bflo(v.w) * sc, bfhi(v.w) * sc); return o; }
DI void ssd_state_phase(const Params& p, LAS unsigned char* lds, int wave, int lane) {
    const int tid = TIDX(wave), c = lane & 15, q = lane >> 4, w = wave, qp = (lane & 15) >> 2, pp = lane & 3;
    LAS float* acsf = (LAS float*)(lds + 0); LAS float* acsb = (LAS float*)(lds + 512); LAS float* dtsf = (LAS float*)(lds + 1024); LAS float* dtsb = (LAS float*)(lds + 1536);
    LAS bf16_t* Xf = (LAS bf16_t*)(lds + 2048); LAS bf16_t* Xb = (LAS bf16_t*)(lds + 2048 + 18432); LAS bf16_t* Bn = (LAS bf16_t*)(lds + 2048 + 2 * 18432);
    const float* dtb = (const float*)(p.ws + WS_DT);
    const bf16_t* XCb = (const bf16_t*)(p.ws + WS_XC);
    bf16_t* Sl = (bf16_t*)(p.ws + WS_SLOC); float* decv = (float*)(p.ws + WS_DEC);
    const int vcu0 = (gridDim.x % 8 == 0) ? ((int)blockIdx.x % 8) * ((int)gridDim.x / 8) + (int)blockIdx.x / 8 : (int)blockIdx.x;
#define SSD_UNIT_OFA(s_) ([&]{ const int cgi_ = vcu0 + (int)gridDim.x * ((s_) >> 2); return cgi_ < 768 ? ((cgi_ >> 1) * 8 + (cgi_ & 1) * 4 + ((s_) & 3)) : -1; }())
    int st_ = 0;
    int it = SSD_UNIT_OFA(0);
    if (it < 0) return;
    SsdUnit I = ssd_decode(p, it);
    float pf0 = 0.f, pf1 = 0.f, pb0 = 0.f, pb1 = 0.f; u32x4 xv[2], bv[4];
    bf16x8 bfr[4];
#define SSD_LOADS_A(I, fresh_) do { \
        if (w == 0) { const float* d_ = dtb + (size_t)((I).tok0 + 2 * lane) * 16 + (I).h; pf0 = d_[0]; pb0 = d_[8]; pf1 = d_[16]; pb1 = d_[24]; } \
        _Pragma("unroll") for (int i = 0; i < 2; ++i) { const int id = tid + NTHR * i, l = id >> 3, pc = id & 7; \
            xv[i] = *(const u32x4*)(XCb + (size_t)((I).h >> 2) * TILE_ELEMS + (size_t)((I).tok0 + l) * 256 + ((I).h & 3) * 64 + 8 * pc); } \
        if (fresh_) { _Pragma("unroll") for (int i = 0; i < 4; ++i) { const int id = tid + NTHR * i, l = id >> 4, ncn = id & 15; \
            bv[i] = *(const u32x4*)(XCb + 2 * TILE_ELEMS + (size_t)((I).tok0 + l) * 256 + (I).g * 128 + 8 * ncn); } } } while (0)
    SSD_LOADS_A(I, true);
    for (; it >= 0; ) {
        const bool fresh = (st_ & 3) == 0;
        if (w == 0) ssd_scan_chunk2(pf0, pf1, pb0, pb1, I.Af, I.Ab, acsf, acsb, dtsf, dtsb, lane);
        LDS_BARRIER();
        const float aendf = acsf[127], aendb = acsb[0];
#pragma unroll
        for (int i = 0; i < 2; ++i) {
            const int id = tid + NTHR * i, l = id >> 3, pc = id & 7;
            *(LAS u32x4*)(Xf + l * 72 + 8 * pc) = scale8(xv[i], dtsf[l] * __expf(aendf - acsf[l]));
            *(LAS u32x4*)(Xb + l * 72 + 8 * pc) = scale8(xv[i], dtsb[l] * __expf(aendb - acsb[l]));
        }
        if (fresh) {
#pragma unroll
            for (int i = 0; i < 4; ++i) { const int id = tid + NTHR * i; *(LAS u32x4*)(Bn + (id >> 4) * 136 + 8 * (id & 15)) = bv[i]; }
        }
        const int itf = I.itf, itb = I.itb;
        ++st_;
        it = SSD_UNIT_OFA(st_);
        if (it >= 0) { I = ssd_decode(p, it); SSD_LOADS_A(I, (st_ & 3) == 0); }
        LDS_BARRIER();
        if (fresh) {
#pragma unroll
            for (int ks = 0; ks < 4; ++ks) { const LAS bf16_t* br = Bn + (32 * ks + 8 * q + qp) * 136 + 16 * w + 4 * pp; bfr[ks] = tr_pair(br, br + 4 * 136); }
        }
        bf16_t* sof = Sl + (size_t)itf * 8192 + 16 * w + 4 * q; bf16_t* sob = Sl + (size_t)itb * 8192 + 16 * w + 4 * q;
#pragma unroll
        for (int pt = 0; pt < 4; ++pt) {
            f32x4 af = {0.f, 0.f, 0.f, 0.f}, ab = {0.f, 0.f, 0.f, 0.f};
#pragma unroll
            for (int ks = 0; ks < 4; ++ks) {
                const LAS bf16_t* xrf = Xf + (32 * ks + 8 * q + qp) * 72 + 16 * pt + 4 * pp;
                const LAS bf16_t* xrb = Xb + (32 * ks + 8 * q + qp) * 72 + 16 * pt + 4 * pp;
                af = __builtin_amdgcn_mfma_f32_16x16x32_bf16(bfr[ks], tr_pair(xrf, xrf + 4 * 72), af, 0, 0, 0);
                ab = __builtin_amdgcn_mfma_f32_16x16x32_bf16(bfr[ks], tr_pair(xrb, xrb + 4 * 72), ab, 0, 0, 0);
            }
            u32x2 o; o.x = pk2(af[0], af[1]); o.y = pk2(af[2], af[3]); *(u32x2*)(sof + (16 * pt + c) * 128) = o;
            o.x = pk2(ab[0], ab[1]); o.y = pk2(ab[2], ab[3]); *(u32x2*)(sob + (16 * pt + c) * 128) = o;
        }
        if (tid == 0) { decv[itf] = __expf(aendf); decv[itb] = __expf(aendb); }
    }
#undef SSD_LOADS_A
#undef SSD_UNIT_OFA
}
DI void ssd_scan_phase(const Params& p, int wave) {
    unsigned* Sl = (unsigned*)(p.ws + WS_SLOC); const float* decv = (const float*)(p.ws + WS_DEC);
    for (int chain = blockIdx.x * NTHR + TIDX(wave); chain < 160 * 4096; chain += gridDim.x * NTHR) {
        const int w = chain >> 12, j = chain & 4095;
        const int nc = w < 128 ? 32 : 64, cb = w < 128 ? 32 * w : 4096 + 64 * (w - 128);
        unsigned* ptr = Sl + (size_t)cb * 4096 + j; const float* dp = decv + cb;
        float s0 = 0.f, s1 = 0.f;
        for (int c0 = 0; c0 < nc; c0 += 8) {
            unsigned v[8]; float d[8];
#pragma unroll
            for (int k = 0; k < 8; ++k) { v[k] = ptr[(size_t)(c0 + k) * 4096]; d[k] = dp[c0 + k]; }
#pragma unroll
            for (int k = 0; k < 8; ++k) { ptr[(size_t)(c0 + k) * 4096] = pk2(s0, s1); s0 = s0 * d[k] + bflo(v[k]); s1 = s1 * d[k] + bfhi(v[k]); }
        }
    }
}
constexpr int SSDC_XF = 4096, SSDC_XB = SSDC_XF + 18432, SSDC_BN = SSDC_XB + 18432, SSDC_SF = SSDC_BN + 128 * 272, SSDC_SB = SSDC_SF + 64 * 272, SSDC_END = SSDC_SB + 64 * 272;
static_assert(SSDC_END <= 131072, "ssd lds");
DI void ssd_out_phase(const Params& p, LAS unsigned char* lds, int wave, int lane) {
    const int tid = TIDX(wave), c = lane & 15, q = lane >> 4, w = wave, qp = (lane & 15) >> 2, pp = lane & 3;
    LAS bf16_t* Xf = (LAS bf16_t*)(lds + SSDC_XF); LAS bf16_t* Xb = (LAS bf16_t*)(lds + SSDC_XB); LAS bf16_t* Bn = (LAS bf16_t*)(lds + SSDC_BN);
    LAS bf16_t* Sf = (LAS bf16_t*)(lds + SSDC_SF); LAS bf16_t* Sb = (LAS bf16_t*)(lds + SSDC_SB);
    const float* dtb = (const float*)(p.ws + WS_DT);
    const bf16_t* XCb = (const bf16_t*)(p.ws + WS_XC);
    const bf16_t* Sl = (const bf16_t*)(p.ws + WS_SLOC);
    const int vcu0 = (gridDim.x % 8 == 0) ? ((int)blockIdx.x % 8) * ((int)gridDim.x / 8) + (int)blockIdx.x / 8 : (int)blockIdx.x;
#define SSD_UNIT_OF(s_) ([&]{ const int cgi_ = vcu0 + (int)gridDim.x * ((s_) >> 2); return cgi_ < 768 ? ((cgi_ >> 1) * 8 + (cgi_ & 1) * 4 + ((s_) & 3)) : -1; }())
    int st_ = 0;
    int it = SSD_UNIT_OF(0);
    if (it < 0) return;
    SsdUnit I = ssd_decode(p, it);
    float pf0 = 0.f, pf1 = 0.f, pb0 = 0.f, pb1 = 0.f; u32x4 xv[2], bv[4], svf[2], svb[2]; bf16x8 Cn[4];
    bf16x8 Cf[4]; f32x4 Gt[8];
#define SSD_LOADS_C(I, fresh_) do { \
        if (w == 0) { const float* d_ = dtb + (size_t)((I).tok0 + 2 * lane) * 16 + (I).h; pf0 = d_[0]; pb0 = d_[8]; pf1 = d_[16]; pb1 = d_[24]; } \
        _Pragma("unroll") for (int i = 0; i < 2; ++i) { const int id = tid + NTHR * i, l = id >> 3, pc = id & 7; \
            xv[i] = *(const u32x4*)(XCb + (size_t)((I).h >> 2) * TILE_ELEMS + (size_t)((I).tok0 + l) * 256 + ((I).h & 3) * 64 + 8 * pc); \
            svf[i] = *(const u32x4*)(Sl + (size_t)(I).itf * 8192 + (size_t)id * 8); svb[i] = *(const u32x4*)(Sl + (size_t)(I).itb * 8192 + (size_t)id * 8); } \
        if (fresh_) { \
        _Pragma("unroll") for (int i = 0; i < 4; ++i) { const int id = tid + NTHR * i, l = id >> 4, ncn = id & 15; \
            bv[i] = *(const u32x4*)(XCb + 2 * TILE_ELEMS + (size_t)((I).tok0 + l) * 256 + (I).g * 128 + 8 * ncn); } \
        { const bf16_t* cr = XCb + 3 * TILE_ELEMS + (size_t)((I).tok0 + 16 * w + c) * 256 + (I).g * 128 + 8 * q; \
          _Pragma("unroll") for (int ks = 0; ks < 4; ++ks) Cn[ks] = *(const bf16x8*)(cr + 32 * ks); } } } while (0)
    SSD_LOADS_C(I, true);
    int par = 0;
    for (; it >= 0; par ^= 1) {
        const bool fresh = (st_ & 3) == 0;
        LAS float* acsf = (LAS float*)(lds + par * 2048); LAS float* acsb = acsf + 128; LAS float* dtsf = acsf + 256; LAS float* dtsb = acsf + 384;
        if (w == 0) ssd_scan_chunk2(pf0, pf1, pb0, pb1, I.Af, I.Ab, acsf, acsb, dtsf, dtsb, lane);
        LDS_BARRIER();
#pragma unroll
        for (int i = 0; i < 2; ++i) {
            const int id = tid + NTHR * i, l = id >> 3, pc = id & 7;
            *(LAS u32x4*)(Xf + l * 72 + 8 * pc) = scale8(xv[i], dtsf[l]);
            *(LAS u32x4*)(Xb + l * 72 + 8 * pc) = scale8(xv[i], dtsb[l]);
            *(LAS u32x4*)(Sf + (id >> 4) * 136 + 8 * (id & 15)) = svf[i];
            *(LAS u32x4*)(Sb + (id >> 4) * 136 + 8 * (id & 15)) = svb[i];
        }
        if (fresh) {
#pragma unroll
            for (int i = 0; i < 4; ++i) { const int id = tid + NTHR * i; *(LAS u32x4*)(Bn + (id >> 4) * 136 + 8 * (id & 15)) = bv[i]; }
#pragma unroll
            for (int ks = 0; ks < 4; ++ks) Cf[ks] = Cn[ks];
        }
        const int tok0 = I.tok0, hh = I.h;
        ++st_;
        it = SSD_UNIT_OF(st_);
        if (it >= 0) { I = ssd_decode(p, it); SSD_LOADS_C(I, (st_ & 3) == 0); }
        LDS_BARRIER();
        if (fresh) {
#pragma unroll
            for (int stt = 0; stt < 8; ++stt) { f32x4 G = {0.f, 0.f, 0.f, 0.f};
#pragma unroll
                for (int ks = 0; ks < 4; ++ks) G = __builtin_amdgcn_mfma_f32_16x16x32_bf16(*(const LAS bf16x8*)(Bn + (16 * stt + c) * 136 + 32 * ks + 8 * q), Cf[ks], G, 0, 0, 0);
                Gt[stt] = G; }
        }
        {
            const int l = 16 * w + c;
            const float alf = acsf[l], alb = acsb[l];
            f32x4 accf[4], accb[4];
#pragma unroll
            for (int pt = 0; pt < 4; ++pt) {
                f32x4 a = {0.f, 0.f, 0.f, 0.f}, b = {0.f, 0.f, 0.f, 0.f};
#pragma unroll
                for (int ks = 0; ks < 4; ++ks) {
                    a = __builtin_amdgcn_mfma_f32_16x16x32_bf16(*(const LAS bf16x8*)(Sf + (16 * pt + c) * 136 + 32 * ks + 8 * q), Cf[ks], a, 0, 0, 0);
                    b = __builtin_amdgcn_mfma_f32_16x16x32_bf16(*(const LAS bf16x8*)(Sb + (16 * pt + c) * 136 + 32 * ks + 8 * q), Cf[ks], b, 0, 0, 0);
                }
                accf[pt] = a * __expf(alf); accb[pt] = b * __expf(alb);
            }
            const int spd = w >> 1;
#pragma unroll
            for (int sp = 0; sp < 4; ++sp) {
                f32x4 Mf[2], Mb[2];
#pragma unroll
                for (int hx = 0; hx < 2; ++hx) {
                    const int st = 2 * sp + hx;
                    const f32x4 G = Gt[st];
#pragma unroll
                    for (int j = 0; j < 4; ++j) {
                        const int sx = 16 * st + 4 * q + j;
                        Mf[hx][j] = (sx <= l) ? G[j] * __expf(alf - acsf[sx]) : 0.f;
                        Mb[hx][j] = (sx >= l) ? G[j] * __expf(alb - acsb[sx]) : 0.f;
                    }
                }
                if (sp <= spd) {
                    u32x4 pw; pw.x = pk2(Mf[0][0], Mf[0][1]); pw.y = pk2(Mf[0][2], Mf[0][3]); pw.z = pk2(Mf[1][0], Mf[1][1]); pw.w = pk2(Mf[1][2], Mf[1][3]);
                    const bf16x8 pf = __builtin_bit_cast(bf16x8, pw);
#pragma unroll
                    for (int pt = 0; pt < 4; ++pt) { const LAS bf16_t* xr = Xf + (32 * sp + 4 * q + qp) * 72 + 16 * pt + 4 * pp;
                        accf[pt] = __builtin_amdgcn_mfma_f32_16x16x32_bf16(tr_pair(xr, xr + 16 * 72), pf, accf[pt], 0, 0, 0); }
                }
                if (sp >= spd) {
                    u32x4 pw; pw.x = pk2(Mb[0][0], Mb[0][1]); pw.y = pk2(Mb[0][2], Mb[0][3]); pw.z = pk2(Mb[1][0], Mb[1][1]); pw.w = pk2(Mb[1][2], Mb[1][3]);
                    const bf16x8 pf = __builtin_bit_cast(bf16x8, pw);
#pragma unroll
                    for (int pt = 0; pt < 4; ++pt) { const LAS bf16_t* xr = Xb + (32 * sp + 4 * q + qp) * 72 + 16 * pt + 4 * pp;
                        accb[pt] = __builtin_amdgcn_mfma_f32_16x16x32_bf16(tr_pair(xr, xr + 16 * 72), pf, accb[pt], 0, 0, 0); }
                }
            }
            bf16_t* yrf = (bf16_t*)(p.ws + WS_YF) + hh * 64 + (size_t)(tok0 + l) * 512 + 4 * q;
#pragma unroll
            for (int pt = 0; pt < 4; ++pt) {
                const f32x4 ys = accf[pt] + accb[pt];
                u32x2 o; o.x = pk2(ys[0], ys[1]); o.y = pk2(ys[2], ys[3]); *(u32x2*)(yrf + 16 * pt) = o;
            }
        }
    }
#undef SSD_LOADS_C
#undef SSD_UNIT_OF
}

DI void gate_phase(const Params& p, int gw, int NGW, int lane) {
    const bf16_t* yf = (const bf16_t*)(p.ws + WS_YF); const bf16_t* yb = (const bf16_t*)(p.ws + WS_YB);
    const bf16_t* xh = (const bf16_t*)(p.ws + WS_XC) + (size_t)(lane >> 5) * TILE_ELEMS + (8 * lane & 255);
    const bf16_t* zt = (const bf16_t*)(p.ws + WS_P) + (size_t)(6 + (lane >> 5)) * TILE_ELEMS + (8 * lane & 255);
    bf16_t* mix = (bf16_t*)(p.ws + WS_MIX) + 512 + 8 * lane;
    const float D = p.in[7][lane >> 3];
    float nw[8];
#pragma unroll
    for (int e = 0; e < 8; ++e) nw[e] = p.in[8][8 * lane + e];
#pragma unroll 4
    for (int t = gw; t < TT; t += NGW) {
        const u32x4 a = *(const u32x4*)(yf + (size_t)t * 512 + 8 * lane); const u32x4 b = {0u, 0u, 0u, 0u};
        const u32x4 x = *(const u32x4*)(xh + (size_t)t * 256), z = *(const u32x4*)(zt + (size_t)t * 256);
        float y[8];
        y[0] = (bflo(a.x) + bflo(b.x) + D * bflo(x.x)) * silu_f(bflo(z.x)); y[1] = (bfhi(a.x) + bfhi(b.x) + D * bfhi(x.x)) * silu_f(bfhi(z.x));
        y[2] = (bflo(a.y) + bflo(b.y) + D * bflo(x.y)) * silu_f(bflo(z.y)); y[3] = (bfhi(a.y) + bfhi(b.y) + D * bfhi(x.y)) * silu_f(bfhi(z.y));
        y[4] = (bflo(a.z) + bflo(b.z) + D * bflo(x.z)) * silu_f(bflo(z.z)); y[5] = (bfhi(a.z) + bfhi(b.z) + D * bfhi(x.z)) * silu_f(bfhi(z.z));
        y[6] = (bflo(a.w) + bflo(b.w) + D * bflo(x.w)) * silu_f(bflo(z.w)); y[7] = (bfhi(a.w) + bfhi(b.w) + D * bfhi(x.w)) * silu_f(bfhi(z.w));
        float ss = 0.f;
#pragma unroll
        for (int e = 0; e < 8; ++e) ss += y[e] * y[e];
        ss = wave_sum(ss);
        const float r = 1.0f / sqrtf(ss * (1.0f / 512.0f) + RMS_EPS);
        u32x4 o; o.x = pk2(y[0] * r * nw[0], y[1] * r * nw[1]); o.y = pk2(y[2] * r * nw[2], y[3] * r * nw[3]); o.z = pk2(y[4] * r * nw[4], y[5] * r * nw[5]); o.w = pk2(y[6] * r * nw[6], y[7] * r * nw[7]);
        *(u32x4*)(mix + (size_t)t * DM) = o;
    }
}

struct TrItem { const float* src; unsigned char* dst; };
template <class F> DI void transpose_items_f8(F item_of, int first, int count, int step, int ldw, int ldt, float scale, LAS float* scr, int lane) {
    if (first >= count) return;
    float cur[32], nxt[32];
    TrItem I = item_of(first);
#pragma unroll
    for (int i = 0; i < 32; ++i) cur[i] = I.src[(size_t)(2 * i + (lane >> 5)) * ldw + (lane & 31)];
    for (int it = first; it < count; it += step) {
        const int itn = it + step; TrItem In = I;
        if (itn < count) { In = item_of(itn);
#pragma unroll
            for (int i = 0; i < 32; ++i) nxt[i] = In.src[(size_t)(2 * i + (lane >> 5)) * ldw + (lane & 31)]; }
#pragma unroll
        for (int i = 0; i < 32; ++i) scr[(2 * i + (lane >> 5)) * 33 + (lane & 31)] = cur[i] * scale;
        LDS_WAIT();
        const int c = lane & 7;
#pragma unroll
        for (int j = 0; j < 4; ++j) { const int n = (lane >> 3) + 8 * j; const LAS float* sp = scr + (8 * c) * 33 + n;
            u32x2 o; o.x = pk4_f8(sp[0 * 33], sp[1 * 33], sp[2 * 33], sp[3 * 33]); o.y = pk4_f8(sp[4 * 33], sp[5 * 33], sp[6 * 33], sp[7 * 33]);
            *(u32x2*)(I.dst + (size_t)n * ldt + 8 * c) = o; }
        LDS_WAIT();
#pragma unroll
        for (int i = 0; i < 32; ++i) cur[i] = nxt[i];
        I = In;
    }
}
DI void expert_gu_weights_phase(const Params& p, LAS unsigned char* lds, int gw, int NGW, int wave, int lane) {
    LAS float* scr = (LAS float*)(lds + wave * 16384);
    const float* Wg = p.in[13]; const float* Wu = p.in[14]; unsigned char* WT = p.ws + WS_WGU;
    auto item_of = [=](int it) {
        const int e = it / 2816, r = it % 2816;
        const int isup = r >= 1408, rr = isup ? r - 1408 : r, kb = rr / 88, nb = rr % 88, n0 = 32 * nb, k0 = 64 * kb;
        TrItem I; I.src = (isup ? Wu : Wg) + (size_t)e * DM * FF + (size_t)k0 * FF + n0;
        I.dst = WT + (size_t)(e * 5632 + 256 * (n0 >> 7) + (n0 & 127) + (isup ? 128 : 0)) * DM + k0;
        return I; };
    transpose_items_f8(item_of, gw, 16 * 2816, NGW, FF, DM, WGU_SCALE, scr, lane);
}
DI void expert_down_weights(const Params& p, LAS unsigned char* lds, int vw, int NVW, int wave, int lane) {
    LAS float* scr = (LAS float*)(lds + 4096 + wave * 16384);
    const float* Wdn = p.in[15]; unsigned char* WT = p.ws + WS_WD;
    auto item_of = [=](int it) {
        const int e = it / 1408, rr = it % 1408, kb = rr / 32, nb = rr % 32;
        TrItem I; I.src = Wdn + (size_t)e * FF * DM + (size_t)(64 * kb) * DM + 32 * nb;
        I.dst = WT + (size_t)(e * 1024 + 32 * nb) * FF + 64 * kb;
        return I; };
    transpose_items_f8(item_of, vw, 16 * 1408, NVW, DM, FF, WD_SCALE, scr, lane);
}

DI void ln1_router_phase(const Params& p, LAS unsigned char* lds, int gw, int NGW, int wave, int lane) {
    const int tid = TIDX(wave);
    LAS float* wT = (LAS float*)lds;
    for (int id = tid; id < 16384; id += NTHR) { const int k = id >> 4, e = id & 15; wT[e * 1024 + k] = p.in[12][id]; }
    __syncthreads();
    f32x4 gg[4], bb[4];
#pragma unroll
    for (int j = 0; j < 4; ++j) { gg[j] = ((const f32x4*)p.in[10])[64 * j + lane]; bb[j] = ((const f32x4*)p.in[11])[64 * j + lane]; }
    unsigned char* x1b = p.ws + WS_X1B; float* aff = (float*)(p.ws + WS_AFF);
    const int ec = ecol(lane);
#pragma unroll 2
    for (int t = gw; t < TT; t += 2 * NGW) {
        const int t2 = (t + NGW < TT) ? t + NGW : t;
        const u32x2* hra = (const u32x2*)((const bf16_t*)(p.ws + WS_H) + (size_t)t * DM) + lane; const u32x2* hrb = (const u32x2*)((const bf16_t*)(p.ws + WS_H) + (size_t)t2 * DM) + lane;
        f32x4 va[4], vb[4]; float sa = 0.f, sb = 0.f;
#pragma unroll
        for (int j = 0; j < 4; ++j) { const u32x2 wa = hra[64 * j], wb = hrb[64 * j]; va[j] = (f32x4){bflo(wa.x), bfhi(wa.x), bflo(wa.y), bfhi(wa.y)}; vb[j] = (f32x4){bflo(wb.x), bfhi(wb.x), bflo(wb.y), bfhi(wb.y)}; sa += (va[j][0] + va[j][1]) + (va[j][2] + va[j][3]); sb += (vb[j][0] + vb[j][1]) + (vb[j][2] + vb[j][3]); }
        const float meana = wave_sum(sa) * (1.0f / DM), meanb = wave_sum(sb) * (1.0f / DM); float qa = 0.f, qb = 0.f;
#pragma unroll
        for (int j = 0; j < 4; ++j) { va[j] = va[j] - meana; vb[j] = vb[j] - meanb;
            qa += (va[j][0] * va[j][0] + va[j][1] * va[j][1]) + (va[j][2] * va[j][2] + va[j][3] * va[j][3]); qb += (vb[j][0] * vb[j][0] + vb[j][1] * vb[j][1]) + (vb[j][2] * vb[j][2] + vb[j][3] * vb[j][3]); }
        const float rstda = 1.0f / sqrtf(wave_sum(qa) * (1.0f / DM) + LN_EPS), rstdb = 1.0f / sqrtf(wave_sum(qb) * (1.0f / DM) + LN_EPS);
        unsigned* o4a = (unsigned*)(x1b + (size_t)t * DM) + lane; unsigned* o4b = (unsigned*)(x1b + (size_t)t2 * DM) + lane;
        u32x2* oha = (u32x2*)((bf16_t*)(p.ws + WS_X1H) + (size_t)t * DM) + lane; u32x2* ohb = (u32x2*)((bf16_t*)(p.ws + WS_X1H) + (size_t)t2 * DM) + lane;
#pragma unroll
        for (int j = 0; j < 4; ++j) {
            va[j] = va[j] * rstda * gg[j] + bb[j]; vb[j] = vb[j] * rstdb * gg[j] + bb[j];
            { u32x2 wv; wv.x = pk2(va[j][0], va[j][1]); wv.y = pk2(va[j][2], va[j][3]); oha[64 * j] = wv; wv.x = pk2(vb[j][0], vb[j][1]); wv.y = pk2(vb[j][2], vb[j][3]); ohb[64 * j] = wv; }
            o4a[64 * j] = pk4_f8(va[j][0], va[j][1], va[j][2], va[j][3]); o4b[64 * j] = pk4_f8(vb[j][0], vb[j][1], vb[j][2], vb[j][3]);
        }
        float ra, rb; dot16x2(va, vb, wT, lane, ra, rb);
        float ma = ra, mb = rb;
#pragma unroll
        for (int o = 1; o < 16; o <<= 1) { ma = fmaxf(ma, __shfl_xor(ma, o)); mb = fmaxf(mb, __shfl_xor(mb, o)); }
        const float ea = __expf(ra - ma), eb = __expf(rb - mb); float da = ea, db = eb;
#pragma unroll
        for (int o = 1; o < 16; o <<= 1) { da += __shfl_xor(da, o); db += __shfl_xor(db, o); }
        if (lane < 16) { aff[(size_t)ec * TT + t] = ea / da; aff[(size_t)ec * TT + t2] = eb / db; }
    }
}

DI void select_phase(const Params& p, LAS unsigned char* lds, int wave, int lane) {
    const int wk = blockIdx.x;
    if (wk >= 32) { expert_down_weights(p, lds, (wk - 32) * 8 + wave, ((int)gridDim.x - 32) * 8, wave, lane); return; }
    const int tid = TIDX(wave);
    const int trunk = wk >> 4, e = wk & 15;
    const int Tn = trunk ? 16384 : 32768, tbase = trunk ? TP : 0, cap = Tn / 8;
    const unsigned* col = (const unsigned*)(p.ws + WS_AFF) + (size_t)e * TT + tbase;
    LAS unsigned* hist = (LAS unsigned*)lds;
    LAS unsigned* ctl = (LAS unsigned*)(lds + 1024);
    LAS unsigned* wcnt = (LAS unsigned*)(lds + 2048);
    const int nblk = Tn / (4 * NTHR);
    u32x4 cv[16];
#pragma unroll
    for (int k = 0; k < 16; ++k) cv[k] = (k < nblk) ? *(const u32x4*)(col + 4 * NTHR * k + 4 * tid) : (u32x4){0u, 0u, 0u, 0u};
    unsigned prefix = 0, remaining = (unsigned)cap;
    for (int pass = 0; pass < 4; ++pass) {
        const int shift = 24 - 8 * pass;
        for (int i = tid; i < 256; i += NTHR) hist[i] = 0u;
        __syncthreads();
#pragma unroll
        for (int k = 0; k < 16; ++k) if (k < nblk) {
            const unsigned bb4[4] = {cv[k].x, cv[k].y, cv[k].z, cv[k].w};
#pragma unroll
            for (int j = 0; j < 4; ++j) if (pass == 0 || (bb4[j] >> (shift + 8)) == prefix) atomicAdd((unsigned*)(hist + ((bb4[j] >> shift) & 255u)), 1u);
        }
        __syncthreads();
        if (wave == 0) {
            const unsigned h0 = hist[4 * lane], h1 = hist[4 * lane + 1], h2 = hist[4 * lane + 2], h3 = hist[4 * lane + 3], tot = h0 + h1 + h2 + h3;
            unsigned v = tot;
#pragma unroll
            for (int o = 1; o < 64; o <<= 1) { const unsigned t = __shfl_down(v, o); if (lane + o < 64) v += t; }
            const unsigned excl = v - tot;
            if (excl < remaining && remaining <= excl + tot) {
                unsigned cum = excl; int b;
                if (cum + h3 >= remaining) b = 3; else { cum += h3; if (cum + h2 >= remaining) b = 2; else { cum += h2; if (cum + h1 >= remaining) b = 1; else { cum += h1; b = 0; } } }
                ctl[0] = (prefix << 8) | (unsigned)(4 * lane + b); ctl[1] = remaining - cum;
            }
        }
        __syncthreads();
        prefix = ctl[0]; remaining = ctl[1];
        __syncthreads();
    }
    const unsigned thr = prefix, need_eq = remaining;
    int* idx = (int*)(p.ws + WS_IDX) + e * SLOTS_E + (trunk ? 4096 : 0);
    int* inv = (int*)(p.ws + WS_INV) + (size_t)e * TT + tbase;
    const int slot0 = e * SLOTS_E + (trunk ? 4096 : 0);
    float* gate = (float*)(p.ws + WS_GATE) + e * SLOTS_E + (trunk ? 4096 : 0);
    unsigned base_gt = 0, base_eq = 0;
#pragma unroll
    for (int k = 0; k < 16; ++k) if (k < nblk) {
        const int b0 = 4 * NTHR * k;
        const unsigned bits[4] = {cv[k].x, cv[k].y, cv[k].z, cv[k].w};
        unsigned packed = 0;
#pragma unroll
        for (int j = 0; j < 4; ++j) packed += (bits[j] > thr ? 1u : 0u) + (bits[j] == thr ? 0x10000u : 0u);
        unsigned v = packed;
#pragma unroll
        for (int o = 1; o < 64; o <<= 1) { const unsigned t = __shfl_up(v, o); if (lane >= o) v += t; }
        if (lane == 63) wcnt[(k & 1) * 8 + wave] = v;
        __syncthreads();
        unsigned off = 0, tot = 0;
#pragma unroll
        for (int w2 = 0; w2 < 8; ++w2) { const unsigned cnt = wcnt[(k & 1) * 8 + w2]; off += (w2 < wave) ? cnt : 0u; tot += cnt; }
        const unsigned ex = off + (v - packed);
        unsigned gt_before = base_gt + (ex & 0xffffu), eq_before = base_eq + (ex >> 16);
        int invv[4];
#pragma unroll
        for (int j = 0; j < 4; ++j) {
            const bool gt = bits[j] > thr, eq = bits[j] == thr;
            const bool sel = gt || (eq && eq_before < need_eq);
            const unsigned pos = gt_before + (eq_before < need_eq ? eq_before : need_eq);
            const bool ok = sel && pos < (unsigned)cap;
            if (ok) { idx[pos] = tbase + b0 + 4 * tid + j; gate[pos] = __uint_as_float(bits[j]); }
            invv[j] = ok ? slot0 + (int)pos : -1;
            gt_before += gt ? 1u : 0u; eq_before += eq ? 1u : 0u;
        }
        *(i32x4*)(inv + b0 + 4 * tid) = (i32x4){invv[0], invv[1], invv[2], invv[3]};
        base_gt += tot & 0xffffu; base_eq += tot >> 16;
    }
}

DI void ln2_phase(const Params& p, int gw, int NGW, int lane) {
    f32x4 gg[4], bb[4];
#pragma unroll
    for (int j = 0; j < 4; ++j) { gg[j] = ((const f32x4*)p.in[16])[64 * j + lane]; bb[j] = ((const f32x4*)p.in[17])[64 * j + lane]; }
    const int* inv = (const int*)(p.ws + WS_INV); const unsigned char* eo = p.ws + WS_EO;
    const bf16_t* x1h = (const bf16_t*)(p.ws + WS_X1H);
    u32x2 nv[4]; int nslot;
    { const int t0 = gw < TT ? gw : 0; const u32x2* r0 = (const u32x2*)(x1h + (size_t)t0 * DM) + lane;
#pragma unroll
      for (int j = 0; j < 4; ++j) nv[j] = r0[64 * j];
      nslot = lane < 16 ? inv[(size_t)lane * TT + t0] : -1; }
    for (int t = gw; t < TT; t += NGW) {
        f32x4* orow = (f32x4*)(p.out + (size_t)t * DM) + lane;
        f32x4 v[4]; float s = 0.f;
#pragma unroll
        for (int j = 0; j < 4; ++j) v[j] = (f32x4){bflo(nv[j].x), bfhi(nv[j].x), bflo(nv[j].y), bfhi(nv[j].y)} * ALPHA;
        const int myslot = nslot;
        { const int tn = t + NGW; if (tn < TT) { const u32x2* rn = (const u32x2*)(x1h + (size_t)tn * DM) + lane;
#pragma unroll
            for (int j = 0; j < 4; ++j) nv[j] = rn[64 * j];
            nslot = lane < 16 ? inv[(size_t)lane * TT + tn] : -1; } }
        for (int e = 0; e < 16; ++e) {
            const int sl = __shfl(myslot, e);
            if (sl >= 0) {
                const unsigned* er = (const unsigned*)(eo + (size_t)sl * DM) + lane;
#pragma unroll
                for (int j = 0; j < 4; ++j) { const int w = (int)er[64 * j];
                    v[j][0] += __builtin_amdgcn_cvt_f32_fp8(w, 0) * (1.0f / EO_SCALE); v[j][1] += __builtin_amdgcn_cvt_f32_fp8(w, 1) * (1.0f / EO_SCALE);
                    v[j][2] += __builtin_amdgcn_cvt_f32_fp8(w, 2) * (1.0f / EO_SCALE); v[j][3] += __builtin_amdgcn_cvt_f32_fp8(w, 3) * (1.0f / EO_SCALE); }
            }
        }
#pragma unroll
        for (int j = 0; j < 4; ++j) s += (v[j][0] + v[j][1]) + (v[j][2] + v[j][3]);
        const float mean = wave_sum(s) * (1.0f / DM); float s2 = 0.f;
#pragma unroll
        for (int j = 0; j < 4; ++j) { v[j] = v[j] - mean; s2 += (v[j][0] * v[j][0] + v[j][1] * v[j][1]) + (v[j][2] * v[j][2] + v[j][3] * v[j][3]); }
        const float rstd = 1.0f / sqrtf(wave_sum(s2) * (1.0f / DM) + LN_EPS);
#pragma unroll
        for (int j = 0; j < 4; ++j) orow[64 * j] = v[j] * rstd * gg[j] + bb[j];
    }
}

constexpr size_t WS_CTL = 19 * MiB;
#define XB_TMO      128
#define XB_XCNT(j)  (256  + 64 * (j))
#define XB_XSUB(j)  (1280 + 64 * (j))
#define XB_XGEN(j)  (2304 + 64 * (j))
#define XB_TOP      3328
#define XB_TOPGEN   3392
#define XCD_BAR_WORDS 3456
#define XB_SPIN_CAP (1u << 18)
DI unsigned xb_ld(unsigned* p)              { return __hip_atomic_load(p, __ATOMIC_RELAXED, __HIP_MEMORY_SCOPE_AGENT); }
DI unsigned xb_add(unsigned* p, unsigned v) { return __hip_atomic_fetch_add(p, v, __ATOMIC_RELAXED, __HIP_MEMORY_SCOPE_AGENT); }
DI unsigned xb_xcc_id() { return (unsigned)__builtin_amdgcn_s_getreg((3 << 11) | 20) & 0xFu; }
#define XB_SPIN(cond, bar) do { unsigned _sp = 0; while (cond) { __builtin_amdgcn_s_sleep(1); \
    if ((++_sp & 255u) == 0u) { if (xb_ld(&(bar)[XB_TMO])) break; if (_sp > XB_SPIN_CAP) { atomicAdd(&(bar)[XB_TMO], 1u); break; } } } } while (0)
struct XcdBarrier { unsigned* bar; unsigned x; volatile LAS unsigned* st; };
DI void xcd_barrier_complete(unsigned* bar, unsigned x, unsigned& nloc, unsigned& nx) {
    const unsigned G = gridDim.x * gridDim.y * gridDim.z;
    unsigned sum, cnt, mine, sp = 0u;
    for (;;) {
        sum = 0u; cnt = 0u; mine = 0u;
#pragma unroll
        for (unsigned j = 0; j < 16; ++j) { const unsigned c = xb_ld(&bar[XB_XCNT(j)]); sum += c; cnt += (c > 0u) ? 1u : 0u; mine = (j == x) ? c : mine; }
        if (sum == G) break;
        __builtin_amdgcn_s_sleep(1);
        if ((++sp & 255u) == 0u) { if (xb_ld(&bar[XB_TMO])) break; if (sp > XB_SPIN_CAP) { atomicAdd(&bar[XB_TMO], 1u); break; } }
    }
    nloc = mine > 0u ? mine : 1u; nx = cnt > 0u ? cnt : 1u;
}
DI void xcd_barrier(const XcdBarrier& b, int wave) {
    asm volatile("s_waitcnt vmcnt(0)" ::: "memory");
    __syncthreads();
    if (wave == 0 && lane_id() == 0) {
        unsigned* bar = b.bar;
        __builtin_amdgcn_s_waitcnt(0);
        unsigned nloc = b.st[0], nx = b.st[1];
        if (nloc == 0u) { xcd_barrier_complete(bar, b.x, nloc, nx); b.st[0] = nloc; b.st[1] = nx; }
        const unsigned old = xb_add(&bar[XB_XSUB(b.x)], 1u);
        const unsigned gen = old / nloc;
        if (old + 1u == (gen + 1u) * nloc) {
            __builtin_amdgcn_fence(__ATOMIC_RELEASE, "agent");
            asm volatile("s_waitcnt vmcnt(0)" ::: "memory");
            const unsigned og = xb_add(&bar[XB_TOP], 1u);
            const unsigned tg = og / nx;
            if (og + 1u == (tg + 1u) * nx) xb_add(&bar[XB_TOPGEN], 1u);
            else XB_SPIN(xb_ld(&bar[XB_TOPGEN]) == tg, bar);
            __builtin_amdgcn_fence(__ATOMIC_ACQUIRE, "agent");
            xb_add(&bar[XB_XGEN(b.x)], 1u);
            asm volatile("s_waitcnt vmcnt(0)" ::: "memory");
        } else {
            XB_SPIN(xb_ld(&bar[XB_XGEN(b.x)]) == gen, bar);
            __builtin_amdgcn_fence(__ATOMIC_ACQUIRE, "agent");
            asm volatile("s_waitcnt vmcnt(0)" ::: "memory");
        }
    }
    __syncthreads();
}

__global__ void __launch_bounds__(NTHR, 2) fwd_megakernel(Params p) {
    extern __shared__ __attribute__((aligned(16))) unsigned char lds_raw[];
    LAS unsigned char* lds = (LAS unsigned char*)lds_raw;
    cg::grid_group grid = cg::this_grid();
    const int wave_k = __builtin_amdgcn_readfirstlane((int)threadIdx.x >> 6);
    XcdBarrier xb; xb.bar = (unsigned*)(p.ws + WS_CTL); xb.x = xb_xcc_id(); xb.st = (volatile LAS unsigned*)(lds + LDS_BYTES - 64);
    if (wave_k == 0 && lane_id() == 0) { xb.st[0] = 0u; xb.st[1] = 0u; (void)xb_add(&xb.bar[XB_XCNT(xb.x)], 1u); }
    __syncthreads();
#define GSYNC() xcd_barrier(xb, wave_k)
#define IDS() const int lane = lane_id(), wave = wave_k; \
    const int G = gridDim.x, gw = blockIdx.x * 8 + wave, NGW = G * 8; (void)lane; (void)gw; (void)NGW; (void)G;
    { IDS(); phase0(p, lds, gw, NGW, wave, lane); }
    if (p.ws == nullptr) grid.sync();
    GSYNC();
    {
        IDS();
        pg8::SchedPlain S; S.init(TT, 3072, G, (int)blockIdx.x);
        pg8::EpiProj E{(bf16_t*)(p.ws + WS_P), (const float*)(p.ws + WS_ROPE)};
        pg8::gemm_phase<pg8::EpiProj, pg8::SchedPlain>(lds, (const bf16_t*)(p.ws + WS_XB), (const bf16_t*)(p.ws + WS_WI), DM, S, E, wave);
    }
    GSYNC();
    conv_phase(p, wave_k);
    { IDS(); const int vcu = (G % 8 == 0) ? ((int)blockIdx.x % 8) * (G / 8) + (int)blockIdx.x / 8 : (int)blockIdx.x;
      attn_phase(p, lds, vcu * 8 + wave, NGW, wave, lane); }
    GSYNC();
    { IDS(); ssd_state_phase(p, lds, wave, lane); }
    GSYNC();
    ssd_scan_phase(p, wave_k);
    GSYNC();
    { IDS(); ssd_out_phase(p, lds, wave, lane); }
    GSYNC();
    { IDS(); gate_phase(p, gw, NGW, lane); }
    GSYNC();
    { IDS(); expert_gu_weights_phase(p, lds, gw, NGW, wave, lane); }
    __syncthreads();
    {
        IDS();
        pg8::SchedPlain S; S.init(TT, DM, G, (int)blockIdx.x);
        pg8::EpiOut E{p};
        pg8::gemm_phase<pg8::EpiOut, pg8::SchedPlain>(lds, (const bf16_t*)(p.ws + WS_MIX), (const bf16_t*)(p.ws + WS_WO), DM, S, E, wave);
    }
    GSYNC();
    { IDS(); ln1_router_phase(p, lds, gw, NGW, wave, lane); }
    GSYNC();
    { IDS(); select_phase(p, lds, wave, lane); }
    GSYNC();
    {
        IDS();
        const int* idx = (const int*)(p.ws + WS_IDX);
        pg8::SchedGrouped<22, true> S{G, (int)blockIdx.x, idx};
        pg8::EpiGU E{p.ws + WS_HID};
        pg8::gemm_phase<pg8::EpiGU, pg8::SchedGrouped<22, true>, true>(lds, (const bf16_t*)(p.ws + WS_X1B), (const bf16_t*)(p.ws + WS_WGU), DM / 2, S, E, wave);
    }
    GSYNC();
    {
        IDS();
        const int* idx = (const int*)(p.ws + WS_IDX);
        const float* gate = (const float*)(p.ws + WS_GATE);
        pg8::SchedGrouped<4, false> S{G, (int)blockIdx.x, idx};
        pg8::EpiDown E{p.ws + WS_EO, gate};
        pg8::gemm_phase<pg8::EpiDown, pg8::SchedGrouped<4, false>, true>(lds, (const bf16_t*)(p.ws + WS_HID), (const bf16_t*)(p.ws + WS_WD), FF / 2, S, E, wave);
    }
    GSYNC();
    { IDS(); ln2_phase(p, gw, NGW, lane); }
#undef IDS
}

extern "C" void kernel_launch(void* const* d_in, const int* in_sizes, int n_in, void* d_out, int out_size, void* d_ws, size_t ws_size, hipStream_t stream) {
    static int grid_blocks = 0;
    if (grid_blocks == 0) {
        if (n_in != 18 || ws_size < WS_END || out_size != TT * DM) { fprintf(stderr, "kernel_launch: unexpected shapes (n_in %d out %d ws %zu)\n", n_in, out_size, ws_size); grid_blocks = -1; return; }
        int dev = 0, cus = 0, per_cu = 0;
        hipGetDevice(&dev);
        hipDeviceGetAttribute(&cus, hipDeviceAttributeMultiprocessorCount, dev);
        if (hipFuncSetAttribute((const void*)fwd_megakernel, hipFuncAttributeMaxDynamicSharedMemorySize, LDS_BYTES) != hipSuccess) { fprintf(stderr, "kernel_launch: hipFuncSetAttribute failed\n"); }
        hipOccupancyMaxActiveBlocksPerMultiprocessor(&per_cu, (const void*)fwd_megakernel, NTHR, LDS_BYTES);
        if (per_cu < 1) per_cu = 1;
        (void)hipGetLastError();
        grid_blocks = cus * per_cu;
    }
    if (grid_blocks < 0) return;
    Params p{};
    for (int i = 0; i < 18; ++i) p.in[i] = (const float*)d_in[i];
    p.out = (float*)d_out; p.ws = (unsigned char*)d_ws;
    if (hipMemsetAsync((char*)d_ws + WS_CTL, 0, 16384, stream) != hipSuccess) { fprintf(stderr, "kernel_launch: hipMemsetAsync failed\n"); return; }
    void* args[] = {&p};
    hipError_t e = hipLaunchCooperativeKernel((void*)fwd_megakernel, dim3(grid_blocks), dim3(NTHR), args, LDS_BYTES, stream);
    if (e != hipSuccess) fprintf(stderr, "cooperative launch failed: %s (grid %d)\n", hipGetErrorString(e), grid_blocks);
}
```
